# Optimizing an MI355X kernel written in HIP

```python
import math
import jax, jax.numpy as jnp
from jax import lax
import numpy as np

D_MODEL = 1024
BATCH = 16
SEQ = 2048
DEPTH = 1

A_HEADS = 8
A_HEAD_DIM = 64
A_KV_GROUPS = 2
A_HEADS_PER_GROUP = A_HEADS // A_KV_GROUPS
A_WIDTH = A_HEADS * A_HEAD_DIM
A_KV_WIDTH = A_KV_GROUPS * A_HEAD_DIM
CMP_BLOCK = 32
CMP_STRIDE = 16
CMP_HIDDEN = 256
SLC_BLOCK = 64
SLC_TOPN = 16
WINDOW = 512
NSA_Q_BLOCK = 32
B_HEADS = 8
B_HEAD_DIM = 64
B_WIDTH = B_HEADS * B_HEAD_DIM
DECAY_LORA = 64
ICLR_LORA = 64
LNX_EPS = 64e-5
REL_BUCKETS = 32
REL_MAX_EXACT = 16
REL_MAX_DIST = 128
NORM_EPS = 1e-6
NEG_INF = -1e30
FORCE_SCORE = 1e30
NSA_IN = 2 * A_WIDTH + 6 * A_KV_WIDTH + 3 * A_HEADS
SHIFT_WIDTH = 3 * B_WIDTH + DECAY_LORA + ICLR_LORA
REST_IN = B_WIDTH + 2 * D_MODEL
IN_WIDTH = NSA_IN + SHIFT_WIDTH + REST_IN

kernel_name = 'hybrid_nsa_rwkv7_block'


def split_last(t, sizes):
    outs, off = [], 0
    for s in sizes:
        outs.append(t[..., off:off + s])
        off += s
    return outs


def rms_norm(x, gain):
    xf = x.astype(jnp.float32)
    y = xf * lax.rsqrt(jnp.mean(xf * xf, axis=-1, keepdims=True) + NORM_EPS)
    return (y * gain.astype(jnp.float32)).astype(x.dtype)


def masked_softmax(logits, mask):
    logits = jnp.where(mask, logits.astype(jnp.float32), NEG_INF)
    return jnp.where(mask, jax.nn.softmax(logits, axis=-1), 0.0)


def t5_bucket(dist):
    n = jnp.maximum(dist, 0)
    nf = jnp.maximum(n, REL_MAX_EXACT).astype(jnp.float32)
    large = REL_MAX_EXACT + (jnp.log(nf / REL_MAX_EXACT) / math.log(REL_MAX_DIST / REL_MAX_EXACT)
                             * (REL_BUCKETS - REL_MAX_EXACT)).astype(jnp.int32)
    return jnp.where(n < REL_MAX_EXACT, n, jnp.minimum(large, REL_BUCKETS - 1))


def shared_rel_bias(rel_bias, dist):
    nq, nk = dist.shape
    bias = rel_bias[t5_bucket(dist)].astype(jnp.float32)
    return bias.transpose(2, 0, 1).reshape(A_KV_GROUPS, A_HEADS_PER_GROUP, nq, nk)


def token_shift(p, mu):
    prev = jnp.pad(p, ((0, 0), (1, 0), (0, 0)))[:, :-1]
    return p + (prev - p) * mu


def compress_blocks(kv, pos_emb, w1, w2):
    b, s, g, dh = kv.shape
    n_cmp = (s - CMP_BLOCK) // CMP_STRIDE + 1
    idx = jnp.arange(n_cmp)[:, None] * CMP_STRIDE + jnp.arange(CMP_BLOCK)[None, :]
    blocks = kv[:, idx] + pos_emb[:, None, :]
    flat = blocks.transpose(0, 3, 1, 2, 4).reshape(b, g, n_cmp, CMP_BLOCK * dh)
    return jax.nn.gelu(flat @ w1) @ w2


def nsa_mixer(q, k_cmp, v_cmp, k_slc, v_slc, k_win, v_win, gate_logits, rel_bias,
              q_norm_gain, k_norm_gain, cmp_pos_k, cmp_pos_v, cmp_k_w1, cmp_k_w2, cmp_v_w1, cmp_v_w2):
    b, s, _ = q.shape
    g, hpg, dh = A_KV_GROUPS, A_HEADS_PER_GROUP, A_HEAD_DIM
    scale = dh ** -0.5
    heads_kv = lambda t: t.reshape(b, s, g, dh)
    qh = rms_norm(q.reshape(b, s, g, hpg, dh), q_norm_gain).transpose(0, 2, 3, 1, 4)
    kc = rms_norm(compress_blocks(heads_kv(k_cmp), cmp_pos_k, cmp_k_w1, cmp_k_w2), k_norm_gain[0])
    vc = compress_blocks(heads_kv(v_cmp), cmp_pos_v, cmp_v_w1, cmp_v_w2)
    n_cmp = kc.shape[2]
    cmp_end = jnp.arange(n_cmp) * CMP_STRIDE + CMP_BLOCK - 1
    n_slc = s // SLC_BLOCK
    top_n = min(SLC_TOPN, n_slc)
    ks = rms_norm(heads_kv(k_slc), k_norm_gain[1]).transpose(0, 2, 1, 3).reshape(b, g, n_slc, SLC_BLOCK, dh)
    vs = heads_kv(v_slc).transpose(0, 2, 1, 3).reshape(b, g, n_slc, SLC_BLOCK, dh)
    r1, r2 = SLC_BLOCK // CMP_STRIDE, CMP_BLOCK // CMP_STRIDE
    imp_idx = (r1 * jnp.arange(n_slc)[:, None, None] + jnp.arange(r1)[None, :, None]
               - jnp.arange(r2)[None, None, :]).reshape(n_slc, r1 * r2)
    imp_valid = (imp_idx >= 0) & (imp_idx < n_cmp)
    imp_idx = jnp.clip(imp_idx, 0, n_cmp - 1)
    blk = jnp.arange(n_slc)
    pad = ((0, 0), (0, 0), (WINDOW, 0), (0, 0))
    kw = jnp.pad(rms_norm(heads_kv(k_win), k_norm_gain[2]).transpose(0, 2, 1, 3), pad)
    vw = jnp.pad(heads_kv(v_win).transpose(0, 2, 1, 3), pad)
    gates = jax.nn.sigmoid(gate_logits.astype(jnp.float32)).reshape(b, s, 3, g, hpg).transpose(2, 0, 3, 4, 1)
    tbl = rel_bias.reshape(REL_BUCKETS, g, hpg).astype(jnp.float32)
    b_ix = jnp.arange(b)[:, None, None, None]
    g_ix = jnp.arange(g)[None, :, None, None]

    def query_block(i):
        q0 = i * NSA_Q_BLOCK
        t = q0 + jnp.arange(NSA_Q_BLOCK)
        qb = lax.dynamic_slice_in_dim(qh, q0, NSA_Q_BLOCK, axis=3)
        gb = lax.dynamic_slice_in_dim(gates, q0, NSA_Q_BLOCK, axis=4)[..., None].astype(q.dtype)
        dist_c = t[:, None] - cmp_end[None, :]
        s_c = jnp.einsum('bghqd,bgnd->bghqn', qb, kc).astype(jnp.float32) * scale + shared_rel_bias(rel_bias, dist_c)
        p_c = masked_softmax(s_c, dist_c >= 0)
        o_c = jnp.einsum('bghqn,bgnd->bghqd', p_c.astype(vc.dtype), vc)
        p_grp = p_c.sum(axis=2)
        imp = jnp.sum(jnp.where(imp_valid, p_grp[..., imp_idx], 0.0), axis=-1)
        cur = t[:, None] // SLC_BLOCK
        forced = (blk[None, :] == 0) | (blk[None, :] == cur) | (blk[None, :] == cur - 1)
        causal = blk[None, :] * SLC_BLOCK <= t[:, None]
        imp = jnp.where(forced, FORCE_SCORE, jnp.where(causal, imp, NEG_INF))
        _, sel = lax.top_k(imp, top_n)
        k_sel = ks[b_ix, g_ix, sel].reshape(b, g, NSA_Q_BLOCK, top_n * SLC_BLOCK, dh)
        v_sel = vs[b_ix, g_ix, sel].reshape(b, g, NSA_Q_BLOCK, top_n * SLC_BLOCK, dh)
        key_pos = (sel[..., None] * SLC_BLOCK + jnp.arange(SLC_BLOCK)).reshape(b, g, NSA_Q_BLOCK, top_n * SLC_BLOCK)
        dist_s = t[:, None] - key_pos
        bias_s = tbl[t5_bucket(dist_s)[:, :, None], jnp.arange(g)[:, None, None, None], jnp.arange(hpg)[:, None, None]]
        s_s = jnp.einsum('bghqd,bgqkd->bghqk', qb, k_sel).astype(jnp.float32) * scale + bias_s
        p_s = masked_softmax(s_s, (dist_s >= 0)[:, :, None])
        o_s = jnp.einsum('bghqk,bgqkd->bghqd', p_s.astype(v_sel.dtype), v_sel)
        kwb = lax.dynamic_slice_in_dim(kw, q0, WINDOW + NSA_Q_BLOCK, axis=2)
        vwb = lax.dynamic_slice_in_dim(vw, q0, WINDOW + NSA_Q_BLOCK, axis=2)
        kpos = q0 - WINDOW + jnp.arange(WINDOW + NSA_Q_BLOCK)
        dist_w = t[:, None] - kpos[None, :]
        mask_w = (dist_w >= 0) & (dist_w < WINDOW) & (kpos[None, :] >= 0)
        s_w = jnp.einsum('bghqd,bgkd->bghqk', qb, kwb).astype(jnp.float32) * scale + shared_rel_bias(rel_bias, dist_w)
        p_w = masked_softmax(s_w, mask_w)
        o_w = jnp.einsum('bghqk,bgkd->bghqd', p_w.astype(vwb.dtype), vwb)
        return gb[0] * o_c + gb[1] * o_s + gb[2] * o_w

    out = lax.map(query_block, jnp.arange(s // NSA_Q_BLOCK))
    return out.transpose(1, 0, 4, 2, 3, 5).reshape(b, s, A_WIDTH)


def rwkv7_mixer(r, k, v, wd, ad, w0, w_lora_up, a0, a_lora_up, k_k, k_a, r_k, ln_x_w, ln_x_b):
    b, s, _ = r.shape
    h, n = B_HEADS, B_HEAD_DIM
    f32 = jnp.float32
    heads = lambda t: t.astype(f32).reshape(b, s, h, n)
    tm = lambda t: t.transpose(1, 0, 2, 3)
    log_w = -jax.nn.softplus(-(w0 + jnp.tanh(wd) @ w_lora_up).astype(f32)) - 0.5
    decay = jnp.exp(-jnp.exp(log_w))
    a = jax.nn.sigmoid((a0 + ad @ a_lora_up).astype(f32))
    kk = heads(k * k_k)
    kk = kk * lax.rsqrt(jnp.maximum(jnp.sum(kk * kk, axis=-1, keepdims=True), 1e-24))
    k_mod = heads(k.astype(f32) * (1.0 + (a - 1.0) * k_a.astype(f32)))
    rh, vh, ah = heads(r), heads(v), heads(a)

    def step(state, inp):
        r_t, w_t, k_t, v_t, a_t, b_t = inp
        sa = jnp.einsum('bhvk,bhk->bhv', state, a_t)
        state = state * w_t[:, :, None, :] + sa[..., None] * b_t[:, :, None, :] + v_t[..., None] * k_t[:, :, None, :]
        return state, jnp.einsum('bhvk,bhk->bhv', state, r_t)

    state0 = jnp.zeros((b, h, n, n), f32)
    _, y = lax.scan(step, state0, (tm(rh), tm(heads(decay)), tm(k_mod), tm(vh), tm(-kk), tm(kk * ah)))
    y = tm(y)
    mean = jnp.mean(y, axis=-1, keepdims=True)
    var = jnp.mean(jnp.square(y - mean), axis=-1, keepdims=True)
    y = ((y - mean) * lax.rsqrt(var + LNX_EPS)).reshape(b, s, B_WIDTH) * ln_x_w + ln_x_b
    bonus = jnp.sum(rh * k_mod * r_k.astype(f32), axis=-1, keepdims=True) * vh
    return (y + bonus.reshape(b, s, B_WIDTH)).astype(r.dtype)


def hybrid_layer(x, c, rel_bias, w_ada, b_ada, norm_gain, w_in, q_norm_gain, k_norm_gain,
                 cmp_pos_k, cmp_pos_v, cmp_k_w1, cmp_k_w2, cmp_v_w1, cmp_v_w2,
                 shift_mu, w0, w_lora_up, a0, a_lora_up, k_k, k_a, r_k, ln_x_w, ln_x_b,
                 w_out_a, w_out_b, w_o):
    shift, scale, gate = jnp.split(jax.nn.silu(c) @ w_ada + b_ada, 3, axis=-1)
    h = rms_norm(x, norm_gain) * (1.0 + scale[:, None, :]) + shift[:, None, :]
    cols = h @ w_in
    cols_a, cols_shift, cols_rest = split_last(cols, (NSA_IN, SHIFT_WIDTH, REST_IN))
    q, k_cmp, v_cmp, k_slc, v_slc, k_win, v_win, a_gate_logits, a_silu = split_last(
        cols_a, (A_WIDTH,) + (A_KV_WIDTH,) * 6 + (3 * A_HEADS, A_WIDTH))
    r, k, v, wd, ad = split_last(token_shift(cols_shift, shift_mu), (B_WIDTH,) * 3 + (DECAY_LORA, ICLR_LORA))
    b_silu, merge_a, merge_b = split_last(cols_rest, (B_WIDTH, D_MODEL, D_MODEL))
    y_a = nsa_mixer(q, k_cmp, v_cmp, k_slc, v_slc, k_win, v_win, a_gate_logits, rel_bias,
                    q_norm_gain, k_norm_gain, cmp_pos_k, cmp_pos_v, cmp_k_w1, cmp_k_w2, cmp_v_w1, cmp_v_w2)
    y_a = y_a * jax.nn.silu(a_silu)
    y_b = rwkv7_mixer(r, k, v, wd, ad, w0, w_lora_up, a0, a_lora_up, k_k, k_a, r_k, ln_x_w, ln_x_b)
    y_b = y_b * jax.nn.silu(b_silu)
    merged = jax.nn.sigmoid(merge_a) * (y_a @ w_out_a) + jax.nn.sigmoid(merge_b) * (y_b @ w_out_b)
    return x + gate[:, None, :] * (merged @ w_o)


def setup_inputs(seed: int = 0) -> dict:
    key = jax.random.key(seed)
    ks = jax.random.split(key, 32)
    nrm = lambda k, shape, s: jax.random.normal(k, shape, jnp.float32) * s
    L = DEPTH
    fan_cmp = CMP_BLOCK * A_HEAD_DIM
    return {
        'x': nrm(ks[0], (BATCH, SEQ, D_MODEL), 1.0),
        'c': nrm(ks[1], (BATCH, D_MODEL), 1.0),
        'w_ada': nrm(ks[2], (L, D_MODEL, 3 * D_MODEL), 0.2 * D_MODEL ** -0.5),
        'b_ada': nrm(ks[3], (L, 3 * D_MODEL), 0.01),
        'norm_gain': 1.0 + nrm(ks[4], (L, D_MODEL), 0.02),
        'w_in': nrm(ks[5], (L, D_MODEL, IN_WIDTH), D_MODEL ** -0.5),
        'q_norm_gain': 1.0 + nrm(ks[6], (L, A_HEAD_DIM), 0.02),
        'k_norm_gain': 1.0 + nrm(ks[7], (L, 3, A_HEAD_DIM), 0.02),
        'cmp_pos_k': nrm(ks[8], (L, CMP_BLOCK, A_HEAD_DIM), 0.1),
        'cmp_pos_v': nrm(ks[9], (L, CMP_BLOCK, A_HEAD_DIM), 0.1),
        'cmp_k_w1': nrm(ks[10], (L, fan_cmp, CMP_HIDDEN), fan_cmp ** -0.5),
        'cmp_k_w2': nrm(ks[11], (L, CMP_HIDDEN, A_HEAD_DIM), CMP_HIDDEN ** -0.5),
        'cmp_v_w1': nrm(ks[12], (L, fan_cmp, CMP_HIDDEN), fan_cmp ** -0.5),
        'cmp_v_w2': nrm(ks[13], (L, CMP_HIDDEN, A_HEAD_DIM), CMP_HIDDEN ** -0.5),
        'rel_bias': nrm(ks[14], (REL_BUCKETS, A_HEADS), 0.5),
        'shift_mu': jax.random.uniform(ks[15], (L, SHIFT_WIDTH), jnp.float32),
        'w0': (-6.0 + 5.0 * jnp.linspace(0.0, 1.0, B_WIDTH))[None, :] + nrm(ks[16], (L, B_WIDTH), 0.1),
        'w_lora_up': nrm(ks[17], (L, DECAY_LORA, B_WIDTH), 0.5 * DECAY_LORA ** -0.5),
        'a0': nrm(ks[18], (L, B_WIDTH), 0.1),
        'a_lora_up': nrm(ks[19], (L, ICLR_LORA, B_WIDTH), ICLR_LORA ** -0.5),
        'k_k': 0.85 + nrm(ks[20], (L, B_WIDTH), 0.02),
        'k_a': 1.0 + nrm(ks[21], (L, B_WIDTH), 0.02),
        'r_k': nrm(ks[22], (L, B_HEADS, B_HEAD_DIM), 0.1),
        'ln_x_w': 1.0 + nrm(ks[23], (L, B_WIDTH), 0.02),
        'ln_x_b': nrm(ks[24], (L, B_WIDTH), 0.01),
        'w_out_a': nrm(ks[25], (L, A_WIDTH, D_MODEL), A_WIDTH ** -0.5),
        'w_out_b': nrm(ks[26], (L, B_WIDTH, D_MODEL), B_WIDTH ** -0.5),
        'w_o': nrm(ks[27], (L, D_MODEL, D_MODEL), D_MODEL ** -0.5),
    }


def reference(x, c, w_ada, b_ada, norm_gain, w_in, q_norm_gain, k_norm_gain, cmp_pos_k, cmp_pos_v,
              cmp_k_w1, cmp_k_w2, cmp_v_w1, cmp_v_w2, rel_bias, shift_mu, w0, w_lora_up, a0, a_lora_up,
              k_k, k_a, r_k, ln_x_w, ln_x_b, w_out_a, w_out_b, w_o):
    for l in range(DEPTH):
        x = hybrid_layer(x, c, rel_bias, w_ada[l], b_ada[l], norm_gain[l], w_in[l], q_norm_gain[l], k_norm_gain[l],
                         cmp_pos_k[l], cmp_pos_v[l], cmp_k_w1[l], cmp_k_w2[l], cmp_v_w1[l], cmp_v_w2[l],
                         shift_mu[l], w0[l], w_lora_up[l], a0[l], a_lora_up[l], k_k[l], k_a[l], r_k[l],
                         ln_x_w[l], ln_x_b[l], w_out_a[l], w_out_b[l], w_o[l])
    return x
```

```cpp
#include <hip/hip_runtime.h>
#include <hip/hip_cooperative_groups.h>
#include <cstdio>
#include <cstdint>
namespace cg = cooperative_groups;

#ifndef USE_CG_SYNC
#define USE_CG_SYNC 0
#endif
#ifndef MK_LAUNCHES
#define MK_LAUNCHES 1
#endif

#define DI __device__ __forceinline__
#define LAS __attribute__((address_space(3)))
typedef unsigned short bf16;
typedef short bf16x8 __attribute__((ext_vector_type(8)));
typedef short s16x4 __attribute__((ext_vector_type(4)));
typedef float f32x2 __attribute__((ext_vector_type(2)));
typedef float f32x4 __attribute__((ext_vector_type(4)));
typedef float f32x16 __attribute__((ext_vector_type(16)));
typedef unsigned u32x2 __attribute__((ext_vector_type(2)));
typedef unsigned u32x4 __attribute__((ext_vector_type(4)));
typedef __bf16 bf16x2_t __attribute__((ext_vector_type(2)));

namespace pg8 {
typedef unsigned short bf16_t;
constexpr int BM = 256, BK = 64, HALF = 128, HTB = HALF * BK * 2, STAGE_BYTES = 8 * HTB, NXCD = 8, WGM = 8;
__host__ __device__ __forceinline__ int lds_byte(int r, int c) { const int st = (r >> 4) * 2 + (c >> 5), rr = r & 15, cc = c & 31, ob = rr * 64 + cc * 2; return st * 1024 + (ob ^ (((ob >> 9) & 1) << 5)); }
__host__ __device__ __forceinline__ void stage_rc(int b, int& R, int& C) { const int st = b / 1024, sb = b % 1024, swz = sb ^ (((sb >> 9) & 1) << 5); R = (st >> 1) * 16 + swz / 64; C = (st & 1) * 32 + (swz % 64) / 2; }
__host__ __device__ __forceinline__ int perm32(int rho) { const int n = rho >> 4, i = rho & 15; return 8 * (i >> 2) + 4 * n + (i & 3); }
struct Unit { int pm, pn; };
struct Gemm { const bf16_t* A; const bf16_t* Bt; int M, N, K, lda, ldb; };
struct StaticOrder {
    int nM, nN, nwg, G, c;
    __host__ __device__ void init(int M, int N, int G_, int c_) { nM = M / BM; nN = N / BM; nwg = nM * nN; G = G_; c = c_; }
    __host__ __device__ bool next(int i, Unit& u) const {
        const long L = (long)i * G + c; if (L >= nwg) return false;
        int wgid = (int)L; { const int q = nwg / NXCD, r = nwg % NXCD, xcd = wgid % NXCD, off = wgid / NXCD; wgid = (xcd < r ? xcd * (q + 1) : r * (q + 1) + (xcd - r) * q) + off; }
        const int nig = WGM * nN, gid = wgid / nig, fm = gid * WGM, gsz = (nM - fm) < WGM ? (nM - fm) : WGM;
        u.pm = fm + ((wgid % nig) % gsz); u.pn = (wgid % nig) / gsz; return true;
    }
};
__device__ __forceinline__ unsigned cvt_pk_bf16(float lo, float hi) { unsigned r; asm volatile("v_cvt_pk_bf16_f32 %0, %1, %2" : "=v"(r) : "v"(lo), "v"(hi)); return r; }

template <class Epi, class Sched, bool ALIGN_EPI = true, bool SP2 = true>
__device__ __forceinline__ void gemm_phase(LAS unsigned char* lds, const Gemm g, const Sched& S, const Epi& E) {
    const int tid = threadIdx.x, wid = __builtin_amdgcn_readfirstlane(tid >> 6), lane = tid & 63, wr = wid >> 2, wc = wid & 3, fr = lane & 15, fq = lane >> 4;
    const int K = g.K, nt = K / BK;
    unsigned voffA[2], voffB[2];
#pragma unroll
    for (int i = 0; i < 2; ++i) { int R, C; stage_rc(tid * 16 + i * 8192, R, C); const int Rb = Epi::PERM ? ((R & ~31) + perm32(R & 31)) : R;
        voffA[i] = (unsigned)(R * g.lda + C) * 2u; voffB[i] = (unsigned)(Rb * g.ldb + C) * 2u; }
    const size_t kstep = (size_t)(BK * 2);
    const size_t hstepA = (size_t)HALF * g.lda * 2, hstepB = (size_t)HALF * g.ldb * 2;
    const size_t tstepA = 2 * hstepA, tstepB = 2 * hstepB;
    const unsigned ldsw = (unsigned)wid * 1024u;
    const int aoff = lds_byte(wr * 64 + fr, fq * 8), boff = lds_byte(wc * 32 + fr, fq * 8);
#define PG8_SA(b, h) (((b) * 2 + (h)) * HTB)
#define PG8_SB(b, h) ((4 + (b) * 2 + (h)) * HTB)
#define PG8_STAGE(bufoff, gbase, voff) do { _Pragma("unroll") for (int _i = 0; _i < 2; ++_i) \
        __builtin_amdgcn_global_load_lds((const unsigned*)((const char*)(gbase) + (voff)[_i]), (LAS unsigned*)(lds + (bufoff) + ldsw + _i * 8192), 16, 0, 0); } while (0)
#define PG8_LDA(dst, b, h) do { _Pragma("unroll") for (int m = 0; m < 4; ++m) _Pragma("unroll") for (int k = 0; k < 2; ++k) dst[m][k] = *(const LAS bf16x8*)(lds + PG8_SA(b, h) + aoff + m * 2048 + k * 1024); } while (0)
#define PG8_LDB(dst, b, h) do { _Pragma("unroll") for (int n = 0; n < 2; ++n) _Pragma("unroll") for (int k = 0; k < 2; ++k) dst[n][k] = *(const LAS bf16x8*)(lds + PG8_SB(b, h) + boff + n * 2048 + k * 1024); } while (0)
#define PG8_MMA(ai, bj, At, Bt) do { __builtin_amdgcn_s_setprio(1); _Pragma("unroll") for (int m = 0; m < 4; ++m) _Pragma("unroll") for (int n = 0; n < 2; ++n) _Pragma("unroll") for (int k = 0; k < 2; ++k) \
        acc[ai][bj][m][n] = __builtin_amdgcn_mfma_f32_16x16x32_bf16(Bt[n][k], At[m][k], acc[ai][bj][m][n], 0, 0, 0); __builtin_amdgcn_s_setprio(0); } while (0)
#define PG8_WAIT_V(n) asm volatile("s_waitcnt vmcnt(" #n ")" ::: "memory")
#define PG8_WAIT_L(n) asm volatile("s_waitcnt lgkmcnt(" #n ")" ::: "memory")
#define PG8_BAR __builtin_amdgcn_s_barrier()
#define PG8_SCHED __builtin_amdgcn_sched_barrier(0)
    Unit cur, nxt; int ui = 0;
    if (!S.next(0, cur)) return;
    f32x4 acc[2][2][4][2];
#pragma unroll
    for (int a = 0; a < 2; ++a)
#pragma unroll
        for (int b = 0; b < 2; ++b)
#pragma unroll
            for (int m = 0; m < 4; ++m)
#pragma unroll
                for (int n = 0; n < 2; ++n) acc[a][b][m][n] = (f32x4){0.f, 0.f, 0.f, 0.f};
    bf16x8 At[4][2], B0[2][2], B1[2][2];
    const char* cA = (const char*)g.A + (size_t)cur.pm * tstepA; const char* cB = (const char*)g.Bt + (size_t)cur.pn * tstepB;
    if constexpr (SP2) {
        PG8_STAGE(PG8_SB(0, 0), cB, voffB); PG8_STAGE(PG8_SB(0, 1), cB + hstepB, voffB); PG8_STAGE(PG8_SA(0, 0), cA, voffA); PG8_STAGE(PG8_SA(0, 1), cA + hstepA, voffA);
        if (wr == 1) PG8_BAR;
        PG8_WAIT_V(2); PG8_BAR;
        PG8_STAGE(PG8_SB(1, 0), cB + kstep, voffB); PG8_STAGE(PG8_SA(1, 0), cA + kstep, voffA); PG8_STAGE(PG8_SB(1, 1), cB + hstepB + kstep, voffB);
        PG8_WAIT_V(6); PG8_BAR;
    } else {
        PG8_STAGE(PG8_SB(0, 0), cB, voffB); PG8_STAGE(PG8_SA(0, 0), cA, voffA); PG8_STAGE(PG8_SB(0, 1), cB + hstepB, voffB); PG8_STAGE(PG8_SA(0, 1), cA + hstepA, voffA);
        if (wr == 1) PG8_BAR;
        PG8_WAIT_V(4); PG8_BAR;
        PG8_STAGE(PG8_SB(1, 0), cB + kstep, voffB); PG8_STAGE(PG8_SA(1, 0), cA + kstep, voffA); PG8_STAGE(PG8_SB(1, 1), cB + hstepB + kstep, voffB);
        PG8_WAIT_V(6); PG8_BAR;
    }
    for (;;) {
        const bool has_next = S.next(ui + 1, nxt);
        const char* nA = has_next ? (const char*)g.A + (size_t)nxt.pm * tstepA : cA; const char* nB = has_next ? (const char*)g.Bt + (size_t)nxt.pn * tstepB : cB;
        for (int t = 0; t < nt; t += 2) {
            const bool last = (t == nt - 2);
            const char* a1 = cA + (size_t)(t + 1) * kstep;
            const char* a2 = last ? nA : cA + (size_t)(t + 2) * kstep; const char* b2 = last ? nB : cB + (size_t)(t + 2) * kstep;
            const char* a3 = a2 + kstep; const char* b3 = b2 + kstep;
            if constexpr (SP2) {
            PG8_LDB(B0, 0, 0); PG8_LDB(B1, 0, 1); PG8_SCHED; PG8_LDA(At, 0, 0); PG8_STAGE(PG8_SA(1, 1), a1 + hstepA, voffA);
            PG8_WAIT_V(8); PG8_WAIT_L(0); PG8_BAR; PG8_MMA(0, 0, At, B0); PG8_MMA(0, 1, At, B1); PG8_BAR; PG8_SCHED;
            PG8_LDA(At, 0, 1); PG8_STAGE(PG8_SB(0, 0), b2, voffB); PG8_STAGE(PG8_SB(0, 1), b2 + hstepB, voffB); PG8_STAGE(PG8_SA(0, 0), a2, voffA);
            PG8_WAIT_V(8); PG8_WAIT_L(0); PG8_BAR; PG8_MMA(1, 0, At, B0); PG8_MMA(1, 1, At, B1); PG8_BAR; PG8_SCHED;
            PG8_LDB(B0, 1, 0); PG8_LDB(B1, 1, 1); PG8_SCHED; PG8_LDA(At, 1, 0); PG8_STAGE(PG8_SA(0, 1), a2 + hstepA, voffA);
            PG8_WAIT_V(8); PG8_WAIT_L(0); PG8_BAR; PG8_MMA(0, 0, At, B0); PG8_MMA(0, 1, At, B1); PG8_BAR; PG8_SCHED;
            PG8_LDA(At, 1, 1); PG8_STAGE(PG8_SB(1, 0), b3, voffB); PG8_STAGE(PG8_SB(1, 1), b3 + hstepB, voffB); PG8_STAGE(PG8_SA(1, 0), a3, voffA);
            PG8_WAIT_V(8); PG8_WAIT_L(0); PG8_BAR; PG8_MMA(1, 0, At, B0); PG8_MMA(1, 1, At, B1); PG8_BAR; PG8_SCHED;
            } else {
            PG8_LDB(B0, 0, 0); PG8_SCHED; PG8_LDA(At, 0, 0); PG8_STAGE(PG8_SA(1, 1), a1 + hstepA, voffA);
            PG8_WAIT_L(8); PG8_BAR; PG8_WAIT_L(0); PG8_MMA(0, 0, At, B0); PG8_BAR; PG8_SCHED;
            PG8_LDB(B1, 0, 1); PG8_STAGE(PG8_SB(0, 0), b2, voffB);
            PG8_BAR; PG8_WAIT_L(0); PG8_MMA(0, 1, At, B1); PG8_BAR;
            PG8_LDA(At, 0, 1); PG8_STAGE(PG8_SA(0, 0), a2, voffA);
            PG8_BAR; PG8_WAIT_L(0); PG8_MMA(1, 0, At, B0); PG8_BAR; PG8_SCHED;
            PG8_STAGE(PG8_SB(0, 1), b2 + hstepB, voffB);
            PG8_WAIT_V(6); PG8_BAR; PG8_MMA(1, 1, At, B1); PG8_BAR;
            PG8_LDB(B0, 1, 0); PG8_SCHED; PG8_LDA(At, 1, 0); PG8_STAGE(PG8_SA(0, 1), a2 + hstepA, voffA);
            PG8_WAIT_L(8); PG8_BAR; PG8_WAIT_L(0); PG8_MMA(0, 0, At, B0); PG8_BAR; PG8_SCHED;
            PG8_LDB(B1, 1, 1); PG8_STAGE(PG8_SB(1, 0), b3, voffB);
            PG8_BAR; PG8_WAIT_L(0); PG8_MMA(0, 1, At, B1); PG8_BAR;
            PG8_LDA(At, 1, 1); PG8_STAGE(PG8_SA(1, 0), a3, voffA);
            PG8_BAR; PG8_WAIT_L(0); PG8_MMA(1, 0, At, B0); PG8_BAR; PG8_SCHED;
            PG8_STAGE(PG8_SB(1, 1), b3 + hstepB, voffB);
            PG8_WAIT_V(6); PG8_BAR; PG8_MMA(1, 1, At, B1); PG8_BAR;
            }
        }
        if constexpr (ALIGN_EPI) { if (wr == 0) PG8_BAR; }
        E(acc, cur, wr, wc, fr, fq);
        if (!has_next) break;
#pragma unroll
        for (int a = 0; a < 2; ++a)
#pragma unroll
            for (int b = 0; b < 2; ++b)
#pragma unroll
                for (int m = 0; m < 4; ++m)
#pragma unroll
                    for (int n = 0; n < 2; ++n) acc[a][b][m][n] = (f32x4){0.f, 0.f, 0.f, 0.f};
        cur = nxt; cA = nA; cB = nB; ++ui;
        if constexpr (ALIGN_EPI) { if (wr == 1) PG8_BAR; }
    }
    PG8_WAIT_V(0);
    if constexpr (!ALIGN_EPI) { if (wr == 0) PG8_BAR; }
    PG8_BAR;
#undef PG8_SA
#undef PG8_SB
#undef PG8_STAGE
#undef PG8_LDA
#undef PG8_LDB
#undef PG8_MMA
#undef PG8_WAIT_V
#undef PG8_WAIT_L
#undef PG8_BAR
#undef PG8_SCHED
}
}

constexpr int NB = 16, SEQ = 2048, DM = 1024, MTOK = NB * SEQ;
constexpr int LD_CAS = 3584, LD_CR = 2560, N_IN_PAD = 6144, N_IN = 6040;
constexpr int Q0 = 0, KC0 = 512, VC0 = 640, KS0 = 768, VS0 = 896, KW0 = 1024, VW0 = 1152, GATE0 = 1280, ASILU0 = 1304;
constexpr int SH0 = 1816, R0 = SH0, K0 = SH0 + 512, V0 = SH0 + 1024, WD0 = SH0 + 1536, AD0 = SH0 + 1600, CAS_USED = 3480;
constexpr int BSILU0 = 0, MA0 = 512, MB0 = 1536;
constexpr float LOG2E = 1.4426950408889634f;
constexpr float QSCALE = 0.125f * LOG2E;

constexpr size_t MiB = 1u << 20;
constexpr size_t WS_CTL = 0, CTL_ZERO_BYTES = 64 * 1024;
constexpr size_t WS_MOD = 256 * 1024;
constexpr size_t WS_POSB = 512 * 1024;
constexpr size_t WS_BIAS = 520 * 1024;
constexpr size_t WS_WA_T = 2 * MiB, WS_WB_T = 3 * MiB;
constexpr size_t WS_WO_T = 4 * MiB;
constexpr size_t WS_W1K_T = 6 * MiB, WS_W1V_T = 7 * MiB;
constexpr size_t WS_W2K_T = 8 * MiB, WS_W2V_T = 8 * MiB + 64 * 1024;
constexpr size_t WS_WLW_T = 8 * MiB + 128 * 1024, WS_WLA_T = 8 * MiB + 192 * 1024;
constexpr size_t WS_KC = 9 * MiB;
constexpr size_t WS_VCT = 9 * MiB + 512 * 1024;
constexpr size_t WS_BONUS = 10 * MiB;
constexpr size_t WS_DUMMY = 11 * MiB;
constexpr size_t WS_VTS = 12 * MiB, WS_VTW = 20 * MiB;
constexpr size_t WS_CAS = 28 * MiB;
constexpr size_t WS_CR = 252 * MiB;
constexpr size_t WS_YA = 412 * MiB, WS_YB = 444 * MiB;
constexpr size_t WS_WIN_T = 476 * MiB;
constexpr size_t WS_HS = 476 * MiB;
constexpr size_t WS_MERGED = WS_CAS;
constexpr size_t WS_END = 508 * MiB;
constexpr size_t OUT_H = 0;
constexpr size_t OUT_G = 0, OUT_Y1 = 32 * MiB, OUT_D = 64 * MiB, OUT_Y2 = 96 * MiB;

constexpr int LDS_BYTES = 147456;

struct Params {
    const float *x, *c, *w_ada, *b_ada, *norm_gain, *w_in, *q_norm_gain, *k_norm_gain, *cmp_pos_k, *cmp_pos_v,
        *cmp_k_w1, *cmp_k_w2, *cmp_v_w1, *cmp_v_w2, *rel_bias, *shift_mu, *w0, *w_lora_up, *a0, *a_lora_up,
        *k_k, *k_a, *r_k, *ln_x_w, *ln_x_b, *w_out_a, *w_out_b, *w_o;
    float* out; unsigned char* ws;
    int ph_lo, ph_hi;
};

DI unsigned f2bf(float f) { unsigned u = __builtin_bit_cast(unsigned, f); return (u + 0x7fffu + ((u >> 16) & 1u)) >> 16; }
DI float bf2f(unsigned h) { return __builtin_bit_cast(float, h << 16); }
DI unsigned pk2(float lo, float hi) { f32x2 v = {lo, hi}; bf16x2_t b = __builtin_convertvector(v, bf16x2_t); return __builtin_bit_cast(unsigned, b); }
DI float bflo(unsigned w) { return __builtin_bit_cast(float, w << 16); }
DI float bfhi(unsigned w) { return __builtin_bit_cast(float, w & 0xffff0000u); }
DI float sigmoidf_(float x) { return __builtin_amdgcn_rcpf(1.f + __expf(-x)); }
DI float siluf_(float x) { return x * __builtin_amdgcn_rcpf(1.f + __expf(-x)); }
DI int crow(int r, int hh) { return (r & 3) + 8 * (r >> 2) + 4 * hh; }
DI int pos16_of_key(int k16) { return 8 * ((k16 >> 2) & 1) + 4 * (k16 >> 3) + (k16 & 3); }
DI int key16_of_pos(int p16) { const int hh = p16 >> 3, j = p16 & 7; return 8 * (j >> 2) + 4 * hh + (j & 3); }
DI float wave_sum(float v) {
#pragma unroll
    for (int o = 1; o < 64; o <<= 1) v += __shfl_xor(v, o);
    return v;
}
DI void unpack8(u32x4 w, float* f) { f[0] = bflo(w.x); f[1] = bfhi(w.x); f[2] = bflo(w.y); f[3] = bfhi(w.y); f[4] = bflo(w.z); f[5] = bfhi(w.z); f[6] = bflo(w.w); f[7] = bfhi(w.w); }
typedef short v4i16_t __attribute__((ext_vector_type(4)));
DI s16x4 tr_read(const LAS bf16* p) { return __builtin_bit_cast(s16x4, __builtin_amdgcn_ds_read_tr16_b64_v4i16((LAS v4i16_t*)p)); }

__device__ const unsigned char T5_BUCKET[129] = {
    0, 1, 2, 3, 4, 5, 6, 7, 8, 9, 10, 11, 12, 13, 14, 15, 16, 16, 16, 17, 17, 18, 18, 18, 19, 19, 19, 20, 20, 20, 20, 21, 21, 21, 21, 22, 22, 22, 22, 22, 23, 23, 23, 23, 23, 23, 24, 24, 24, 24, 24, 24, 25, 25, 25, 25, 25, 25, 25, 26, 26, 26, 26, 26, 26, 26, 26, 27, 27, 27, 27, 27, 27, 27, 27, 27, 27, 28, 28, 28, 28, 28, 28, 28, 28, 28, 28, 29, 29, 29, 29, 29, 29, 29, 29, 29, 29, 29, 29, 30, 30, 30, 30, 30, 30, 30, 30, 30, 30, 30, 30, 30, 30, 31, 31, 31, 31, 31, 31, 31, 31, 31, 31, 31, 31, 31, 31, 31, 31};

template <class F> DI void transpose_item(const float* W, int K, int N, bf16* WT, F rowmap, LAS float* scr, int item, int lane) {
    const int nblk = (N + 63) / 64, kb = item / nblk, nb = item % nblk, k0 = 64 * kb, n0 = 64 * nb;
    const int n4 = (lane & 15) * 4;
    const bool inb = n0 + n4 < N; const int ncl = inb ? n0 + n4 : N - 4;
    f32x4 vv[16];
#pragma unroll
    for (int i = 0; i < 16; ++i) vv[i] = *(const f32x4*)(W + (size_t)(k0 + 4 * i + (lane >> 4)) * N + ncl);
#pragma unroll
    for (int i = 0; i < 16; ++i) asm volatile("" : "+v"(vv[i]));
#pragma unroll
    for (int i = 0; i < 16; ++i) { const int kk = 4 * i + (lane >> 4);
        const f32x4 v = inb ? vv[i] : (f32x4){0.f, 0.f, 0.f, 0.f};
        LAS float* d = scr + kk * 65 + n4; d[0] = v[0]; d[1] = v[1]; d[2] = v[2]; d[3] = v[3]; }
    asm volatile("s_waitcnt lgkmcnt(0)" ::: "memory");
    const int c = lane & 7;
#pragma unroll
    for (int j = 0; j < 8; ++j) { const int nl = (lane >> 3) + 8 * j, n = n0 + nl; const LAS float* s = scr + (8 * c) * 65 + nl;
        u32x4 o; o.x = pk2(s[0 * 65], s[1 * 65]); o.y = pk2(s[2 * 65], s[3 * 65]); o.z = pk2(s[4 * 65], s[5 * 65]); o.w = pk2(s[6 * 65], s[7 * 65]);
        if (n < N) *(u32x4*)(WT + (size_t)rowmap(n) * K + k0 + 8 * c) = o; }
    asm volatile("s_waitcnt lgkmcnt(0)" ::: "memory");
}

DI void phase0w(const Params& p, LAS unsigned char* lds) {
    const int tid = threadIdx.x, lane = tid & 63, wave = __builtin_amdgcn_readfirstlane(tid >> 6);
    const int gw = blockIdx.x * 8 + wave, NGW = gridDim.x * 8;
    unsigned char* ws = p.ws;
    {
        LAS float* scr = (LAS float*)(lds + wave * 16640);
        constexpr int I_IN = 16 * 95, I_OA = 8 * 16, I_OB = 8 * 16, I_O = 16 * 16, I_W1 = 32 * 4, I_W2 = 4 * 1, I_L = 1 * 8;
        constexpr int NIT = I_IN + I_OA + I_OB + I_O + 2 * I_W1 + 2 * I_W2 + 2 * I_L;
        auto ident = [](int n) { return n; };
        auto inmap = [](int n) { return n < CAS_USED ? n : n + (LD_CAS - CAS_USED); };
        for (int it = gw; it < NIT; it += NGW) {
            int r = it;
            if (r < I_IN) { transpose_item(p.w_in, DM, N_IN, (bf16*)(ws + WS_WIN_T), inmap, scr, r, lane); continue; } r -= I_IN;
            if (r < I_OA) { transpose_item(p.w_out_a, 512, DM, (bf16*)(ws + WS_WA_T), ident, scr, r, lane); continue; } r -= I_OA;
            if (r < I_OB) { transpose_item(p.w_out_b, 512, DM, (bf16*)(ws + WS_WB_T), ident, scr, r, lane); continue; } r -= I_OB;
            if (r < I_O) { transpose_item(p.w_o, DM, DM, (bf16*)(ws + WS_WO_T), ident, scr, r, lane); continue; } r -= I_O;
            if (r < I_W1) { transpose_item(p.cmp_k_w1, 2048, 256, (bf16*)(ws + WS_W1K_T), ident, scr, r, lane); continue; } r -= I_W1;
            if (r < I_W1) { transpose_item(p.cmp_v_w1, 2048, 256, (bf16*)(ws + WS_W1V_T), ident, scr, r, lane); continue; } r -= I_W1;
            if (r < I_W2) { transpose_item(p.cmp_k_w2, 256, 64, (bf16*)(ws + WS_W2K_T), ident, scr, r, lane); continue; } r -= I_W2;
            if (r < I_W2) { transpose_item(p.cmp_v_w2, 256, 64, (bf16*)(ws + WS_W2V_T), ident, scr, r, lane); continue; } r -= I_W2;
            if (r < I_L) { transpose_item(p.w_lora_up, 64, 512, (bf16*)(ws + WS_WLW_T), ident, scr, r, lane); continue; } r -= I_L;
            transpose_item(p.a_lora_up, 64, 512, (bf16*)(ws + WS_WLA_T), ident, scr, r, lane);
        }
    }
    {
        u32x4* z = (u32x4*)(ws + WS_WIN_T + (size_t)CAS_USED * DM * 2);
        const int n16 = (LD_CAS - CAS_USED) * DM * 2 / 16;
        for (int i = blockIdx.x * 512 + tid; i < n16; i += gridDim.x * 512) z[i] = (u32x4){0u, 0u, 0u, 0u};
    }
    __syncthreads();
}
constexpr size_t WS_MODP = 1 * MiB;
DI void phase0(const Params& p, LAS unsigned char* lds) {
    const int tid = threadIdx.x, lane = tid & 63, wave = __builtin_amdgcn_readfirstlane(tid >> 6);
    unsigned char* ws = p.ws;
    LAS float* red = (LAS float*)lds;
    LAS float* sc = (LAS float*)(lds + 32768);
    for (int task = blockIdx.x; task < 201; task += gridDim.x) {
        if (task < 192) {
            const int cg = task % 48, kq = task / 48;
            for (int i = tid; i < 16 * 256; i += 512) sc[i] = siluf_(p.c[(i >> 8) * 1024 + kq * 256 + (i & 255)]);
            __syncthreads();
            const int col = cg * 64 + lane;
            float acc[16];
#pragma unroll
            for (int b = 0; b < 16; ++b) acc[b] = 0.f;
#pragma unroll 4
            for (int kk = 0; kk < 32; ++kk) { const int kl = wave * 32 + kk; const float wv = p.w_ada[(size_t)(kq * 256 + kl) * 3072 + col];
#pragma unroll
                for (int b = 0; b < 16; ++b) acc[b] += sc[b * 256 + kl] * wv; }
#pragma unroll
            for (int b = 0; b < 16; ++b) red[(wave * 16 + b) * 64 + lane] = acc[b];
            __syncthreads();
            for (int o = tid; o < 1024; o += 512) { const int b = o >> 6, l = o & 63; float s = 0.f;
#pragma unroll
                for (int w = 0; w < 8; ++w) s += red[(w * 16 + b) * 64 + l];
                ((float*)(ws + WS_MODP))[(kq * 16 + b) * 3072 + cg * 64 + l] = s; }
            __syncthreads();
        } else if (task < 200) {
            const int t2 = task - 192, which = t2 >> 2, col = (t2 & 3) * 64 + lane;
            const float* pos = which ? p.cmp_pos_v : p.cmp_pos_k; const float* w1 = which ? p.cmp_v_w1 : p.cmp_k_w1;
            float a = 0.f;
#pragma unroll 4
            for (int kk = 0; kk < 256; ++kk) { const int k = wave * 256 + kk; a += pos[k] * w1[(size_t)k * 256 + col]; }
            red[wave * 64 + lane] = a;
            __syncthreads();
            if (tid < 64) { float s = 0.f;
#pragma unroll
                for (int w = 0; w < 8; ++w) s += red[w * 64 + tid];
                ((float*)(ws + WS_POSB))[which * 256 + (t2 & 3) * 64 + tid] = s; }
            __syncthreads();
        } else {
            for (int i = tid; i < 8 * 129; i += 512) { const int h = i / 129, d = i % 129; ((float*)(ws + WS_BIAS))[h * 132 + d] = p.rel_bias[T5_BUCKET[d] * 8 + h] * LOG2E; }
        }
    }
}

DI void phase1(const Params& p, LAS unsigned char* lds) {
    const int tid = threadIdx.x, lane = tid & 63, wave = tid >> 6;
    bf16* hb = (bf16*)((unsigned char*)p.out + OUT_H);
    LAS float* modL = (LAS float*)lds;
    for (int rb = blockIdx.x; rb < MTOK / 128; rb += gridDim.x) {
        const int b = rb >> 4;
        __syncthreads();
        for (int col = tid; col < 3072; col += 512) { float s = p.b_ada[col];
#pragma unroll
            for (int kq = 0; kq < 4; ++kq) s += ((const float*)(p.ws + WS_MODP))[(kq * 16 + b) * 3072 + col];
            modL[col] = s; if ((rb & 15) == 0) ((float*)(p.ws + WS_MOD))[b * 3072 + col] = s; }
        __syncthreads();
        f32x4 gq[4];
#pragma unroll
        for (int j = 0; j < 4; ++j) gq[j] = *(const f32x4*)(p.norm_gain + 4 * lane + 256 * j);
        for (int r = wave; r < 128; r += 8) {
            const int m = rb * 128 + r;
            const f32x4* xr = (const f32x4*)(p.x + (size_t)m * DM) + lane;
            f32x4 v[4]; float s = 0.f;
#pragma unroll
            for (int j = 0; j < 4; ++j) { v[j] = xr[64 * j]; s += (v[j].x * v[j].x + v[j].y * v[j].y) + (v[j].z * v[j].z + v[j].w * v[j].w); }
            const float rinv = rsqrtf(wave_sum(s) * (1.f / DM) + 1e-6f);
            u32x2* o8 = (u32x2*)(hb + (size_t)m * DM) + lane;
#pragma unroll
            for (int j = 0; j < 4; ++j) {
                const int k = 4 * lane + 256 * j;
                const f32x4 g = gq[j], sh = *(const LAS f32x4*)(modL + k), scl = *(const LAS f32x4*)(modL + 1024 + k);
                f32x4 h = v[j] * rinv * g * (scl + 1.f) + sh;
                u32x2 o; o.x = pk2(h.x, h.y); o.y = pk2(h.z, h.w); o8[64 * j] = o;
            }
        }
    }
    __syncthreads();
}

struct EpiInProj {
    static constexpr bool PERM = true;
    bf16* cas; bf16* cr;
    DI void operator()(const f32x4 (&acc)[2][2][4][2], const pg8::Unit& u, int wr, int wc, int fr, int fq) const {
        const int row0 = u.pm * 256 + wr * 64 + fr;
        bf16* base; int ldc, colt;
        if (u.pn < 14) { base = cas; ldc = LD_CAS; colt = u.pn * 256; } else { base = cr; ldc = LD_CR; colt = (u.pn - 14) * 256; }
        const int col0 = colt + wc * 32 + 8 * fq;
#pragma unroll
        for (int ai = 0; ai < 2; ++ai)
#pragma unroll
            for (int m = 0; m < 4; ++m) { bf16* rowp = base + (size_t)(row0 + ai * 128 + m * 16) * ldc + col0;
#pragma unroll
                for (int bj = 0; bj < 2; ++bj) { const f32x4 v0 = acc[ai][bj][m][0], v1 = acc[ai][bj][m][1];
                    u32x4 w; w.x = pk2(v0[0], v0[1]); w.y = pk2(v0[2], v0[3]); w.z = pk2(v1[0], v1[1]); w.w = pk2(v1[2], v1[3]);
                    *(u32x4*)(rowp + bj * 128) = w; } }
    }
};
template <int WHICH> struct EpiGate {
    static constexpr bool PERM = true;
    bf16* merged; const bf16* cr;
    DI void operator()(const f32x4 (&acc)[2][2][4][2], const pg8::Unit& u, int wr, int wc, int fr, int fq) const {
        const int row0 = u.pm * 256 + wr * 64 + fr, col0 = u.pn * 256 + wc * 32 + 8 * fq;
#pragma unroll
        for (int ai = 0; ai < 2; ++ai)
#pragma unroll
            for (int mp2 = 0; mp2 < 2; ++mp2) {
                u32x4 gw[2][2], ow[2][2];
#pragma unroll
                for (int m2 = 0; m2 < 2; ++m2)
#pragma unroll
                    for (int bj = 0; bj < 2; ++bj) { const size_t row = (size_t)(row0 + ai * 128 + (2 * mp2 + m2) * 16); const int col = col0 + bj * 128;
                        gw[m2][bj] = *(const u32x4*)(cr + row * LD_CR + (WHICH ? MB0 : MA0) + col);
                        if (WHICH) ow[m2][bj] = *(const u32x4*)(merged + row * DM + col); }
#pragma unroll
                for (int m2 = 0; m2 < 2; ++m2)
#pragma unroll
                    for (int bj = 0; bj < 2; ++bj) { asm volatile("" : "+v"(gw[m2][bj])); if (WHICH) asm volatile("" : "+v"(ow[m2][bj])); }
#pragma unroll
                for (int m2 = 0; m2 < 2; ++m2)
#pragma unroll
                    for (int bj = 0; bj < 2; ++bj) { const int m = 2 * mp2 + m2; const size_t row = (size_t)(row0 + ai * 128 + m * 16); const int col = col0 + bj * 128;
                        float gl[8]; unpack8(gw[m2][bj], gl);
                        const f32x4 v0 = acc[ai][bj][m][0], v1 = acc[ai][bj][m][1];
                        float r[8] = {v0[0], v0[1], v0[2], v0[3], v1[0], v1[1], v1[2], v1[3]};
                        if (WHICH) { float old[8]; unpack8(ow[m2][bj], old);
#pragma unroll
                            for (int i = 0; i < 8; ++i) r[i] = old[i] + sigmoidf_(gl[i]) * r[i]; }
                        else {
#pragma unroll
                            for (int i = 0; i < 8; ++i) r[i] = sigmoidf_(gl[i]) * r[i]; }
                        u32x4 w; w.x = pk2(r[0], r[1]); w.y = pk2(r[2], r[3]); w.z = pk2(r[4], r[5]); w.w = pk2(r[6], r[7]);
                        *(u32x4*)(merged + row * DM + col) = w; }
            }
    }
};
struct EpiFinal {
    static constexpr bool PERM = false;
    const float* x; const float* mod; float* out;
    DI void operator()(const f32x4 (&acc)[2][2][4][2], const pg8::Unit& u, int wr, int wc, int fr, int fq) const {
        const int row0 = u.pm * 256 + wr * 64 + fr, col0 = u.pn * 256 + wc * 32 + 4 * fq;
        const int b = (u.pm * 256) >> 11;
        f32x4 gv[2][2];
#pragma unroll
        for (int bj = 0; bj < 2; ++bj)
#pragma unroll
            for (int n = 0; n < 2; ++n) gv[bj][n] = *(const f32x4*)(mod + b * 3072 + 2048 + col0 + bj * 128 + n * 16);
#define EF_ADDR(B, m2, bj, n) ((size_t)(row0 + ((B) >> 1) * 128 + (2 * ((B) & 1) + (m2)) * 16) * DM + col0 + (bj) * 128 + (n) * 16)
#define EF_LOAD(X, B) do { _Pragma("unroll") for (int m2 = 0; m2 < 2; ++m2) _Pragma("unroll") for (int bj = 0; bj < 2; ++bj) _Pragma("unroll") for (int n = 0; n < 2; ++n) \
            X[m2][bj][n] = *(const f32x4*)(x + EF_ADDR(B, m2, bj, n)); } while (0)
#define EF_STORE(X, B) do { _Pragma("unroll") for (int m2 = 0; m2 < 2; ++m2) _Pragma("unroll") for (int bj = 0; bj < 2; ++bj) _Pragma("unroll") for (int n = 0; n < 2; ++n) asm volatile("" : "+v"(X[m2][bj][n])); \
            _Pragma("unroll") for (int m2 = 0; m2 < 2; ++m2) _Pragma("unroll") for (int bj = 0; bj < 2; ++bj) _Pragma("unroll") for (int n = 0; n < 2; ++n) \
                *(f32x4*)(out + EF_ADDR(B, m2, bj, n)) = X[m2][bj][n] + gv[bj][n] * acc[(B) >> 1][bj][2 * ((B) & 1) + m2][n]; } while (0)
        f32x4 xa[2][2][2], xb[2][2][2];
        EF_LOAD(xa, 0);
        EF_LOAD(xb, 1); EF_STORE(xa, 0);
        EF_LOAD(xa, 2); EF_STORE(xb, 1);
        EF_LOAD(xb, 3); EF_STORE(xa, 2);
        EF_STORE(xb, 3);
#undef EF_ADDR
#undef EF_LOAD
#undef EF_STORE
    }
};

DI void phase3a(const Params& p, LAS unsigned char* lds) {
    const int tid = threadIdx.x, lane = tid & 63, wave = tid >> 6;
    const int gw = blockIdx.x * 8 + wave, NGW = gridDim.x * 8;
    bf16* cas = (bf16*)(p.ws + WS_CAS);
    {
        float gq[8], gk[8];
        const int dq = (8 * lane) & 63;
#pragma unroll
        for (int i = 0; i < 8; ++i) gq[i] = p.q_norm_gain[dq + i] * QSCALE;
        const int kr = (lane < 16) ? 1 : 2, dk = (8 * lane) & 63;
#pragma unroll
        for (int i = 0; i < 8; ++i) gk[i] = p.k_norm_gain[kr * 64 + dk + i];
        const int kcol = (lane < 16) ? (KS0 + 8 * lane) : (KW0 + 8 * (lane & 15));
        for (int m0 = gw * 4; m0 < MTOK; m0 += NGW * 4) {
            u32x4 qw[4], kw[4];
#pragma unroll
            for (int u = 0; u < 4; ++u) { bf16* row = cas + (size_t)(m0 + u) * LD_CAS;
                qw[u] = *(const u32x4*)(row + Q0 + 8 * lane);
                kw[u] = (lane < 32) ? *(const u32x4*)(row + kcol) : (u32x4){0u, 0u, 0u, 0u}; }
#pragma unroll
            for (int u = 0; u < 4; ++u) {
                bf16* row = cas + (size_t)(m0 + u) * LD_CAS;
                float q[8], k[8]; unpack8(qw[u], q); unpack8(kw[u], k);
                float sq = 0.f, sk = 0.f;
#pragma unroll
                for (int i = 0; i < 8; ++i) { sq += q[i] * q[i]; sk += k[i] * k[i]; }
#pragma unroll
                for (int o = 1; o < 8; o <<= 1) { sq += __shfl_xor(sq, o); sk += __shfl_xor(sk, o); }
                const float rq = rsqrtf(sq * (1.f / 64.f) + 1e-6f), rk = rsqrtf(sk * (1.f / 64.f) + 1e-6f);
#pragma unroll
                for (int i = 0; i < 8; ++i) { q[i] *= rq * gq[i]; k[i] *= rk * gk[i]; }
                u32x4 o; o.x = pk2(q[0], q[1]); o.y = pk2(q[2], q[3]); o.z = pk2(q[4], q[5]); o.w = pk2(q[6], q[7]);
                *(u32x4*)(row + Q0 + 8 * lane) = o;
                if (lane < 32) { u32x4 o2; o2.x = pk2(k[0], k[1]); o2.y = pk2(k[2], k[3]); o2.z = pk2(k[4], k[5]); o2.w = pk2(k[6], k[7]); *(u32x4*)(row + kcol) = o2; }
            }
        }
    }
    {
        LAS bf16* tile = (LAS bf16*)lds;
        for (int it = blockIdx.x; it < 2048; it += gridDim.x) {
            const int which = it >> 10, bg = (it >> 5) & 31, j = it & 31, b = bg >> 1, g = bg & 1;
            const int key = tid >> 3, ch = tid & 7;
            __syncthreads();
            *(LAS u32x4*)(tile + key * 72 + 8 * ch) = *(const u32x4*)(cas + (size_t)(b * SEQ + 64 * j + key) * LD_CAS + (which ? VW0 : VS0) + g * 64 + 8 * ch);
            __syncthreads();
            const int d = tid >> 3, pc = tid & 7;
            unsigned short v[8];
#pragma unroll
            for (int i = 0; i < 8; ++i) { const int pos = 8 * pc + i, k2 = (pos & ~15) | key16_of_pos(pos & 15); v[i] = tile[k2 * 72 + d]; }
            u32x4 o; o.x = v[0] | ((unsigned)v[1] << 16); o.y = v[2] | ((unsigned)v[3] << 16); o.z = v[4] | ((unsigned)v[5] << 16); o.w = v[6] | ((unsigned)v[7] << 16);
            bf16* vt = (bf16*)(p.ws + (which ? WS_VTW : WS_VTS)) + ((size_t)(bg * 32 + j) * 64 + d) * 64 + 8 * pc;
            *(u32x4*)vt = o;
        }
        __syncthreads();
    }
}

DI float gelu_tanh(float x) { const float u = 0.7978845608028654f * (x + 0.044715f * x * x * x); const float t = 1.f - 2.f * __builtin_amdgcn_rcpf(__expf(2.f * u) + 1.f); return 0.5f * x * (1.f + t); }
DI void phase3b(const Params& p, LAS unsigned char* lds) {
    const int tid = threadIdx.x, lane = tid & 63, wave = __builtin_amdgcn_readfirstlane(tid >> 6), l31 = lane & 31, hh = lane >> 5;
    const bf16* cas = (const bf16*)(p.ws + WS_CAS);
    LAS bf16* h1 = (LAS bf16*)lds;
    LAS float* o2 = (LAS float*)(lds + 32 * 264 * 2);
    LAS unsigned char* xs = lds + 32768;
    float kgain[8];
#pragma unroll
    for (int i = 0; i < 8; ++i) kgain[i] = p.k_norm_gain[(tid & 7) * 8 + i];
    for (int it = blockIdx.x; it < 256; it += gridDim.x) {
        const int which = it >> 7, bg = (it >> 2) & 31, rq = it & 3, b = bg >> 1, g = bg & 1;
        {
            const bf16* xsrc = cas + (size_t)(b * SEQ) * LD_CAS + (which ? VC0 : KC0) + g * 64;
            for (int i = tid; i < 528 * 8; i += 512) { const int tr = i >> 3, ch = i & 7; int tok = 512 * rq + tr; tok = tok < SEQ ? tok : SEQ - 1;
                *(LAS u32x4*)(xs + tr * 128 + ((ch ^ ((tr >> 4) & 7)) << 4)) = *(const u32x4*)(xsrc + (size_t)tok * LD_CAS + 8 * ch); }
        }
        __syncthreads();
        const bf16* brow = (const bf16*)(p.ws + (which ? WS_W1V_T : WS_W1K_T)) + (size_t)(32 * wave + l31) * 2048 + 8 * hh;
        f32x16 acc = {};
#pragma unroll 16
        for (int s = 0; s < 128; ++s) {
            const int kk = 16 * s, tr = 16 * l31 + (kk >> 6), ch = ((kk & 63) >> 3) + hh;
            const bf16x8 a = *(const LAS bf16x8*)(xs + tr * 128 + ((ch ^ ((tr >> 4) & 7)) << 4));
            const bf16x8 bb = *(const bf16x8*)(brow + kk);
            acc = __builtin_amdgcn_mfma_f32_32x32x16_bf16(a, bb, acc, 0, 0, 0);
        }
        const float pb = ((const float*)(p.ws + WS_POSB))[which * 256 + 32 * wave + l31];
        __syncthreads();
#pragma unroll
        for (int r = 0; r < 16; ++r) h1[crow(r, hh) * 264 + 32 * wave + l31] = (bf16)f2bf(gelu_tanh(acc[r] + pb));
        __syncthreads();
        if (wave < 2) {
            const bf16* b2 = (const bf16*)(p.ws + (which ? WS_W2V_T : WS_W2K_T)) + (size_t)(32 * wave + l31) * 256 + 8 * hh;
            f32x16 a2 = {};
#pragma unroll
            for (int s = 0; s < 16; ++s) {
                const bf16x8 a = *(const LAS bf16x8*)(h1 + l31 * 264 + 16 * s + 8 * hh);
                const bf16x8 bb = *(const bf16x8*)(b2 + 16 * s);
                a2 = __builtin_amdgcn_mfma_f32_32x32x16_bf16(a, bb, a2, 0, 0, 0);
            }
#pragma unroll
            for (int r = 0; r < 16; ++r) o2[crow(r, hh) * 65 + 32 * wave + l31] = a2[r];
        }
        __syncthreads();
        if (tid < 256) {
            const int nl = tid >> 3, e8 = (tid & 7) * 8, nn = 32 * rq + nl;
            float v[8]; float ss = 0.f;
#pragma unroll
            for (int i = 0; i < 8; ++i) { v[i] = o2[nl * 65 + e8 + i]; ss += v[i] * v[i]; }
            if (which == 0) {
#pragma unroll
                for (int o = 1; o < 8; o <<= 1) ss += __shfl_xor(ss, o);
                const float rinv = rsqrtf(ss * (1.f / 64.f) + 1e-6f);
#pragma unroll
                for (int i = 0; i < 8; ++i) v[i] = (nn < 127) ? v[i] * rinv * kgain[i] : 0.f;
                u32x4 o; o.x = pk2(v[0], v[1]); o.y = pk2(v[2], v[3]); o.z = pk2(v[4], v[5]); o.w = pk2(v[6], v[7]);
                *(u32x4*)((bf16*)(p.ws + WS_KC) + (size_t)(bg * 128 + nn) * 64 + e8) = o;
            } else {
                const int pos = (nn & ~15) | pos16_of_key(nn & 15);
                bf16* vct = (bf16*)(p.ws + WS_VCT) + (size_t)bg * 64 * 128 + pos;
#pragma unroll
                for (int i = 0; i < 8; ++i) vct[(size_t)(e8 + i) * 128] = (bf16)f2bf((nn < 127) ? v[i] : 0.f);
            }
        }
        __syncthreads();
    }
}

constexpr int SLOTB = 8192;
DI int sw_el(int row, int col) { return row * 64 + ((((col >> 3) ^ (row & 7)) << 3) | (col & 7)); }
DI int swf_el(int row, int col) { return row * 64 + ((((col >> 2) ^ (row & 15)) << 2) | (col & 3)); }
DI bf16x8 frag_row(const LAS bf16* Mx, int row, int kc) { return *(const LAS bf16x8*)(Mx + sw_el(row, kc)); }
DI bf16x8 frag_col(const LAS bf16* Mx, int k0, int colbase, int lane) {
    const int i16 = lane & 15, q = i16 >> 2, pp = i16 & 3, blk = (lane >> 4) & 1, col = colbase + 16 * blk + 4 * pp;
    const s16x4 lo = tr_read(Mx + sw_el(k0 + q, col)), hi = tr_read(Mx + sw_el(k0 + 4 + q, col));
    return __builtin_shufflevector(lo, hi, 0, 1, 2, 3, 4, 5, 6, 7);
}
template <bool TA, bool TB> DI void mm_acc(f32x16& acc, const LAS bf16* A, const LAS bf16* Bm, int ti, int tj, int lane) {
    const int l31 = lane & 31, hh = lane >> 5;
#pragma unroll
    for (int s = 0; s < 4; ++s) {
        const int k0 = 16 * s + 8 * hh;
        bf16x8 x, y;
        if (TB) x = frag_row(Bm, 32 * tj + l31, k0); else x = frag_col(Bm, k0, 32 * tj, lane);
        if (TA) y = frag_col(A, k0, 32 * ti, lane); else y = frag_row(A, 32 * ti + l31, k0);
        acc = __builtin_amdgcn_mfma_f32_32x32x16_bf16(x, y, acc, 0, 0, 0);
    }
}
DI void ld_tile(f32x16& acc, const LAS bf16* Mx, int ti, int tj, int l31, int hh) {
#pragma unroll
    for (int g = 0; g < 4; ++g) { const u32x2 w = *(const LAS u32x2*)(Mx + sw_el(32 * ti + l31, 32 * tj + 8 * g + 4 * hh));
        acc[4 * g] = bflo(w.x); acc[4 * g + 1] = bfhi(w.x); acc[4 * g + 2] = bflo(w.y); acc[4 * g + 3] = bfhi(w.y); }
}
DI void st_tile(LAS bf16* Mx, const f32x16& acc, int ti, int tj, int l31, int hh) {
#pragma unroll
    for (int g = 0; g < 4; ++g) { u32x2 w; w.x = pk2(acc[4 * g], acc[4 * g + 1]); w.y = pk2(acc[4 * g + 2], acc[4 * g + 3]);
        *(LAS u32x2*)(Mx + sw_el(32 * ti + l31, 32 * tj + 8 * g + 4 * hh)) = w; }
}
DI void st_native_global(bf16* Tm, const f32x16& acc, int tile, int lane) {
    u32x4 a, b;
    a.x = pk2(acc[0], acc[1]); a.y = pk2(acc[2], acc[3]); a.z = pk2(acc[4], acc[5]); a.w = pk2(acc[6], acc[7]);
    b.x = pk2(acc[8], acc[9]); b.y = pk2(acc[10], acc[11]); b.z = pk2(acc[12], acc[13]); b.w = pk2(acc[14], acc[15]);
    u32x4* d = (u32x4*)(Tm + (size_t)tile * 1024 + lane * 8); d[0] = a; d[64] = b;
}
DI void ld_native_global(f32x16& acc, const bf16* Tm, int tile, int lane) {
    const u32x4* d = (const u32x4*)(Tm + (size_t)tile * 1024 + lane * 8); const u32x4 a = d[0], b = d[64];
    acc[0] = bflo(a.x); acc[1] = bfhi(a.x); acc[2] = bflo(a.y); acc[3] = bfhi(a.y); acc[4] = bflo(a.z); acc[5] = bfhi(a.z); acc[6] = bflo(a.w); acc[7] = bfhi(a.w);
    acc[8] = bflo(b.x); acc[9] = bfhi(b.x); acc[10] = bflo(b.y); acc[11] = bfhi(b.y); acc[12] = bflo(b.z); acc[13] = bfhi(b.z); acc[14] = bflo(b.w); acc[15] = bfhi(b.w);
}
DI bf16x8 pack8(const f32x16& x, int s) {
    u32x4 w; w.x = pk2(x[8 * s], x[8 * s + 1]); w.y = pk2(x[8 * s + 2], x[8 * s + 3]); w.z = pk2(x[8 * s + 4], x[8 * s + 5]); w.w = pk2(x[8 * s + 6], x[8 * s + 7]);
    return __builtin_bit_cast(bf16x8, w);
}
DI bf16x8 frag_col_perm(const LAS bf16* Mx, int kb16, int colbase, int lane) {
    const int i16 = lane & 15, q = i16 >> 2, pp = i16 & 3, blk = (lane >> 4) & 1, hh = lane >> 5, col = colbase + 16 * blk + 4 * pp;
    const s16x4 lo = tr_read(Mx + sw_el(kb16 + 4 * hh + q, col)), hi = tr_read(Mx + sw_el(kb16 + 8 + 4 * hh + q, col));
    return __builtin_shufflevector(lo, hi, 0, 1, 2, 3, 4, 5, 6, 7);
}
DI void mm32_acc(f32x16& C, const f32x16& A, const LAS bf16* Bm, int kb, int colbase, int lane) {
    const bf16x8 a0 = pack8(A, 0), a1 = pack8(A, 1);
    C = __builtin_amdgcn_mfma_f32_32x32x16_bf16(frag_col_perm(Bm, kb, colbase, lane), a0, C, 0, 0, 0);
    C = __builtin_amdgcn_mfma_f32_32x32x16_bf16(frag_col_perm(Bm, kb + 16, colbase, lane), a1, C, 0, 0, 0);
}
DI u32x4 pack8f(const float* v) { u32x4 o; o.x = pk2(v[0], v[1]); o.y = pk2(v[2], v[3]); o.z = pk2(v[4], v[5]); o.w = pk2(v[6], v[7]); return o; }

DI void phase3c(const Params& p, LAS unsigned char* lds) {
    const int tid0 = threadIdx.x, wave = __builtin_amdgcn_readfirstlane(tid0 >> 6);
    const int half = wave >> 2, lw = wave & 3, ti = (lw >> 1) & 1, tj = lw & 1;
    const bf16* cas = (const bf16*)(p.ws + WS_CAS);
    LAS unsigned char* hb = lds + half * 65536;
#define SL(i) ((LAS bf16*)(hb + (i) * SLOTB))
    LAS float* F1 = (LAS float*)(hb);
    LAS float* F2 = (LAS float*)(hb + 2 * SLOTB);
    LAS float* gam = (LAS float*)(lds + 131072) + half * 64;
    LAS float* tot = (LAS float*)(lds + 131072 + 512) + half * 256;
    LAS float* parL = (LAS float*)(lds + 131072 + 512 + 2048) + half * 640;
    int par_h = -1;
#define LDS_BAR() asm volatile("s_waitcnt lgkmcnt(0)\n\ts_barrier" ::: "memory")
    u32x4 nwd[2], nad[2], npw[2], npa[2];
#define E1_FETCH(PR) do { const int it_ = 2 * (PR) + half; const int c_ = it_ & 31; const size_t me_ = (size_t)(it_ >> 8) * SEQ + 64 * c_ + ((tid0 & 255) >> 2); \
        const bool hp_ = (64 * c_ + ((tid0 & 255) >> 2)) > 0; const int j16_ = (tid0 & 3) * 16; \
        _Pragma("unroll") for (int sp = 0; sp < 2; ++sp) { \
            nwd[sp] = *(const u32x4*)(cas + me_ * LD_CAS + WD0 + j16_ + 8 * sp); nad[sp] = *(const u32x4*)(cas + me_ * LD_CAS + AD0 + j16_ + 8 * sp); \
            npw[sp] = *(const u32x4*)(cas + (me_ - (hp_ ? 1 : 0)) * LD_CAS + WD0 + j16_ + 8 * sp); npa[sp] = *(const u32x4*)(cas + (me_ - (hp_ ? 1 : 0)) * LD_CAS + AD0 + j16_ + 8 * sp); } } while (0)
    unsigned pf0 = 0u, pf1 = 0u;
    if ((int)blockIdx.x < 2048) E1_FETCH((int)blockIdx.x);
#pragma unroll
    for (int k = 0; k < 8; ++k) *(u32x4*)(p.ws + WS_DUMMY + (size_t)k * 8192 + tid0 * 16) = (u32x4){0u, 0u, 0u, 0u};
    for (int pr = blockIdx.x; pr < 2048; pr += gridDim.x) {
        int tid = tid0; asm volatile("" : "+v"(tid));
        const int lane = tid & 63, l31 = lane & 31, hh = lane >> 5, ltid = tid & 255;
        const int item = 2 * pr + half;
        const int c = item & 31, h = (item >> 5) & 7, b = item >> 8;
        const size_t m0 = (size_t)b * SEQ + 64 * c;
        const int te = ltid >> 2, c16 = (ltid & 3) * 16; const size_t me = m0 + te; const bool hpv = (64 * c + te) > 0;
        if (h != par_h) {
            par_h = h;
            for (int i = ltid; i < 640; i += 256) { const int rw = i >> 6, cc = i & 63; float v;
                if (rw == 0) v = p.w0[h * 64 + cc]; else if (rw == 1) v = p.a0[h * 64 + cc]; else if (rw == 2) v = p.k_k[h * 64 + cc]; else if (rw == 3) v = p.k_a[h * 64 + cc];
                else if (rw == 4) v = p.r_k[h * 64 + cc]; else if (rw < 8) v = p.shift_mu[(rw - 5) * 512 + h * 64 + cc]; else v = p.shift_mu[1536 + (rw - 8) * 64 + cc];
                parL[i] = v; }
            LDS_BAR();
        }
        u32x4 gk[2], gr[2], gv[2], gkp[2], grp[2], gvp[2];
#pragma unroll
        for (int sp = 0; sp < 2; ++sp) { const int hc8 = h * 64 + c16 + 8 * sp;
            gk[sp] = *(const u32x4*)(cas + me * LD_CAS + K0 + hc8); gr[sp] = *(const u32x4*)(cas + me * LD_CAS + R0 + hc8); gv[sp] = *(const u32x4*)(cas + me * LD_CAS + V0 + hc8);
            const size_t mp = me - (hpv ? 1 : 0);
            gkp[sp] = *(const u32x4*)(cas + mp * LD_CAS + K0 + hc8); grp[sp] = *(const u32x4*)(cas + mp * LD_CAS + R0 + hc8); gvp[sp] = *(const u32x4*)(cas + mp * LD_CAS + V0 + hc8); }
        bf16x8 wfr[2][4];
#pragma unroll
        for (int pd = 0; pd < 2; ++pd) { const bf16* wt = (const bf16*)(p.ws + (pd ? WS_WLA_T : WS_WLW_T)) + (size_t)(h * 64 + 32 * tj + l31) * 64;
#pragma unroll
            for (int s = 0; s < 4; ++s) wfr[pd][s] = *(const bf16x8*)(wt + 16 * s + 8 * hh); }
#pragma unroll
        for (int sp = 0; sp < 2; ++sp) {
            const int j8 = c16 + 8 * sp;
            float wd[8], ad[8], pw[8], pa[8];
            asm volatile("" : "+v"(npw[sp]), "+v"(npa[sp]));
            unpack8(nwd[sp], wd); unpack8(nad[sp], ad); unpack8(hpv ? npw[sp] : (u32x4){0u, 0u, 0u, 0u}, pw); unpack8(hpv ? npa[sp] : (u32x4){0u, 0u, 0u, 0u}, pa);
#pragma unroll
            for (int i = 0; i < 8; ++i) { const float x = wd[i] + (pw[i] - wd[i]) * parL[512 + j8 + i]; const float e2 = __expf(2.f * x); wd[i] = 1.f - 2.f * __builtin_amdgcn_rcpf(e2 + 1.f);
                ad[i] = ad[i] + (pa[i] - ad[i]) * parL[576 + j8 + i]; }
            *(LAS u32x4*)(SL(6) + sw_el(te, j8)) = pack8f(wd);
            *(LAS u32x4*)(SL(7) + sw_el(te, j8)) = pack8f(ad);
        }
        E1_FETCH(min(pr + (int)gridDim.x, 2047));
        LDS_BAR();
#pragma unroll
        for (int pd = 0; pd < 2; ++pd) {
            const LAS bf16* Am = pd ? SL(7) : SL(6);
            f32x16 acc = {};
#pragma unroll
            for (int s = 0; s < 4; ++s) { const int k0 = 16 * s + 8 * hh;
                const bf16x8 y = frag_row(Am, 32 * ti + l31, k0);
                acc = __builtin_amdgcn_mfma_f32_32x32x16_bf16(wfr[pd][s], y, acc, 0, 0, 0); }
            LAS float* F = pd ? F2 : F1;
#pragma unroll
            for (int g = 0; g < 4; ++g) *(LAS f32x4*)(F + swf_el(32 * ti + l31, 32 * tj + 8 * g + 4 * hh)) = (f32x4){acc[4 * g], acc[4 * g + 1], acc[4 * g + 2], acc[4 * g + 3]};
        }
        LDS_BAR();
        asm volatile("" :: "v"(pf0), "v"(pf1));
        float lw16[16], av16[16], bv16[16], km16[16], rs16[16];
        {
            float kraw[16], icl[16]; float ss = 0.f, bon = 0.f;
#pragma unroll
            for (int sp = 0; sp < 2; ++sp) {
                const int c8 = c16 + 8 * sp, hc8 = h * 64 + c8;
                float kc_[8], kp_[8], rc_[8], rp_[8], vc_[8], vp_[8];
                asm volatile("" : "+v"(gkp[sp]), "+v"(grp[sp]), "+v"(gvp[sp]));
                const u32x4 z4 = {0u, 0u, 0u, 0u};
                unpack8(gk[sp], kc_); unpack8(gr[sp], rc_); unpack8(gv[sp], vc_); unpack8(hpv ? gkp[sp] : z4, kp_); unpack8(hpv ? grp[sp] : z4, rp_); unpack8(hpv ? gvp[sp] : z4, vp_);
                const f32x4 z0 = *(const LAS f32x4*)(F1 + swf_el(te, c8)), z1 = *(const LAS f32x4*)(F1 + swf_el(te, c8 + 4));
                const f32x4 a0_ = *(const LAS f32x4*)(F2 + swf_el(te, c8)), a1_ = *(const LAS f32x4*)(F2 + swf_el(te, c8 + 4));
                const float zz[8] = {z0[0], z0[1], z0[2], z0[3], z1[0], z1[1], z1[2], z1[3]}, ap[8] = {a0_[0], a0_[1], a0_[2], a0_[3], a1_[0], a1_[1], a1_[2], a1_[3]};
                float vs[8];
#pragma unroll
                for (int i = 0; i < 8; ++i) {
                    const int e = 8 * sp + i;
                    const int pc = c8 + i;
                    const float ks = kc_[i] + (kp_[i] - kc_[i]) * parL[384 + pc];
                    rs16[e] = rc_[i] + (rp_[i] - rc_[i]) * parL[320 + pc];
                    vs[i] = vc_[i] + (vp_[i] - vc_[i]) * parL[448 + pc];
                    const float nz = -(parL[pc] + zz[i]), spv = nz > 20.f ? nz : __logf(1.f + __expf(nz));
                    lw16[e] = -__expf(-spv - 0.5f);
                    icl[e] = sigmoidf_(parL[64 + pc] + ap[i]);
                    kraw[e] = ks * parL[128 + pc]; ss += kraw[e] * kraw[e];
                    km16[e] = ks * (1.f + (icl[e] - 1.f) * parL[192 + pc]);
                    bon += rs16[e] * km16[e] * parL[256 + pc];
                }
                *(LAS u32x4*)(SL(7) + sw_el(te, c8)) = pack8f(vs);
            }
            ss += __shfl_xor(ss, 1); ss += __shfl_xor(ss, 2); bon += __shfl_xor(bon, 1); bon += __shfl_xor(bon, 2);
            const float rn = rsqrtf(fmaxf(ss, 1e-24f));
#pragma unroll
            for (int e = 0; e < 16; ++e) { const float kk = kraw[e] * rn; av16[e] = -kk; bv16[e] = kk * icl[e]; }
#pragma unroll
            for (int q4 = 0; q4 < 4; ++q4) *(LAS f32x4*)(F1 + swf_el(te, c16 + 4 * q4)) = (f32x4){lw16[4 * q4], lw16[4 * q4 + 1], lw16[4 * q4 + 2], lw16[4 * q4 + 3]};
            if ((ltid & 3) == 0) ((float*)(p.ws + WS_BONUS))[me * 8 + h] = bon;
        }
        LDS_BAR();
        {
            const int cc = ltid & 63, tq = ltid >> 6;
            float L[16]; L[0] = F1[swf_el(16 * tq, cc)];
#pragma unroll
            for (int i = 1; i < 16; ++i) L[i] = L[i - 1] + F1[swf_el(16 * tq + i, cc)];
            tot[tq * 64 + cc] = L[15];
            LDS_BAR();
            float off = 0.f;
            for (int q = 0; q < tq; ++q) off += tot[q * 64 + cc];
#pragma unroll
            for (int i = 0; i < 16; ++i) F1[swf_el(16 * tq + i, cc)] = off + L[i];
            if (tq == 3) gam[cc] = __expf(off + L[15]);
        }
        LDS_BAR();
        {
            float Lt[16];
#pragma unroll
            for (int q4 = 0; q4 < 4; ++q4) { const f32x4 a = *(const LAS f32x4*)(F1 + swf_el(te, c16 + 4 * q4)); Lt[4 * q4] = a[0]; Lt[4 * q4 + 1] = a[1]; Lt[4 * q4 + 2] = a[2]; Lt[4 * q4 + 3] = a[3]; }
#pragma unroll
            for (int sp = 0; sp < 2; ++sp) {
                float oa[8], ob[8], ok[8], orr[8];
#pragma unroll
                for (int i = 0; i < 8; ++i) { const int e = 8 * sp + i; const float ep = __expf(Lt[e]), en = __builtin_amdgcn_rcpf(ep), e3 = __expf(Lt[e] - lw16[e]);
                    oa[i] = av16[e] * e3; ob[i] = bv16[e] * en; ok[i] = km16[e] * en; orr[i] = rs16[e] * ep; }
                *(LAS u32x4*)(SL(4) + sw_el(te, c16 + 8 * sp)) = pack8f(oa);
                *(LAS u32x4*)(SL(5) + sw_el(te, c16 + 8 * sp)) = pack8f(ob);
                *(LAS u32x4*)(SL(6) + sw_el(te, c16 + 8 * sp)) = pack8f(ok);
                *(LAS u32x4*)(SL(3) + sw_el(te, c16 + 8 * sp)) = pack8f(orr);
            }
        }
        LDS_BAR();
        { const int itn = 2 * min(pr + (int)gridDim.x, 2047) + half; const int w3 = ltid & 3;
          const bf16* rowp = cas + ((size_t)(itn >> 8) * SEQ + 64 * (itn & 31) + te) * LD_CAS + (w3 == 1 ? R0 : w3 == 2 ? V0 : K0) + ((itn >> 5) & 7) * 64;
          pf0 = *(const unsigned*)rowp; pf1 = *(const unsigned*)(rowp + 56); }
        u32x2 rtw[4]; f32x16 y2p, dp;
        {
            const int row = 32 * ti + l31;
            bf16x8 aA[4], aR[4], bB[4], bK0[4], bK1[4];
#pragma unroll
            for (int s = 0; s < 4; ++s) { const int k0 = 16 * s + 8 * hh;
                aA[s] = frag_row(SL(4), row, k0); aR[s] = frag_row(SL(3), row, k0); bB[s] = frag_row(SL(5), 32 * tj + l31, k0);
                bK0[s] = frag_row(SL(6), l31, k0); bK1[s] = frag_row(SL(6), 32 + l31, k0); }
            f32x16 acc = {};
#pragma unroll
            for (int s = 0; s < 4; ++s) acc = __builtin_amdgcn_mfma_f32_32x32x16_bf16(bB[s], aA[s], acc, 0, 0, 0);
#pragma unroll
            for (int r = 0; r < 16; ++r) acc[r] = (32 * tj + crow(r, hh) < row) ? acc[r] : 0.f;
            st_tile(SL(0), acc, ti, tj, l31, hh);
            acc = (f32x16){};
#pragma unroll
            for (int s = 0; s < 4; ++s) acc = __builtin_amdgcn_mfma_f32_32x32x16_bf16(tj ? bK1[s] : bK0[s], aA[s], acc, 0, 0, 0);
#pragma unroll
            for (int r = 0; r < 16; ++r) acc[r] = (32 * tj + crow(r, hh) < row) ? acc[r] : 0.f;
            st_tile(SL(2), acc, ti, tj, l31, hh);
            acc = (f32x16){};
#pragma unroll
            for (int s = 0; s < 4; ++s) acc = __builtin_amdgcn_mfma_f32_32x32x16_bf16(bB[s], aR[s], acc, 0, 0, 0);
#pragma unroll
            for (int r = 0; r < 16; ++r) acc[r] = (32 * tj + crow(r, hh) <= row) ? acc[r] : 0.f;
            st_tile(SL(1), acc, ti, tj, l31, hh);
            f32x16 ak0 = {}, ak1 = {};
#pragma unroll
            for (int s = 0; s < 4; ++s) ak0 = __builtin_amdgcn_mfma_f32_32x32x16_bf16(bK0[s], aR[s], ak0, 0, 0, 0);
#pragma unroll
            for (int r = 0; r < 16; ++r) ak0[r] = (crow(r, hh) <= row) ? ak0[r] : 0.f;
            y2p = (f32x16){};
            mm32_acc(y2p, ak0, SL(7), 0, 32 * tj, lane);
            if (ti) {
#pragma unroll
                for (int s = 0; s < 4; ++s) ak1 = __builtin_amdgcn_mfma_f32_32x32x16_bf16(bK1[s], aR[s], ak1, 0, 0, 0);
#pragma unroll
                for (int r = 0; r < 16; ++r) ak1[r] = (32 + crow(r, hh) <= row) ? ak1[r] : 0.f;
                mm32_acc(y2p, ak1, SL(7), 32, 32 * tj, lane);
            }
            dp = (f32x16){};
            mm_acc<true, false>(dp, SL(7), SL(6), ti, tj, lane);
#pragma unroll
            for (int g = 0; g < 4; ++g) rtw[g] = *(const LAS u32x2*)(SL(3) + sw_el(row, 32 * tj + 8 * g + 4 * hh));
        }
        LDS_BAR();
        if (lw == 0) {
            f32x16 Q0, Q1, T0, T1;
            ld_tile(Q0, SL(0), 0, 0, l31, hh); ld_tile(Q1, SL(0), 1, 1, l31, hh);
#pragma unroll
            for (int r = 0; r < 16; ++r) { const float idn = (crow(r, hh) == l31) ? 1.f : 0.f; T0[r] = Q0[r] + idn; T1[r] = Q1[r] + idn; }
            { f32x16 S0 = {}, S1 = {}; mm32_acc(S0, Q0, SL(0), 0, 0, lane); mm32_acc(S1, Q1, SL(0), 32, 32, lane); Q0 = S0; Q1 = S1; }
#pragma unroll
            for (int k = 1; k <= 4; ++k) {
                st_tile(SL(3), Q0, 0, 0, l31, hh); st_tile(SL(3), Q1, 1, 1, l31, hh);
                const bf16x8 b00 = frag_col_perm(SL(3), 0, 0, lane), b01 = frag_col_perm(SL(3), 16, 0, lane);
                const bf16x8 b10 = frag_col_perm(SL(3), 32, 32, lane), b11 = frag_col_perm(SL(3), 48, 32, lane);
                const bf16x8 t00 = pack8(T0, 0), t01 = pack8(T0, 1), t10 = pack8(T1, 0), t11 = pack8(T1, 1);
                T0 = __builtin_amdgcn_mfma_f32_32x32x16_bf16(b00, t00, T0, 0, 0, 0); T1 = __builtin_amdgcn_mfma_f32_32x32x16_bf16(b10, t10, T1, 0, 0, 0);
                T0 = __builtin_amdgcn_mfma_f32_32x32x16_bf16(b01, t01, T0, 0, 0, 0); T1 = __builtin_amdgcn_mfma_f32_32x32x16_bf16(b11, t11, T1, 0, 0, 0);
                if (k < 4) {
                    const bf16x8 q00 = pack8(Q0, 0), q01 = pack8(Q0, 1), q10 = pack8(Q1, 0), q11 = pack8(Q1, 1);
                    f32x16 S0 = {}, S1 = {};
                    S0 = __builtin_amdgcn_mfma_f32_32x32x16_bf16(b00, q00, S0, 0, 0, 0); S1 = __builtin_amdgcn_mfma_f32_32x32x16_bf16(b10, q10, S1, 0, 0, 0);
                    S0 = __builtin_amdgcn_mfma_f32_32x32x16_bf16(b01, q01, S0, 0, 0, 0); S1 = __builtin_amdgcn_mfma_f32_32x32x16_bf16(b11, q11, S1, 0, 0, 0);
                    Q0 = S0; Q1 = S1;
                }
            }
            st_tile(SL(3), T0, 0, 0, l31, hh); st_tile(SL(3), T1, 1, 1, l31, hh);
            { const f32x16 z = {}; st_tile(SL(3), z, 0, 1, l31, hh); }
            f32x16 Mx = {};
#pragma unroll
            for (int s = 0; s < 2; ++s) { const int k0 = 16 * s + 8 * hh;
                Mx = __builtin_amdgcn_mfma_f32_32x32x16_bf16(frag_col(SL(3), k0, 0, lane), frag_row(SL(0), 32 + l31, k0), Mx, 0, 0, 0); }
            st_tile(SL(3), Mx, 1, 0, l31, hh);
            f32x16 T21 = {};
            mm32_acc(T21, T1, SL(3), 32, 0, lane);
            st_tile(SL(3), T21, 1, 0, l31, hh);
        } else if (lw == 3) {
            f32x16 x0 = {}, x1 = {};
#pragma unroll
            for (int s = 0; s < 2; ++s) { const int k0 = 16 * s + 8 * hh; const bf16x8 a = frag_row(SL(2), l31, k0);
                x0 = __builtin_amdgcn_mfma_f32_32x32x16_bf16(frag_col(SL(7), k0, 0, lane), a, x0, 0, 0, 0);
                x1 = __builtin_amdgcn_mfma_f32_32x32x16_bf16(frag_col(SL(7), k0, 32, lane), a, x1, 0, 0, 0); }
            st_tile(SL(6), x0, 0, 0, l31, hh); st_tile(SL(6), x1, 0, 1, l31, hh);
        } else {
            f32x16 x = {}; mm_acc<false, false>(x, SL(2), SL(7), 1, lw - 1, lane); st_tile(SL(6), x, 1, lw - 1, l31, hh);
        }
        LDS_BAR();
        { f32x16 acc = {}; mm_acc<false, false>(acc, SL(3), SL(4), ti, tj, lane); st_tile(SL(0), acc, ti, tj, l31, hh);
          f32x16 a2 = {}; mm_acc<false, false>(a2, SL(3), SL(6), ti, tj, lane); st_tile(SL(2), a2, ti, tj, l31, hh); }
        LDS_BAR();
        {
            unsigned char* ob = (unsigned char*)p.out;
            { f32x16 acc;
#pragma unroll
              for (int g = 0; g < 4; ++g) { acc[4 * g] = bflo(rtw[g].x); acc[4 * g + 1] = bfhi(rtw[g].x); acc[4 * g + 2] = bflo(rtw[g].y); acc[4 * g + 3] = bfhi(rtw[g].y); }
              mm_acc<false, false>(acc, SL(1), SL(0), ti, tj, lane);
              st_native_global((bf16*)(ob + OUT_Y1) + (size_t)item * 4096, acc, ti * 2 + tj, lane); }
            { f32x16 g2 = {};
              mm_acc<true, false>(g2, SL(5), SL(0), ti, tj, lane);
              const float gm = gam[32 * ti + l31];
#pragma unroll
              for (int r = 0; r < 16; ++r) g2[r] = (g2[r] + ((32 * tj + crow(r, hh) == 32 * ti + l31) ? 1.f : 0.f)) * gm;
              st_native_global((bf16*)(ob + OUT_G) + (size_t)item * 4096, g2, ti * 2 + tj, lane); }
            { mm_acc<false, false>(y2p, SL(1), SL(2), ti, tj, lane);
              st_native_global((bf16*)(ob + OUT_Y2) + (size_t)item * 4096, y2p, tj * 2 + ti, lane); }
            { mm_acc<true, false>(dp, SL(2), SL(5), ti, tj, lane);
#pragma unroll
              for (int r = 0; r < 16; ++r) dp[r] *= gam[32 * tj + crow(r, hh)];
              st_native_global((bf16*)(ob + OUT_D) + (size_t)item * 4096, dp, tj * 2 + ti, lane); }
        }
    }
#undef SL
#undef LDS_BAR
#undef E1_FETCH
}

DI void phase5a(const Params& p) {
    const int tid = threadIdx.x, lane = tid & 63, wave = tid >> 6, l31 = lane & 31, hh = lane >> 5;
    if (blockIdx.x >= 16) return;
    const unsigned char* ob = (const unsigned char*)p.out;
    {
        const int chain = blockIdx.x * 8 + wave;
        f32x16 H[2][2];
#pragma unroll
        for (int a = 0; a < 2; ++a)
#pragma unroll
            for (int c2 = 0; c2 < 2; ++c2) H[a][c2] = (f32x16){};
        bf16x8 gf[2][2][2];
        { const bf16* Gp = (const bf16*)(ob + OUT_G) + (size_t)chain * 32 * 4096;
#pragma unroll
          for (int ti = 0; ti < 2; ++ti)
#pragma unroll
              for (int tk = 0; tk < 2; ++tk)
#pragma unroll
                  for (int s = 0; s < 2; ++s) gf[ti][tk][s] = *(const bf16x8*)(Gp + (ti * 2 + tk) * 1024 + 512 * s + lane * 8); }
        for (int c = 0; c < 32; ++c) {
            const size_t item = (size_t)chain * 32 + c;
            const bf16* Dn = (const bf16*)(ob + OUT_D) + item * 4096;
            bf16x8 gn[2][2][2];
            { const bf16* Gp = (const bf16*)(ob + OUT_G) + (item + (c < 31 ? 1 : 0)) * 4096;
#pragma unroll
              for (int ti = 0; ti < 2; ++ti)
#pragma unroll
                  for (int tk = 0; tk < 2; ++tk)
#pragma unroll
                      for (int s = 0; s < 2; ++s) gn[ti][tk][s] = *(const bf16x8*)(Gp + (ti * 2 + tk) * 1024 + 512 * s + lane * 8); }
            f32x16 Dv[2][2];
#pragma unroll
            for (int ti = 0; ti < 2; ++ti)
#pragma unroll
                for (int tj = 0; tj < 2; ++tj) ld_native_global(Dv[ti][tj], Dn, ti * 2 + tj, lane);
            bf16x8 hp[2][2][2];
            u32x4* hs = (u32x4*)((bf16*)(p.ws + WS_HS) + item * 4096);
#pragma unroll
            for (int tk = 0; tk < 2; ++tk)
#pragma unroll
                for (int tj = 0; tj < 2; ++tj)
#pragma unroll
                    for (int s = 0; s < 2; ++s) { hp[tk][tj][s] = pack8(H[tk][tj], s); hs[((tk * 2 + tj) * 2 + s) * 64 + lane] = __builtin_bit_cast(u32x4, hp[tk][tj][s]); }
#pragma unroll
            for (int ti = 0; ti < 2; ++ti)
#pragma unroll
                for (int tj = 0; tj < 2; ++tj) {
                    f32x16 acc = Dv[ti][tj];
#pragma unroll
                    for (int tk = 0; tk < 2; ++tk)
#pragma unroll
                        for (int s = 0; s < 2; ++s) acc = __builtin_amdgcn_mfma_f32_32x32x16_bf16(gf[ti][tk][s], hp[tk][tj][s], acc, 0, 0, 0);
                    H[ti][tj] = acc;
                }
#pragma unroll
            for (int ti = 0; ti < 2; ++ti)
#pragma unroll
                for (int tk = 0; tk < 2; ++tk)
#pragma unroll
                    for (int s = 0; s < 2; ++s) gf[ti][tk][s] = gn[ti][tk][s];
        }
    }
    asm volatile("s_waitcnt vmcnt(0)" ::: "memory");
    __syncthreads();
    if (tid == 0) { __builtin_amdgcn_fence(__ATOMIC_RELEASE, "agent"); asm volatile("s_waitcnt vmcnt(0)" ::: "memory");
        __hip_atomic_fetch_add((unsigned*)(p.ws + WS_CTL) + 12288, 1u, __ATOMIC_RELAXED, __HIP_MEMORY_SCOPE_AGENT); }
}
DI void phase5b(const Params& p, LAS unsigned char* lds) {
    const int tid0 = threadIdx.x, wave = __builtin_amdgcn_readfirstlane(tid0 >> 6);
    const bf16* cas = (const bf16*)(p.ws + WS_CAS); const bf16* cr = (const bf16*)(p.ws + WS_CR);
    const unsigned char* ob = (const unsigned char*)p.out;
    LAS float* Zl = (LAS float*)(lds + wave * 17408);
    LAS unsigned* qL = (LAS unsigned*)(lds + 8 * 17408);
    __syncthreads();
    if (tid0 == 0) { unsigned* done = (unsigned*)(p.ws + WS_CTL) + 12288; unsigned sp = 0;
        while (__hip_atomic_load(done, __ATOMIC_RELAXED, __HIP_MEMORY_SCOPE_AGENT) < 16u) { __builtin_amdgcn_s_sleep(4); if (++sp > (1u << 24)) break; }
        __builtin_amdgcn_fence(__ATOMIC_ACQUIRE, "agent"); asm volatile("s_waitcnt vmcnt(0)" ::: "memory"); }
    __syncthreads();
    unsigned* q5 = (unsigned*)(p.ws + WS_CTL) + 12352;
    for (;;) {
        if (tid0 == 0) qL[0] = atomicAdd(q5, 1u);
        __syncthreads();
        const unsigned qb = qL[0];
        __syncthreads();
        if (qb >= 512u) break;
        const int item = (int)qb * 8 + wave;
        int tid = tid0; asm volatile("" : "+v"(tid));
        const int lane = tid & 63, l31 = lane & 31, hh = lane >> 5;
        const int c = item & 31, h = (item >> 5) & 7, b = item >> 8;
        const bf16* Y1p = (const bf16*)(ob + OUT_Y1) + (size_t)item * 4096; const bf16* Y2n = (const bf16*)(ob + OUT_Y2) + (size_t)item * 4096;
        const u32x4* hs = (const u32x4*)((const bf16*)(p.ws + WS_HS) + (size_t)item * 4096);
        bf16x8 hp[2][2][2];
#pragma unroll
        for (int tk = 0; tk < 2; ++tk)
#pragma unroll
            for (int tj = 0; tj < 2; ++tj)
#pragma unroll
                for (int s = 0; s < 2; ++s) hp[tk][tj][s] = __builtin_bit_cast(bf16x8, hs[((tk * 2 + tj) * 2 + s) * 64 + lane]);
#pragma unroll
        for (int tt = 0; tt < 2; ++tt) {
            f32x16 Z[2];
#pragma unroll
            for (int vj = 0; vj < 2; ++vj) {
                ld_native_global(Z[vj], Y2n, vj * 2 + tt, lane);
#pragma unroll
                for (int tk = 0; tk < 2; ++tk)
#pragma unroll
                    for (int s = 0; s < 2; ++s) {
                        const bf16x8 bb = *(const bf16x8*)(Y1p + (tt * 2 + tk) * 1024 + 512 * s + lane * 8);
                        Z[vj] = __builtin_amdgcn_mfma_f32_32x32x16_bf16(hp[tk][vj][s], bb, Z[vj], 0, 0, 0);
                    }
            }
            float sum = 0.f;
#pragma unroll
            for (int vj = 0; vj < 2; ++vj)
#pragma unroll
                for (int r = 0; r < 16; ++r) sum += Z[vj][r];
            sum += __shfl_xor(sum, 32);
            const float mean = sum * (1.f / 64.f);
            float sq = 0.f;
#pragma unroll
            for (int vj = 0; vj < 2; ++vj)
#pragma unroll
                for (int r = 0; r < 16; ++r) { const float d = Z[vj][r] - mean; sq += d * d; }
            sq += __shfl_xor(sq, 32);
            const float rstd = rsqrtf(sq * (1.f / 64.f) + 64e-5f);
#pragma unroll
            for (int vj = 0; vj < 2; ++vj)
#pragma unroll
                for (int g = 0; g < 4; ++g)
                    *(LAS f32x4*)(Zl + (32 * tt + l31) * 68 + 32 * vj + 8 * g + 4 * hh) =
                        (f32x4){(Z[vj][4 * g] - mean) * rstd, (Z[vj][4 * g + 1] - mean) * rstd, (Z[vj][4 * g + 2] - mean) * rstd, (Z[vj][4 * g + 3] - mean) * rstd};
        }
        const int v8 = (lane & 7) * 8, col = h * 64 + v8;
        float mu[8], lw[8], lb[8];
#pragma unroll
        for (int i = 0; i < 8; ++i) { mu[i] = p.shift_mu[1024 + col + i]; lw[i] = p.ln_x_w[col + i]; lb[i] = p.ln_x_b[col + i]; }
#pragma unroll 2
        for (int ps = 0; ps < 8; ++ps) {
            const int t = ps * 8 + (lane >> 3); const size_t m = (size_t)b * SEQ + 64 * c + t; const bool hprev = (64 * c + t) > 0;
            float cu[8], pv[8], sg[8];
            unpack8(*(const u32x4*)(cas + m * LD_CAS + V0 + col), cu);
            if (hprev) unpack8(*(const u32x4*)(cas + (m - 1) * LD_CAS + V0 + col), pv); else {
#pragma unroll
                for (int i = 0; i < 8; ++i) pv[i] = 0.f; }
            unpack8(*(const u32x4*)(cr + m * LD_CR + BSILU0 + col), sg);
            const float bon = ((const float*)(p.ws + WS_BONUS))[m * 8 + h];
            const f32x4 z0 = *(const LAS f32x4*)(Zl + t * 68 + v8), z1 = *(const LAS f32x4*)(Zl + t * 68 + v8 + 4);
            const float zz[8] = {z0[0], z0[1], z0[2], z0[3], z1[0], z1[1], z1[2], z1[3]};
            float o[8];
#pragma unroll
            for (int i = 0; i < 8; ++i) { const float vsh = cu[i] + (pv[i] - cu[i]) * mu[i]; o[i] = (zz[i] * lw[i] + lb[i] + bon * vsh) * siluf_(sg[i]); }
            u32x4 w; w.x = pk2(o[0], o[1]); w.y = pk2(o[2], o[3]); w.z = pk2(o[4], o[5]); w.w = pk2(o[6], o[7]);
            *(u32x4*)((bf16*)(p.ws + WS_YB) + m * 512 + col) = w;
        }
    }
}

constexpr int A_STAGE = 81920, A_TILE = 8192;
DI int swz_off(int row, int chunk) { return row * 128 + ((chunk ^ ((row >> 1) & 7)) << 4); }
DI void attn_qk(f32x16& s0, f32x16& s1, const LAS unsigned char* kl, const bf16x8 (&qr)[4], const f32x16& cinit, int l31, int hh) {
#pragma unroll
    for (int d0 = 0; d0 < 4; ++d0) {
        const bf16x8 k0f = *(const LAS bf16x8*)(kl + swz_off(l31, 2 * d0 + hh));
        const bf16x8 k1f = *(const LAS bf16x8*)(kl + swz_off(32 + l31, 2 * d0 + hh));
        s0 = __builtin_amdgcn_mfma_f32_32x32x16_bf16(k0f, qr[d0], d0 == 0 ? cinit : s0, 0, 0, 0);
        s1 = __builtin_amdgcn_mfma_f32_32x32x16_bf16(k1f, qr[d0], d0 == 0 ? cinit : s1, 0, 0, 0);
    }
}
DI void attn_sv(f32x16& s0, f32x16& s1, const LAS unsigned char* vl, int key0, int tq, bool laneok, int tmin, const LAS float* bl, bool win, bool bound,
                float& m_run, float& l_run, f32x16 (&O)[2], int l31, int hh) {
    const bool far = (tmin - (key0 + 63)) >= 128;
    const bool fast = far && !bound;
    int dbase = tq - key0; asm volatile("" : "+v"(dbase));
    float rm = -1e30f, cb = 0.f;
    if (fast) {
        cb = bl[128];
#pragma unroll
        for (int r = 0; r < 16; ++r) rm = fmaxf(rm, fmaxf(s0[r], s1[r]));
        rm = laneok ? rm + cb : -1e30f;
    } else {
        const int dmax = win ? 512 : 0x7fffffff, dmin = bound ? 0 : -0x7fffffff;
#pragma unroll
        for (int r = 0; r < 16; ++r) {
            const int d0_ = dbase - crow(r, hh), d1_ = d0_ - 32;
            const bool v0 = laneok && d0_ >= dmin && d0_ < dmax, v1 = laneok && d1_ >= dmin && d1_ < dmax;
            const float b0 = bl[min(max(d0_, 0), 128)], b1 = bl[min(max(d1_, 0), 128)];
            s0[r] = v0 ? s0[r] + b0 : -1e30f; s1[r] = v1 ? s1[r] + b1 : -1e30f;
            rm = fmaxf(rm, fmaxf(s0[r], s1[r]));
        }
    }
    rm = fmaxf(rm, __shfl_xor(rm, 32));
    if (__any(rm > m_run + 8.f)) {
        const float m_new = fmaxf(m_run, rm), alpha = __builtin_amdgcn_exp2f(m_run - m_new);
        l_run *= alpha; m_run = m_new;
#pragma unroll
        for (int dt = 0; dt < 2; ++dt)
#pragma unroll
            for (int r = 0; r < 16; ++r) O[dt][r] *= alpha;
    }
    const float sh = m_run - cb;
    float rs = 0.f;
    if (fast) {
#pragma unroll
        for (int r = 0; r < 16; ++r) { s0[r] = __builtin_amdgcn_exp2f(s0[r] - sh); s1[r] = __builtin_amdgcn_exp2f(s1[r] - sh); rs += s0[r] + s1[r]; }
        if (!__all(laneok)) { if (!laneok) {
#pragma unroll
            for (int r = 0; r < 16; ++r) { s0[r] = 0.f; s1[r] = 0.f; }
            rs = 0.f; } }
    } else {
#pragma unroll
        for (int r = 0; r < 16; ++r) {
            s0[r] = (s0[r] > -1e29f) ? __builtin_amdgcn_exp2f(s0[r] - sh) : 0.f; s1[r] = (s1[r] > -1e29f) ? __builtin_amdgcn_exp2f(s1[r] - sh) : 0.f;
            rs += s0[r] + s1[r];
        }
    }
    rs += __shfl_xor(rs, 32);
    l_run += rs;
    const bf16x8 p00 = pack8(s0, 0), p01 = pack8(s0, 1), p10 = pack8(s1, 0), p11 = pack8(s1, 1);
#pragma unroll
    for (int dt = 0; dt < 2; ++dt) {
        const int d = 32 * dt + l31;
        O[dt] = __builtin_amdgcn_mfma_f32_32x32x16_bf16(*(const LAS bf16x8*)(vl + swz_off(d, 0 + hh)), p00, O[dt], 0, 0, 0);
        O[dt] = __builtin_amdgcn_mfma_f32_32x32x16_bf16(*(const LAS bf16x8*)(vl + swz_off(d, 2 + hh)), p01, O[dt], 0, 0, 0);
        O[dt] = __builtin_amdgcn_mfma_f32_32x32x16_bf16(*(const LAS bf16x8*)(vl + swz_off(d, 4 + hh)), p10, O[dt], 0, 0, 0);
        O[dt] = __builtin_amdgcn_mfma_f32_32x32x16_bf16(*(const LAS bf16x8*)(vl + swz_off(d, 6 + hh)), p11, O[dt], 0, 0, 0);
    }
}
DI void attn_sv_fast(f32x16& s0, f32x16& s1, const LAS unsigned char* vl, int key0, int tq, bool laneok, int tmin, const LAS float* bl, bool win, bool bound, float cb,
                     float& l_run, f32x16 (&O)[2], int l31, int hh) {
    const bool far = (tmin - (key0 + 63)) >= 128;
    float rs = 0.f;
    if (far && !bound) {
#pragma unroll
        for (int r = 0; r < 16; ++r) { s0[r] = __builtin_amdgcn_exp2f(s0[r]); s1[r] = __builtin_amdgcn_exp2f(s1[r]); }
        if (!__all(laneok)) {
#pragma unroll
            for (int r = 0; r < 16; ++r) { s0[r] = laneok ? s0[r] : 0.f; s1[r] = laneok ? s1[r] : 0.f; }
        }
    } else {
        int dbase = tq - key0; asm volatile("" : "+v"(dbase));
        const int dmax = win ? 512 : 0x7fffffff, dmin = bound ? 0 : -0x7fffffff;
        float b0[16], b1[16];
#pragma unroll
        for (int r = 0; r < 16; ++r) { const int d0_ = dbase - crow(r, hh), d1_ = d0_ - 32; b0[r] = bl[min(max(d0_, 0), 128)]; b1[r] = bl[min(max(d1_, 0), 128)]; }
#pragma unroll
        for (int r = 0; r < 16; ++r) asm volatile("" : "+v"(b0[r]), "+v"(b1[r]));
#pragma unroll
        for (int r = 0; r < 16; ++r) {
            const int d0_ = dbase - crow(r, hh), d1_ = d0_ - 32;
            const bool v0 = laneok && d0_ >= dmin && d0_ < dmax, v1 = laneok && d1_ >= dmin && d1_ < dmax;
            const float e0 = __builtin_amdgcn_exp2f(s0[r] + (b0[r] - cb)), e1 = __builtin_amdgcn_exp2f(s1[r] + (b1[r] - cb));
            s0[r] = v0 ? e0 : 0.f; s1[r] = v1 ? e1 : 0.f;
        }
    }
#pragma unroll
    for (int r = 0; r < 16; ++r) rs += s0[r] + s1[r];
    l_run += rs;
    const bf16x8 p00 = pack8(s0, 0), p01 = pack8(s0, 1), p10 = pack8(s1, 0), p11 = pack8(s1, 1);
#pragma unroll
    for (int dt = 0; dt < 2; ++dt) {
        const int d = 32 * dt + l31;
        O[dt] = __builtin_amdgcn_mfma_f32_32x32x16_bf16(*(const LAS bf16x8*)(vl + swz_off(d, 0 + hh)), p00, O[dt], 0, 0, 0);
        O[dt] = __builtin_amdgcn_mfma_f32_32x32x16_bf16(*(const LAS bf16x8*)(vl + swz_off(d, 2 + hh)), p01, O[dt], 0, 0, 0);
        O[dt] = __builtin_amdgcn_mfma_f32_32x32x16_bf16(*(const LAS bf16x8*)(vl + swz_off(d, 4 + hh)), p10, O[dt], 0, 0, 0);
        O[dt] = __builtin_amdgcn_mfma_f32_32x32x16_bf16(*(const LAS bf16x8*)(vl + swz_off(d, 6 + hh)), p11, O[dt], 0, 0, 0);
    }
}
DI float imp_sum(const LAS float* sL, const LAS float* cL, int q, int j) {
    float v = 0.f;
#pragma unroll
    for (int h4 = 0; h4 < 4; ++h4) { v += sL[(h4 * 64 + q) * 33 + j]; if (j > 0) v += cL[(h4 * 64 + q) * 33 + j]; }
    return v;
}
template <bool FAST>
DI void attn_stream(LAS unsigned char* lds, const bf16* ksel, const bf16* kwin, const bf16* vts, const bf16* vtw, unsigned U, unsigned mysel, int qt, int tq, int tmin,
                    const LAS float* bl, const bf16x8 (&qr)[4], const float (&g3)[3], LAS float* stash, f32x16 (&Ot)[2], int tid, int l31, int hh) {
    const int nsel = __builtin_popcount(U), w0 = qt > 8 ? qt - 8 : 0, ntile = nsel + (qt - w0 + 1);
    const int srow = tid >> 3, sch = tid & 7;
    unsigned rem = U;
    int jseq = 0;
    int jt = 0; bool wt = false;
#define NEXT_TILE() do { if (jseq < nsel) { jt = __builtin_ctz(rem); rem &= rem - 1; wt = false; } else { jt = w0 + (jseq - nsel); wt = true; } ++jseq; } while (0)
#define LOAD_TILE(KR, VR) do { KR = *(const u32x4*)((wt ? kwin : ksel) + (size_t)(64 * jt + srow) * LD_CAS + 8 * sch); \
                               VR = *(const u32x4*)((wt ? vtw : vts) + (size_t)jt * 4096 + srow * 64 + 8 * sch); } while (0)
    u32x4 kr0, vr0, kr1, vr1;
    NEXT_TILE(); int j0 = jt; bool wn0 = wt; LOAD_TILE(kr0, vr0);
    *(LAS u32x4*)(lds + A_STAGE + swz_off(srow, sch)) = kr0; *(LAS u32x4*)(lds + A_STAGE + 2 * A_TILE + swz_off(srow, sch)) = vr0;
    int j1 = 0; bool wn1 = false;
    if (ntile > 1) { NEXT_TILE(); j1 = jt; wn1 = wt; LOAD_TILE(kr0, vr0); }
    __syncthreads();
    float m_run = -1e30f, l_run = 0.f; f32x16 O[2]; O[0] = (f32x16){}; O[1] = (f32x16){};
    const float cbf = bl[128];
    f32x16 cinit;
#pragma unroll
    for (int r = 0; r < 16; ++r) cinit[r] = FAST ? cbf : 0.f;
#define TILE_ITER(I, KRA, VRA, KRB, VRB) do { \
        const int jc = j0; const bool wc = wn0; j0 = j1; wn0 = wn1; \
        if ((I) + 2 < ntile) { NEXT_TILE(); j1 = jt; wn1 = wt; LOAD_TILE(KRB, VRB); } \
        if ((I) == nsel) { if (FAST) l_run += __shfl_xor(l_run, 32); const float f_ = l_run > 0.f ? g3[1] / l_run : 0.f; \
            _Pragma("unroll") for (int dt = 0; dt < 2; ++dt) _Pragma("unroll") for (int r = 0; r < 16; ++r) { stash[(dt * 16 + r) * 64] += f_ * O[dt][r]; O[dt][r] = 0.f; } \
            m_run = -1e30f; l_run = 0.f; } \
        const LAS unsigned char* kl = lds + A_STAGE + ((I) & 1) * A_TILE; \
        const LAS unsigned char* vl = lds + A_STAGE + 2 * A_TILE + ((I) % 3) * A_TILE; \
        const bool ok_ = wc ? true : (bool)((mysel >> jc) & 1u); \
        if (__any(ok_)) { f32x16 s0, s1; attn_qk(s0, s1, kl, qr, cinit, l31, hh); \
            const bool bnd = wc ? (jc == qt || jc + 8 == qt) : (jc == qt); \
            if (FAST) attn_sv_fast(s0, s1, vl, 64 * jc, tq, ok_, tmin, bl, wc, bnd, cbf, l_run, O, l31, hh); \
            else attn_sv(s0, s1, vl, 64 * jc, tq, ok_, tmin, bl, wc, bnd, m_run, l_run, O, l31, hh); } \
        if ((I) + 1 < ntile) { *(LAS u32x4*)(lds + A_STAGE + (((I) + 1) & 1) * A_TILE + swz_off(srow, sch)) = KRA; \
                               *(LAS u32x4*)(lds + A_STAGE + 2 * A_TILE + (((I) + 1) % 3) * A_TILE + swz_off(srow, sch)) = VRA; } \
        asm volatile("s_waitcnt lgkmcnt(0)\n\ts_barrier" ::: "memory"); } while (0)
    for (int i = 0; i < ntile; i += 2) {
        TILE_ITER(i, kr0, vr0, kr1, vr1);
        if (i + 1 < ntile) TILE_ITER(i + 1, kr1, vr1, kr0, vr0);
    }
#undef TILE_ITER
#undef LOAD_TILE
#undef NEXT_TILE
    if (FAST) l_run += __shfl_xor(l_run, 32);
    const float f = l_run > 0.f ? g3[2] / l_run : 0.f;
#pragma unroll
    for (int dt = 0; dt < 2; ++dt)
#pragma unroll
        for (int r = 0; r < 16; ++r) Ot[dt][r] = stash[(dt * 16 + r) * 64] + f * O[dt][r];
}
DI void phase4(const Params& p, LAS unsigned char* lds) {
    const int tid0 = threadIdx.x, wave = __builtin_amdgcn_readfirstlane(tid0 >> 6);
    const int hp = wave & 3, qh = wave >> 2;
    const bf16* cas = (const bf16*)(p.ws + WS_CAS);
    LAS float* biasL = (LAS float*)lds;
    LAS float* sL = (LAS float*)(lds + 4608);
    LAS float* cL = (LAS float*)(lds + 4608 + 33792);
    LAS unsigned* selL = (LAS unsigned*)(lds + 4608 + 2 * 33792);
    LAS unsigned* uL = selL + 64;
    LAS float* impT = (LAS float*)(lds + 4608 + 2 * 33792 + 512);
    LAS float* auxL = (LAS float*)(lds + 81152);
    for (int i = tid0; i < 8 * 132; i += 512) biasL[i] = ((const float*)(p.ws + WS_BIAS))[i];
    if (tid0 == 0) uL[0] = 0u;
    __syncthreads();
    if (tid0 < 8) { float bm = 0.f; for (int d = 0; d <= 128; ++d) bm = fmaxf(bm, fabsf(biasL[tid0 * 132 + d])); auxL[tid0] = bm; }
    if (tid0 == 8 || tid0 == 9) { float gm = 0.f; for (int d = 0; d < 64; ++d) gm = fmaxf(gm, fabsf(p.k_norm_gain[(tid0 - 7) * 64 + d])); auxL[tid0] = gm; }
    if (tid0 == 10) { float gm = 0.f; for (int d = 0; d < 64; ++d) gm = fmaxf(gm, fabsf(p.q_norm_gain[d])); auxL[10] = gm; }
    __syncthreads();
    bool fastmode;
    { float bm = 0.f;
#pragma unroll
      for (int hq = 0; hq < 8; ++hq) bm = fmaxf(bm, auxL[hq]);
      fastmode = (8.1f * auxL[10] * QSCALE) * (8.1f * fmaxf(auxL[8], auxL[9])) + bm <= 96.f; }
    unsigned* qctr = (unsigned*)(p.ws + WS_CTL) + 8192 + 64 * (blockIdx.x & 7);
    for (;;) {
        if (tid0 == 0) uL[1] = atomicAdd(qctr, 1u);
        __syncthreads();
        const unsigned qi = uL[1];
        __syncthreads();
        if (qi >= 128u) break;
        int tid = tid0; asm volatile("" : "+v"(tid));
        const int lane = tid & 63, l31 = lane & 31, hh = lane >> 5;
        const int qt = 31 - (int)(qi & 31), bg = (blockIdx.x & 7) + 8 * (int)(qi >> 5);
        const int b = bg >> 1, g = bg & 1, head = g * 4 + hp, t0 = 64 * qt, tmin = t0 + 32 * qh, tq = tmin + l31;
        const size_t m = (size_t)b * SEQ + tq;
        const LAS float* bl = biasL + head * 132;
        bf16x8 qr[4];
#pragma unroll
        for (int d0 = 0; d0 < 4; ++d0) qr[d0] = *(const bf16x8*)(cas + m * LD_CAS + Q0 + head * 64 + 16 * d0 + 8 * hh);
        float g3[3];
#pragma unroll
        for (int br = 0; br < 3; ++br) g3[br] = sigmoidf_(bf2f(cas[m * LD_CAS + GATE0 + br * 8 + head]));
        f32x16 Ot[2]; Ot[0] = (f32x16){}; Ot[1] = (f32x16){};
        {
            const bf16* kcb = (const bf16*)(p.ws + WS_KC) + (size_t)bg * 128 * 64;
            const bf16* vcb = (const bf16*)(p.ws + WS_VCT) + (size_t)bg * 64 * 128;
            f32x16 sc[4];
#pragma unroll
            for (int kt = 0; kt < 4; ++kt) { sc[kt] = (f32x16){};
#pragma unroll
                for (int d0 = 0; d0 < 4; ++d0) sc[kt] = __builtin_amdgcn_mfma_f32_32x32x16_bf16(*(const bf16x8*)(kcb + (size_t)(32 * kt + l31) * 64 + 16 * d0 + 8 * hh), qr[d0], sc[kt], 0, 0, 0); }
            float mc = -1e30f;
#pragma unroll
            for (int kt = 0; kt < 4; ++kt) {
                float bv[16];
#pragma unroll
                for (int r = 0; r < 16; ++r) { const int n = 32 * kt + crow(r, hh), dist = tq - 16 * n - 31; bv[r] = bl[min(max(dist, 0), 128)]; }
#pragma unroll
                for (int r = 0; r < 16; ++r) asm volatile("" : "+v"(bv[r]));
#pragma unroll
                for (int r = 0; r < 16; ++r) { const int n = 32 * kt + crow(r, hh), dist = tq - 16 * n - 31; const bool ok = dist >= 0 && n < 127;
                    sc[kt][r] = ok ? sc[kt][r] + bv[r] : -1e30f; mc = fmaxf(mc, sc[kt][r]); }
            }
            mc = fmaxf(mc, __shfl_xor(mc, 32));
            float lc = 0.f;
#pragma unroll
            for (int kt = 0; kt < 4; ++kt)
#pragma unroll
                for (int r = 0; r < 16; ++r) { sc[kt][r] = (sc[kt][r] > -1e29f) ? __builtin_amdgcn_exp2f(sc[kt][r] - mc) : 0.f; lc += sc[kt][r]; }
            lc += __shfl_xor(lc, 32);
            const float inv = lc > 0.f ? 1.f / lc : 0.f;
            const int q = 32 * qh + l31;
#pragma unroll
            for (int kt = 0; kt < 4; ++kt) {
#pragma unroll
                for (int r = 0; r < 16; ++r) sc[kt][r] *= inv;
#pragma unroll
                for (int g4 = 0; g4 < 4; ++g4) { const int j = 8 * kt + 2 * g4 + hh;
                    sL[(hp * 64 + q) * 33 + j] = 2.f * (sc[kt][4 * g4] + sc[kt][4 * g4 + 1] + sc[kt][4 * g4 + 2]) + sc[kt][4 * g4 + 3];
                    cL[(hp * 64 + q) * 33 + j + 1] = sc[kt][4 * g4 + 3]; }
            }
            f32x16 oc[2]; oc[0] = (f32x16){}; oc[1] = (f32x16){};
#pragma unroll
            for (int dt = 0; dt < 2; ++dt)
#pragma unroll
                for (int kt = 0; kt < 4; ++kt)
#pragma unroll
                    for (int s = 0; s < 2; ++s)
                        oc[dt] = __builtin_amdgcn_mfma_f32_32x32x16_bf16(*(const bf16x8*)(vcb + (size_t)(32 * dt + l31) * 128 + 32 * kt + 16 * s + 8 * hh), pack8(sc[kt], s), oc[dt], 0, 0, 0);
#pragma unroll
            for (int dt = 0; dt < 2; ++dt)
#pragma unroll
                for (int r = 0; r < 16; ++r) Ot[dt][r] = g3[0] * oc[dt][r];
        }
        __syncthreads();
        {
            const int q = tid >> 3, sub = tid & 7;
            unsigned mask = 0u;
            if (qt < 16) mask = (2u << qt) - 1u;
            else {
#pragma unroll
                for (int i2 = 0; i2 < 4; ++i2) impT[q * 33 + sub + 8 * i2] = imp_sum(sL, cL, q, sub + 8 * i2);
                __syncthreads();
                float vj[4]; int rank[4];
#pragma unroll
                for (int i2 = 0; i2 < 4; ++i2) { vj[i2] = impT[q * 33 + sub + 8 * i2]; rank[i2] = 0; }
#pragma unroll 2
                for (int jj = 1; jj <= qt - 2; ++jj) {
                    const float vv = impT[q * 33 + jj];
#pragma unroll
                    for (int i2 = 0; i2 < 4; ++i2) { const int j = sub + 8 * i2;
                        rank[i2] += (int)((jj != j) & ((vv > vj[i2]) | ((vv == vj[i2]) & (jj < j)))); }
                }
#pragma unroll
                for (int i2 = 0; i2 < 4; ++i2) { const int j = sub + 8 * i2;
                    const bool forced = (j == 0) || (j == qt) || (j == qt - 1), cand = (j >= 1) && (j <= qt - 2);
                    if (forced || (cand && rank[i2] < 13)) mask |= 1u << j; }
                mask |= __shfl_xor(mask, 1); mask |= __shfl_xor(mask, 2); mask |= __shfl_xor(mask, 4);
            }
            if (sub == 0) { selL[q] = mask; __hip_atomic_fetch_or(uL, mask, __ATOMIC_RELAXED, __HIP_MEMORY_SCOPE_WORKGROUP); }
        }
        __syncthreads();
        const unsigned mysel = selL[32 * qh + l31], U = uL[0];
        LAS float* stash = (LAS float*)(lds + 4608 + wave * 8192) + lane;
#pragma unroll
        for (int dt = 0; dt < 2; ++dt)
#pragma unroll
            for (int r = 0; r < 16; ++r) stash[(dt * 16 + r) * 64] = Ot[dt][r];
        {
            const bf16* ksel = cas + (size_t)(b * SEQ) * LD_CAS + KS0 + g * 64; const bf16* kwin = cas + (size_t)(b * SEQ) * LD_CAS + KW0 + g * 64;
            const bf16* vts = (const bf16*)(p.ws + WS_VTS) + (size_t)bg * 32 * 4096; const bf16* vtw = (const bf16*)(p.ws + WS_VTW) + (size_t)bg * 32 * 4096;
            if (fastmode) attn_stream<true>(lds, ksel, kwin, vts, vtw, U, mysel, qt, tq, tmin, bl, qr, g3, stash, Ot, tid, l31, hh);
            else attn_stream<false>(lds, ksel, kwin, vts, vtw, U, mysel, qt, tq, tmin, bl, qr, g3, stash, Ot, tid, l31, hh);
        }
        __syncthreads();
#pragma unroll
        for (int dt = 0; dt < 2; ++dt)
#pragma unroll
            for (int g4 = 0; g4 < 4; ++g4) {
                const int col = head * 64 + 32 * dt + 8 * g4 + 4 * hh;
                const u32x2 aw = *(const u32x2*)(cas + m * LD_CAS + ASILU0 + col);
                u32x2 w; w.x = pk2(Ot[dt][4 * g4] * siluf_(bflo(aw.x)), Ot[dt][4 * g4 + 1] * siluf_(bfhi(aw.x)));
                w.y = pk2(Ot[dt][4 * g4 + 2] * siluf_(bflo(aw.y)), Ot[dt][4 * g4 + 3] * siluf_(bfhi(aw.y)));
                *(u32x2*)((bf16*)(p.ws + WS_YA) + m * 512 + col) = w;
            }
        if (tid == 0) uL[0] = 0u;
    }
}
DI void phase3(const Params& p, LAS unsigned char* lds) { phase3a(p, lds); phase3b(p, lds); phase3c(p, lds); }


#define XB_TMO      128
#define XB_XCNT(j)  (256  + 64 * (j))
#define XB_XSUB(j)  (1280 + 64 * (j))
#define XB_XGEN(j)  (2304 + 64 * (j))
#define XB_TOP      3328
#define XB_TOPGEN   3392
#define XCD_BAR_WORDS 3456
#define XB_SPIN_CAP (1u << 22)
DI unsigned xb_ld(unsigned* p)              { return __hip_atomic_load(p, __ATOMIC_RELAXED, __HIP_MEMORY_SCOPE_AGENT); }
DI unsigned xb_add(unsigned* p, unsigned v) { return __hip_atomic_fetch_add(p, v, __ATOMIC_RELAXED, __HIP_MEMORY_SCOPE_AGENT); }
DI unsigned xb_xcc_id() { return (unsigned)__builtin_amdgcn_s_getreg((3 << 11) | 20) & 0xFu; }
#define XB_SPIN(cond, bar) do { unsigned _sp = 0; while (cond) { __builtin_amdgcn_s_sleep(1); \
    if ((++_sp & 255u) == 0u) { if (xb_ld(&(bar)[XB_TMO])) break; if (_sp > XB_SPIN_CAP) { atomicAdd(&(bar)[XB_TMO], 1u); break; } } } } while (0)
struct XcdBarrier { unsigned* bar; unsigned x; volatile LAS unsigned* st; };
DI XcdBarrier xcd_barrier_post(unsigned* bar, volatile LAS unsigned* st) {
    XcdBarrier b; b.bar = bar; b.x = xb_xcc_id(); b.st = st;
    if (threadIdx.x == 0) (void)xb_add(&bar[XB_XCNT(b.x)], 1u);
    return b;
}
DI void xcd_barrier_complete(unsigned* bar, unsigned x, unsigned& nloc, unsigned& nx) {
    const unsigned G = gridDim.x * gridDim.y * gridDim.z;
    unsigned sum, cnt, mine, sp = 0u;
    for (;;) {
        sum = 0u; cnt = 0u; mine = 0u;
#pragma unroll
        for (unsigned j = 0; j < 16; ++j) { const unsigned c = xb_ld(&bar[XB_XCNT(j)]); sum += c; cnt += (c > 0u) ? 1u : 0u; mine = (j == x) ? c : mine; }
        if (sum == G) break;
        __builtin_amdgcn_s_sleep(1);
        if ((++sp & 255u) == 0u) { if (xb_ld(&bar[XB_TMO])) break; if (sp > XB_SPIN_CAP) { atomicAdd(&bar[XB_TMO], 1u); break; } }
    }
    nloc = mine > 0u ? mine : 1u; nx = cnt > 0u ? cnt : 1u;
}
DI void xcd_barrier(const XcdBarrier& b) {
    asm volatile("s_waitcnt vmcnt(0)" ::: "memory");
    __syncthreads();
    if (threadIdx.x == 0) {
        unsigned* bar = b.bar;
        __builtin_amdgcn_s_waitcnt(0);
        unsigned nloc = b.st[0], nx = b.st[1];
        if (nloc == 0u) { xcd_barrier_complete(bar, b.x, nloc, nx); b.st[0] = nloc; b.st[1] = nx; }
        const unsigned old = xb_add(&bar[XB_XSUB(b.x)], 1u);
        const unsigned gen = old / nloc;
        if (old + 1u == (gen + 1u) * nloc) {
            __builtin_amdgcn_fence(__ATOMIC_RELEASE, "agent");
            asm volatile("s_waitcnt vmcnt(0)" ::: "memory");
            const unsigned og = xb_add(&bar[XB_TOP], 1u);
            const unsigned tg = og / nx;
            if (og + 1u == (tg + 1u) * nx) xb_add(&bar[XB_TOPGEN], 1u);
            else XB_SPIN(xb_ld(&bar[XB_TOPGEN]) == tg, bar);
            __builtin_amdgcn_fence(__ATOMIC_ACQUIRE, "agent");
            xb_add(&bar[XB_XGEN(b.x)], 1u);
            asm volatile("s_waitcnt vmcnt(0)" ::: "memory");
        } else {
            XB_SPIN(xb_ld(&bar[XB_XGEN(b.x)]) == gen, bar);
            __builtin_amdgcn_fence(__ATOMIC_ACQUIRE, "agent");
            asm volatile("s_waitcnt vmcnt(0)" ::: "memory");
        }
    }
    __syncthreads();
}

__global__ void __launch_bounds__(512, 2) hybrid_fwd(Params p) {
    extern __shared__ __attribute__((aligned(16))) unsigned char lds_raw[];
    LAS unsigned char* lds = (LAS unsigned char*)lds_raw;
#if USE_CG_SYNC
    cg::grid_group grid = cg::this_grid();
#define GRID_BAR() grid.sync()
#else
    volatile LAS unsigned* bst = (volatile LAS unsigned*)(lds + LDS_BYTES - 64);
    if (threadIdx.x < 2) bst[threadIdx.x] = 0u;
    __syncthreads();
    const XcdBarrier xbar = xcd_barrier_post((unsigned*)(p.ws + WS_CTL) + 1024, bst);
#define GRID_BAR() xcd_barrier(xbar)
#endif
    const int lo = p.ph_lo, hi = p.ph_hi;
#ifdef ONLYP
#define IN(k) ((k) == ONLYP && lo <= (k) && (k) < hi)
#else
#define IN(k) (lo <= (k) && (k) < hi)
#endif
#define SEAM(k) do { if (IN(k) && IN((k) + 1)) GRID_BAR(); } while (0)
    unsigned char* ws = p.ws;
    if (IN(0)) { phase0(p, lds); }
    SEAM(0);
    if (IN(1)) { phase1(p, lds); phase0w(p, lds); }
    SEAM(1);
    if (IN(2)) {
        pg8::Gemm g{(const bf16*)((unsigned char*)p.out + OUT_H), (const bf16*)(ws + WS_WIN_T), MTOK, N_IN_PAD, DM, DM, DM};
        pg8::StaticOrder S; S.init(MTOK, N_IN_PAD, gridDim.x, blockIdx.x);
        EpiInProj E{(bf16*)(ws + WS_CAS), (bf16*)(ws + WS_CR)};
        pg8::gemm_phase<EpiInProj, pg8::StaticOrder>(lds, g, S, E);
    }
    SEAM(2);
    if (IN(3)) { phase3(p, lds); }
    SEAM(3);
    if (IN(4)) { phase5a(p); phase4(p, lds); __syncthreads(); phase5b(p, lds); }
    SEAM(5);
    if (IN(6)) {
        { pg8::Gemm g{(const bf16*)(ws + WS_YA), (const bf16*)(ws + WS_WA_T), MTOK, DM, 512, 512, 512};
          pg8::StaticOrder S; S.init(MTOK, DM, gridDim.x, blockIdx.x);
          EpiGate<0> E{(bf16*)(ws + WS_MERGED), (const bf16*)(ws + WS_CR)};
          pg8::gemm_phase<EpiGate<0>, pg8::StaticOrder>(lds, g, S, E); }
        { pg8::Gemm g{(const bf16*)(ws + WS_YB), (const bf16*)(ws + WS_WB_T), MTOK, DM, 512, 512, 512};
          pg8::StaticOrder S; S.init(MTOK, DM, gridDim.x, blockIdx.x);
          EpiGate<1> E{(bf16*)(ws + WS_MERGED), (const bf16*)(ws + WS_CR)};
          pg8::gemm_phase<EpiGate<1>, pg8::StaticOrder>(lds, g, S, E); }
    }
    SEAM(6);
    if (IN(7)) {
        pg8::Gemm g{(const bf16*)(ws + WS_MERGED), (const bf16*)(ws + WS_WO_T), MTOK, DM, DM, DM, DM};
        pg8::StaticOrder S; S.init(MTOK, DM, gridDim.x, blockIdx.x);
        EpiFinal E{p.x, (const float*)(ws + WS_MOD), p.out};
        pg8::gemm_phase<EpiFinal, pg8::StaticOrder>(lds, g, S, E);
    }
#undef IN
#undef SEAM
}

extern "C" void kernel_launch(void* const* d_in, const int* in_sizes, int n_in, void* d_out, int out_size, void* d_ws, size_t ws_size, hipStream_t stream) {
    static int grid = 0;
    if (grid == 0) {
        if (n_in != 28 || out_size != MTOK * DM || ws_size < WS_END) { fprintf(stderr, "kernel_launch: unexpected shapes (n_in %d out %d ws %zu)\n", n_in, out_size, ws_size); grid = -1; return; }
        int dev = 0, cus = 0, per_cu = 0;
        (void)hipGetDevice(&dev); (void)hipDeviceGetAttribute(&cus, hipDeviceAttributeMultiprocessorCount, dev);
        if (hipFuncSetAttribute((const void*)hybrid_fwd, hipFuncAttributeMaxDynamicSharedMemorySize, LDS_BYTES) != hipSuccess) { fprintf(stderr, "kernel_launch: hipFuncSetAttribute failed\n"); grid = -1; return; }
        if (hipOccupancyMaxActiveBlocksPerMultiprocessor(&per_cu, (const void*)hybrid_fwd, 512, LDS_BYTES) != hipSuccess || per_cu < 1) { fprintf(stderr, "kernel_launch: occupancy query says %d\n", per_cu); per_cu = 1; }
        (void)hipGetLastError();
        grid = cus * 1;
        if (grid <= 0) grid = 256;
    }
    if (grid < 0) return;
    (void)hipMemsetAsync((char*)d_ws + WS_CTL, 0, CTL_ZERO_BYTES, stream);
    Params p{};
    const float** pp = (const float**)&p;
    for (int i = 0; i < 28; ++i) pp[i] = (const float*)d_in[i];
    p.out = (float*)d_out; p.ws = (unsigned char*)d_ws;
#if MK_LAUNCHES == 1
    p.ph_lo = 0; p.ph_hi = 8;
    void* args[] = {&p};
    hipError_t e = hipLaunchCooperativeKernel((const void*)hybrid_fwd, dim3(grid), dim3(512), args, LDS_BYTES, stream);
    if (e != hipSuccess) fprintf(stderr, "cooperative launch failed: %s (grid %d)\n", hipGetErrorString(e), grid);
#else
    const int cuts[][2] = {{0, 1}, {1, 2}, {2, 3}, {3, 4}, {4, 5}, {5, 6}, {6, 7}, {7, 8}};
    for (int li = 0; li < 8; ++li) {
        p.ph_lo = cuts[li][0]; p.ph_hi = cuts[li][1];
        hipLaunchKernelGGL(hybrid_fwd, dim3(grid), dim3(512), LDS_BYTES, stream, p);
    }
#endif
}
```

```cpp
#include <hip/hip_runtime.h>
#include <hip/hip_cooperative_groups.h>
#include <cstdio>
#include <cstdint>
namespace cg = cooperative_groups;

#ifndef USE_CG_SYNC
#define USE_CG_SYNC 0
#endif
#ifndef MK_LAUNCHES
#define MK_LAUNCHES 1
#endif

#define DI __device__ __forceinline__
#define LAS __attribute__((address_space(3)))
typedef unsigned short bf16;
typedef short bf16x8 __attribute__((ext_vector_type(8)));
typedef short s16x4 __attribute__((ext_vector_type(4)));
typedef float f32x2 __attribute__((ext_vector_type(2)));
typedef float f32x4 __attribute__((ext_vector_type(4)));
typedef float f32x16 __attribute__((ext_vector_type(16)));
typedef unsigned u32x2 __attribute__((ext_vector_type(2)));
typedef unsigned u32x4 __attribute__((ext_vector_type(4)));
typedef __bf16 bf16x2_t __attribute__((ext_vector_type(2)));

namespace pg8 {
typedef unsigned short bf16_t;
constexpr int BM = 256, BK = 64, HALF = 128, HTB = HALF * BK * 2, STAGE_BYTES = 8 * HTB, NXCD = 8, WGM = 8;
__host__ __device__ __forceinline__ int lds_byte(int r, int c) { const int st = (r >> 4) * 2 + (c >> 5), rr = r & 15, cc = c & 31, ob = rr * 64 + cc * 2; return st * 1024 + (ob ^ (((ob >> 9) & 1) << 5)); }
__host__ __device__ __forceinline__ void stage_rc(int b, int& R, int& C) { const int st = b / 1024, sb = b % 1024, swz = sb ^ (((sb >> 9) & 1) << 5); R = (st >> 1) * 16 + swz / 64; C = (st & 1) * 32 + (swz % 64) / 2; }
__host__ __device__ __forceinline__ int perm32(int rho) { const int n = rho >> 4, i = rho & 15; return 8 * (i >> 2) + 4 * n + (i & 3); }
struct Unit { int pm, pn; };
struct Gemm { const bf16_t* A; const bf16_t* Bt; int M, N, K, lda, ldb; };
struct StaticOrder {
    int nM, nN, nwg, G, c;
    __host__ __device__ void init(int M, int N, int G_, int c_) { nM = M / BM; nN = N / BM; nwg = nM * nN; G = G_; c = c_; }
    __host__ __device__ bool next(int i, Unit& u) const {
        const long L = (long)i * G + c; if (L >= nwg) return false;
        int wgid = (int)L; { const int q = nwg / NXCD, r = nwg % NXCD, xcd = wgid % NXCD, off = wgid / NXCD; wgid = (xcd < r ? xcd * (q + 1) : r * (q + 1) + (xcd - r) * q) + off; }
        const int nig = WGM * nN, gid = wgid / nig, fm = gid * WGM, gsz = (nM - fm) < WGM ? (nM - fm) : WGM;
        u.pm = fm + ((wgid % nig) % gsz); u.pn = (wgid % nig) / gsz; return true;
    }
};
__device__ __forceinline__ unsigned cvt_pk_bf16(float lo, float hi) { unsigned r; asm volatile("v_cvt_pk_bf16_f32 %0, %1, %2" : "=v"(r) : "v"(lo), "v"(hi)); return r; }

template <class Epi, class Sched, bool ALIGN_EPI = true, bool SP2 = true>
__device__ __forceinline__ void gemm_phase(LAS unsigned char* lds, const Gemm g, const Sched& S, const Epi& E) {
    const int tid = threadIdx.x, wid = __builtin_amdgcn_readfirstlane(tid >> 6), lane = tid & 63, wr = wid >> 2, wc = wid & 3, fr = lane & 15, fq = lane >> 4;
    const int K = g.K, nt = K / BK;
    unsigned voffA[2], voffB[2];
#pragma unroll
    for (int i = 0; i < 2; ++i) { int R, C; stage_rc(tid * 16 + i * 8192, R, C); const int Rb = Epi::PERM ? ((R & ~31) + perm32(R & 31)) : R;
        voffA[i] = (unsigned)(R * g.lda + C) * 2u; voffB[i] = (unsigned)(Rb * g.ldb + C) * 2u; }
    const size_t kstep = (size_t)(BK * 2);
    const size_t hstepA = (size_t)HALF * g.lda * 2, hstepB = (size_t)HALF * g.ldb * 2;
    const size_t tstepA = 2 * hstepA, tstepB = 2 * hstepB;
    const unsigned ldsw = (unsigned)wid * 1024u;
    const int aoff = lds_byte(wr * 64 + fr, fq * 8), boff = lds_byte(wc * 32 + fr, fq * 8);
#define PG8_SA(b, h) (((b) * 2 + (h)) * HTB)
#define PG8_SB(b, h) ((4 + (b) * 2 + (h)) * HTB)
#define PG8_STAGE(bufoff, gbase, voff) do { _Pragma("unroll") for (int _i = 0; _i < 2; ++_i) \
        __builtin_amdgcn_global_load_lds((const unsigned*)((const char*)(gbase) + (voff)[_i]), (LAS unsigned*)(lds + (bufoff) + ldsw + _i * 8192), 16, 0, 0); } while (0)
#define PG8_LDA(dst, b, h) do { _Pragma("unroll") for (int m = 0; m < 4; ++m) _Pragma("unroll") for (int k = 0; k < 2; ++k) dst[m][k] = *(const LAS bf16x8*)(lds + PG8_SA(b, h) + aoff + m * 2048 + k * 1024); } while (0)
#define PG8_LDB(dst, b, h) do { _Pragma("unroll") for (int n = 0; n < 2; ++n) _Pragma("unroll") for (int k = 0; k < 2; ++k) dst[n][k] = *(const LAS bf16x8*)(lds + PG8_SB(b, h) + boff + n * 2048 + k * 1024); } while (0)
#define PG8_MMA(ai, bj, At, Bt) do { __builtin_amdgcn_s_setprio(1); _Pragma("unroll") for (int m = 0; m < 4; ++m) _Pragma("unroll") for (int n = 0; n < 2; ++n) _Pragma("unroll") for (int k = 0; k < 2; ++k) \
        acc[ai][bj][m][n] = __builtin_amdgcn_mfma_f32_16x16x32_bf16(Bt[n][k], At[m][k], acc[ai][bj][m][n], 0, 0, 0); __builtin_amdgcn_s_setprio(0); } while (0)
#define PG8_WAIT_V(n) asm volatile("s_waitcnt vmcnt(" #n ")" ::: "memory")
#define PG8_WAIT_L(n) asm volatile("s_waitcnt lgkmcnt(" #n ")" ::: "memory")
#define PG8_BAR __builtin_amdgcn_s_barrier()
#define PG8_SCHED __builtin_amdgcn_sched_barrier(0)
    Unit cur, nxt; int ui = 0;
    if (!S.next(0, cur)) return;
    f32x4 acc[2][2][4][2];
#pragma unroll
    for (int a = 0; a < 2; ++a)
#pragma unroll
        for (int b = 0; b < 2; ++b)
#pragma unroll
            for (int m = 0; m < 4; ++m)
#pragma unroll
                for (int n = 0; n < 2; ++n) acc[a][b][m][n] = (f32x4){0.f, 0.f, 0.f, 0.f};
    bf16x8 At[4][2], B0[2][2], B1[2][2];
    const char* cA = (const char*)g.A + (size_t)cur.pm * tstepA; const char* cB = (const char*)g.Bt + (size_t)cur.pn * tstepB;
    if constexpr (SP2) {
        PG8_STAGE(PG8_SB(0, 0), cB, voffB); PG8_STAGE(PG8_SB(0, 1), cB + hstepB, voffB); PG8_STAGE(PG8_SA(0, 0), cA, voffA); PG8_STAGE(PG8_SA(0, 1), cA + hstepA, voffA);
        if (wr == 1) PG8_BAR;
        PG8_WAIT_V(2); PG8_BAR;
        PG8_STAGE(PG8_SB(1, 0), cB + kstep, voffB); PG8_STAGE(PG8_SA(1, 0), cA + kstep, voffA); PG8_STAGE(PG8_SB(1, 1), cB + hstepB + kstep, voffB);
        PG8_WAIT_V(6); PG8_BAR;
    } else {
        PG8_STAGE(PG8_SB(0, 0), cB, voffB); PG8_STAGE(PG8_SA(0, 0), cA, voffA); PG8_STAGE(PG8_SB(0, 1), cB + hstepB, voffB); PG8_STAGE(PG8_SA(0, 1), cA + hstepA, voffA);
        if (wr == 1) PG8_BAR;
        PG8_WAIT_V(4); PG8_BAR;
        PG8_STAGE(PG8_SB(1, 0), cB + kstep, voffB); PG8_STAGE(PG8_SA(1, 0), cA + kstep, voffA); PG8_STAGE(PG8_SB(1, 1), cB + hstepB + kstep, voffB);
        PG8_WAIT_V(6); PG8_BAR;
    }
    for (;;) {
        const bool has_next = S.next(ui + 1, nxt);
        const char* nA = has_next ? (const char*)g.A + (size_t)nxt.pm * tstepA : cA; const char* nB = has_next ? (const char*)g.Bt + (size_t)nxt.pn * tstepB : cB;
        for (int t = 0; t < nt; t += 2) {
            const bool last = (t == nt - 2);
            const char* a1 = cA + (size_t)(t + 1) * kstep;
            const char* a2 = last ? nA : cA + (size_t)(t + 2) * kstep; const char* b2 = last ? nB : cB + (size_t)(t + 2) * kstep;
            const char* a3 = a2 + kstep; const char* b3 = b2 + kstep;
            if constexpr (SP2) {
            PG8_LDB(B0, 0, 0); PG8_LDB(B1, 0, 1); PG8_SCHED; PG8_LDA(At, 0, 0); PG8_STAGE(PG8_SA(1, 1), a1 + hstepA, voffA);
            PG8_WAIT_V(8); PG8_WAIT_L(0); PG8_BAR; PG8_MMA(0, 0, At, B0); PG8_MMA(0, 1, At, B1); PG8_BAR; PG8_SCHED;
            PG8_LDA(At, 0, 1); PG8_STAGE(PG8_SB(0, 0), b2, voffB); PG8_STAGE(PG8_SB(0, 1), b2 + hstepB, voffB); PG8_STAGE(PG8_SA(0, 0), a2, voffA);
            PG8_WAIT_V(8); PG8_WAIT_L(0); PG8_BAR; PG8_MMA(1, 0, At, B0); PG8_MMA(1, 1, At, B1); PG8_BAR; PG8_SCHED;
            PG8_LDB(B0, 1, 0); PG8_LDB(B1, 1, 1); PG8_SCHED; PG8_LDA(At, 1, 0); PG8_STAGE(PG8_SA(0, 1), a2 + hstepA, voffA);
            PG8_WAIT_V(8); PG8_WAIT_L(0); PG8_BAR; PG8_MMA(0, 0, At, B0); PG8_MMA(0, 1, At, B1); PG8_BAR; PG8_SCHED;
            PG8_LDA(At, 1, 1); PG8_STAGE(PG8_SB(1, 0), b3, voffB); PG8_STAGE(PG8_SB(1, 1), b3 + hstepB, voffB); PG8_STAGE(PG8_SA(1, 0), a3, voffA);
            PG8_WAIT_V(8); PG8_WAIT_L(0); PG8_BAR; PG8_MMA(1, 0, At, B0); PG8_MMA(1, 1, At, B1); PG8_BAR; PG8_SCHED;
            } else {
            PG8_LDB(B0, 0, 0); PG8_SCHED; PG8_LDA(At, 0, 0); PG8_STAGE(PG8_SA(1, 1), a1 + hstepA, voffA);
            PG8_WAIT_L(8); PG8_BAR; PG8_WAIT_L(0); PG8_MMA(0, 0, At, B0); PG8_BAR; PG8_SCHED;
            PG8_LDB(B1, 0, 1); PG8_STAGE(PG8_SB(0, 0), b2, voffB);
            PG8_BAR; PG8_WAIT_L(0); PG8_MMA(0, 1, At, B1); PG8_BAR;
            PG8_LDA(At, 0, 1); PG8_STAGE(PG8_SA(0, 0), a2, voffA);
            PG8_BAR; PG8_WAIT_L(0); PG8_MMA(1, 0, At, B0); PG8_BAR; PG8_SCHED;
            PG8_STAGE(PG8_SB(0, 1), b2 + hstepB, voffB);
            PG8_WAIT_V(6); PG8_BAR; PG8_MMA(1, 1, At, B1); PG8_BAR;
            PG8_LDB(B0, 1, 0); PG8_SCHED; PG8_LDA(At, 1, 0); PG8_STAGE(PG8_SA(0, 1), a2 + hstepA, voffA);
            PG8_WAIT_L(8); PG8_BAR; PG8_WAIT_L(0); PG8_MMA(0, 0, At, B0); PG8_BAR; PG8_SCHED;
            PG8_LDB(B1, 1, 1); PG8_STAGE(PG8_SB(1, 0), b3, voffB);
            PG8_BAR; PG8_WAIT_L(0); PG8_MMA(0, 1, At, B1); PG8_BAR;
            PG8_LDA(At, 1, 1); PG8_STAGE(PG8_SA(1, 0), a3, voffA);
            PG8_BAR; PG8_WAIT_L(0); PG8_MMA(1, 0, At, B0); PG8_BAR; PG8_SCHED;
            PG8_STAGE(PG8_SB(1, 1), b3 + hstepB, voffB);
            PG8_WAIT_V(6); PG8_BAR; PG8_MMA(1, 1, At, B1); PG8_BAR;
            }
        }
        if constexpr (ALIGN_EPI) { if (wr == 0) PG8_BAR; }
        E(acc, cur, wr, wc, fr, fq);
        if (!has_next) break;
#pragma unroll
        for (int a = 0; a < 2; ++a)
#pragma unroll
            for (int b = 0; b < 2; ++b)
#pragma unroll
                for (int m = 0; m < 4; ++m)
#pragma unroll
                    for (int n = 0; n < 2; ++n) acc[a][b][m][n] = (f32x4){0.f, 0.f, 0.f, 0.f};
        cur = nxt; cA = nA; cB = nB; ++ui;
        if constexpr (ALIGN_EPI) { if (wr == 1) PG8_BAR; }
    }
    PG8_WAIT_V(0);
    if constexpr (!ALIGN_EPI) { if (wr == 0) PG8_BAR; }
    PG8_BAR;
#undef PG8_SA
#undef PG8_SB
#undef PG8_STAGE
#undef PG8_LDA
#undef PG8_LDB
#undef PG8_MMA
#undef PG8_WAIT_V
#undef PG8_WAIT_L
#undef PG8_BAR
#undef PG8_SCHED
}
}

constexpr int NB = 16, SEQ = 2048, DM = 1024, MTOK = NB * SEQ;
constexpr int LD_CAS = 3584, LD_CR = 2560, N_IN_PAD = 6144, N_IN = 6040;
constexpr int Q0 = 0, KC0 = 512, VC0 = 640, KS0 = 768, VS0 = 896, KW0 = 1024, VW0 = 1152, GATE0 = 1280, ASILU0 = 1304;
constexpr int SH0 = 1816, R0 = SH0, K0 = SH0 + 512, V0 = SH0 + 1024, WD0 = SH0 + 1536, AD0 = SH0 + 1600, CAS_USED = 3480;
constexpr int BSILU0 = 0, MA0 = 512, MB0 = 1536;
constexpr float LOG2E = 1.4426950408889634f;
constexpr float QSCALE = 0.125f * LOG2E;

constexpr size_t MiB = 1u << 20;
constexpr size_t WS_CTL = 0, CTL_ZERO_BYTES = 64 * 1024;
constexpr size_t WS_MOD = 256 * 1024;
constexpr size_t WS_POSB = 512 * 1024;
constexpr size_t WS_BIAS = 520 * 1024;
constexpr size_t WS_WA_T = 2 * MiB, WS_WB_T = 3 * MiB;
constexpr size_t WS_WO_T = 4 * MiB;
constexpr size_t WS_W1K_T = 6 * MiB, WS_W1V_T = 7 * MiB;
constexpr size_t WS_W2K_T = 8 * MiB, WS_W2V_T = 8 * MiB + 64 * 1024;
constexpr size_t WS_WLW_T = 8 * MiB + 128 * 1024, WS_WLA_T = 8 * MiB + 192 * 1024;
constexpr size_t WS_KC = 9 * MiB;
constexpr size_t WS_VCT = 9 * MiB + 512 * 1024;
constexpr size_t WS_BONUS = 10 * MiB;
constexpr size_t WS_DUMMY = 11 * MiB;
constexpr size_t WS_VTS = 12 * MiB, WS_VTW = 20 * MiB;
constexpr size_t WS_CAS = 28 * MiB;
constexpr size_t WS_CR = 252 * MiB;
constexpr size_t WS_YA = 412 * MiB, WS_YB = 444 * MiB;
constexpr size_t WS_WIN_T = 476 * MiB;
constexpr size_t WS_HS = 476 * MiB;
constexpr size_t WS_MERGED = WS_CAS;
constexpr size_t WS_END = 508 * MiB;
constexpr size_t OUT_H = 0;
constexpr size_t OUT_G = 0, OUT_Y1 = 32 * MiB, OUT_D = 64 * MiB, OUT_Y2 = 96 * MiB;

constexpr int LDS_BYTES = 147456;

struct Params {
    const float *x, *c, *w_ada, *b_ada, *norm_gain, *w_in, *q_norm_gain, *k_norm_gain, *cmp_pos_k, *cmp_pos_v,
        *cmp_k_w1, *cmp_k_w2, *cmp_v_w1, *cmp_v_w2, *rel_bias, *shift_mu, *w0, *w_lora_up, *a0, *a_lora_up,
        *k_k, *k_a, *r_k, *ln_x_w, *ln_x_b, *w_out_a, *w_out_b, *w_o;
    float* out; unsigned char* ws;
    int ph_lo, ph_hi;
};

DI unsigned f2bf(float f) { unsigned u = __builtin_bit_cast(unsigned, f); return (u + 0x7fffu + ((u >> 16) & 1u)) >> 16; }
DI float bf2f(unsigned h) { return __builtin_bit_cast(float, h << 16); }
DI unsigned pk2(float lo, float hi) { f32x2 v = {lo, hi}; bf16x2_t b = __builtin_convertvector(v, bf16x2_t); return __builtin_bit_cast(unsigned, b); }
DI float bflo(unsigned w) { return __builtin_bit_cast(float, w << 16); }
DI float bfhi(unsigned w) { return __builtin_bit_cast(float, w & 0xffff0000u); }
DI float sigmoidf_(float x) { return __builtin_amdgcn_rcpf(1.f + __expf(-x)); }
DI float siluf_(float x) { return x * __builtin_amdgcn_rcpf(1.f + __expf(-x)); }
DI int crow(int r, int hh) { return (r & 3) + 8 * (r >> 2) + 4 * hh; }
DI int pos16_of_key(int k16) { return 8 * ((k16 >> 2) & 1) + 4 * (k16 >> 3) + (k16 & 3); }
DI int key16_of_pos(int p16) { const int hh = p16 >> 3, j = p16 & 7; return 8 * (j >> 2) + 4 * hh + (j & 3); }
DI float wave_sum(float v) {
#pragma unroll
    for (int o = 1; o < 64; o <<= 1) v += __shfl_xor(v, o);
    return v;
}
DI void unpack8(u32x4 w, float* f) { f[0] = bflo(w.x); f[1] = bfhi(w.x); f[2] = bflo(w.y); f[3] = bfhi(w.y); f[4] = bflo(w.z); f[5] = bfhi(w.z); f[6] = bflo(w.w); f[7] = bfhi(w.w); }
typedef short v4i16_t __attribute__((ext_vector_type(4)));
DI s16x4 tr_read(const LAS bf16* p) { return __builtin_bit_cast(s16x4, __builtin_amdgcn_ds_read_tr16_b64_v4i16((LAS v4i16_t*)p)); }

__device__ const unsigned char T5_BUCKET[129] = {
    0, 1, 2, 3, 4, 5, 6, 7, 8, 9, 10, 11, 12, 13, 14, 15, 16, 16, 16, 17, 17, 18, 18, 18, 19, 19, 19, 20, 20, 20, 20, 21, 21, 21, 21, 22, 22, 22, 22, 22, 23, 23, 23, 23, 23, 23, 24, 24, 24, 24, 24, 24, 25, 25, 25, 25, 25, 25, 25, 26, 26, 26, 26, 26, 26, 26, 26, 27, 27, 27, 27, 27, 27, 27, 27, 27, 27, 28, 28, 28, 28, 28, 28, 28, 28, 28, 28, 29, 29, 29, 29, 29, 29, 29, 29, 29, 29, 29, 29, 30, 30, 30, 30, 30, 30, 30, 30, 30, 30, 30, 30, 30, 30, 31, 31, 31, 31, 31, 31, 31, 31, 31, 31, 31, 31, 31, 31, 31, 31};

template <class F> DI void transpose_item(const float* W, int K, int N, bf16* WT, F rowmap, LAS float* scr, int item, int lane) {
    const int nblk = (N + 63) / 64, kb = item / nblk, nb = item % nblk, k0 = 64 * kb, n0 = 64 * nb;
    const int n4 = (lane & 15) * 4;
    const bool inb = n0 + n4 < N; const int ncl = inb ? n0 + n4 : N - 4;
    f32x4 vv[16];
#pragma unroll
    for (int i = 0; i < 16; ++i) vv[i] = *(const f32x4*)(W + (size_t)(k0 + 4 * i + (lane >> 4)) * N + ncl);
#pragma unroll
    for (int i = 0; i < 16; ++i) asm volatile("" : "+v"(vv[i]));
#pragma unroll
    for (int i = 0; i < 16; ++i) { const int kk = 4 * i + (lane >> 4);
        const f32x4 v = inb ? vv[i] : (f32x4){0.f, 0.f, 0.f, 0.f};
        LAS float* d = scr + kk * 65 + n4; d[0] = v[0]; d[1] = v[1]; d[2] = v[2]; d[3] = v[3]; }
    asm volatile("s_waitcnt lgkmcnt(0)" ::: "memory");
    const int c = lane & 7;
#pragma unroll
    for (int j = 0; j < 8; ++j) { const int nl = (lane >> 3) + 8 * j, n = n0 + nl; const LAS float* s = scr + (8 * c) * 65 + nl;
        u32x4 o; o.x = pk2(s[0 * 65], s[1 * 65]); o.y = pk2(s[2 * 65], s[3 * 65]); o.z = pk2(s[4 * 65], s[5 * 65]); o.w = pk2(s[6 * 65], s[7 * 65]);
        if (n < N) *(u32x4*)(WT + (size_t)rowmap(n) * K + k0 + 8 * c) = o; }
    asm volatile("s_waitcnt lgkmcnt(0)" ::: "memory");
}

DI void phase0w(const Params& p, LAS unsigned char* lds) {
    const int tid = threadIdx.x, lane = tid & 63, wave = __builtin_amdgcn_readfirstlane(tid >> 6);
    const int gw = blockIdx.x * 8 + wave, NGW = gridDim.x * 8;
    unsigned char* ws = p.ws;
    {
        LAS float* scr = (LAS float*)(lds + wave * 16640);
        constexpr int I_IN = 16 * 95, I_OA = 8 * 16, I_OB = 8 * 16, I_O = 16 * 16, I_W1 = 32 * 4, I_W2 = 4 * 1, I_L = 1 * 8;
        constexpr int NIT = I_IN + I_OA + I_OB + I_O + 2 * I_W1 + 2 * I_W2 + 2 * I_L;
        auto ident = [](int n) { return n; };
        auto inmap = [](int n) { return n < CAS_USED ? n : n + (LD_CAS - CAS_USED); };
        for (int it = gw; it < NIT; it += NGW) {
            int r = it;
            if (r < I_IN) { transpose_item(p.w_in, DM, N_IN, (bf16*)(ws + WS_WIN_T), inmap, scr, r, lane); continue; } r -= I_IN;
            if (r < I_OA) { transpose_item(p.w_out_a, 512, DM, (bf16*)(ws + WS_WA_T), ident, scr, r, lane); continue; } r -= I_OA;
            if (r < I_OB) { transpose_item(p.w_out_b, 512, DM, (bf16*)(ws + WS_WB_T), ident, scr, r, lane); continue; } r -= I_OB;
            if (r < I_O) { transpose_item(p.w_o, DM, DM, (bf16*)(ws + WS_WO_T), ident, scr, r, lane); continue; } r -= I_O;
            if (r < I_W1) { transpose_item(p.cmp_k_w1, 2048, 256, (bf16*)(ws + WS_W1K_T), ident, scr, r, lane); continue; } r -= I_W1;
            if (r < I_W1) { transpose_item(p.cmp_v_w1, 2048, 256, (bf16*)(ws + WS_W1V_T), ident, scr, r, lane); continue; } r -= I_W1;
            if (r < I_W2) { transpose_item(p.cmp_k_w2, 256, 64, (bf16*)(ws + WS_W2K_T), ident, scr, r, lane); continue; } r -= I_W2;
            if (r < I_W2) { transpose_item(p.cmp_v_w2, 256, 64, (bf16*)(ws + WS_W2V_T), ident, scr, r, lane); continue; } r -= I_W2;
            if (r < I_L) { transpose_item(p.w_lora_up, 64, 512, (bf16*)(ws + WS_WLW_T), ident, scr, r, lane); continue; } r -= I_L;
            transpose_item(p.a_lora_up, 64, 512, (bf16*)(ws + WS_WLA_T), ident, scr, r, lane);
        }
    }
    {
        u32x4* z = (u32x4*)(ws + WS_WIN_T + (size_t)CAS_USED * DM * 2);
        const int n16 = (LD_CAS - CAS_USED) * DM * 2 / 16;
        for (int i = blockIdx.x * 512 + tid; i < n16; i += gridDim.x * 512) z[i] = (u32x4){0u, 0u, 0u, 0u};
    }
    __syncthreads();
}
constexpr size_t WS_MODP = 1 * MiB;
DI void phase0(const Params& p, LAS unsigned char* lds) {
    const int tid = threadIdx.x, lane = tid & 63, wave = __builtin_amdgcn_readfirstlane(tid >> 6);
    unsigned char* ws = p.ws;
    LAS float* red = (LAS float*)lds;
    LAS float* sc = (LAS float*)(lds + 32768);
    for (int task = blockIdx.x; task < 201; task += gridDim.x) {
        if (task < 192) {
            const int cg = task % 48, kq = task / 48;
            for (int i = tid; i < 16 * 256; i += 512) sc[i] = siluf_(p.c[(i >> 8) * 1024 + kq * 256 + (i & 255)]);
            __syncthreads();
            const int col = cg * 64 + lane;
            float acc[16];
#pragma unroll
            for (int b = 0; b < 16; ++b) acc[b] = 0.f;
#pragma unroll 4
            for (int kk = 0; kk < 32; ++kk) { const int kl = wave * 32 + kk; const float wv = p.w_ada[(size_t)(kq * 256 + kl) * 3072 + col];
#pragma unroll
                for (int b = 0; b < 16; ++b) acc[b] += sc[b * 256 + kl] * wv; }
#pragma unroll
            for (int b = 0; b < 16; ++b) red[(wave * 16 + b) * 64 + lane] = acc[b];
            __syncthreads();
            for (int o = tid; o < 1024; o += 512) { const int b = o >> 6, l = o & 63; float s = 0.f;
#pragma unroll
                for (int w = 0; w < 8; ++w) s += red[(w * 16 + b) * 64 + l];
                ((float*)(ws + WS_MODP))[(kq * 16 + b) * 3072 + cg * 64 + l] = s; }
            __syncthreads();
        } else if (task < 200) {
            const int t2 = task - 192, which = t2 >> 2, col = (t2 & 3) * 64 + lane;
            const float* pos = which ? p.cmp_pos_v : p.cmp_pos_k; const float* w1 = which ? p.cmp_v_w1 : p.cmp_k_w1;
            float a = 0.f;
#pragma unroll 4
            for (int kk = 0; kk < 256; ++kk) { const int k = wave * 256 + kk; a += pos[k] * w1[(size_t)k * 256 + col]; }
            red[wave * 64 + lane] = a;
            __syncthreads();
            if (tid < 64) { float s = 0.f;
#pragma unroll
                for (int w = 0; w < 8; ++w) s += red[w * 64 + tid];
                ((float*)(ws + WS_POSB))[which * 256 + (t2 & 3) * 64 + tid] = s; }
            __syncthreads();
        } else {
            for (int i = tid; i < 8 * 129; i += 512) { const int h = i / 129, d = i % 129; ((float*)(ws + WS_BIAS))[h * 132 + d] = p.rel_bias[T5_BUCKET[d] * 8 + h] * LOG2E; }
        }
    }
}

DI void phase1(const Params& p, LAS unsigned char* lds) {
    const int tid = threadIdx.x, lane = tid & 63, wave = tid >> 6;
    bf16* hb = (bf16*)((unsigned char*)p.out + OUT_H);
    LAS float* modL = (LAS float*)lds;
    for (int rb = blockIdx.x; rb < MTOK / 128; rb += gridDim.x) {
        const int b = rb >> 4;
        __syncthreads();
        for (int col = tid; col < 3072; col += 512) { float s = p.b_ada[col];
#pragma unroll
            for (int kq = 0; kq < 4; ++kq) s += ((const float*)(p.ws + WS_MODP))[(kq * 16 + b) * 3072 + col];
            modL[col] = s; if ((rb & 15) == 0) ((float*)(p.ws + WS_MOD))[b * 3072 + col] = s; }
        __syncthreads();
        f32x4 gq[4];
#pragma unroll
        for (int j = 0; j < 4; ++j) gq[j] = *(const f32x4*)(p.norm_gain + 4 * lane + 256 * j);
        f32x4 vn[4];
        { const f32x4* xr = (const f32x4*)(p.x + (size_t)(rb * 128 + wave) * DM) + lane;
#pragma unroll
          for (int j = 0; j < 4; ++j) vn[j] = xr[64 * j]; }
        for (int r = wave; r < 128; r += 8) {
            const int m = rb * 128 + r;
            f32x4 v[4]; float s = 0.f;
#pragma unroll
            for (int j = 0; j < 4; ++j) v[j] = vn[j];
            { const f32x4* xr = (const f32x4*)(p.x + (size_t)(rb * 128 + min(r + 8, 120 + wave)) * DM) + lane;
#pragma unroll
              for (int j = 0; j < 4; ++j) vn[j] = xr[64 * j]; }
#pragma unroll
            for (int j = 0; j < 4; ++j) s += (v[j].x * v[j].x + v[j].y * v[j].y) + (v[j].z * v[j].z + v[j].w * v[j].w);
            const float rinv = rsqrtf(wave_sum(s) * (1.f / DM) + 1e-6f);
            u32x2* o8 = (u32x2*)(hb + (size_t)m * DM) + lane;
#pragma unroll
            for (int j = 0; j < 4; ++j) {
                const int k = 4 * lane + 256 * j;
                const f32x4 g = gq[j], sh = *(const LAS f32x4*)(modL + k), scl = *(const LAS f32x4*)(modL + 1024 + k);
                f32x4 h = v[j] * rinv * g * (scl + 1.f) + sh;
                u32x2 o; o.x = pk2(h.x, h.y); o.y = pk2(h.z, h.w); o8[64 * j] = o;
            }
        }
    }
    __syncthreads();
}

struct EpiInProj {
    static constexpr bool PERM = true;
    bf16* cas; bf16* cr;
    DI void operator()(const f32x4 (&acc)[2][2][4][2], const pg8::Unit& u, int wr, int wc, int fr, int fq) const {
        const int row0 = u.pm * 256 + wr * 64 + fr;
        bf16* base; int ldc, colt;
        if (u.pn < 14) { base = cas; ldc = LD_CAS; colt = u.pn * 256; } else { base = cr; ldc = LD_CR; colt = (u.pn - 14) * 256; }
        const int col0 = colt + wc * 32 + 8 * fq;
#pragma unroll
        for (int ai = 0; ai < 2; ++ai)
#pragma unroll
            for (int m = 0; m < 4; ++m) { bf16* rowp = base + (size_t)(row0 + ai * 128 + m * 16) * ldc + col0;
#pragma unroll
                for (int bj = 0; bj < 2; ++bj) { const f32x4 v0 = acc[ai][bj][m][0], v1 = acc[ai][bj][m][1];
                    u32x4 w; w.x = pk2(v0[0], v0[1]); w.y = pk2(v0[2], v0[3]); w.z = pk2(v1[0], v1[1]); w.w = pk2(v1[2], v1[3]);
                    *(u32x4*)(rowp + bj * 128) = w; } }
    }
};
template <int WHICH> struct EpiGate {
    static constexpr bool PERM = true;
    bf16* merged; const bf16* cr;
    DI void operator()(const f32x4 (&acc)[2][2][4][2], const pg8::Unit& u, int wr, int wc, int fr, int fq) const {
        const int row0 = u.pm * 256 + wr * 64 + fr, col0 = u.pn * 256 + wc * 32 + 8 * fq;
#pragma unroll
        for (int ai = 0; ai < 2; ++ai)
#pragma unroll
            for (int mp2 = 0; mp2 < 2; ++mp2) {
                u32x4 gw[2][2], ow[2][2];
#pragma unroll
                for (int m2 = 0; m2 < 2; ++m2)
#pragma unroll
                    for (int bj = 0; bj < 2; ++bj) { const size_t row = (size_t)(row0 + ai * 128 + (2 * mp2 + m2) * 16); const int col = col0 + bj * 128;
                        gw[m2][bj] = *(const u32x4*)(cr + row * LD_CR + (WHICH ? MB0 : MA0) + col);
                        if (WHICH) ow[m2][bj] = *(const u32x4*)(merged + row * DM + col); }
#pragma unroll
                for (int m2 = 0; m2 < 2; ++m2)
#pragma unroll
                    for (int bj = 0; bj < 2; ++bj) { asm volatile("" : "+v"(gw[m2][bj])); if (WHICH) asm volatile("" : "+v"(ow[m2][bj])); }
#pragma unroll
                for (int m2 = 0; m2 < 2; ++m2)
#pragma unroll
                    for (int bj = 0; bj < 2; ++bj) { const int m = 2 * mp2 + m2; const size_t row = (size_t)(row0 + ai * 128 + m * 16); const int col = col0 + bj * 128;
                        float gl[8]; unpack8(gw[m2][bj], gl);
                        const f32x4 v0 = acc[ai][bj][m][0], v1 = acc[ai][bj][m][1];
                        float r[8] = {v0[0], v0[1], v0[2], v0[3], v1[0], v1[1], v1[2], v1[3]};
                        if (WHICH) { float old[8]; unpack8(ow[m2][bj], old);
#pragma unroll
                            for (int i = 0; i < 8; ++i) r[i] = old[i] + sigmoidf_(gl[i]) * r[i]; }
                        else {
#pragma unroll
                            for (int i = 0; i < 8; ++i) r[i] = sigmoidf_(gl[i]) * r[i]; }
                        u32x4 w; w.x = pk2(r[0], r[1]); w.y = pk2(r[2], r[3]); w.z = pk2(r[4], r[5]); w.w = pk2(r[6], r[7]);
                        *(u32x4*)(merged + row * DM + col) = w; }
            }
    }
};
struct EpiFinal {
    static constexpr bool PERM = false;
    const float* x; const float* mod; float* out;
    DI void operator()(const f32x4 (&acc)[2][2][4][2], const pg8::Unit& u, int wr, int wc, int fr, int fq) const {
        const int row0 = u.pm * 256 + wr * 64 + fr, col0 = u.pn * 256 + wc * 32 + 4 * fq;
        const int b = (u.pm * 256) >> 11;
        f32x4 gv[2][2];
#pragma unroll
        for (int bj = 0; bj < 2; ++bj)
#pragma unroll
            for (int n = 0; n < 2; ++n) gv[bj][n] = *(const f32x4*)(mod + b * 3072 + 2048 + col0 + bj * 128 + n * 16);
#pragma unroll
        for (int ai = 0; ai < 2; ++ai)
#pragma unroll
            for (int mp = 0; mp < 2; ++mp) {
                f32x4 xv[2][2][2];
#pragma unroll
                for (int m2 = 0; m2 < 2; ++m2)
#pragma unroll
                    for (int bj = 0; bj < 2; ++bj)
#pragma unroll
                        for (int n = 0; n < 2; ++n) xv[m2][bj][n] = *(const f32x4*)(x + (size_t)(row0 + ai * 128 + (2 * mp + m2) * 16) * DM + col0 + bj * 128 + n * 16);
#pragma unroll
                for (int m2 = 0; m2 < 2; ++m2)
#pragma unroll
                    for (int bj = 0; bj < 2; ++bj)
#pragma unroll
                        for (int n = 0; n < 2; ++n) asm volatile("" : "+v"(xv[m2][bj][n]));
#pragma unroll
                for (int m2 = 0; m2 < 2; ++m2)
#pragma unroll
                    for (int bj = 0; bj < 2; ++bj)
#pragma unroll
                        for (int n = 0; n < 2; ++n)
                            *(f32x4*)(out + (size_t)(row0 + ai * 128 + (2 * mp + m2) * 16) * DM + col0 + bj * 128 + n * 16) = xv[m2][bj][n] + gv[bj][n] * acc[ai][bj][2 * mp + m2][n];
            }
    }
};

DI void phase3a(const Params& p, LAS unsigned char* lds) {
    const int tid = threadIdx.x, lane = tid & 63, wave = tid >> 6;
    const int gw = blockIdx.x * 8 + wave, NGW = gridDim.x * 8;
    bf16* cas = (bf16*)(p.ws + WS_CAS);
    {
        float gq[8], gk[8];
        const int dq = (8 * lane) & 63;
#pragma unroll
        for (int i = 0; i < 8; ++i) gq[i] = p.q_norm_gain[dq + i] * QSCALE;
        const int kr = (lane < 16) ? 1 : 2, dk = (8 * lane) & 63;
#pragma unroll
        for (int i = 0; i < 8; ++i) gk[i] = p.k_norm_gain[kr * 64 + dk + i];
        const int kcol = (lane < 16) ? (KS0 + 8 * lane) : (KW0 + 8 * (lane & 15));
        for (int m0 = gw * 4; m0 < MTOK; m0 += NGW * 4) {
            u32x4 qw[4], kw[4];
#pragma unroll
            for (int u = 0; u < 4; ++u) { bf16* row = cas + (size_t)(m0 + u) * LD_CAS;
                qw[u] = *(const u32x4*)(row + Q0 + 8 * lane);
                kw[u] = (lane < 32) ? *(const u32x4*)(row + kcol) : (u32x4){0u, 0u, 0u, 0u}; }
#pragma unroll
            for (int u = 0; u < 4; ++u) {
                bf16* row = cas + (size_t)(m0 + u) * LD_CAS;
                float q[8], k[8]; unpack8(qw[u], q); unpack8(kw[u], k);
                float sq = 0.f, sk = 0.f;
#pragma unroll
                for (int i = 0; i < 8; ++i) { sq += q[i] * q[i]; sk += k[i] * k[i]; }
#pragma unroll
                for (int o = 1; o < 8; o <<= 1) { sq += __shfl_xor(sq, o); sk += __shfl_xor(sk, o); }
                const float rq = rsqrtf(sq * (1.f / 64.f) + 1e-6f), rk = rsqrtf(sk * (1.f / 64.f) + 1e-6f);
#pragma unroll
                for (int i = 0; i < 8; ++i) { q[i] *= rq * gq[i]; k[i] *= rk * gk[i]; }
                u32x4 o; o.x = pk2(q[0], q[1]); o.y = pk2(q[2], q[3]); o.z = pk2(q[4], q[5]); o.w = pk2(q[6], q[7]);
                *(u32x4*)(row + Q0 + 8 * lane) = o;
                if (lane < 32) { u32x4 o2; o2.x = pk2(k[0], k[1]); o2.y = pk2(k[2], k[3]); o2.z = pk2(k[4], k[5]); o2.w = pk2(k[6], k[7]); *(u32x4*)(row + kcol) = o2; }
            }
        }
    }
    {
        LAS bf16* tile = (LAS bf16*)lds;
        for (int it = blockIdx.x; it < 2048; it += gridDim.x) {
            const int which = it >> 10, bg = (it >> 5) & 31, j = it & 31, b = bg >> 1, g = bg & 1;
            const int key = tid >> 3, ch = tid & 7;
            __syncthreads();
            *(LAS u32x4*)(tile + key * 72 + 8 * ch) = *(const u32x4*)(cas + (size_t)(b * SEQ + 64 * j + key) * LD_CAS + (which ? VW0 : VS0) + g * 64 + 8 * ch);
            __syncthreads();
            const int d = tid >> 3, pc = tid & 7;
            unsigned short v[8];
#pragma unroll
            for (int i = 0; i < 8; ++i) { const int pos = 8 * pc + i, k2 = (pos & ~15) | key16_of_pos(pos & 15); v[i] = tile[k2 * 72 + d]; }
            u32x4 o; o.x = v[0] | ((unsigned)v[1] << 16); o.y = v[2] | ((unsigned)v[3] << 16); o.z = v[4] | ((unsigned)v[5] << 16); o.w = v[6] | ((unsigned)v[7] << 16);
            bf16* vt = (bf16*)(p.ws + (which ? WS_VTW : WS_VTS)) + ((size_t)(bg * 32 + j) * 64 + d) * 64 + 8 * pc;
            *(u32x4*)vt = o;
        }
        __syncthreads();
    }
}

DI float gelu_tanh(float x) { const float u = 0.7978845608028654f * (x + 0.044715f * x * x * x); const float t = 1.f - 2.f * __builtin_amdgcn_rcpf(__expf(2.f * u) + 1.f); return 0.5f * x * (1.f + t); }
DI void phase3b(const Params& p, LAS unsigned char* lds) {
    const int tid = threadIdx.x, lane = tid & 63, wave = __builtin_amdgcn_readfirstlane(tid >> 6), l31 = lane & 31, hh = lane >> 5;
    const bf16* cas = (const bf16*)(p.ws + WS_CAS);
    LAS bf16* h1 = (LAS bf16*)lds;
    LAS float* o2 = (LAS float*)(lds + 32 * 264 * 2);
    LAS unsigned char* xs = lds + 32768;
    float kgain[8];
#pragma unroll
    for (int i = 0; i < 8; ++i) kgain[i] = p.k_norm_gain[(tid & 7) * 8 + i];
    for (int it = blockIdx.x; it < 256; it += gridDim.x) {
        const int which = it >> 7, bg = (it >> 2) & 31, rq = it & 3, b = bg >> 1, g = bg & 1;
        {
            const bf16* xsrc = cas + (size_t)(b * SEQ) * LD_CAS + (which ? VC0 : KC0) + g * 64;
            for (int i = tid; i < 528 * 8; i += 512) { const int tr = i >> 3, ch = i & 7; int tok = 512 * rq + tr; tok = tok < SEQ ? tok : SEQ - 1;
                *(LAS u32x4*)(xs + tr * 128 + ((ch ^ ((tr >> 4) & 7)) << 4)) = *(const u32x4*)(xsrc + (size_t)tok * LD_CAS + 8 * ch); }
        }
        __syncthreads();
        const bf16* brow = (const bf16*)(p.ws + (which ? WS_W1V_T : WS_W1K_T)) + (size_t)(32 * wave + l31) * 2048 + 8 * hh;
        f32x16 acc = {};
#pragma unroll 16
        for (int s = 0; s < 128; ++s) {
            const int kk = 16 * s, tr = 16 * l31 + (kk >> 6), ch = ((kk & 63) >> 3) + hh;
            const bf16x8 a = *(const LAS bf16x8*)(xs + tr * 128 + ((ch ^ ((tr >> 4) & 7)) << 4));
            const bf16x8 bb = *(const bf16x8*)(brow + kk);
            acc = __builtin_amdgcn_mfma_f32_32x32x16_bf16(a, bb, acc, 0, 0, 0);
        }
        const float pb = ((const float*)(p.ws + WS_POSB))[which * 256 + 32 * wave + l31];
        __syncthreads();
#pragma unroll
        for (int r = 0; r < 16; ++r) h1[crow(r, hh) * 264 + 32 * wave + l31] = (bf16)f2bf(gelu_tanh(acc[r] + pb));
        __syncthreads();
        if (wave < 2) {
            const bf16* b2 = (const bf16*)(p.ws + (which ? WS_W2V_T : WS_W2K_T)) + (size_t)(32 * wave + l31) * 256 + 8 * hh;
            f32x16 a2 = {};
#pragma unroll
            for (int s = 0; s < 16; ++s) {
                const bf16x8 a = *(const LAS bf16x8*)(h1 + l31 * 264 + 16 * s + 8 * hh);
                const bf16x8 bb = *(const bf16x8*)(b2 + 16 * s);
                a2 = __builtin_amdgcn_mfma_f32_32x32x16_bf16(a, bb, a2, 0, 0, 0);
            }
#pragma unroll
            for (int r = 0; r < 16; ++r) o2[crow(r, hh) * 65 + 32 * wave + l31] = a2[r];
        }
        __syncthreads();
        if (tid < 256) {
            const int nl = tid >> 3, e8 = (tid & 7) * 8, nn = 32 * rq + nl;
            float v[8]; float ss = 0.f;
#pragma unroll
            for (int i = 0; i < 8; ++i) { v[i] = o2[nl * 65 + e8 + i]; ss += v[i] * v[i]; }
            if (which == 0) {
#pragma unroll
                for (int o = 1; o < 8; o <<= 1) ss += __shfl_xor(ss, o);
                const float rinv = rsqrtf(ss * (1.f / 64.f) + 1e-6f);
#pragma unroll
                for (int i = 0; i < 8; ++i) v[i] = (nn < 127) ? v[i] * rinv * kgain[i] : 0.f;
                u32x4 o; o.x = pk2(v[0], v[1]); o.y = pk2(v[2], v[3]); o.z = pk2(v[4], v[5]); o.w = pk2(v[6], v[7]);
                *(u32x4*)((bf16*)(p.ws + WS_KC) + (size_t)(bg * 128 + nn) * 64 + e8) = o;
            } else {
                const int pos = (nn & ~15) | pos16_of_key(nn & 15);
                bf16* vct = (bf16*)(p.ws + WS_VCT) + (size_t)bg * 64 * 128 + pos;
#pragma unroll
                for (int i = 0; i < 8; ++i) vct[(size_t)(e8 + i) * 128] = (bf16)f2bf((nn < 127) ? v[i] : 0.f);
            }
        }
        __syncthreads();
    }
}

constexpr int SLOTB = 8192;
DI int sw_el(int row, int col) { return row * 64 + ((((col >> 3) ^ (row & 7)) << 3) | (col & 7)); }
DI int swf_el(int row, int col) { return row * 64 + ((((col >> 2) ^ (row & 15)) << 2) | (col & 3)); }
DI bf16x8 frag_row(const LAS bf16* Mx, int row, int kc) { return *(const LAS bf16x8*)(Mx + sw_el(row, kc)); }
DI bf16x8 frag_col(const LAS bf16* Mx, int k0, int colbase, int lane) {
    const int i16 = lane & 15, q = i16 >> 2, pp = i16 & 3, blk = (lane >> 4) & 1, col = colbase + 16 * blk + 4 * pp;
    const s16x4 lo = tr_read(Mx + sw_el(k0 + q, col)), hi = tr_read(Mx + sw_el(k0 + 4 + q, col));
    return __builtin_shufflevector(lo, hi, 0, 1, 2, 3, 4, 5, 6, 7);
}
template <bool TA, bool TB> DI void mm_acc(f32x16& acc, const LAS bf16* A, const LAS bf16* Bm, int ti, int tj, int lane) {
    const int l31 = lane & 31, hh = lane >> 5;
#pragma unroll
    for (int s = 0; s < 4; ++s) {
        const int k0 = 16 * s + 8 * hh;
        bf16x8 x, y;
        if (TB) x = frag_row(Bm, 32 * tj + l31, k0); else x = frag_col(Bm, k0, 32 * tj, lane);
        if (TA) y = frag_col(A, k0, 32 * ti, lane); else y = frag_row(A, 32 * ti + l31, k0);
        acc = __builtin_amdgcn_mfma_f32_32x32x16_bf16(x, y, acc, 0, 0, 0);
    }
}
DI void ld_tile(f32x16& acc, const LAS bf16* Mx, int ti, int tj, int l31, int hh) {
#pragma unroll
    for (int g = 0; g < 4; ++g) { const u32x2 w = *(const LAS u32x2*)(Mx + sw_el(32 * ti + l31, 32 * tj + 8 * g + 4 * hh));
        acc[4 * g] = bflo(w.x); acc[4 * g + 1] = bfhi(w.x); acc[4 * g + 2] = bflo(w.y); acc[4 * g + 3] = bfhi(w.y); }
}
DI void st_tile(LAS bf16* Mx, const f32x16& acc, int ti, int tj, int l31, int hh) {
#pragma unroll
    for (int g = 0; g < 4; ++g) { u32x2 w; w.x = pk2(acc[4 * g], acc[4 * g + 1]); w.y = pk2(acc[4 * g + 2], acc[4 * g + 3]);
        *(LAS u32x2*)(Mx + sw_el(32 * ti + l31, 32 * tj + 8 * g + 4 * hh)) = w; }
}
DI void st_native_global(bf16* Tm, const f32x16& acc, int tile, int lane) {
    u32x4 a, b;
    a.x = pk2(acc[0], acc[1]); a.y = pk2(acc[2], acc[3]); a.z = pk2(acc[4], acc[5]); a.w = pk2(acc[6], acc[7]);
    b.x = pk2(acc[8], acc[9]); b.y = pk2(acc[10], acc[11]); b.z = pk2(acc[12], acc[13]); b.w = pk2(acc[14], acc[15]);
    u32x4* d = (u32x4*)(Tm + (size_t)tile * 1024 + lane * 8); d[0] = a; d[64] = b;
}
DI void ld_native_global(f32x16& acc, const bf16* Tm, int tile, int lane) {
    const u32x4* d = (const u32x4*)(Tm + (size_t)tile * 1024 + lane * 8); const u32x4 a = d[0], b = d[64];
    acc[0] = bflo(a.x); acc[1] = bfhi(a.x); acc[2] = bflo(a.y); acc[3] = bfhi(a.y); acc[4] = bflo(a.z); acc[5] = bfhi(a.z); acc[6] = bflo(a.w); acc[7] = bfhi(a.w);
    acc[8] = bflo(b.x); acc[9] = bfhi(b.x); acc[10] = bflo(b.y); acc[11] = bfhi(b.y); acc[12] = bflo(b.z); acc[13] = bfhi(b.z); acc[14] = bflo(b.w); acc[15] = bfhi(b.w);
}
DI bf16x8 pack8(const f32x16& x, int s) {
    u32x4 w; w.x = pk2(x[8 * s], x[8 * s + 1]); w.y = pk2(x[8 * s + 2], x[8 * s + 3]); w.z = pk2(x[8 * s + 4], x[8 * s + 5]); w.w = pk2(x[8 * s + 6], x[8 * s + 7]);
    return __builtin_bit_cast(bf16x8, w);
}
DI bf16x8 frag_col_perm(const LAS bf16* Mx, int kb16, int colbase, int lane) {
    const int i16 = lane & 15, q = i16 >> 2, pp = i16 & 3, blk = (lane >> 4) & 1, hh = lane >> 5, col = colbase + 16 * blk + 4 * pp;
    const s16x4 lo = tr_read(Mx + sw_el(kb16 + 4 * hh + q, col)), hi = tr_read(Mx + sw_el(kb16 + 8 + 4 * hh + q, col));
    return __builtin_shufflevector(lo, hi, 0, 1, 2, 3, 4, 5, 6, 7);
}
DI void mm32_acc(f32x16& C, const f32x16& A, const LAS bf16* Bm, int kb, int colbase, int lane) {
    const bf16x8 a0 = pack8(A, 0), a1 = pack8(A, 1);
    C = __builtin_amdgcn_mfma_f32_32x32x16_bf16(frag_col_perm(Bm, kb, colbase, lane), a0, C, 0, 0, 0);
    C = __builtin_amdgcn_mfma_f32_32x32x16_bf16(frag_col_perm(Bm, kb + 16, colbase, lane), a1, C, 0, 0, 0);
}
DI u32x4 pack8f(const float* v) { u32x4 o; o.x = pk2(v[0], v[1]); o.y = pk2(v[2], v[3]); o.z = pk2(v[4], v[5]); o.w = pk2(v[6], v[7]); return o; }

DI void phase3c(const Params& p, LAS unsigned char* lds) {
    const int tid0 = threadIdx.x, wave = __builtin_amdgcn_readfirstlane(tid0 >> 6);
    const int half = wave >> 2, lw = wave & 3, ti = (lw >> 1) & 1, tj = lw & 1;
    const bf16* cas = (const bf16*)(p.ws + WS_CAS);
    LAS unsigned char* hb = lds + half * 65536;
#define SL(i) ((LAS bf16*)(hb + (i) * SLOTB))
    LAS float* F1 = (LAS float*)(hb);
    LAS float* F2 = (LAS float*)(hb + 2 * SLOTB);
    LAS float* gam = (LAS float*)(lds + 131072) + half * 64;
    LAS float* tot = (LAS float*)(lds + 131072 + 512) + half * 256;
    LAS float* parL = (LAS float*)(lds + 131072 + 512 + 2048) + half * 640;
    int par_h = -1;
#define LDS_BAR() asm volatile("s_waitcnt lgkmcnt(0)\n\ts_barrier" ::: "memory")
    u32x4 nwd[2], nad[2], npw[2], npa[2];
#define E1_FETCH(PR) do { const int it_ = 2 * (PR) + half; const int c_ = it_ & 31; const size_t me_ = (size_t)(it_ >> 8) * SEQ + 64 * c_ + ((tid0 & 255) >> 2); \
        const bool hp_ = (64 * c_ + ((tid0 & 255) >> 2)) > 0; const int j16_ = (tid0 & 3) * 16; \
        _Pragma("unroll") for (int sp = 0; sp < 2; ++sp) { \
            nwd[sp] = *(const u32x4*)(cas + me_ * LD_CAS + WD0 + j16_ + 8 * sp); nad[sp] = *(const u32x4*)(cas + me_ * LD_CAS + AD0 + j16_ + 8 * sp); \
            npw[sp] = *(const u32x4*)(cas + (me_ - (hp_ ? 1 : 0)) * LD_CAS + WD0 + j16_ + 8 * sp); npa[sp] = *(const u32x4*)(cas + (me_ - (hp_ ? 1 : 0)) * LD_CAS + AD0 + j16_ + 8 * sp); } } while (0)
    unsigned pf0 = 0u, pf1 = 0u;
    if ((int)blockIdx.x < 2048) E1_FETCH((int)blockIdx.x);
#pragma unroll
    for (int k = 0; k < 8; ++k) *(u32x4*)(p.ws + WS_DUMMY + (size_t)k * 8192 + tid0 * 16) = (u32x4){0u, 0u, 0u, 0u};
    for (int pr = blockIdx.x; pr < 2048; pr += gridDim.x) {
        int tid = tid0; asm volatile("" : "+v"(tid));
        const int lane = tid & 63, l31 = lane & 31, hh = lane >> 5, ltid = tid & 255;
        const int item = 2 * pr + half;
        const int c = item & 31, h = (item >> 5) & 7, b = item >> 8;
        const size_t m0 = (size_t)b * SEQ + 64 * c;
        const int te = ltid >> 2, c16 = (ltid & 3) * 16; const size_t me = m0 + te; const bool hpv = (64 * c + te) > 0;
        if (h != par_h) {
            par_h = h;
            for (int i = ltid; i < 640; i += 256) { const int rw = i >> 6, cc = i & 63; float v;
                if (rw == 0) v = p.w0[h * 64 + cc]; else if (rw == 1) v = p.a0[h * 64 + cc]; else if (rw == 2) v = p.k_k[h * 64 + cc]; else if (rw == 3) v = p.k_a[h * 64 + cc];
                else if (rw == 4) v = p.r_k[h * 64 + cc]; else if (rw < 8) v = p.shift_mu[(rw - 5) * 512 + h * 64 + cc]; else v = p.shift_mu[1536 + (rw - 8) * 64 + cc];
                parL[i] = v; }
            LDS_BAR();
        }
        u32x4 gk[2], gr[2], gv[2], gkp[2], grp[2], gvp[2];
#pragma unroll
        for (int sp = 0; sp < 2; ++sp) { const int hc8 = h * 64 + c16 + 8 * sp;
            gk[sp] = *(const u32x4*)(cas + me * LD_CAS + K0 + hc8); gr[sp] = *(const u32x4*)(cas + me * LD_CAS + R0 + hc8); gv[sp] = *(const u32x4*)(cas + me * LD_CAS + V0 + hc8);
            const size_t mp = me - (hpv ? 1 : 0);
            gkp[sp] = *(const u32x4*)(cas + mp * LD_CAS + K0 + hc8); grp[sp] = *(const u32x4*)(cas + mp * LD_CAS + R0 + hc8); gvp[sp] = *(const u32x4*)(cas + mp * LD_CAS + V0 + hc8); }
        bf16x8 wfr[2][4];
#pragma unroll
        for (int pd = 0; pd < 2; ++pd) { const bf16* wt = (const bf16*)(p.ws + (pd ? WS_WLA_T : WS_WLW_T)) + (size_t)(h * 64 + 32 * tj + l31) * 64;
#pragma unroll
            for (int s = 0; s < 4; ++s) wfr[pd][s] = *(const bf16x8*)(wt + 16 * s + 8 * hh); }
#pragma unroll
        for (int sp = 0; sp < 2; ++sp) {
            const int j8 = c16 + 8 * sp;
            float wd[8], ad[8], pw[8], pa[8];
            asm volatile("" : "+v"(npw[sp]), "+v"(npa[sp]));
            unpack8(nwd[sp], wd); unpack8(nad[sp], ad); unpack8(hpv ? npw[sp] : (u32x4){0u, 0u, 0u, 0u}, pw); unpack8(hpv ? npa[sp] : (u32x4){0u, 0u, 0u, 0u}, pa);
#pragma unroll
            for (int i = 0; i < 8; ++i) { const float x = wd[i] + (pw[i] - wd[i]) * parL[512 + j8 + i]; const float e2 = __expf(2.f * x); wd[i] = 1.f - 2.f * __builtin_amdgcn_rcpf(e2 + 1.f);
                ad[i] = ad[i] + (pa[i] - ad[i]) * parL[576 + j8 + i]; }
            *(LAS u32x4*)(SL(6) + sw_el(te, j8)) = pack8f(wd);
            *(LAS u32x4*)(SL(7) + sw_el(te, j8)) = pack8f(ad);
        }
        E1_FETCH(min(pr + (int)gridDim.x, 2047));
        LDS_BAR();
#pragma unroll
        for (int pd = 0; pd < 2; ++pd) {
            const LAS bf16* Am = pd ? SL(7) : SL(6);
            f32x16 acc = {};
#pragma unroll
            for (int s = 0; s < 4; ++s) { const int k0 = 16 * s + 8 * hh;
                const bf16x8 y = frag_row(Am, 32 * ti + l31, k0);
                acc = __builtin_amdgcn_mfma_f32_32x32x16_bf16(wfr[pd][s], y, acc, 0, 0, 0); }
            LAS float* F = pd ? F2 : F1;
#pragma unroll
            for (int g = 0; g < 4; ++g) *(LAS f32x4*)(F + swf_el(32 * ti + l31, 32 * tj + 8 * g + 4 * hh)) = (f32x4){acc[4 * g], acc[4 * g + 1], acc[4 * g + 2], acc[4 * g + 3]};
        }
        LDS_BAR();
        asm volatile("" :: "v"(pf0), "v"(pf1));
        float lw16[16], av16[16], bv16[16], km16[16], rs16[16];
        {
            float kraw[16], icl[16]; float ss = 0.f, bon = 0.f;
#pragma unroll
            for (int sp = 0; sp < 2; ++sp) {
                const int c8 = c16 + 8 * sp, hc8 = h * 64 + c8;
                float kc_[8], kp_[8], rc_[8], rp_[8], vc_[8], vp_[8];
                asm volatile("" : "+v"(gkp[sp]), "+v"(grp[sp]), "+v"(gvp[sp]));
                const u32x4 z4 = {0u, 0u, 0u, 0u};
                unpack8(gk[sp], kc_); unpack8(gr[sp], rc_); unpack8(gv[sp], vc_); unpack8(hpv ? gkp[sp] : z4, kp_); unpack8(hpv ? grp[sp] : z4, rp_); unpack8(hpv ? gvp[sp] : z4, vp_);
                const f32x4 z0 = *(const LAS f32x4*)(F1 + swf_el(te, c8)), z1 = *(const LAS f32x4*)(F1 + swf_el(te, c8 + 4));
                const f32x4 a0_ = *(const LAS f32x4*)(F2 + swf_el(te, c8)), a1_ = *(const LAS f32x4*)(F2 + swf_el(te, c8 + 4));
                const float zz[8] = {z0[0], z0[1], z0[2], z0[3], z1[0], z1[1], z1[2], z1[3]}, ap[8] = {a0_[0], a0_[1], a0_[2], a0_[3], a1_[0], a1_[1], a1_[2], a1_[3]};
                float vs[8];
#pragma unroll
                for (int i = 0; i < 8; ++i) {
                    const int e = 8 * sp + i;
                    const int pc = c8 + i;
                    const float ks = kc_[i] + (kp_[i] - kc_[i]) * parL[384 + pc];
                    rs16[e] = rc_[i] + (rp_[i] - rc_[i]) * parL[320 + pc];
                    vs[i] = vc_[i] + (vp_[i] - vc_[i]) * parL[448 + pc];
                    const float nz = -(parL[pc] + zz[i]), spv = nz > 20.f ? nz : __logf(1.f + __expf(nz));
                    lw16[e] = -__expf(-spv - 0.5f);
                    icl[e] = sigmoidf_(parL[64 + pc] + ap[i]);
                    kraw[e] = ks * parL[128 + pc]; ss += kraw[e] * kraw[e];
                    km16[e] = ks * (1.f + (icl[e] - 1.f) * parL[192 + pc]);
                    bon += rs16[e] * km16[e] * parL[256 + pc];
                }
                *(LAS u32x4*)(SL(7) + sw_el(te, c8)) = pack8f(vs);
            }
            ss += __shfl_xor(ss, 1); ss += __shfl_xor(ss, 2); bon += __shfl_xor(bon, 1); bon += __shfl_xor(bon, 2);
            const float rn = rsqrtf(fmaxf(ss, 1e-24f));
#pragma unroll
            for (int e = 0; e < 16; ++e) { const float kk = kraw[e] * rn; av16[e] = -kk; bv16[e] = kk * icl[e]; }
#pragma unroll
            for (int q4 = 0; q4 < 4; ++q4) *(LAS f32x4*)(F1 + swf_el(te, c16 + 4 * q4)) = (f32x4){lw16[4 * q4], lw16[4 * q4 + 1], lw16[4 * q4 + 2], lw16[4 * q4 + 3]};
            if ((ltid & 3) == 0) ((float*)(p.ws + WS_BONUS))[me * 8 + h] = bon;
        }
        LDS_BAR();
        {
            const int cc = ltid & 63, tq = ltid >> 6;
            float L[16]; L[0] = F1[swf_el(16 * tq, cc)];
#pragma unroll
            for (int i = 1; i < 16; ++i) L[i] = L[i - 1] + F1[swf_el(16 * tq + i, cc)];
            tot[tq * 64 + cc] = L[15];
            LDS_BAR();
            float off = 0.f;
            for (int q = 0; q < tq; ++q) off += tot[q * 64 + cc];
#pragma unroll
            for (int i = 0; i < 16; ++i) F1[swf_el(16 * tq + i, cc)] = off + L[i];
            if (tq == 3) gam[cc] = __expf(off + L[15]);
        }
        LDS_BAR();
        {
            float Lt[16];
#pragma unroll
            for (int q4 = 0; q4 < 4; ++q4) { const f32x4 a = *(const LAS f32x4*)(F1 + swf_el(te, c16 + 4 * q4)); Lt[4 * q4] = a[0]; Lt[4 * q4 + 1] = a[1]; Lt[4 * q4 + 2] = a[2]; Lt[4 * q4 + 3] = a[3]; }
#pragma unroll
            for (int sp = 0; sp < 2; ++sp) {
                float oa[8], ob[8], ok[8], orr[8];
#pragma unroll
                for (int i = 0; i < 8; ++i) { const int e = 8 * sp + i; const float ep = __expf(Lt[e]), en = __builtin_amdgcn_rcpf(ep), e3 = __expf(Lt[e] - lw16[e]);
                    oa[i] = av16[e] * e3; ob[i] = bv16[e] * en; ok[i] = km16[e] * en; orr[i] = rs16[e] * ep; }
                *(LAS u32x4*)(SL(4) + sw_el(te, c16 + 8 * sp)) = pack8f(oa);
                *(LAS u32x4*)(SL(5) + sw_el(te, c16 + 8 * sp)) = pack8f(ob);
                *(LAS u32x4*)(SL(6) + sw_el(te, c16 + 8 * sp)) = pack8f(ok);
                *(LAS u32x4*)(SL(3) + sw_el(te, c16 + 8 * sp)) = pack8f(orr);
            }
        }
        LDS_BAR();
        { const int itn = 2 * min(pr + (int)gridDim.x, 2047) + half; const int w3 = ltid & 3;
          const bf16* rowp = cas + ((size_t)(itn >> 8) * SEQ + 64 * (itn & 31) + te) * LD_CAS + (w3 == 1 ? R0 : w3 == 2 ? V0 : K0) + ((itn >> 5) & 7) * 64;
          pf0 = *(const unsigned*)rowp; pf1 = *(const unsigned*)(rowp + 56); }
        u32x2 rtw[4]; f32x16 y2p, dp;
        {
            const int row = 32 * ti + l31;
            bf16x8 aA[4], aR[4], bB[4], bK0[4], bK1[4];
#pragma unroll
            for (int s = 0; s < 4; ++s) { const int k0 = 16 * s + 8 * hh;
                aA[s] = frag_row(SL(4), row, k0); aR[s] = frag_row(SL(3), row, k0); bB[s] = frag_row(SL(5), 32 * tj + l31, k0);
                bK0[s] = frag_row(SL(6), l31, k0); bK1[s] = frag_row(SL(6), 32 + l31, k0); }
            f32x16 acc = {};
#pragma unroll
            for (int s = 0; s < 4; ++s) acc = __builtin_amdgcn_mfma_f32_32x32x16_bf16(bB[s], aA[s], acc, 0, 0, 0);
#pragma unroll
            for (int r = 0; r < 16; ++r) acc[r] = (32 * tj + crow(r, hh) < row) ? acc[r] : 0.f;
            st_tile(SL(0), acc, ti, tj, l31, hh);
            acc = (f32x16){};
#pragma unroll
            for (int s = 0; s < 4; ++s) acc = __builtin_amdgcn_mfma_f32_32x32x16_bf16(tj ? bK1[s] : bK0[s], aA[s], acc, 0, 0, 0);
#pragma unroll
            for (int r = 0; r < 16; ++r) acc[r] = (32 * tj + crow(r, hh) < row) ? acc[r] : 0.f;
            st_tile(SL(2), acc, ti, tj, l31, hh);
            acc = (f32x16){};
#pragma unroll
            for (int s = 0; s < 4; ++s) acc = __builtin_amdgcn_mfma_f32_32x32x16_bf16(bB[s], aR[s], acc, 0, 0, 0);
#pragma unroll
            for (int r = 0; r < 16; ++r) acc[r] = (32 * tj + crow(r, hh) <= row) ? acc[r] : 0.f;
            st_tile(SL(1), acc, ti, tj, l31, hh);
            f32x16 ak0 = {}, ak1 = {};
#pragma unroll
            for (int s = 0; s < 4; ++s) ak0 = __builtin_amdgcn_mfma_f32_32x32x16_bf16(bK0[s], aR[s], ak0, 0, 0, 0);
#pragma unroll
            for (int r = 0; r < 16; ++r) ak0[r] = (crow(r, hh) <= row) ? ak0[r] : 0.f;
            y2p = (f32x16){};
            mm32_acc(y2p, ak0, SL(7), 0, 32 * tj, lane);
            if (ti) {
#pragma unroll
                for (int s = 0; s < 4; ++s) ak1 = __builtin_amdgcn_mfma_f32_32x32x16_bf16(bK1[s], aR[s], ak1, 0, 0, 0);
#pragma unroll
                for (int r = 0; r < 16; ++r) ak1[r] = (32 + crow(r, hh) <= row) ? ak1[r] : 0.f;
                mm32_acc(y2p, ak1, SL(7), 32, 32 * tj, lane);
            }
            dp = (f32x16){};
            mm_acc<true, false>(dp, SL(7), SL(6), ti, tj, lane);
#pragma unroll
            for (int g = 0; g < 4; ++g) rtw[g] = *(const LAS u32x2*)(SL(3) + sw_el(row, 32 * tj + 8 * g + 4 * hh));
        }
        LDS_BAR();
        if (lw == 0) {
            f32x16 Q0, Q1, T0, T1;
            ld_tile(Q0, SL(0), 0, 0, l31, hh); ld_tile(Q1, SL(0), 1, 1, l31, hh);
#pragma unroll
            for (int r = 0; r < 16; ++r) { const float idn = (crow(r, hh) == l31) ? 1.f : 0.f; T0[r] = Q0[r] + idn; T1[r] = Q1[r] + idn; }
            { f32x16 S0 = {}, S1 = {}; mm32_acc(S0, Q0, SL(0), 0, 0, lane); mm32_acc(S1, Q1, SL(0), 32, 32, lane); Q0 = S0; Q1 = S1; }
#pragma unroll
            for (int k = 1; k <= 4; ++k) {
                st_tile(SL(3), Q0, 0, 0, l31, hh); st_tile(SL(3), Q1, 1, 1, l31, hh);
                const bf16x8 b00 = frag_col_perm(SL(3), 0, 0, lane), b01 = frag_col_perm(SL(3), 16, 0, lane);
                const bf16x8 b10 = frag_col_perm(SL(3), 32, 32, lane), b11 = frag_col_perm(SL(3), 48, 32, lane);
                const bf16x8 t00 = pack8(T0, 0), t01 = pack8(T0, 1), t10 = pack8(T1, 0), t11 = pack8(T1, 1);
                T0 = __builtin_amdgcn_mfma_f32_32x32x16_bf16(b00, t00, T0, 0, 0, 0); T1 = __builtin_amdgcn_mfma_f32_32x32x16_bf16(b10, t10, T1, 0, 0, 0);
                T0 = __builtin_amdgcn_mfma_f32_32x32x16_bf16(b01, t01, T0, 0, 0, 0); T1 = __builtin_amdgcn_mfma_f32_32x32x16_bf16(b11, t11, T1, 0, 0, 0);
                if (k < 4) {
                    const bf16x8 q00 = pack8(Q0, 0), q01 = pack8(Q0, 1), q10 = pack8(Q1, 0), q11 = pack8(Q1, 1);
                    f32x16 S0 = {}, S1 = {};
                    S0 = __builtin_amdgcn_mfma_f32_32x32x16_bf16(b00, q00, S0, 0, 0, 0); S1 = __builtin_amdgcn_mfma_f32_32x32x16_bf16(b10, q10, S1, 0, 0, 0);
                    S0 = __builtin_amdgcn_mfma_f32_32x32x16_bf16(b01, q01, S0, 0, 0, 0); S1 = __builtin_amdgcn_mfma_f32_32x32x16_bf16(b11, q11, S1, 0, 0, 0);
                    Q0 = S0; Q1 = S1;
                }
            }
            st_tile(SL(3), T0, 0, 0, l31, hh); st_tile(SL(3), T1, 1, 1, l31, hh);
            { const f32x16 z = {}; st_tile(SL(3), z, 0, 1, l31, hh); }
            f32x16 Mx = {};
#pragma unroll
            for (int s = 0; s < 2; ++s) { const int k0 = 16 * s + 8 * hh;
                Mx = __builtin_amdgcn_mfma_f32_32x32x16_bf16(frag_col(SL(3), k0, 0, lane), frag_row(SL(0), 32 + l31, k0), Mx, 0, 0, 0); }
            st_tile(SL(3), Mx, 1, 0, l31, hh);
            f32x16 T21 = {};
            mm32_acc(T21, T1, SL(3), 32, 0, lane);
            st_tile(SL(3), T21, 1, 0, l31, hh);
        } else if (lw == 3) {
            f32x16 x0 = {}, x1 = {};
#pragma unroll
            for (int s = 0; s < 2; ++s) { const int k0 = 16 * s + 8 * hh; const bf16x8 a = frag_row(SL(2), l31, k0);
                x0 = __builtin_amdgcn_mfma_f32_32x32x16_bf16(frag_col(SL(7), k0, 0, lane), a, x0, 0, 0, 0);
                x1 = __builtin_amdgcn_mfma_f32_32x32x16_bf16(frag_col(SL(7), k0, 32, lane), a, x1, 0, 0, 0); }
            st_tile(SL(6), x0, 0, 0, l31, hh); st_tile(SL(6), x1, 0, 1, l31, hh);
        } else {
            f32x16 x = {}; mm_acc<false, false>(x, SL(2), SL(7), 1, lw - 1, lane); st_tile(SL(6), x, 1, lw - 1, l31, hh);
        }
        LDS_BAR();
        { f32x16 acc = {}; mm_acc<false, false>(acc, SL(3), SL(4), ti, tj, lane); st_tile(SL(0), acc, ti, tj, l31, hh);
          f32x16 a2 = {}; mm_acc<false, false>(a2, SL(3), SL(6), ti, tj, lane); st_tile(SL(2), a2, ti, tj, l31, hh); }
        LDS_BAR();
        {
            unsigned char* ob = (unsigned char*)p.out;
            { f32x16 acc;
#pragma unroll
              for (int g = 0; g < 4; ++g) { acc[4 * g] = bflo(rtw[g].x); acc[4 * g + 1] = bfhi(rtw[g].x); acc[4 * g + 2] = bflo(rtw[g].y); acc[4 * g + 3] = bfhi(rtw[g].y); }
              mm_acc<false, false>(acc, SL(1), SL(0), ti, tj, lane);
              st_native_global((bf16*)(ob + OUT_Y1) + (size_t)item * 4096, acc, ti * 2 + tj, lane); }
            { f32x16 g2 = {};
              mm_acc<true, false>(g2, SL(5), SL(0), ti, tj, lane);
              const float gm = gam[32 * ti + l31];
#pragma unroll
              for (int r = 0; r < 16; ++r) g2[r] = (g2[r] + ((32 * tj + crow(r, hh) == 32 * ti + l31) ? 1.f : 0.f)) * gm;
              st_native_global((bf16*)(ob + OUT_G) + (size_t)item * 4096, g2, ti * 2 + tj, lane); }
            { mm_acc<false, false>(y2p, SL(1), SL(2), ti, tj, lane);
              st_native_global((bf16*)(ob + OUT_Y2) + (size_t)item * 4096, y2p, tj * 2 + ti, lane); }
            { mm_acc<true, false>(dp, SL(2), SL(5), ti, tj, lane);
#pragma unroll
              for (int r = 0; r < 16; ++r) dp[r] *= gam[32 * tj + crow(r, hh)];
              st_native_global((bf16*)(ob + OUT_D) + (size_t)item * 4096, dp, tj * 2 + ti, lane); }
        }
    }
#undef SL
#undef LDS_BAR
#undef E1_FETCH
}

DI void phase5a(const Params& p) {
    const int tid = threadIdx.x, lane = tid & 63, wave = tid >> 6, l31 = lane & 31, hh = lane >> 5;
    if (blockIdx.x >= 16) return;
    const unsigned char* ob = (const unsigned char*)p.out;
    {
        const int chain = blockIdx.x * 8 + wave;
        f32x16 H[2][2];
#pragma unroll
        for (int a = 0; a < 2; ++a)
#pragma unroll
            for (int c2 = 0; c2 < 2; ++c2) H[a][c2] = (f32x16){};
        bf16x8 gf[2][2][2];
        { const bf16* Gp = (const bf16*)(ob + OUT_G) + (size_t)chain * 32 * 4096;
#pragma unroll
          for (int ti = 0; ti < 2; ++ti)
#pragma unroll
              for (int tk = 0; tk < 2; ++tk)
#pragma unroll
                  for (int s = 0; s < 2; ++s) gf[ti][tk][s] = *(const bf16x8*)(Gp + (ti * 2 + tk) * 1024 + 512 * s + lane * 8); }
        for (int c = 0; c < 32; ++c) {
            const size_t item = (size_t)chain * 32 + c;
            const bf16* Dn = (const bf16*)(ob + OUT_D) + item * 4096;
            bf16x8 gn[2][2][2];
            { const bf16* Gp = (const bf16*)(ob + OUT_G) + (item + (c < 31 ? 1 : 0)) * 4096;
#pragma unroll
              for (int ti = 0; ti < 2; ++ti)
#pragma unroll
                  for (int tk = 0; tk < 2; ++tk)
#pragma unroll
                      for (int s = 0; s < 2; ++s) gn[ti][tk][s] = *(const bf16x8*)(Gp + (ti * 2 + tk) * 1024 + 512 * s + lane * 8); }
            f32x16 Dv[2][2];
#pragma unroll
            for (int ti = 0; ti < 2; ++ti)
#pragma unroll
                for (int tj = 0; tj < 2; ++tj) ld_native_global(Dv[ti][tj], Dn, ti * 2 + tj, lane);
            bf16x8 hp[2][2][2];
            u32x4* hs = (u32x4*)((bf16*)(p.ws + WS_HS) + item * 4096);
#pragma unroll
            for (int tk = 0; tk < 2; ++tk)
#pragma unroll
                for (int tj = 0; tj < 2; ++tj)
#pragma unroll
                    for (int s = 0; s < 2; ++s) { hp[tk][tj][s] = pack8(H[tk][tj], s); hs[((tk * 2 + tj) * 2 + s) * 64 + lane] = __builtin_bit_cast(u32x4, hp[tk][tj][s]); }
#pragma unroll
            for (int ti = 0; ti < 2; ++ti)
#pragma unroll
                for (int tj = 0; tj < 2; ++tj) {
                    f32x16 acc = Dv[ti][tj];
#pragma unroll
                    for (int tk = 0; tk < 2; ++tk)
#pragma unroll
                        for (int s = 0; s < 2; ++s) acc = __builtin_amdgcn_mfma_f32_32x32x16_bf16(gf[ti][tk][s], hp[tk][tj][s], acc, 0, 0, 0);
                    H[ti][tj] = acc;
                }
#pragma unroll
            for (int ti = 0; ti < 2; ++ti)
#pragma unroll
                for (int tk = 0; tk < 2; ++tk)
#pragma unroll
                    for (int s = 0; s < 2; ++s) gf[ti][tk][s] = gn[ti][tk][s];
        }
    }
    asm volatile("s_waitcnt vmcnt(0)" ::: "memory");
    __syncthreads();
    if (tid == 0) { __builtin_amdgcn_fence(__ATOMIC_RELEASE, "agent"); asm volatile("s_waitcnt vmcnt(0)" ::: "memory");
        __hip_atomic_fetch_add((unsigned*)(p.ws + WS_CTL) + 12288, 1u, __ATOMIC_RELAXED, __HIP_MEMORY_SCOPE_AGENT); }
}
DI void phase5b(const Params& p, LAS unsigned char* lds) {
    const int tid0 = threadIdx.x, wave = __builtin_amdgcn_readfirstlane(tid0 >> 6);
    const bf16* cas = (const bf16*)(p.ws + WS_CAS); const bf16* cr = (const bf16*)(p.ws + WS_CR);
    const unsigned char* ob = (const unsigned char*)p.out;
    LAS float* Zl = (LAS float*)(lds + wave * 17408);
    LAS unsigned* qL = (LAS unsigned*)(lds + 8 * 17408);
    __syncthreads();
    if (tid0 == 0) { unsigned* done = (unsigned*)(p.ws + WS_CTL) + 12288; unsigned sp = 0;
        while (__hip_atomic_load(done, __ATOMIC_RELAXED, __HIP_MEMORY_SCOPE_AGENT) < 16u) { __builtin_amdgcn_s_sleep(4); if (++sp > (1u << 24)) break; }
        __builtin_amdgcn_fence(__ATOMIC_ACQUIRE, "agent"); asm volatile("s_waitcnt vmcnt(0)" ::: "memory"); }
    __syncthreads();
    unsigned* q5 = (unsigned*)(p.ws + WS_CTL) + 12352;
    for (;;) {
        if (tid0 == 0) qL[0] = atomicAdd(q5, 1u);
        __syncthreads();
        const unsigned qb = qL[0];
        __syncthreads();
        if (qb >= 512u) break;
        const int item = (int)qb * 8 + wave;
        int tid = tid0; asm volatile("" : "+v"(tid));
        const int lane = tid & 63, l31 = lane & 31, hh = lane >> 5;
        const int c = item & 31, h = (item >> 5) & 7, b = item >> 8;
        const bf16* Y1p = (const bf16*)(ob + OUT_Y1) + (size_t)item * 4096; const bf16* Y2n = (const bf16*)(ob + OUT_Y2) + (size_t)item * 4096;
        const u32x4* hs = (const u32x4*)((const bf16*)(p.ws + WS_HS) + (size_t)item * 4096);
        bf16x8 hp[2][2][2];
#pragma unroll
        for (int tk = 0; tk < 2; ++tk)
#pragma unroll
            for (int tj = 0; tj < 2; ++tj)
#pragma unroll
                for (int s = 0; s < 2; ++s) hp[tk][tj][s] = __builtin_bit_cast(bf16x8, hs[((tk * 2 + tj) * 2 + s) * 64 + lane]);
#pragma unroll
        for (int tt = 0; tt < 2; ++tt) {
            f32x16 Z[2];
#pragma unroll
            for (int vj = 0; vj < 2; ++vj) {
                ld_native_global(Z[vj], Y2n, vj * 2 + tt, lane);
#pragma unroll
                for (int tk = 0; tk < 2; ++tk)
#pragma unroll
                    for (int s = 0; s < 2; ++s) {
                        const bf16x8 bb = *(const bf16x8*)(Y1p + (tt * 2 + tk) * 1024 + 512 * s + lane * 8);
                        Z[vj] = __builtin_amdgcn_mfma_f32_32x32x16_bf16(hp[tk][vj][s], bb, Z[vj], 0, 0, 0);
                    }
            }
            float sum = 0.f;
#pragma unroll
            for (int vj = 0; vj < 2; ++vj)
#pragma unroll
                for (int r = 0; r < 16; ++r) sum += Z[vj][r];
            sum += __shfl_xor(sum, 32);
            const float mean = sum * (1.f / 64.f);
            float sq = 0.f;
#pragma unroll
            for (int vj = 0; vj < 2; ++vj)
#pragma unroll
                for (int r = 0; r < 16; ++r) { const float d = Z[vj][r] - mean; sq += d * d; }
            sq += __shfl_xor(sq, 32);
            const float rstd = rsqrtf(sq * (1.f / 64.f) + 64e-5f);
#pragma unroll
            for (int vj = 0; vj < 2; ++vj)
#pragma unroll
                for (int g = 0; g < 4; ++g)
                    *(LAS f32x4*)(Zl + (32 * tt + l31) * 68 + 32 * vj + 8 * g + 4 * hh) =
                        (f32x4){(Z[vj][4 * g] - mean) * rstd, (Z[vj][4 * g + 1] - mean) * rstd, (Z[vj][4 * g + 2] - mean) * rstd, (Z[vj][4 * g + 3] - mean) * rstd};
        }
        const int v8 = (lane & 7) * 8, col = h * 64 + v8;
        float mu[8], lw[8], lb[8];
#pragma unroll
        for (int i = 0; i < 8; ++i) { mu[i] = p.shift_mu[1024 + col + i]; lw[i] = p.ln_x_w[col + i]; lb[i] = p.ln_x_b[col + i]; }
#pragma unroll 2
        for (int ps = 0; ps < 8; ++ps) {
            const int t = ps * 8 + (lane >> 3); const size_t m = (size_t)b * SEQ + 64 * c + t; const bool hprev = (64 * c + t) > 0;
            float cu[8], pv[8], sg[8];
            unpack8(*(const u32x4*)(cas + m * LD_CAS + V0 + col), cu);
            if (hprev) unpack8(*(const u32x4*)(cas + (m - 1) * LD_CAS + V0 + col), pv); else {
#pragma unroll
                for (int i = 0; i < 8; ++i) pv[i] = 0.f; }
            unpack8(*(const u32x4*)(cr + m * LD_CR + BSILU0 + col), sg);
            const float bon = ((const float*)(p.ws + WS_BONUS))[m * 8 + h];
            const f32x4 z0 = *(const LAS f32x4*)(Zl + t * 68 + v8), z1 = *(const LAS f32x4*)(Zl + t * 68 + v8 + 4);
            const float zz[8] = {z0[0], z0[1], z0[2], z0[3], z1[0], z1[1], z1[2], z1[3]};
            float o[8];
#pragma unroll
            for (int i = 0; i < 8; ++i) { const float vsh = cu[i] + (pv[i] - cu[i]) * mu[i]; o[i] = (zz[i] * lw[i] + lb[i] + bon * vsh) * siluf_(sg[i]); }
            u32x4 w; w.x = pk2(o[0], o[1]); w.y = pk2(o[2], o[3]); w.z = pk2(o[4], o[5]); w.w = pk2(o[6], o[7]);
            *(u32x4*)((bf16*)(p.ws + WS_YB) + m * 512 + col) = w;
        }
    }
}

constexpr int A_STAGE = 81920, A_TILE = 8192;
DI int swz_off(int row, int chunk) { return row * 128 + ((chunk ^ ((row >> 1) & 7)) << 4); }
DI void attn_qk(f32x16& s0, f32x16& s1, const LAS unsigned char* kl, const bf16x8 (&qr)[4], const f32x16& cinit, int l31, int hh) {
#pragma unroll
    for (int d0 = 0; d0 < 4; ++d0) {
        const bf16x8 k0f = *(const LAS bf16x8*)(kl + swz_off(l31, 2 * d0 + hh));
        const bf16x8 k1f = *(const LAS bf16x8*)(kl + swz_off(32 + l31, 2 * d0 + hh));
        s0 = __builtin_amdgcn_mfma_f32_32x32x16_bf16(k0f, qr[d0], d0 == 0 ? cinit : s0, 0, 0, 0);
        s1 = __builtin_amdgcn_mfma_f32_32x32x16_bf16(k1f, qr[d0], d0 == 0 ? cinit : s1, 0, 0, 0);
    }
}
DI void attn_sv(f32x16& s0, f32x16& s1, const LAS unsigned char* vl, int key0, int tq, bool laneok, int tmin, const LAS float* bl, bool win, bool bound,
                float& m_run, float& l_run, f32x16 (&O)[2], int l31, int hh) {
    const bool far = (tmin - (key0 + 63)) >= 128;
    const bool fast = far && !bound;
    int dbase = tq - key0; asm volatile("" : "+v"(dbase));
    float rm = -1e30f, cb = 0.f;
    if (fast) {
        cb = bl[128];
#pragma unroll
        for (int r = 0; r < 16; ++r) rm = fmaxf(rm, fmaxf(s0[r], s1[r]));
        rm = laneok ? rm + cb : -1e30f;
    } else {
        const int dmax = win ? 512 : 0x7fffffff, dmin = bound ? 0 : -0x7fffffff;
#pragma unroll
        for (int r = 0; r < 16; ++r) {
            const int d0_ = dbase - crow(r, hh), d1_ = d0_ - 32;
            const bool v0 = laneok && d0_ >= dmin && d0_ < dmax, v1 = laneok && d1_ >= dmin && d1_ < dmax;
            const float b0 = bl[min(max(d0_, 0), 128)], b1 = bl[min(max(d1_, 0), 128)];
            s0[r] = v0 ? s0[r] + b0 : -1e30f; s1[r] = v1 ? s1[r] + b1 : -1e30f;
            rm = fmaxf(rm, fmaxf(s0[r], s1[r]));
        }
    }
    rm = fmaxf(rm, __shfl_xor(rm, 32));
    if (__any(rm > m_run + 8.f)) {
        const float m_new = fmaxf(m_run, rm), alpha = __builtin_amdgcn_exp2f(m_run - m_new);
        l_run *= alpha; m_run = m_new;
#pragma unroll
        for (int dt = 0; dt < 2; ++dt)
#pragma unroll
            for (int r = 0; r < 16; ++r) O[dt][r] *= alpha;
    }
    const float sh = m_run - cb;
    float rs = 0.f;
    if (fast) {
#pragma unroll
        for (int r = 0; r < 16; ++r) { s0[r] = __builtin_amdgcn_exp2f(s0[r] - sh); s1[r] = __builtin_amdgcn_exp2f(s1[r] - sh); rs += s0[r] + s1[r]; }
        if (!__all(laneok)) { if (!laneok) {
#pragma unroll
            for (int r = 0; r < 16; ++r) { s0[r] = 0.f; s1[r] = 0.f; }
            rs = 0.f; } }
    } else {
#pragma unroll
        for (int r = 0; r < 16; ++r) {
            s0[r] = (s0[r] > -1e29f) ? __builtin_amdgcn_exp2f(s0[r] - sh) : 0.f; s1[r] = (s1[r] > -1e29f) ? __builtin_amdgcn_exp2f(s1[r] - sh) : 0.f;
            rs += s0[r] + s1[r];
        }
    }
    rs += __shfl_xor(rs, 32);
    l_run += rs;
    const bf16x8 p00 = pack8(s0, 0), p01 = pack8(s0, 1), p10 = pack8(s1, 0), p11 = pack8(s1, 1);
#pragma unroll
    for (int dt = 0; dt < 2; ++dt) {
        const int d = 32 * dt + l31;
        O[dt] = __builtin_amdgcn_mfma_f32_32x32x16_bf16(*(const LAS bf16x8*)(vl + swz_off(d, 0 + hh)), p00, O[dt], 0, 0, 0);
        O[dt] = __builtin_amdgcn_mfma_f32_32x32x16_bf16(*(const LAS bf16x8*)(vl + swz_off(d, 2 + hh)), p01, O[dt], 0, 0, 0);
        O[dt] = __builtin_amdgcn_mfma_f32_32x32x16_bf16(*(const LAS bf16x8*)(vl + swz_off(d, 4 + hh)), p10, O[dt], 0, 0, 0);
        O[dt] = __builtin_amdgcn_mfma_f32_32x32x16_bf16(*(const LAS bf16x8*)(vl + swz_off(d, 6 + hh)), p11, O[dt], 0, 0, 0);
    }
}
DI void attn_sv_fast(f32x16& s0, f32x16& s1, const LAS unsigned char* vl, int key0, int tq, bool laneok, int tmin, const LAS float* bl, bool win, bool bound, float cb,
                     float& l_run, f32x16 (&O)[2], int l31, int hh) {
    const bool far = (tmin - (key0 + 63)) >= 128;
    float rs = 0.f;
    if (far && !bound) {
#pragma unroll
        for (int r = 0; r < 16; ++r) { s0[r] = __builtin_amdgcn_exp2f(s0[r]); s1[r] = __builtin_amdgcn_exp2f(s1[r]); }
        if (!__all(laneok)) {
#pragma unroll
            for (int r = 0; r < 16; ++r) { s0[r] = laneok ? s0[r] : 0.f; s1[r] = laneok ? s1[r] : 0.f; }
        }
    } else {
        int dbase = tq - key0; asm volatile("" : "+v"(dbase));
        const int dmax = win ? 512 : 0x7fffffff, dmin = bound ? 0 : -0x7fffffff;
        float b0[16], b1[16];
#pragma unroll
        for (int r = 0; r < 16; ++r) { const int d0_ = dbase - crow(r, hh), d1_ = d0_ - 32; b0[r] = bl[min(max(d0_, 0), 128)]; b1[r] = bl[min(max(d1_, 0), 128)]; }
#pragma unroll
        for (int r = 0; r < 16; ++r) asm volatile("" : "+v"(b0[r]), "+v"(b1[r]));
#pragma unroll
        for (int r = 0; r < 16; ++r) {
            const int d0_ = dbase - crow(r, hh), d1_ = d0_ - 32;
            const bool v0 = laneok && d0_ >= dmin && d0_ < dmax, v1 = laneok && d1_ >= dmin && d1_ < dmax;
            const float e0 = __builtin_amdgcn_exp2f(s0[r] + (b0[r] - cb)), e1 = __builtin_amdgcn_exp2f(s1[r] + (b1[r] - cb));
            s0[r] = v0 ? e0 : 0.f; s1[r] = v1 ? e1 : 0.f;
        }
    }
#pragma unroll
    for (int r = 0; r < 16; ++r) rs += s0[r] + s1[r];
    l_run += rs;
    const bf16x8 p00 = pack8(s0, 0), p01 = pack8(s0, 1), p10 = pack8(s1, 0), p11 = pack8(s1, 1);
#pragma unroll
    for (int dt = 0; dt < 2; ++dt) {
        const int d = 32 * dt + l31;
        O[dt] = __builtin_amdgcn_mfma_f32_32x32x16_bf16(*(const LAS bf16x8*)(vl + swz_off(d, 0 + hh)), p00, O[dt], 0, 0, 0);
        O[dt] = __builtin_amdgcn_mfma_f32_32x32x16_bf16(*(const LAS bf16x8*)(vl + swz_off(d, 2 + hh)), p01, O[dt], 0, 0, 0);
        O[dt] = __builtin_amdgcn_mfma_f32_32x32x16_bf16(*(const LAS bf16x8*)(vl + swz_off(d, 4 + hh)), p10, O[dt], 0, 0, 0);
        O[dt] = __builtin_amdgcn_mfma_f32_32x32x16_bf16(*(const LAS bf16x8*)(vl + swz_off(d, 6 + hh)), p11, O[dt], 0, 0, 0);
    }
}
DI float imp_sum(const LAS float* sL, const LAS float* cL, int q, int j) {
    float v = 0.f;
#pragma unroll
    for (int h4 = 0; h4 < 4; ++h4) { v += sL[(h4 * 64 + q) * 33 + j]; if (j > 0) v += cL[(h4 * 64 + q) * 33 + j]; }
    return v;
}
template <bool FAST>
DI void attn_stream(LAS unsigned char* lds, const bf16* ksel, const bf16* kwin, const bf16* vts, const bf16* vtw, unsigned U, unsigned mysel, int qt, int tq, int tmin,
                    const LAS float* bl, const bf16x8 (&qr)[4], const float (&g3)[3], LAS float* stash, f32x16 (&Ot)[2], int tid, int l31, int hh) {
    const int nsel = __builtin_popcount(U), w0 = qt > 8 ? qt - 8 : 0, ntile = nsel + (qt - w0 + 1);
    const int srow = tid >> 3, sch = tid & 7;
    unsigned rem = U;
    int jseq = 0;
    int jt = 0; bool wt = false;
#define NEXT_TILE() do { if (jseq < nsel) { jt = __builtin_ctz(rem); rem &= rem - 1; wt = false; } else { jt = w0 + (jseq - nsel); wt = true; } ++jseq; } while (0)
#define LOAD_TILE(KR, VR) do { KR = *(const u32x4*)((wt ? kwin : ksel) + (size_t)(64 * jt + srow) * LD_CAS + 8 * sch); \
                               VR = *(const u32x4*)((wt ? vtw : vts) + (size_t)jt * 4096 + srow * 64 + 8 * sch); } while (0)
    u32x4 kr0, vr0, kr1, vr1;
    NEXT_TILE(); int j0 = jt; bool wn0 = wt; LOAD_TILE(kr0, vr0);
    *(LAS u32x4*)(lds + A_STAGE + swz_off(srow, sch)) = kr0; *(LAS u32x4*)(lds + A_STAGE + 2 * A_TILE + swz_off(srow, sch)) = vr0;
    int j1 = 0; bool wn1 = false;
    if (ntile > 1) { NEXT_TILE(); j1 = jt; wn1 = wt; LOAD_TILE(kr0, vr0); }
    __syncthreads();
    float m_run = -1e30f, l_run = 0.f; f32x16 O[2]; O[0] = (f32x16){}; O[1] = (f32x16){};
    const float cbf = bl[128];
    f32x16 cinit;
#pragma unroll
    for (int r = 0; r < 16; ++r) cinit[r] = FAST ? cbf : 0.f;
#define TILE_ITER(I, KRA, VRA, KRB, VRB) do { \
        const int jc = j0; const bool wc = wn0; j0 = j1; wn0 = wn1; \
        if ((I) + 2 < ntile) { NEXT_TILE(); j1 = jt; wn1 = wt; LOAD_TILE(KRB, VRB); } \
        if ((I) == nsel) { if (FAST) l_run += __shfl_xor(l_run, 32); const float f_ = l_run > 0.f ? g3[1] / l_run : 0.f; \
            _Pragma("unroll") for (int dt = 0; dt < 2; ++dt) _Pragma("unroll") for (int r = 0; r < 16; ++r) { stash[(dt * 16 + r) * 64] += f_ * O[dt][r]; O[dt][r] = 0.f; } \
            m_run = -1e30f; l_run = 0.f; } \
        const LAS unsigned char* kl = lds + A_STAGE + ((I) & 1) * A_TILE; \
        const LAS unsigned char* vl = lds + A_STAGE + 2 * A_TILE + ((I) % 3) * A_TILE; \
        const bool ok_ = wc ? true : (bool)((mysel >> jc) & 1u); \
        if (__any(ok_)) { f32x16 s0, s1; attn_qk(s0, s1, kl, qr, cinit, l31, hh); \
            const bool bnd = wc ? (jc == qt || jc + 8 == qt) : (jc == qt); \
            if (FAST) attn_sv_fast(s0, s1, vl, 64 * jc, tq, ok_, tmin, bl, wc, bnd, cbf, l_run, O, l31, hh); \
            else attn_sv(s0, s1, vl, 64 * jc, tq, ok_, tmin, bl, wc, bnd, m_run, l_run, O, l31, hh); } \
        if ((I) + 1 < ntile) { *(LAS u32x4*)(lds + A_STAGE + (((I) + 1) & 1) * A_TILE + swz_off(srow, sch)) = KRA; \
                               *(LAS u32x4*)(lds + A_STAGE + 2 * A_TILE + (((I) + 1) % 3) * A_TILE + swz_off(srow, sch)) = VRA; } \
        asm volatile("s_waitcnt lgkmcnt(0)\n\ts_barrier" ::: "memory"); } while (0)
    for (int i = 0; i < ntile; i += 2) {
        TILE_ITER(i, kr0, vr0, kr1, vr1);
        if (i + 1 < ntile) TILE_ITER(i + 1, kr1, vr1, kr0, vr0);
    }
#undef TILE_ITER
#undef LOAD_TILE
#undef NEXT_TILE
    if (FAST) l_run += __shfl_xor(l_run, 32);
    const float f = l_run > 0.f ? g3[2] / l_run : 0.f;
#pragma unroll
    for (int dt = 0; dt < 2; ++dt)
#pragma unroll
        for (int r = 0; r < 16; ++r) Ot[dt][r] = stash[(dt * 16 + r) * 64] + f * O[dt][r];
}
DI void phase4(const Params& p, LAS unsigned char* lds) {
    const int tid0 = threadIdx.x, wave = __builtin_amdgcn_readfirstlane(tid0 >> 6);
    const int hp = wave & 3, qh = wave >> 2;
    const bf16* cas = (const bf16*)(p.ws + WS_CAS);
    LAS float* biasL = (LAS float*)lds;
    LAS float* sL = (LAS float*)(lds + 4608);
    LAS float* cL = (LAS float*)(lds + 4608 + 33792);
    LAS unsigned* selL = (LAS unsigned*)(lds + 4608 + 2 * 33792);
    LAS unsigned* uL = selL + 64;
    LAS float* impT = (LAS float*)(lds + 4608 + 2 * 33792 + 512);
    LAS float* auxL = (LAS float*)(lds + 81152);
    for (int i = tid0; i < 8 * 132; i += 512) biasL[i] = ((const float*)(p.ws + WS_BIAS))[i];
    if (tid0 == 0) uL[0] = 0u;
    __syncthreads();
    if (tid0 < 8) { float bm = 0.f; for (int d = 0; d <= 128; ++d) bm = fmaxf(bm, fabsf(biasL[tid0 * 132 + d])); auxL[tid0] = bm; }
    if (tid0 == 8 || tid0 == 9) { float gm = 0.f; for (int d = 0; d < 64; ++d) gm = fmaxf(gm, fabsf(p.k_norm_gain[(tid0 - 7) * 64 + d])); auxL[tid0] = gm; }
    if (tid0 == 10) { float gm = 0.f; for (int d = 0; d < 64; ++d) gm = fmaxf(gm, fabsf(p.q_norm_gain[d])); auxL[10] = gm; }
    __syncthreads();
    bool fastmode;
    { float bm = 0.f;
#pragma unroll
      for (int hq = 0; hq < 8; ++hq) bm = fmaxf(bm, auxL[hq]);
      fastmode = (8.1f * auxL[10] * QSCALE) * (8.1f * fmaxf(auxL[8], auxL[9])) + bm <= 96.f; }
    unsigned* qctr = (unsigned*)(p.ws + WS_CTL) + 8192 + 64 * (blockIdx.x & 7);
    for (;;) {
        if (tid0 == 0) uL[1] = atomicAdd(qctr, 1u);
        __syncthreads();
        const unsigned qi = uL[1];
        __syncthreads();
        if (qi >= 128u) break;
        int tid = tid0; asm volatile("" : "+v"(tid));
        const int lane = tid & 63, l31 = lane & 31, hh = lane >> 5;
        const int qt = 31 - (int)(qi & 31), bg = (blockIdx.x & 7) + 8 * (int)(qi >> 5);
        const int b = bg >> 1, g = bg & 1, head = g * 4 + hp, t0 = 64 * qt, tmin = t0 + 32 * qh, tq = tmin + l31;
        const size_t m = (size_t)b * SEQ + tq;
        const LAS float* bl = biasL + head * 132;
        bf16x8 qr[4];
#pragma unroll
        for (int d0 = 0; d0 < 4; ++d0) qr[d0] = *(const bf16x8*)(cas + m * LD_CAS + Q0 + head * 64 + 16 * d0 + 8 * hh);
        float g3[3];
#pragma unroll
        for (int br = 0; br < 3; ++br) g3[br] = sigmoidf_(bf2f(cas[m * LD_CAS + GATE0 + br * 8 + head]));
        f32x16 Ot[2]; Ot[0] = (f32x16){}; Ot[1] = (f32x16){};
        {
            const bf16* kcb = (const bf16*)(p.ws + WS_KC) + (size_t)bg * 128 * 64;
            const bf16* vcb = (const bf16*)(p.ws + WS_VCT) + (size_t)bg * 64 * 128;
            f32x16 sc[4];
#pragma unroll
            for (int kt = 0; kt < 4; ++kt) { sc[kt] = (f32x16){};
#pragma unroll
                for (int d0 = 0; d0 < 4; ++d0) sc[kt] = __builtin_amdgcn_mfma_f32_32x32x16_bf16(*(const bf16x8*)(kcb + (size_t)(32 * kt + l31) * 64 + 16 * d0 + 8 * hh), qr[d0], sc[kt], 0, 0, 0); }
            float mc = -1e30f;
#pragma unroll
            for (int kt = 0; kt < 4; ++kt) {
                float bv[16];
#pragma unroll
                for (int r = 0; r < 16; ++r) { const int n = 32 * kt + crow(r, hh), dist = tq - 16 * n - 31; bv[r] = bl[min(max(dist, 0), 128)]; }
#pragma unroll
                for (int r = 0; r < 16; ++r) asm volatile("" : "+v"(bv[r]));
#pragma unroll
                for (int r = 0; r < 16; ++r) { const int n = 32 * kt + crow(r, hh), dist = tq - 16 * n - 31; const bool ok = dist >= 0 && n < 127;
                    sc[kt][r] = ok ? sc[kt][r] + bv[r] : -1e30f; mc = fmaxf(mc, sc[kt][r]); }
            }
            mc = fmaxf(mc, __shfl_xor(mc, 32));
            float lc = 0.f;
#pragma unroll
            for (int kt = 0; kt < 4; ++kt)
#pragma unroll
                for (int r = 0; r < 16; ++r) { sc[kt][r] = (sc[kt][r] > -1e29f) ? __builtin_amdgcn_exp2f(sc[kt][r] - mc) : 0.f; lc += sc[kt][r]; }
            lc += __shfl_xor(lc, 32);
            const float inv = lc > 0.f ? 1.f / lc : 0.f;
            const int q = 32 * qh + l31;
#pragma unroll
            for (int kt = 0; kt < 4; ++kt) {
#pragma unroll
                for (int r = 0; r < 16; ++r) sc[kt][r] *= inv;
#pragma unroll
                for (int g4 = 0; g4 < 4; ++g4) { const int j = 8 * kt + 2 * g4 + hh;
                    sL[(hp * 64 + q) * 33 + j] = 2.f * (sc[kt][4 * g4] + sc[kt][4 * g4 + 1] + sc[kt][4 * g4 + 2]) + sc[kt][4 * g4 + 3];
                    cL[(hp * 64 + q) * 33 + j + 1] = sc[kt][4 * g4 + 3]; }
            }
            f32x16 oc[2]; oc[0] = (f32x16){}; oc[1] = (f32x16){};
#pragma unroll
            for (int dt = 0; dt < 2; ++dt)
#pragma unroll
                for (int kt = 0; kt < 4; ++kt)
#pragma unroll
                    for (int s = 0; s < 2; ++s)
                        oc[dt] = __builtin_amdgcn_mfma_f32_32x32x16_bf16(*(const bf16x8*)(vcb + (size_t)(32 * dt + l31) * 128 + 32 * kt + 16 * s + 8 * hh), pack8(sc[kt], s), oc[dt], 0, 0, 0);
#pragma unroll
            for (int dt = 0; dt < 2; ++dt)
#pragma unroll
                for (int r = 0; r < 16; ++r) Ot[dt][r] = g3[0] * oc[dt][r];
        }
        __syncthreads();
        {
            const int q = tid >> 3, sub = tid & 7;
            unsigned mask = 0u;
            if (qt < 16) mask = (2u << qt) - 1u;
            else {
#pragma unroll
                for (int i2 = 0; i2 < 4; ++i2) impT[q * 33 + sub + 8 * i2] = imp_sum(sL, cL, q, sub + 8 * i2);
                __syncthreads();
                float vj[4]; int rank[4];
#pragma unroll
                for (int i2 = 0; i2 < 4; ++i2) { vj[i2] = impT[q * 33 + sub + 8 * i2]; rank[i2] = 0; }
#pragma unroll 2
                for (int jj = 1; jj <= qt - 2; ++jj) {
                    const float vv = impT[q * 33 + jj];
#pragma unroll
                    for (int i2 = 0; i2 < 4; ++i2) { const int j = sub + 8 * i2;
                        rank[i2] += (int)((jj != j) & ((vv > vj[i2]) | ((vv == vj[i2]) & (jj < j)))); }
                }
#pragma unroll
                for (int i2 = 0; i2 < 4; ++i2) { const int j = sub + 8 * i2;
                    const bool forced = (j == 0) || (j == qt) || (j == qt - 1), cand = (j >= 1) && (j <= qt - 2);
                    if (forced || (cand && rank[i2] < 13)) mask |= 1u << j; }
                mask |= __shfl_xor(mask, 1); mask |= __shfl_xor(mask, 2); mask |= __shfl_xor(mask, 4);
            }
            if (sub == 0) { selL[q] = mask; __hip_atomic_fetch_or(uL, mask, __ATOMIC_RELAXED, __HIP_MEMORY_SCOPE_WORKGROUP); }
        }
        __syncthreads();
        const unsigned mysel = selL[32 * qh + l31], U = uL[0];
        LAS float* stash = (LAS float*)(lds + 4608 + wave * 8192) + lane;
#pragma unroll
        for (int dt = 0; dt < 2; ++dt)
#pragma unroll
            for (int r = 0; r < 16; ++r) stash[(dt * 16 + r) * 64] = Ot[dt][r];
        {
            const bf16* ksel = cas + (size_t)(b * SEQ) * LD_CAS + KS0 + g * 64; const bf16* kwin = cas + (size_t)(b * SEQ) * LD_CAS + KW0 + g * 64;
            const bf16* vts = (const bf16*)(p.ws + WS_VTS) + (size_t)bg * 32 * 4096; const bf16* vtw = (const bf16*)(p.ws + WS_VTW) + (size_t)bg * 32 * 4096;
            if (fastmode) attn_stream<true>(lds, ksel, kwin, vts, vtw, U, mysel, qt, tq, tmin, bl, qr, g3, stash, Ot, tid, l31, hh);
            else attn_stream<false>(lds, ksel, kwin, vts, vtw, U, mysel, qt, tq, tmin, bl, qr, g3, stash, Ot, tid, l31, hh);
        }
        __syncthreads();
#pragma unroll
        for (int dt = 0; dt < 2; ++dt)
#pragma unroll
            for (int g4 = 0; g4 < 4; ++g4) {
                const int col = head * 64 + 32 * dt + 8 * g4 + 4 * hh;
                const u32x2 aw = *(const u32x2*)(cas + m * LD_CAS + ASILU0 + col);
                u32x2 w; w.x = pk2(Ot[dt][4 * g4] * siluf_(bflo(aw.x)), Ot[dt][4 * g4 + 1] * siluf_(bfhi(aw.x)));
                w.y = pk2(Ot[dt][4 * g4 + 2] * siluf_(bflo(aw.y)), Ot[dt][4 * g4 + 3] * siluf_(bfhi(aw.y)));
                *(u32x2*)((bf16*)(p.ws + WS_YA) + m * 512 + col) = w;
            }
        if (tid == 0) uL[0] = 0u;
    }
}
DI void phase3(const Params& p, LAS unsigned char* lds) { phase3a(p, lds); phase3b(p, lds); phase3c(p, lds); }


#define XB_TMO      128
#define XB_XCNT(j)  (256  + 64 * (j))
#define XB_XSUB(j)  (1280 + 64 * (j))
#define XB_XGEN(j)  (2304 + 64 * (j))
#define XB_TOP      3328
#define XB_TOPGEN   3392
#define XCD_BAR_WORDS 3456
#define XB_SPIN_CAP (1u << 22)
DI unsigned xb_ld(unsigned* p)              { return __hip_atomic_load(p, __ATOMIC_RELAXED, __HIP_MEMORY_SCOPE_AGENT); }
DI unsigned xb_add(unsigned* p, unsigned v) { return __hip_atomic_fetch_add(p, v, __ATOMIC_RELAXED, __HIP_MEMORY_SCOPE_AGENT); }
DI unsigned xb_xcc_id() { return (unsigned)__builtin_amdgcn_s_getreg((3 << 11) | 20) & 0xFu; }
#define XB_SPIN(cond, bar) do { unsigned _sp = 0; while (cond) { __builtin_amdgcn_s_sleep(1); \
    if ((++_sp & 255u) == 0u) { if (xb_ld(&(bar)[XB_TMO])) break; if (_sp > XB_SPIN_CAP) { atomicAdd(&(bar)[XB_TMO], 1u); break; } } } } while (0)
struct XcdBarrier { unsigned* bar; unsigned x; volatile LAS unsigned* st; };
DI XcdBarrier xcd_barrier_post(unsigned* bar, volatile LAS unsigned* st) {
    XcdBarrier b; b.bar = bar; b.x = xb_xcc_id(); b.st = st;
    if (threadIdx.x == 0) (void)xb_add(&bar[XB_XCNT(b.x)], 1u);
    return b;
}
DI void xcd_barrier_complete(unsigned* bar, unsigned x, unsigned& nloc, unsigned& nx) {
    const unsigned G = gridDim.x * gridDim.y * gridDim.z;
    unsigned sum, cnt, mine, sp = 0u;
    for (;;) {
        sum = 0u; cnt = 0u; mine = 0u;
#pragma unroll
        for (unsigned j = 0; j < 16; ++j) { const unsigned c = xb_ld(&bar[XB_XCNT(j)]); sum += c; cnt += (c > 0u) ? 1u : 0u; mine = (j == x) ? c : mine; }
        if (sum == G) break;
        __builtin_amdgcn_s_sleep(1);
        if ((++sp & 255u) == 0u) { if (xb_ld(&bar[XB_TMO])) break; if (sp > XB_SPIN_CAP) { atomicAdd(&bar[XB_TMO], 1u); break; } }
    }
    nloc = mine > 0u ? mine : 1u; nx = cnt > 0u ? cnt : 1u;
}
DI void xcd_barrier(const XcdBarrier& b) {
    asm volatile("s_waitcnt vmcnt(0)" ::: "memory");
    __syncthreads();
    if (threadIdx.x == 0) {
        unsigned* bar = b.bar;
        __builtin_amdgcn_s_waitcnt(0);
        unsigned nloc = b.st[0], nx = b.st[1];
        if (nloc == 0u) { xcd_barrier_complete(bar, b.x, nloc, nx); b.st[0] = nloc; b.st[1] = nx; }
        const unsigned old = xb_add(&bar[XB_XSUB(b.x)], 1u);
        const unsigned gen = old / nloc;
        if (old + 1u == (gen + 1u) * nloc) {
            __builtin_amdgcn_fence(__ATOMIC_RELEASE, "agent");
            asm volatile("s_waitcnt vmcnt(0)" ::: "memory");
            const unsigned og = xb_add(&bar[XB_TOP], 1u);
            const unsigned tg = og / nx;
            if (og + 1u == (tg + 1u) * nx) xb_add(&bar[XB_TOPGEN], 1u);
            else XB_SPIN(xb_ld(&bar[XB_TOPGEN]) == tg, bar);
            __builtin_amdgcn_fence(__ATOMIC_ACQUIRE, "agent");
            xb_add(&bar[XB_XGEN(b.x)], 1u);
            asm volatile("s_waitcnt vmcnt(0)" ::: "memory");
        } else {
            XB_SPIN(xb_ld(&bar[XB_XGEN(b.x)]) == gen, bar);
            __builtin_amdgcn_fence(__ATOMIC_ACQUIRE, "agent");
            asm volatile("s_waitcnt vmcnt(0)" ::: "memory");
        }
    }
    __syncthreads();
}

__global__ void __launch_bounds__(512, 2) hybrid_fwd(Params p) {
    extern __shared__ __attribute__((aligned(16))) unsigned char lds_raw[];
    LAS unsigned char* lds = (LAS unsigned char*)lds_raw;
#if USE_CG_SYNC
    cg::grid_group grid = cg::this_grid();
#define GRID_BAR() grid.sync()
#else
    volatile LAS unsigned* bst = (volatile LAS unsigned*)(lds + LDS_BYTES - 64);
    if (threadIdx.x < 2) bst[threadIdx.x] = 0u;
    __syncthreads();
    const XcdBarrier xbar = xcd_barrier_post((unsigned*)(p.ws + WS_CTL) + 1024, bst);
#define GRID_BAR() xcd_barrier(xbar)
#endif
    const int lo = p.ph_lo, hi = p.ph_hi;
#ifdef ONLYP
#define IN(k) ((k) == ONLYP && lo <= (k) && (k) < hi)
#else
#define IN(k) (lo <= (k) && (k) < hi)
#endif
#define SEAM(k) do { if (IN(k) && IN((k) + 1)) GRID_BAR(); } while (0)
    unsigned char* ws = p.ws;
    if (IN(0)) { phase0(p, lds); }
    SEAM(0);
    if (IN(1)) { phase1(p, lds); phase0w(p, lds); }
    SEAM(1);
    if (IN(2)) {
        pg8::Gemm g{(const bf16*)((unsigned char*)p.out + OUT_H), (const bf16*)(ws + WS_WIN_T), MTOK, N_IN_PAD, DM, DM, DM};
        pg8::StaticOrder S; S.init(MTOK, N_IN_PAD, gridDim.x, blockIdx.x);
        EpiInProj E{(bf16*)(ws + WS_CAS), (bf16*)(ws + WS_CR)};
        pg8::gemm_phase<EpiInProj, pg8::StaticOrder>(lds, g, S, E);
    }
    SEAM(2);
    if (IN(3)) { phase3(p, lds); }
    SEAM(3);
    if (IN(4)) { phase5a(p); phase4(p, lds); __syncthreads(); phase5b(p, lds); }
    SEAM(5);
    if (IN(6)) {
        { pg8::Gemm g{(const bf16*)(ws + WS_YA), (const bf16*)(ws + WS_WA_T), MTOK, DM, 512, 512, 512};
          pg8::StaticOrder S; S.init(MTOK, DM, gridDim.x, blockIdx.x);
          EpiGate<0> E{(bf16*)(ws + WS_MERGED), (const bf16*)(ws + WS_CR)};
          pg8::gemm_phase<EpiGate<0>, pg8::StaticOrder>(lds, g, S, E); }
        { pg8::Gemm g{(const bf16*)(ws + WS_YB), (const bf16*)(ws + WS_WB_T), MTOK, DM, 512, 512, 512};
          pg8::StaticOrder S; S.init(MTOK, DM, gridDim.x, blockIdx.x);
          EpiGate<1> E{(bf16*)(ws + WS_MERGED), (const bf16*)(ws + WS_CR)};
          pg8::gemm_phase<EpiGate<1>, pg8::StaticOrder>(lds, g, S, E); }
    }
    SEAM(6);
    if (IN(7)) {
        pg8::Gemm g{(const bf16*)(ws + WS_MERGED), (const bf16*)(ws + WS_WO_T), MTOK, DM, DM, DM, DM};
        pg8::StaticOrder S; S.init(MTOK, DM, gridDim.x, blockIdx.x);
        EpiFinal E{p.x, (const float*)(ws + WS_MOD), p.out};
        pg8::gemm_phase<EpiFinal, pg8::StaticOrder>(lds, g, S, E);
    }
#undef IN
#undef SEAM
}

extern "C" void kernel_launch(void* const* d_in, const int* in_sizes, int n_in, void* d_out, int out_size, void* d_ws, size_t ws_size, hipStream_t stream) {
    static int grid = 0;
    if (grid == 0) {
        if (n_in != 28 || out_size != MTOK * DM || ws_size < WS_END) { fprintf(stderr, "kernel_launch: unexpected shapes (n_in %d out %d ws %zu)\n", n_in, out_size, ws_size); grid = -1; return; }
        int dev = 0, cus = 0, per_cu = 0;
        (void)hipGetDevice(&dev); (void)hipDeviceGetAttribute(&cus, hipDeviceAttributeMultiprocessorCount, dev);
        if (hipFuncSetAttribute((const void*)hybrid_fwd, hipFuncAttributeMaxDynamicSharedMemorySize, LDS_BYTES) != hipSuccess) { fprintf(stderr, "kernel_launch: hipFuncSetAttribute failed\n"); grid = -1; return; }
        if (hipOccupancyMaxActiveBlocksPerMultiprocessor(&per_cu, (const void*)hybrid_fwd, 512, LDS_BYTES) != hipSuccess || per_cu < 1) { fprintf(stderr, "kernel_launch: occupancy query says %d\n", per_cu); per_cu = 1; }
        (void)hipGetLastError();
        grid = cus * 1;
        if (grid <= 0) grid = 256;
    }
    if (grid < 0) return;
    (void)hipMemsetAsync((char*)d_ws + WS_CTL, 0, CTL_ZERO_BYTES, stream);
    Params p{};
    const float** pp = (const float**)&p;
    for (int i = 0; i < 28; ++i) pp[i] = (const float*)d_in[i];
    p.out = (float*)d_out; p.ws = (unsigned char*)d_ws;
#if MK_LAUNCHES == 1
    p.ph_lo = 0; p.ph_hi = 8;
    void* args[] = {&p};
    hipError_t e = hipLaunchCooperativeKernel((const void*)hybrid_fwd, dim3(grid), dim3(512), args, LDS_BYTES, stream);
    if (e != hipSuccess) fprintf(stderr, "cooperative launch failed: %s (grid %d)\n", hipGetErrorString(e), grid);
#else
    const int cuts[][2] = {{0, 1}, {1, 2}, {2, 3}, {3, 4}, {4, 5}, {5, 6}, {6, 7}, {7, 8}};
    for (int li = 0; li < 8; ++li) {
        p.ph_lo = cuts[li][0]; p.ph_hi = cuts[li][1];
        hipLaunchKernelGGL(hybrid_fwd, dim3(grid), dim3(512), LDS_BYTES, stream, p);
    }
#endif
}
```

```cpp
#include <hip/hip_runtime.h>
#include <hip/hip_cooperative_groups.h>
#include <cstdio>
#include <cstdint>
namespace cg = cooperative_groups;

#ifndef USE_CG_SYNC
#define USE_CG_SYNC 0
#endif
#ifndef MK_LAUNCHES
#define MK_LAUNCHES 1
#endif

#define DI __device__ __forceinline__
#define LAS __attribute__((address_space(3)))
typedef unsigned short bf16;
typedef short bf16x8 __attribute__((ext_vector_type(8)));
typedef short s16x4 __attribute__((ext_vector_type(4)));
typedef float f32x2 __attribute__((ext_vector_type(2)));
typedef float f32x4 __attribute__((ext_vector_type(4)));
typedef float f32x16 __attribute__((ext_vector_type(16)));
typedef unsigned u32x2 __attribute__((ext_vector_type(2)));
typedef unsigned u32x4 __attribute__((ext_vector_type(4)));
typedef __bf16 bf16x2_t __attribute__((ext_vector_type(2)));

namespace pg8 {
typedef unsigned short bf16_t;
constexpr int BM = 256, BK = 64, HALF = 128, HTB = HALF * BK * 2, STAGE_BYTES = 8 * HTB, NXCD = 8, WGM = 8;
__host__ __device__ __forceinline__ int lds_byte(int r, int c) { const int st = (r >> 4) * 2 + (c >> 5), rr = r & 15, cc = c & 31, ob = rr * 64 + cc * 2; return st * 1024 + (ob ^ (((ob >> 9) & 1) << 5)); }
__host__ __device__ __forceinline__ void stage_rc(int b, int& R, int& C) { const int st = b / 1024, sb = b % 1024, swz = sb ^ (((sb >> 9) & 1) << 5); R = (st >> 1) * 16 + swz / 64; C = (st & 1) * 32 + (swz % 64) / 2; }
__host__ __device__ __forceinline__ int perm32(int rho) { const int n = rho >> 4, i = rho & 15; return 8 * (i >> 2) + 4 * n + (i & 3); }
struct Unit { int pm, pn; };
struct Gemm { const bf16_t* A; const bf16_t* Bt; int M, N, K, lda, ldb; };
struct StaticOrder {
    int nM, nN, nwg, G, c;
    __host__ __device__ void init(int M, int N, int G_, int c_) { nM = M / BM; nN = N / BM; nwg = nM * nN; G = G_; c = c_; }
    __host__ __device__ bool next(int i, Unit& u) const {
        const long L = (long)i * G + c; if (L >= nwg) return false;
        int wgid = (int)L; { const int q = nwg / NXCD, r = nwg % NXCD, xcd = wgid % NXCD, off = wgid / NXCD; wgid = (xcd < r ? xcd * (q + 1) : r * (q + 1) + (xcd - r) * q) + off; }
        const int nig = WGM * nN, gid = wgid / nig, fm = gid * WGM, gsz = (nM - fm) < WGM ? (nM - fm) : WGM;
        u.pm = fm + ((wgid % nig) % gsz); u.pn = (wgid % nig) / gsz; return true;
    }
};
__device__ __forceinline__ unsigned cvt_pk_bf16(float lo, float hi) { unsigned r; asm volatile("v_cvt_pk_bf16_f32 %0, %1, %2" : "=v"(r) : "v"(lo), "v"(hi)); return r; }

template <class Epi, class Sched, bool ALIGN_EPI = true, bool SP2 = true>
__device__ __forceinline__ void gemm_phase(LAS unsigned char* lds, const Gemm g, const Sched& S, const Epi& E) {
    const int tid = threadIdx.x, wid = __builtin_amdgcn_readfirstlane(tid >> 6), lane = tid & 63, wr = wid >> 2, wc = wid & 3, fr = lane & 15, fq = lane >> 4;
    const int K = g.K, nt = K / BK;
    unsigned voffA[2], voffB[2];
#pragma unroll
    for (int i = 0; i < 2; ++i) { int R, C; stage_rc(tid * 16 + i * 8192, R, C); const int Rb = Epi::PERM ? ((R & ~31) + perm32(R & 31)) : R;
        voffA[i] = (unsigned)(R * g.lda + C) * 2u; voffB[i] = (unsigned)(Rb * g.ldb + C) * 2u; }
    const size_t kstep = (size_t)(BK * 2);
    const size_t hstepA = (size_t)HALF * g.lda * 2, hstepB = (size_t)HALF * g.ldb * 2;
    const size_t tstepA = 2 * hstepA, tstepB = 2 * hstepB;
    const unsigned ldsw = (unsigned)wid * 1024u;
    const int aoff = lds_byte(wr * 64 + fr, fq * 8), boff = lds_byte(wc * 32 + fr, fq * 8);
#define PG8_SA(b, h) (((b) * 2 + (h)) * HTB)
#define PG8_SB(b, h) ((4 + (b) * 2 + (h)) * HTB)
#define PG8_STAGE(bufoff, gbase, voff) do { _Pragma("unroll") for (int _i = 0; _i < 2; ++_i) \
        __builtin_amdgcn_global_load_lds((const unsigned*)((const char*)(gbase) + (voff)[_i]), (LAS unsigned*)(lds + (bufoff) + ldsw + _i * 8192), 16, 0, 0); } while (0)
#define PG8_LDA(dst, b, h) do { _Pragma("unroll") for (int m = 0; m < 4; ++m) _Pragma("unroll") for (int k = 0; k < 2; ++k) dst[m][k] = *(const LAS bf16x8*)(lds + PG8_SA(b, h) + aoff + m * 2048 + k * 1024); } while (0)
#define PG8_LDB(dst, b, h) do { _Pragma("unroll") for (int n = 0; n < 2; ++n) _Pragma("unroll") for (int k = 0; k < 2; ++k) dst[n][k] = *(const LAS bf16x8*)(lds + PG8_SB(b, h) + boff + n * 2048 + k * 1024); } while (0)
#define PG8_MMA(ai, bj, At, Bt) do { __builtin_amdgcn_s_setprio(1); _Pragma("unroll") for (int m = 0; m < 4; ++m) _Pragma("unroll") for (int n = 0; n < 2; ++n) _Pragma("unroll") for (int k = 0; k < 2; ++k) \
        acc[ai][bj][m][n] = __builtin_amdgcn_mfma_f32_16x16x32_bf16(Bt[n][k], At[m][k], acc[ai][bj][m][n], 0, 0, 0); __builtin_amdgcn_s_setprio(0); } while (0)
#define PG8_WAIT_V(n) asm volatile("s_waitcnt vmcnt(" #n ")" ::: "memory")
#define PG8_WAIT_L(n) asm volatile("s_waitcnt lgkmcnt(" #n ")" ::: "memory")
#define PG8_BAR __builtin_amdgcn_s_barrier()
#define PG8_SCHED __builtin_amdgcn_sched_barrier(0)
    Unit cur, nxt; int ui = 0;
    if (!S.next(0, cur)) return;
    f32x4 acc[2][2][4][2];
#pragma unroll
    for (int a = 0; a < 2; ++a)
#pragma unroll
        for (int b = 0; b < 2; ++b)
#pragma unroll
            for (int m = 0; m < 4; ++m)
#pragma unroll
                for (int n = 0; n < 2; ++n) acc[a][b][m][n] = (f32x4){0.f, 0.f, 0.f, 0.f};
    bf16x8 At[4][2], B0[2][2], B1[2][2];
    const char* cA = (const char*)g.A + (size_t)cur.pm * tstepA; const char* cB = (const char*)g.Bt + (size_t)cur.pn * tstepB;
    if constexpr (SP2) {
        PG8_STAGE(PG8_SB(0, 0), cB, voffB); PG8_STAGE(PG8_SB(0, 1), cB + hstepB, voffB); PG8_STAGE(PG8_SA(0, 0), cA, voffA); PG8_STAGE(PG8_SA(0, 1), cA + hstepA, voffA);
        if (wr == 1) PG8_BAR;
        PG8_WAIT_V(2); PG8_BAR;
        PG8_STAGE(PG8_SB(1, 0), cB + kstep, voffB); PG8_STAGE(PG8_SA(1, 0), cA + kstep, voffA); PG8_STAGE(PG8_SB(1, 1), cB + hstepB + kstep, voffB);
        PG8_WAIT_V(6); PG8_BAR;
    } else {
        PG8_STAGE(PG8_SB(0, 0), cB, voffB); PG8_STAGE(PG8_SA(0, 0), cA, voffA); PG8_STAGE(PG8_SB(0, 1), cB + hstepB, voffB); PG8_STAGE(PG8_SA(0, 1), cA + hstepA, voffA);
        if (wr == 1) PG8_BAR;
        PG8_WAIT_V(4); PG8_BAR;
        PG8_STAGE(PG8_SB(1, 0), cB + kstep, voffB); PG8_STAGE(PG8_SA(1, 0), cA + kstep, voffA); PG8_STAGE(PG8_SB(1, 1), cB + hstepB + kstep, voffB);
        PG8_WAIT_V(6); PG8_BAR;
    }
    for (;;) {
        const bool has_next = S.next(ui + 1, nxt);
        const char* nA = has_next ? (const char*)g.A + (size_t)nxt.pm * tstepA : cA; const char* nB = has_next ? (const char*)g.Bt + (size_t)nxt.pn * tstepB : cB;
        for (int t = 0; t < nt; t += 2) {
            const bool last = (t == nt - 2);
            const char* a1 = cA + (size_t)(t + 1) * kstep;
            const char* a2 = last ? nA : cA + (size_t)(t + 2) * kstep; const char* b2 = last ? nB : cB + (size_t)(t + 2) * kstep;
            const char* a3 = a2 + kstep; const char* b3 = b2 + kstep;
            if constexpr (SP2) {
            PG8_LDB(B0, 0, 0); PG8_LDB(B1, 0, 1); PG8_SCHED; PG8_LDA(At, 0, 0); PG8_STAGE(PG8_SA(1, 1), a1 + hstepA, voffA);
            PG8_WAIT_V(8); PG8_WAIT_L(0); PG8_BAR; PG8_MMA(0, 0, At, B0); PG8_MMA(0, 1, At, B1); PG8_BAR; PG8_SCHED;
            PG8_LDA(At, 0, 1); PG8_STAGE(PG8_SB(0, 0), b2, voffB); PG8_STAGE(PG8_SB(0, 1), b2 + hstepB, voffB); PG8_STAGE(PG8_SA(0, 0), a2, voffA);
            PG8_WAIT_V(8); PG8_WAIT_L(0); PG8_BAR; PG8_MMA(1, 0, At, B0); PG8_MMA(1, 1, At, B1); PG8_BAR; PG8_SCHED;
            PG8_LDB(B0, 1, 0); PG8_LDB(B1, 1, 1); PG8_SCHED; PG8_LDA(At, 1, 0); PG8_STAGE(PG8_SA(0, 1), a2 + hstepA, voffA);
            PG8_WAIT_V(8); PG8_WAIT_L(0); PG8_BAR; PG8_MMA(0, 0, At, B0); PG8_MMA(0, 1, At, B1); PG8_BAR; PG8_SCHED;
            PG8_LDA(At, 1, 1); PG8_STAGE(PG8_SB(1, 0), b3, voffB); PG8_STAGE(PG8_SB(1, 1), b3 + hstepB, voffB); PG8_STAGE(PG8_SA(1, 0), a3, voffA);
            PG8_WAIT_V(8); PG8_WAIT_L(0); PG8_BAR; PG8_MMA(1, 0, At, B0); PG8_MMA(1, 1, At, B1); PG8_BAR; PG8_SCHED;
            } else {
            PG8_LDB(B0, 0, 0); PG8_SCHED; PG8_LDA(At, 0, 0); PG8_STAGE(PG8_SA(1, 1), a1 + hstepA, voffA);
            PG8_WAIT_L(8); PG8_BAR; PG8_WAIT_L(0); PG8_MMA(0, 0, At, B0); PG8_BAR; PG8_SCHED;
            PG8_LDB(B1, 0, 1); PG8_STAGE(PG8_SB(0, 0), b2, voffB);
            PG8_BAR; PG8_WAIT_L(0); PG8_MMA(0, 1, At, B1); PG8_BAR;
            PG8_LDA(At, 0, 1); PG8_STAGE(PG8_SA(0, 0), a2, voffA);
            PG8_BAR; PG8_WAIT_L(0); PG8_MMA(1, 0, At, B0); PG8_BAR; PG8_SCHED;
            PG8_STAGE(PG8_SB(0, 1), b2 + hstepB, voffB);
            PG8_WAIT_V(6); PG8_BAR; PG8_MMA(1, 1, At, B1); PG8_BAR;
            PG8_LDB(B0, 1, 0); PG8_SCHED; PG8_LDA(At, 1, 0); PG8_STAGE(PG8_SA(0, 1), a2 + hstepA, voffA);
            PG8_WAIT_L(8); PG8_BAR; PG8_WAIT_L(0); PG8_MMA(0, 0, At, B0); PG8_BAR; PG8_SCHED;
            PG8_LDB(B1, 1, 1); PG8_STAGE(PG8_SB(1, 0), b3, voffB);
            PG8_BAR; PG8_WAIT_L(0); PG8_MMA(0, 1, At, B1); PG8_BAR;
            PG8_LDA(At, 1, 1); PG8_STAGE(PG8_SA(1, 0), a3, voffA);
            PG8_BAR; PG8_WAIT_L(0); PG8_MMA(1, 0, At, B0); PG8_BAR; PG8_SCHED;
            PG8_STAGE(PG8_SB(1, 1), b3 + hstepB, voffB);
            PG8_WAIT_V(6); PG8_BAR; PG8_MMA(1, 1, At, B1); PG8_BAR;
            }
        }
        if constexpr (ALIGN_EPI) { if (wr == 0) PG8_BAR; }
        E(acc, cur, wr, wc, fr, fq);
        if (!has_next) break;
#pragma unroll
        for (int a = 0; a < 2; ++a)
#pragma unroll
            for (int b = 0; b < 2; ++b)
#pragma unroll
                for (int m = 0; m < 4; ++m)
#pragma unroll
                    for (int n = 0; n < 2; ++n) acc[a][b][m][n] = (f32x4){0.f, 0.f, 0.f, 0.f};
        cur = nxt; cA = nA; cB = nB; ++ui;
        if constexpr (ALIGN_EPI) { if (wr == 1) PG8_BAR; }
    }
    PG8_WAIT_V(0);
    if constexpr (!ALIGN_EPI) { if (wr == 0) PG8_BAR; }
    PG8_BAR;
#undef PG8_SA
#undef PG8_SB
#undef PG8_STAGE
#undef PG8_LDA
#undef PG8_LDB
#undef PG8_MMA
#undef PG8_WAIT_V
#undef PG8_WAIT_L
#undef PG8_BAR
#undef PG8_SCHED
}
}

constexpr int NB = 16, SEQ = 2048, DM = 1024, MTOK = NB * SEQ;
constexpr int LD_CAS = 3584, LD_CR = 2560, N_IN_PAD = 6144, N_IN = 6040;
constexpr int Q0 = 0, KC0 = 512, VC0 = 640, KS0 = 768, VS0 = 896, KW0 = 1024, VW0 = 1152, GATE0 = 1280, ASILU0 = 1304;
constexpr int SH0 = 1816, R0 = SH0, K0 = SH0 + 512, V0 = SH0 + 1024, WD0 = SH0 + 1536, AD0 = SH0 + 1600, CAS_USED = 3480;
constexpr int BSILU0 = 0, MA0 = 512, MB0 = 1536;
constexpr float LOG2E = 1.4426950408889634f;
constexpr float QSCALE = 0.125f * LOG2E;

constexpr size_t MiB = 1u << 20;
constexpr size_t WS_CTL = 0, CTL_ZERO_BYTES = 64 * 1024;
constexpr size_t WS_MOD = 256 * 1024;
constexpr size_t WS_POSB = 512 * 1024;
constexpr size_t WS_BIAS = 520 * 1024;
constexpr size_t WS_WA_T = 2 * MiB, WS_WB_T = 3 * MiB;
constexpr size_t WS_WO_T = 4 * MiB;
constexpr size_t WS_W1K_T = 6 * MiB, WS_W1V_T = 7 * MiB;
constexpr size_t WS_W2K_T = 8 * MiB, WS_W2V_T = 8 * MiB + 64 * 1024;
constexpr size_t WS_WLW_T = 8 * MiB + 128 * 1024, WS_WLA_T = 8 * MiB + 192 * 1024;
constexpr size_t WS_KC = 9 * MiB;
constexpr size_t WS_VCT = 9 * MiB + 512 * 1024;
constexpr size_t WS_BONUS = 10 * MiB;
constexpr size_t WS_DUMMY = 11 * MiB;
constexpr size_t WS_VTS = 12 * MiB, WS_VTW = 20 * MiB;
constexpr size_t WS_CAS = 28 * MiB;
constexpr size_t WS_CR = 252 * MiB;
constexpr size_t WS_YA = 412 * MiB, WS_YB = 444 * MiB;
constexpr size_t WS_WIN_T = 476 * MiB;
constexpr size_t WS_HS = 476 * MiB;
constexpr size_t WS_MERGED = WS_CAS;
constexpr size_t WS_END = 508 * MiB;
constexpr size_t OUT_H = 0;
constexpr size_t OUT_G = 0, OUT_Y1 = 32 * MiB, OUT_D = 64 * MiB, OUT_Y2 = 96 * MiB;

constexpr int LDS_BYTES = 147456;

struct Params {
    const float *x, *c, *w_ada, *b_ada, *norm_gain, *w_in, *q_norm_gain, *k_norm_gain, *cmp_pos_k, *cmp_pos_v,
        *cmp_k_w1, *cmp_k_w2, *cmp_v_w1, *cmp_v_w2, *rel_bias, *shift_mu, *w0, *w_lora_up, *a0, *a_lora_up,
        *k_k, *k_a, *r_k, *ln_x_w, *ln_x_b, *w_out_a, *w_out_b, *w_o;
    float* out; unsigned char* ws;
    int ph_lo, ph_hi;
};

DI unsigned f2bf(float f) { unsigned u = __builtin_bit_cast(unsigned, f); return (u + 0x7fffu + ((u >> 16) & 1u)) >> 16; }
DI float bf2f(unsigned h) { return __builtin_bit_cast(float, h << 16); }
DI unsigned pk2(float lo, float hi) { f32x2 v = {lo, hi}; bf16x2_t b = __builtin_convertvector(v, bf16x2_t); return __builtin_bit_cast(unsigned, b); }
DI float bflo(unsigned w) { return __builtin_bit_cast(float, w << 16); }
DI float bfhi(unsigned w) { return __builtin_bit_cast(float, w & 0xffff0000u); }
DI float sigmoidf_(float x) { return __builtin_amdgcn_rcpf(1.f + __expf(-x)); }
DI float siluf_(float x) { return x * __builtin_amdgcn_rcpf(1.f + __expf(-x)); }
DI int crow(int r, int hh) { return (r & 3) + 8 * (r >> 2) + 4 * hh; }
DI int pos16_of_key(int k16) { return 8 * ((k16 >> 2) & 1) + 4 * (k16 >> 3) + (k16 & 3); }
DI int key16_of_pos(int p16) { const int hh = p16 >> 3, j = p16 & 7; return 8 * (j >> 2) + 4 * hh + (j & 3); }
DI float wave_sum(float v) {
#pragma unroll
    for (int o = 1; o < 64; o <<= 1) v += __shfl_xor(v, o);
    return v;
}
DI void unpack8(u32x4 w, float* f) { f[0] = bflo(w.x); f[1] = bfhi(w.x); f[2] = bflo(w.y); f[3] = bfhi(w.y); f[4] = bflo(w.z); f[5] = bfhi(w.z); f[6] = bflo(w.w); f[7] = bfhi(w.w); }
typedef short v4i16_t __attribute__((ext_vector_type(4)));
DI s16x4 tr_read(const LAS bf16* p) { return __builtin_bit_cast(s16x4, __builtin_amdgcn_ds_read_tr16_b64_v4i16((LAS v4i16_t*)p)); }

__device__ const unsigned char T5_BUCKET[129] = {
    0, 1, 2, 3, 4, 5, 6, 7, 8, 9, 10, 11, 12, 13, 14, 15, 16, 16, 16, 17, 17, 18, 18, 18, 19, 19, 19, 20, 20, 20, 20, 21, 21, 21, 21, 22, 22, 22, 22, 22, 23, 23, 23, 23, 23, 23, 24, 24, 24, 24, 24, 24, 25, 25, 25, 25, 25, 25, 25, 26, 26, 26, 26, 26, 26, 26, 26, 27, 27, 27, 27, 27, 27, 27, 27, 27, 27, 28, 28, 28, 28, 28, 28, 28, 28, 28, 28, 29, 29, 29, 29, 29, 29, 29, 29, 29, 29, 29, 29, 30, 30, 30, 30, 30, 30, 30, 30, 30, 30, 30, 30, 30, 30, 31, 31, 31, 31, 31, 31, 31, 31, 31, 31, 31, 31, 31, 31, 31, 31};

template <class F> DI void transpose_item(const float* W, int K, int N, bf16* WT, F rowmap, LAS float* scr, int item, int lane) {
    const int nblk = (N + 63) / 64, kb = item / nblk, nb = item % nblk, k0 = 64 * kb, n0 = 64 * nb;
    const int n4 = (lane & 15) * 4;
    const bool inb = n0 + n4 < N; const int ncl = inb ? n0 + n4 : N - 4;
    f32x4 vv[16];
#pragma unroll
    for (int i = 0; i < 16; ++i) vv[i] = *(const f32x4*)(W + (size_t)(k0 + 4 * i + (lane >> 4)) * N + ncl);
#pragma unroll
    for (int i = 0; i < 16; ++i) asm volatile("" : "+v"(vv[i]));
#pragma unroll
    for (int i = 0; i < 16; ++i) { const int kk = 4 * i + (lane >> 4);
        const f32x4 v = inb ? vv[i] : (f32x4){0.f, 0.f, 0.f, 0.f};
        LAS float* d = scr + kk * 65 + n4; d[0] = v[0]; d[1] = v[1]; d[2] = v[2]; d[3] = v[3]; }
    asm volatile("s_waitcnt lgkmcnt(0)" ::: "memory");
    const int c = lane & 7;
#pragma unroll
    for (int j = 0; j < 8; ++j) { const int nl = (lane >> 3) + 8 * j, n = n0 + nl; const LAS float* s = scr + (8 * c) * 65 + nl;
        u32x4 o; o.x = pk2(s[0 * 65], s[1 * 65]); o.y = pk2(s[2 * 65], s[3 * 65]); o.z = pk2(s[4 * 65], s[5 * 65]); o.w = pk2(s[6 * 65], s[7 * 65]);
        if (n < N) *(u32x4*)(WT + (size_t)rowmap(n) * K + k0 + 8 * c) = o; }
    asm volatile("s_waitcnt lgkmcnt(0)" ::: "memory");
}

DI void phase0w(const Params& p, LAS unsigned char* lds) {
    const int tid = threadIdx.x, lane = tid & 63, wave = __builtin_amdgcn_readfirstlane(tid >> 6);
    const int gw = blockIdx.x * 8 + wave, NGW = gridDim.x * 8;
    unsigned char* ws = p.ws;
    {
        LAS float* scr = (LAS float*)(lds + wave * 16640);
        constexpr int I_IN = 16 * 95, I_OA = 8 * 16, I_OB = 8 * 16, I_O = 16 * 16, I_W1 = 32 * 4, I_W2 = 4 * 1, I_L = 1 * 8;
        constexpr int NIT = I_IN + I_OA + I_OB + I_O + 2 * I_W1 + 2 * I_W2 + 2 * I_L;
        auto ident = [](int n) { return n; };
        auto inmap = [](int n) { return n < CAS_USED ? n : n + (LD_CAS - CAS_USED); };
        for (int it = gw; it < NIT; it += NGW) {
            int r = it;
            if (r < I_IN) { transpose_item(p.w_in, DM, N_IN, (bf16*)(ws + WS_WIN_T), inmap, scr, r, lane); continue; } r -= I_IN;
            if (r < I_OA) { transpose_item(p.w_out_a, 512, DM, (bf16*)(ws + WS_WA_T), ident, scr, r, lane); continue; } r -= I_OA;
            if (r < I_OB) { transpose_item(p.w_out_b, 512, DM, (bf16*)(ws + WS_WB_T), ident, scr, r, lane); continue; } r -= I_OB;
            if (r < I_O) { transpose_item(p.w_o, DM, DM, (bf16*)(ws + WS_WO_T), ident, scr, r, lane); continue; } r -= I_O;
            if (r < I_W1) { transpose_item(p.cmp_k_w1, 2048, 256, (bf16*)(ws + WS_W1K_T), ident, scr, r, lane); continue; } r -= I_W1;
            if (r < I_W1) { transpose_item(p.cmp_v_w1, 2048, 256, (bf16*)(ws + WS_W1V_T), ident, scr, r, lane); continue; } r -= I_W1;
            if (r < I_W2) { transpose_item(p.cmp_k_w2, 256, 64, (bf16*)(ws + WS_W2K_T), ident, scr, r, lane); continue; } r -= I_W2;
            if (r < I_W2) { transpose_item(p.cmp_v_w2, 256, 64, (bf16*)(ws + WS_W2V_T), ident, scr, r, lane); continue; } r -= I_W2;
            if (r < I_L) { transpose_item(p.w_lora_up, 64, 512, (bf16*)(ws + WS_WLW_T), ident, scr, r, lane); continue; } r -= I_L;
            transpose_item(p.a_lora_up, 64, 512, (bf16*)(ws + WS_WLA_T), ident, scr, r, lane);
        }
    }
    {
        u32x4* z = (u32x4*)(ws + WS_WIN_T + (size_t)CAS_USED * DM * 2);
        const int n16 = (LD_CAS - CAS_USED) * DM * 2 / 16;
        for (int i = blockIdx.x * 512 + tid; i < n16; i += gridDim.x * 512) z[i] = (u32x4){0u, 0u, 0u, 0u};
    }
    __syncthreads();
}
constexpr size_t WS_MODP = 1 * MiB;
DI void phase0(const Params& p, LAS unsigned char* lds) {
    const int tid = threadIdx.x, lane = tid & 63, wave = __builtin_amdgcn_readfirstlane(tid >> 6);
    unsigned char* ws = p.ws;
    LAS float* red = (LAS float*)lds;
    LAS float* sc = (LAS float*)(lds + 32768);
    for (int task = blockIdx.x; task < 201; task += gridDim.x) {
        if (task < 192) {
            const int cg = task % 48, kq = task / 48;
            for (int i = tid; i < 16 * 256; i += 512) sc[i] = siluf_(p.c[(i >> 8) * 1024 + kq * 256 + (i & 255)]);
            __syncthreads();
            const int col = cg * 64 + lane;
            float acc[16];
#pragma unroll
            for (int b = 0; b < 16; ++b) acc[b] = 0.f;
#pragma unroll 4
            for (int kk = 0; kk < 32; ++kk) { const int kl = wave * 32 + kk; const float wv = p.w_ada[(size_t)(kq * 256 + kl) * 3072 + col];
#pragma unroll
                for (int b = 0; b < 16; ++b) acc[b] += sc[b * 256 + kl] * wv; }
#pragma unroll
            for (int b = 0; b < 16; ++b) red[(wave * 16 + b) * 64 + lane] = acc[b];
            __syncthreads();
            for (int o = tid; o < 1024; o += 512) { const int b = o >> 6, l = o & 63; float s = 0.f;
#pragma unroll
                for (int w = 0; w < 8; ++w) s += red[(w * 16 + b) * 64 + l];
                ((float*)(ws + WS_MODP))[(kq * 16 + b) * 3072 + cg * 64 + l] = s; }
            __syncthreads();
        } else if (task < 200) {
            const int t2 = task - 192, which = t2 >> 2, col = (t2 & 3) * 64 + lane;
            const float* pos = which ? p.cmp_pos_v : p.cmp_pos_k; const float* w1 = which ? p.cmp_v_w1 : p.cmp_k_w1;
            float a = 0.f;
#pragma unroll 4
            for (int kk = 0; kk < 256; ++kk) { const int k = wave * 256 + kk; a += pos[k] * w1[(size_t)k * 256 + col]; }
            red[wave * 64 + lane] = a;
            __syncthreads();
            if (tid < 64) { float s = 0.f;
#pragma unroll
                for (int w = 0; w < 8; ++w) s += red[w * 64 + tid];
                ((float*)(ws + WS_POSB))[which * 256 + (t2 & 3) * 64 + tid] = s; }
            __syncthreads();
        } else {
            for (int i = tid; i < 8 * 129; i += 512) { const int h = i / 129, d = i % 129; ((float*)(ws + WS_BIAS))[h * 132 + d] = p.rel_bias[T5_BUCKET[d] * 8 + h] * LOG2E; }
        }
    }
}

DI void phase1(const Params& p, LAS unsigned char* lds) {
    const int tid = threadIdx.x, lane = tid & 63, wave = tid >> 6;
    bf16* hb = (bf16*)((unsigned char*)p.out + OUT_H);
    LAS float* modL = (LAS float*)lds;
    for (int rb = blockIdx.x; rb < MTOK / 128; rb += gridDim.x) {
        const int b = rb >> 4;
        __syncthreads();
        for (int col = tid; col < 3072; col += 512) { float s = p.b_ada[col];
#pragma unroll
            for (int kq = 0; kq < 4; ++kq) s += ((const float*)(p.ws + WS_MODP))[(kq * 16 + b) * 3072 + col];
            modL[col] = s; if ((rb & 15) == 0) ((float*)(p.ws + WS_MOD))[b * 3072 + col] = s; }
        __syncthreads();
        f32x4 gq[4];
#pragma unroll
        for (int j = 0; j < 4; ++j) gq[j] = *(const f32x4*)(p.norm_gain + 4 * lane + 256 * j);
        for (int r = wave; r < 128; r += 8) {
            const int m = rb * 128 + r;
            const f32x4* xr = (const f32x4*)(p.x + (size_t)m * DM) + lane;
            f32x4 v[4]; float s = 0.f;
#pragma unroll
            for (int j = 0; j < 4; ++j) { v[j] = xr[64 * j]; s += (v[j].x * v[j].x + v[j].y * v[j].y) + (v[j].z * v[j].z + v[j].w * v[j].w); }
            const float rinv = rsqrtf(wave_sum(s) * (1.f / DM) + 1e-6f);
            u32x2* o8 = (u32x2*)(hb + (size_t)m * DM) + lane;
#pragma unroll
            for (int j = 0; j < 4; ++j) {
                const int k = 4 * lane + 256 * j;
                const f32x4 g = gq[j], sh = *(const LAS f32x4*)(modL + k), scl = *(const LAS f32x4*)(modL + 1024 + k);
                f32x4 h = v[j] * rinv * g * (scl + 1.f) + sh;
                u32x2 o; o.x = pk2(h.x, h.y); o.y = pk2(h.z, h.w); o8[64 * j] = o;
            }
        }
    }
    __syncthreads();
}

struct EpiInProj {
    static constexpr bool PERM = true;
    bf16* cas; bf16* cr;
    DI void operator()(const f32x4 (&acc)[2][2][4][2], const pg8::Unit& u, int wr, int wc, int fr, int fq) const {
        const int row0 = u.pm * 256 + wr * 64 + fr;
        bf16* base; int ldc, colt;
        if (u.pn < 14) { base = cas; ldc = LD_CAS; colt = u.pn * 256; } else { base = cr; ldc = LD_CR; colt = (u.pn - 14) * 256; }
        const int col0 = colt + wc * 32 + 8 * fq;
#pragma unroll
        for (int ai = 0; ai < 2; ++ai)
#pragma unroll
            for (int m = 0; m < 4; ++m) { bf16* rowp = base + (size_t)(row0 + ai * 128 + m * 16) * ldc + col0;
#pragma unroll
                for (int bj = 0; bj < 2; ++bj) { const f32x4 v0 = acc[ai][bj][m][0], v1 = acc[ai][bj][m][1];
                    u32x4 w; w.x = pk2(v0[0], v0[1]); w.y = pk2(v0[2], v0[3]); w.z = pk2(v1[0], v1[1]); w.w = pk2(v1[2], v1[3]);
                    *(u32x4*)(rowp + bj * 128) = w; } }
    }
};
template <int WHICH> struct EpiGate {
    static constexpr bool PERM = true;
    bf16* merged; const bf16* cr;
    DI void operator()(const f32x4 (&acc)[2][2][4][2], const pg8::Unit& u, int wr, int wc, int fr, int fq) const {
        const int row0 = u.pm * 256 + wr * 64 + fr, col0 = u.pn * 256 + wc * 32 + 8 * fq;
#pragma unroll
        for (int ai = 0; ai < 2; ++ai)
#pragma unroll
            for (int mp2 = 0; mp2 < 2; ++mp2) {
                u32x4 gw[2][2], ow[2][2];
#pragma unroll
                for (int m2 = 0; m2 < 2; ++m2)
#pragma unroll
                    for (int bj = 0; bj < 2; ++bj) { const size_t row = (size_t)(row0 + ai * 128 + (2 * mp2 + m2) * 16); const int col = col0 + bj * 128;
                        gw[m2][bj] = *(const u32x4*)(cr + row * LD_CR + (WHICH ? MB0 : MA0) + col);
                        if (WHICH) ow[m2][bj] = *(const u32x4*)(merged + row * DM + col); }
#pragma unroll
                for (int m2 = 0; m2 < 2; ++m2)
#pragma unroll
                    for (int bj = 0; bj < 2; ++bj) { asm volatile("" : "+v"(gw[m2][bj])); if (WHICH) asm volatile("" : "+v"(ow[m2][bj])); }
#pragma unroll
                for (int m2 = 0; m2 < 2; ++m2)
#pragma unroll
                    for (int bj = 0; bj < 2; ++bj) { const int m = 2 * mp2 + m2; const size_t row = (size_t)(row0 + ai * 128 + m * 16); const int col = col0 + bj * 128;
                        float gl[8]; unpack8(gw[m2][bj], gl);
                        const f32x4 v0 = acc[ai][bj][m][0], v1 = acc[ai][bj][m][1];
                        float r[8] = {v0[0], v0[1], v0[2], v0[3], v1[0], v1[1], v1[2], v1[3]};
                        if (WHICH) { float old[8]; unpack8(ow[m2][bj], old);
#pragma unroll
                            for (int i = 0; i < 8; ++i) r[i] = old[i] + sigmoidf_(gl[i]) * r[i]; }
                        else {
#pragma unroll
                            for (int i = 0; i < 8; ++i) r[i] = sigmoidf_(gl[i]) * r[i]; }
                        u32x4 w; w.x = pk2(r[0], r[1]); w.y = pk2(r[2], r[3]); w.z = pk2(r[4], r[5]); w.w = pk2(r[6], r[7]);
                        *(u32x4*)(merged + row * DM + col) = w; }
            }
    }
};
struct EpiFinal {
    static constexpr bool PERM = false;
    const float* x; const float* mod; float* out;
    DI void operator()(const f32x4 (&acc)[2][2][4][2], const pg8::Unit& u, int wr, int wc, int fr, int fq) const {
        const int row0 = u.pm * 256 + wr * 64 + fr, col0 = u.pn * 256 + wc * 32 + 4 * fq;
        const int b = (u.pm * 256) >> 11;
        f32x4 gv[2][2];
#pragma unroll
        for (int bj = 0; bj < 2; ++bj)
#pragma unroll
            for (int n = 0; n < 2; ++n) gv[bj][n] = *(const f32x4*)(mod + b * 3072 + 2048 + col0 + bj * 128 + n * 16);
#pragma unroll
        for (int ai = 0; ai < 2; ++ai)
#pragma unroll
            for (int mp = 0; mp < 2; ++mp) {
                f32x4 xv[2][2][2];
#pragma unroll
                for (int m2 = 0; m2 < 2; ++m2)
#pragma unroll
                    for (int bj = 0; bj < 2; ++bj)
#pragma unroll
                        for (int n = 0; n < 2; ++n) xv[m2][bj][n] = *(const f32x4*)(x + (size_t)(row0 + ai * 128 + (2 * mp + m2) * 16) * DM + col0 + bj * 128 + n * 16);
#pragma unroll
                for (int m2 = 0; m2 < 2; ++m2)
#pragma unroll
                    for (int bj = 0; bj < 2; ++bj)
#pragma unroll
                        for (int n = 0; n < 2; ++n) asm volatile("" : "+v"(xv[m2][bj][n]));
#pragma unroll
                for (int m2 = 0; m2 < 2; ++m2)
#pragma unroll
                    for (int bj = 0; bj < 2; ++bj)
#pragma unroll
                        for (int n = 0; n < 2; ++n)
                            *(f32x4*)(out + (size_t)(row0 + ai * 128 + (2 * mp + m2) * 16) * DM + col0 + bj * 128 + n * 16) = xv[m2][bj][n] + gv[bj][n] * acc[ai][bj][2 * mp + m2][n];
            }
    }
};

DI void phase3a(const Params& p, LAS unsigned char* lds) {
    const int tid = threadIdx.x, lane = tid & 63, wave = tid >> 6;
    const int gw = blockIdx.x * 8 + wave, NGW = gridDim.x * 8;
    bf16* cas = (bf16*)(p.ws + WS_CAS);
    {
        float gq[8], gk[8];
        const int dq = (8 * lane) & 63;
#pragma unroll
        for (int i = 0; i < 8; ++i) gq[i] = p.q_norm_gain[dq + i] * QSCALE;
        const int kr = (lane < 16) ? 1 : 2, dk = (8 * lane) & 63;
#pragma unroll
        for (int i = 0; i < 8; ++i) gk[i] = p.k_norm_gain[kr * 64 + dk + i];
        const int kcol = (lane < 16) ? (KS0 + 8 * lane) : (KW0 + 8 * (lane & 15));
        for (int m0 = gw * 4; m0 < MTOK; m0 += NGW * 4) {
            u32x4 qw[4], kw[4];
#pragma unroll
            for (int u = 0; u < 4; ++u) { bf16* row = cas + (size_t)(m0 + u) * LD_CAS;
                qw[u] = *(const u32x4*)(row + Q0 + 8 * lane);
                kw[u] = (lane < 32) ? *(const u32x4*)(row + kcol) : (u32x4){0u, 0u, 0u, 0u}; }
#pragma unroll
            for (int u = 0; u < 4; ++u) {
                bf16* row = cas + (size_t)(m0 + u) * LD_CAS;
                float q[8], k[8]; unpack8(qw[u], q); unpack8(kw[u], k);
                float sq = 0.f, sk = 0.f;
#pragma unroll
                for (int i = 0; i < 8; ++i) { sq += q[i] * q[i]; sk += k[i] * k[i]; }
#pragma unroll
                for (int o = 1; o < 8; o <<= 1) { sq += __shfl_xor(sq, o); sk += __shfl_xor(sk, o); }
                const float rq = rsqrtf(sq * (1.f / 64.f) + 1e-6f), rk = rsqrtf(sk * (1.f / 64.f) + 1e-6f);
#pragma unroll
                for (int i = 0; i < 8; ++i) { q[i] *= rq * gq[i]; k[i] *= rk * gk[i]; }
                u32x4 o; o.x = pk2(q[0], q[1]); o.y = pk2(q[2], q[3]); o.z = pk2(q[4], q[5]); o.w = pk2(q[6], q[7]);
                *(u32x4*)(row + Q0 + 8 * lane) = o;
                if (lane < 32) { u32x4 o2; o2.x = pk2(k[0], k[1]); o2.y = pk2(k[2], k[3]); o2.z = pk2(k[4], k[5]); o2.w = pk2(k[6], k[7]); *(u32x4*)(row + kcol) = o2; }
            }
        }
    }
    {
        LAS bf16* tile = (LAS bf16*)lds;
        const int key = tid >> 3, ch = tid & 7;
#define V_SRC(IT) (cas + (size_t)(((((IT) >> 5) & 31) >> 1) * SEQ + 64 * ((IT) & 31) + key) * LD_CAS + (((IT) >> 10) ? VW0 : VS0) + ((((IT) >> 5) & 31) & 1) * 64 + 8 * ch)
        u32x4 curv = *(const u32x4*)V_SRC(min((int)blockIdx.x, 2047));
        for (int it = blockIdx.x; it < 2048; it += gridDim.x) {
            const int which = it >> 10, bg = (it >> 5) & 31, j = it & 31;
            asm volatile("s_waitcnt lgkmcnt(0)\n\ts_barrier" ::: "memory");
            *(LAS u32x4*)(tile + key * 72 + 8 * ch) = curv;
            curv = *(const u32x4*)V_SRC(min(it + (int)gridDim.x, 2047));
            asm volatile("s_waitcnt lgkmcnt(0)\n\ts_barrier" ::: "memory");
            const int d = tid >> 3, pc = tid & 7;
            unsigned short v[8];
#pragma unroll
            for (int i = 0; i < 8; ++i) { const int pos = 8 * pc + i, k2 = (pos & ~15) | key16_of_pos(pos & 15); v[i] = tile[k2 * 72 + d]; }
            u32x4 o; o.x = v[0] | ((unsigned)v[1] << 16); o.y = v[2] | ((unsigned)v[3] << 16); o.z = v[4] | ((unsigned)v[5] << 16); o.w = v[6] | ((unsigned)v[7] << 16);
            bf16* vt = (bf16*)(p.ws + (which ? WS_VTW : WS_VTS)) + ((size_t)(bg * 32 + j) * 64 + d) * 64 + 8 * pc;
            *(u32x4*)vt = o;
        }
#undef V_SRC
        __syncthreads();
    }
}

DI float gelu_tanh(float x) { const float u = 0.7978845608028654f * (x + 0.044715f * x * x * x); const float t = 1.f - 2.f * __builtin_amdgcn_rcpf(__expf(2.f * u) + 1.f); return 0.5f * x * (1.f + t); }
DI void phase3b(const Params& p, LAS unsigned char* lds) {
    const int tid = threadIdx.x, lane = tid & 63, wave = __builtin_amdgcn_readfirstlane(tid >> 6), l31 = lane & 31, hh = lane >> 5;
    const bf16* cas = (const bf16*)(p.ws + WS_CAS);
    LAS bf16* h1 = (LAS bf16*)lds;
    LAS float* o2 = (LAS float*)(lds + 32 * 264 * 2);
    LAS unsigned char* xs = lds + 32768;
    float kgain[8];
#pragma unroll
    for (int i = 0; i < 8; ++i) kgain[i] = p.k_norm_gain[(tid & 7) * 8 + i];
    for (int it = blockIdx.x; it < 256; it += gridDim.x) {
        const int which = it >> 7, bg = (it >> 2) & 31, rq = it & 3, b = bg >> 1, g = bg & 1;
        {
            const bf16* xsrc = cas + (size_t)(b * SEQ) * LD_CAS + (which ? VC0 : KC0) + g * 64;
            for (int i = tid; i < 528 * 8; i += 512) { const int tr = i >> 3, ch = i & 7; int tok = 512 * rq + tr; tok = tok < SEQ ? tok : SEQ - 1;
                *(LAS u32x4*)(xs + tr * 128 + ((ch ^ ((tr >> 4) & 7)) << 4)) = *(const u32x4*)(xsrc + (size_t)tok * LD_CAS + 8 * ch); }
        }
        __syncthreads();
        const bf16* brow = (const bf16*)(p.ws + (which ? WS_W1V_T : WS_W1K_T)) + (size_t)(32 * wave + l31) * 2048 + 8 * hh;
        f32x16 acc = {};
#pragma unroll 16
        for (int s = 0; s < 128; ++s) {
            const int kk = 16 * s, tr = 16 * l31 + (kk >> 6), ch = ((kk & 63) >> 3) + hh;
            const bf16x8 a = *(const LAS bf16x8*)(xs + tr * 128 + ((ch ^ ((tr >> 4) & 7)) << 4));
            const bf16x8 bb = *(const bf16x8*)(brow + kk);
            acc = __builtin_amdgcn_mfma_f32_32x32x16_bf16(a, bb, acc, 0, 0, 0);
        }
        const float pb = ((const float*)(p.ws + WS_POSB))[which * 256 + 32 * wave + l31];
        __syncthreads();
#pragma unroll
        for (int r = 0; r < 16; ++r) h1[crow(r, hh) * 264 + 32 * wave + l31] = (bf16)f2bf(gelu_tanh(acc[r] + pb));
        __syncthreads();
        if (wave < 2) {
            const bf16* b2 = (const bf16*)(p.ws + (which ? WS_W2V_T : WS_W2K_T)) + (size_t)(32 * wave + l31) * 256 + 8 * hh;
            f32x16 a2 = {};
#pragma unroll
            for (int s = 0; s < 16; ++s) {
                const bf16x8 a = *(const LAS bf16x8*)(h1 + l31 * 264 + 16 * s + 8 * hh);
                const bf16x8 bb = *(const bf16x8*)(b2 + 16 * s);
                a2 = __builtin_amdgcn_mfma_f32_32x32x16_bf16(a, bb, a2, 0, 0, 0);
            }
#pragma unroll
            for (int r = 0; r < 16; ++r) o2[crow(r, hh) * 65 + 32 * wave + l31] = a2[r];
        }
        __syncthreads();
        if (tid < 256) {
            const int nl = tid >> 3, e8 = (tid & 7) * 8, nn = 32 * rq + nl;
            float v[8]; float ss = 0.f;
#pragma unroll
            for (int i = 0; i < 8; ++i) { v[i] = o2[nl * 65 + e8 + i]; ss += v[i] * v[i]; }
            if (which == 0) {
#pragma unroll
                for (int o = 1; o < 8; o <<= 1) ss += __shfl_xor(ss, o);
                const float rinv = rsqrtf(ss * (1.f / 64.f) + 1e-6f);
#pragma unroll
                for (int i = 0; i < 8; ++i) v[i] = (nn < 127) ? v[i] * rinv * kgain[i] : 0.f;
                u32x4 o; o.x = pk2(v[0], v[1]); o.y = pk2(v[2], v[3]); o.z = pk2(v[4], v[5]); o.w = pk2(v[6], v[7]);
                *(u32x4*)((bf16*)(p.ws + WS_KC) + (size_t)(bg * 128 + nn) * 64 + e8) = o;
            } else {
                const int pos = (nn & ~15) | pos16_of_key(nn & 15);
                bf16* vct = (bf16*)(p.ws + WS_VCT) + (size_t)bg * 64 * 128 + pos;
#pragma unroll
                for (int i = 0; i < 8; ++i) vct[(size_t)(e8 + i) * 128] = (bf16)f2bf((nn < 127) ? v[i] : 0.f);
            }
        }
        __syncthreads();
    }
}

constexpr int SLOTB = 8192;
DI int sw_el(int row, int col) { return row * 64 + ((((col >> 3) ^ (row & 7)) << 3) | (col & 7)); }
DI int swf_el(int row, int col) { return row * 64 + ((((col >> 2) ^ (row & 15)) << 2) | (col & 3)); }
DI bf16x8 frag_row(const LAS bf16* Mx, int row, int kc) { return *(const LAS bf16x8*)(Mx + sw_el(row, kc)); }
DI bf16x8 frag_col(const LAS bf16* Mx, int k0, int colbase, int lane) {
    const int i16 = lane & 15, q = i16 >> 2, pp = i16 & 3, blk = (lane >> 4) & 1, col = colbase + 16 * blk + 4 * pp;
    const s16x4 lo = tr_read(Mx + sw_el(k0 + q, col)), hi = tr_read(Mx + sw_el(k0 + 4 + q, col));
    return __builtin_shufflevector(lo, hi, 0, 1, 2, 3, 4, 5, 6, 7);
}
template <bool TA, bool TB> DI void mm_acc(f32x16& acc, const LAS bf16* A, const LAS bf16* Bm, int ti, int tj, int lane) {
    const int l31 = lane & 31, hh = lane >> 5;
#pragma unroll
    for (int s = 0; s < 4; ++s) {
        const int k0 = 16 * s + 8 * hh;
        bf16x8 x, y;
        if (TB) x = frag_row(Bm, 32 * tj + l31, k0); else x = frag_col(Bm, k0, 32 * tj, lane);
        if (TA) y = frag_col(A, k0, 32 * ti, lane); else y = frag_row(A, 32 * ti + l31, k0);
        acc = __builtin_amdgcn_mfma_f32_32x32x16_bf16(x, y, acc, 0, 0, 0);
    }
}
DI void ld_tile(f32x16& acc, const LAS bf16* Mx, int ti, int tj, int l31, int hh) {
#pragma unroll
    for (int g = 0; g < 4; ++g) { const u32x2 w = *(const LAS u32x2*)(Mx + sw_el(32 * ti + l31, 32 * tj + 8 * g + 4 * hh));
        acc[4 * g] = bflo(w.x); acc[4 * g + 1] = bfhi(w.x); acc[4 * g + 2] = bflo(w.y); acc[4 * g + 3] = bfhi(w.y); }
}
DI void st_tile(LAS bf16* Mx, const f32x16& acc, int ti, int tj, int l31, int hh) {
#pragma unroll
    for (int g = 0; g < 4; ++g) { u32x2 w; w.x = pk2(acc[4 * g], acc[4 * g + 1]); w.y = pk2(acc[4 * g + 2], acc[4 * g + 3]);
        *(LAS u32x2*)(Mx + sw_el(32 * ti + l31, 32 * tj + 8 * g + 4 * hh)) = w; }
}
DI void st_native_global(bf16* Tm, const f32x16& acc, int tile, int lane) {
    u32x4 a, b;
    a.x = pk2(acc[0], acc[1]); a.y = pk2(acc[2], acc[3]); a.z = pk2(acc[4], acc[5]); a.w = pk2(acc[6], acc[7]);
    b.x = pk2(acc[8], acc[9]); b.y = pk2(acc[10], acc[11]); b.z = pk2(acc[12], acc[13]); b.w = pk2(acc[14], acc[15]);
    u32x4* d = (u32x4*)(Tm + (size_t)tile * 1024 + lane * 8); d[0] = a; d[64] = b;
}
DI void ld_native_global(f32x16& acc, const bf16* Tm, int tile, int lane) {
    const u32x4* d = (const u32x4*)(Tm + (size_t)tile * 1024 + lane * 8); const u32x4 a = d[0], b = d[64];
    acc[0] = bflo(a.x); acc[1] = bfhi(a.x); acc[2] = bflo(a.y); acc[3] = bfhi(a.y); acc[4] = bflo(a.z); acc[5] = bfhi(a.z); acc[6] = bflo(a.w); acc[7] = bfhi(a.w);
    acc[8] = bflo(b.x); acc[9] = bfhi(b.x); acc[10] = bflo(b.y); acc[11] = bfhi(b.y); acc[12] = bflo(b.z); acc[13] = bfhi(b.z); acc[14] = bflo(b.w); acc[15] = bfhi(b.w);
}
DI bf16x8 pack8(const f32x16& x, int s) {
    u32x4 w; w.x = pk2(x[8 * s], x[8 * s + 1]); w.y = pk2(x[8 * s + 2], x[8 * s + 3]); w.z = pk2(x[8 * s + 4], x[8 * s + 5]); w.w = pk2(x[8 * s + 6], x[8 * s + 7]);
    return __builtin_bit_cast(bf16x8, w);
}
DI bf16x8 frag_col_perm(const LAS bf16* Mx, int kb16, int colbase, int lane) {
    const int i16 = lane & 15, q = i16 >> 2, pp = i16 & 3, blk = (lane >> 4) & 1, hh = lane >> 5, col = colbase + 16 * blk + 4 * pp;
    const s16x4 lo = tr_read(Mx + sw_el(kb16 + 4 * hh + q, col)), hi = tr_read(Mx + sw_el(kb16 + 8 + 4 * hh + q, col));
    return __builtin_shufflevector(lo, hi, 0, 1, 2, 3, 4, 5, 6, 7);
}
DI void mm32_acc(f32x16& C, const f32x16& A, const LAS bf16* Bm, int kb, int colbase, int lane) {
    const bf16x8 a0 = pack8(A, 0), a1 = pack8(A, 1);
    C = __builtin_amdgcn_mfma_f32_32x32x16_bf16(frag_col_perm(Bm, kb, colbase, lane), a0, C, 0, 0, 0);
    C = __builtin_amdgcn_mfma_f32_32x32x16_bf16(frag_col_perm(Bm, kb + 16, colbase, lane), a1, C, 0, 0, 0);
}
DI u32x4 pack8f(const float* v) { u32x4 o; o.x = pk2(v[0], v[1]); o.y = pk2(v[2], v[3]); o.z = pk2(v[4], v[5]); o.w = pk2(v[6], v[7]); return o; }

DI void phase3c(const Params& p, LAS unsigned char* lds) {
    const int tid0 = threadIdx.x, wave = __builtin_amdgcn_readfirstlane(tid0 >> 6);
    const int half = wave >> 2, lw = wave & 3, ti = (lw >> 1) & 1, tj = lw & 1;
    const bf16* cas = (const bf16*)(p.ws + WS_CAS);
    LAS unsigned char* hb = lds + half * 65536;
#define SL(i) ((LAS bf16*)(hb + (i) * SLOTB))
    LAS float* F1 = (LAS float*)(hb);
    LAS float* F2 = (LAS float*)(hb + 2 * SLOTB);
    LAS float* gam = (LAS float*)(lds + 131072) + half * 64;
    LAS float* tot = (LAS float*)(lds + 131072 + 512) + half * 256;
    LAS float* parL = (LAS float*)(lds + 131072 + 512 + 2048) + half * 640;
    int par_h = -1;
#define LDS_BAR() asm volatile("s_waitcnt lgkmcnt(0)\n\ts_barrier" ::: "memory")
    u32x4 nwd[2], nad[2], npw[2], npa[2];
#define E1_FETCH(PR) do { const int it_ = 2 * (PR) + half; const int c_ = it_ & 31; const size_t me_ = (size_t)(it_ >> 8) * SEQ + 64 * c_ + ((tid0 & 255) >> 2); \
        const bool hp_ = (64 * c_ + ((tid0 & 255) >> 2)) > 0; const int j16_ = (tid0 & 3) * 16; \
        _Pragma("unroll") for (int sp = 0; sp < 2; ++sp) { \
            nwd[sp] = *(const u32x4*)(cas + me_ * LD_CAS + WD0 + j16_ + 8 * sp); nad[sp] = *(const u32x4*)(cas + me_ * LD_CAS + AD0 + j16_ + 8 * sp); \
            npw[sp] = *(const u32x4*)(cas + (me_ - (hp_ ? 1 : 0)) * LD_CAS + WD0 + j16_ + 8 * sp); npa[sp] = *(const u32x4*)(cas + (me_ - (hp_ ? 1 : 0)) * LD_CAS + AD0 + j16_ + 8 * sp); } } while (0)
    unsigned pf0 = 0u, pf1 = 0u;
    if ((int)blockIdx.x < 2048) E1_FETCH((int)blockIdx.x);
#pragma unroll
    for (int k = 0; k < 8; ++k) *(u32x4*)(p.ws + WS_DUMMY + (size_t)k * 8192 + tid0 * 16) = (u32x4){0u, 0u, 0u, 0u};
    for (int pr = blockIdx.x; pr < 2048; pr += gridDim.x) {
        int tid = tid0; asm volatile("" : "+v"(tid));
        const int lane = tid & 63, l31 = lane & 31, hh = lane >> 5, ltid = tid & 255;
        const int item = 2 * pr + half;
        const int c = item & 31, h = (item >> 5) & 7, b = item >> 8;
        const size_t m0 = (size_t)b * SEQ + 64 * c;
        const int te = ltid >> 2, c16 = (ltid & 3) * 16; const size_t me = m0 + te; const bool hpv = (64 * c + te) > 0;
        if (h != par_h) {
            par_h = h;
            for (int i = ltid; i < 640; i += 256) { const int rw = i >> 6, cc = i & 63; float v;
                if (rw == 0) v = p.w0[h * 64 + cc]; else if (rw == 1) v = p.a0[h * 64 + cc]; else if (rw == 2) v = p.k_k[h * 64 + cc]; else if (rw == 3) v = p.k_a[h * 64 + cc];
                else if (rw == 4) v = p.r_k[h * 64 + cc]; else if (rw < 8) v = p.shift_mu[(rw - 5) * 512 + h * 64 + cc]; else v = p.shift_mu[1536 + (rw - 8) * 64 + cc];
                parL[i] = v; }
            LDS_BAR();
        }
        u32x4 gk[2], gr[2], gv[2], gkp[2], grp[2], gvp[2];
#pragma unroll
        for (int sp = 0; sp < 2; ++sp) { const int hc8 = h * 64 + c16 + 8 * sp;
            gk[sp] = *(const u32x4*)(cas + me * LD_CAS + K0 + hc8); gr[sp] = *(const u32x4*)(cas + me * LD_CAS + R0 + hc8); gv[sp] = *(const u32x4*)(cas + me * LD_CAS + V0 + hc8);
            const size_t mp = me - (hpv ? 1 : 0);
            gkp[sp] = *(const u32x4*)(cas + mp * LD_CAS + K0 + hc8); grp[sp] = *(const u32x4*)(cas + mp * LD_CAS + R0 + hc8); gvp[sp] = *(const u32x4*)(cas + mp * LD_CAS + V0 + hc8); }
        bf16x8 wfr[2][4];
#pragma unroll
        for (int pd = 0; pd < 2; ++pd) { const bf16* wt = (const bf16*)(p.ws + (pd ? WS_WLA_T : WS_WLW_T)) + (size_t)(h * 64 + 32 * tj + l31) * 64;
#pragma unroll
            for (int s = 0; s < 4; ++s) wfr[pd][s] = *(const bf16x8*)(wt + 16 * s + 8 * hh); }
#pragma unroll
        for (int sp = 0; sp < 2; ++sp) {
            const int j8 = c16 + 8 * sp;
            float wd[8], ad[8], pw[8], pa[8];
            asm volatile("" : "+v"(npw[sp]), "+v"(npa[sp]));
            unpack8(nwd[sp], wd); unpack8(nad[sp], ad); unpack8(hpv ? npw[sp] : (u32x4){0u, 0u, 0u, 0u}, pw); unpack8(hpv ? npa[sp] : (u32x4){0u, 0u, 0u, 0u}, pa);
#pragma unroll
            for (int i = 0; i < 8; ++i) { const float x = wd[i] + (pw[i] - wd[i]) * parL[512 + j8 + i]; const float e2 = __expf(2.f * x); wd[i] = 1.f - 2.f * __builtin_amdgcn_rcpf(e2 + 1.f);
                ad[i] = ad[i] + (pa[i] - ad[i]) * parL[576 + j8 + i]; }
            *(LAS u32x4*)(SL(6) + sw_el(te, j8)) = pack8f(wd);
            *(LAS u32x4*)(SL(7) + sw_el(te, j8)) = pack8f(ad);
        }
        E1_FETCH(min(pr + (int)gridDim.x, 2047));
        LDS_BAR();
#pragma unroll
        for (int pd = 0; pd < 2; ++pd) {
            const LAS bf16* Am = pd ? SL(7) : SL(6);
            f32x16 acc = {};
#pragma unroll
            for (int s = 0; s < 4; ++s) { const int k0 = 16 * s + 8 * hh;
                const bf16x8 y = frag_row(Am, 32 * ti + l31, k0);
                acc = __builtin_amdgcn_mfma_f32_32x32x16_bf16(wfr[pd][s], y, acc, 0, 0, 0); }
            LAS float* F = pd ? F2 : F1;
#pragma unroll
            for (int g = 0; g < 4; ++g) *(LAS f32x4*)(F + swf_el(32 * ti + l31, 32 * tj + 8 * g + 4 * hh)) = (f32x4){acc[4 * g], acc[4 * g + 1], acc[4 * g + 2], acc[4 * g + 3]};
        }
        LDS_BAR();
        asm volatile("" :: "v"(pf0), "v"(pf1));
        float lw16[16], av16[16], bv16[16], km16[16], rs16[16];
        {
            float kraw[16], icl[16]; float ss = 0.f, bon = 0.f;
#pragma unroll
            for (int sp = 0; sp < 2; ++sp) {
                const int c8 = c16 + 8 * sp, hc8 = h * 64 + c8;
                float kc_[8], kp_[8], rc_[8], rp_[8], vc_[8], vp_[8];
                asm volatile("" : "+v"(gkp[sp]), "+v"(grp[sp]), "+v"(gvp[sp]));
                const u32x4 z4 = {0u, 0u, 0u, 0u};
                unpack8(gk[sp], kc_); unpack8(gr[sp], rc_); unpack8(gv[sp], vc_); unpack8(hpv ? gkp[sp] : z4, kp_); unpack8(hpv ? grp[sp] : z4, rp_); unpack8(hpv ? gvp[sp] : z4, vp_);
                const f32x4 z0 = *(const LAS f32x4*)(F1 + swf_el(te, c8)), z1 = *(const LAS f32x4*)(F1 + swf_el(te, c8 + 4));
                const f32x4 a0_ = *(const LAS f32x4*)(F2 + swf_el(te, c8)), a1_ = *(const LAS f32x4*)(F2 + swf_el(te, c8 + 4));
                const float zz[8] = {z0[0], z0[1], z0[2], z0[3], z1[0], z1[1], z1[2], z1[3]}, ap[8] = {a0_[0], a0_[1], a0_[2], a0_[3], a1_[0], a1_[1], a1_[2], a1_[3]};
                float vs[8];
#pragma unroll
                for (int i = 0; i < 8; ++i) {
                    const int e = 8 * sp + i;
                    const int pc = c8 + i;
                    const float ks = kc_[i] + (kp_[i] - kc_[i]) * parL[384 + pc];
                    rs16[e] = rc_[i] + (rp_[i] - rc_[i]) * parL[320 + pc];
                    vs[i] = vc_[i] + (vp_[i] - vc_[i]) * parL[448 + pc];
                    const float nz = -(parL[pc] + zz[i]), spv = nz > 20.f ? nz : __logf(1.f + __expf(nz));
                    lw16[e] = -__expf(-spv - 0.5f);
                    icl[e] = sigmoidf_(parL[64 + pc] + ap[i]);
                    kraw[e] = ks * parL[128 + pc]; ss += kraw[e] * kraw[e];
                    km16[e] = ks * (1.f + (icl[e] - 1.f) * parL[192 + pc]);
                    bon += rs16[e] * km16[e] * parL[256 + pc];
                }
                *(LAS u32x4*)(SL(7) + sw_el(te, c8)) = pack8f(vs);
            }
            ss += __shfl_xor(ss, 1); ss += __shfl_xor(ss, 2); bon += __shfl_xor(bon, 1); bon += __shfl_xor(bon, 2);
            const float rn = rsqrtf(fmaxf(ss, 1e-24f));
#pragma unroll
            for (int e = 0; e < 16; ++e) { const float kk = kraw[e] * rn; av16[e] = -kk; bv16[e] = kk * icl[e]; }
#pragma unroll
            for (int q4 = 0; q4 < 4; ++q4) *(LAS f32x4*)(F1 + swf_el(te, c16 + 4 * q4)) = (f32x4){lw16[4 * q4], lw16[4 * q4 + 1], lw16[4 * q4 + 2], lw16[4 * q4 + 3]};
            if ((ltid & 3) == 0) ((float*)(p.ws + WS_BONUS))[me * 8 + h] = bon;
        }
        LDS_BAR();
        {
            const int cc = ltid & 63, tq = ltid >> 6;
            float L[16]; L[0] = F1[swf_el(16 * tq, cc)];
#pragma unroll
            for (int i = 1; i < 16; ++i) L[i] = L[i - 1] + F1[swf_el(16 * tq + i, cc)];
            tot[tq * 64 + cc] = L[15];
            LDS_BAR();
            float off = 0.f;
            for (int q = 0; q < tq; ++q) off += tot[q * 64 + cc];
#pragma unroll
            for (int i = 0; i < 16; ++i) F1[swf_el(16 * tq + i, cc)] = off + L[i];
            if (tq == 3) gam[cc] = __expf(off + L[15]);
        }
        LDS_BAR();
        {
            float Lt[16];
#pragma unroll
            for (int q4 = 0; q4 < 4; ++q4) { const f32x4 a = *(const LAS f32x4*)(F1 + swf_el(te, c16 + 4 * q4)); Lt[4 * q4] = a[0]; Lt[4 * q4 + 1] = a[1]; Lt[4 * q4 + 2] = a[2]; Lt[4 * q4 + 3] = a[3]; }
#pragma unroll
            for (int sp = 0; sp < 2; ++sp) {
                float oa[8], ob[8], ok[8], orr[8];
#pragma unroll
                for (int i = 0; i < 8; ++i) { const int e = 8 * sp + i; const float ep = __expf(Lt[e]), en = __builtin_amdgcn_rcpf(ep), e3 = __expf(Lt[e] - lw16[e]);
                    oa[i] = av16[e] * e3; ob[i] = bv16[e] * en; ok[i] = km16[e] * en; orr[i] = rs16[e] * ep; }
                *(LAS u32x4*)(SL(4) + sw_el(te, c16 + 8 * sp)) = pack8f(oa);
                *(LAS u32x4*)(SL(5) + sw_el(te, c16 + 8 * sp)) = pack8f(ob);
                *(LAS u32x4*)(SL(6) + sw_el(te, c16 + 8 * sp)) = pack8f(ok);
                *(LAS u32x4*)(SL(3) + sw_el(te, c16 + 8 * sp)) = pack8f(orr);
            }
        }
        LDS_BAR();
        { const int itn = 2 * min(pr + (int)gridDim.x, 2047) + half; const int w3 = ltid & 3;
          const bf16* rowp = cas + ((size_t)(itn >> 8) * SEQ + 64 * (itn & 31) + te) * LD_CAS + (w3 == 1 ? R0 : w3 == 2 ? V0 : K0) + ((itn >> 5) & 7) * 64;
          pf0 = *(const unsigned*)rowp; pf1 = *(const unsigned*)(rowp + 56); }
        u32x2 rtw[4]; f32x16 y2p, dp;
        {
            const int row = 32 * ti + l31;
            bf16x8 aA[4], aR[4], bB[4], bK0[4], bK1[4];
#pragma unroll
            for (int s = 0; s < 4; ++s) { const int k0 = 16 * s + 8 * hh;
                aA[s] = frag_row(SL(4), row, k0); aR[s] = frag_row(SL(3), row, k0); bB[s] = frag_row(SL(5), 32 * tj + l31, k0);
                bK0[s] = frag_row(SL(6), l31, k0); bK1[s] = frag_row(SL(6), 32 + l31, k0); }
            f32x16 acc = {};
#pragma unroll
            for (int s = 0; s < 4; ++s) acc = __builtin_amdgcn_mfma_f32_32x32x16_bf16(bB[s], aA[s], acc, 0, 0, 0);
#pragma unroll
            for (int r = 0; r < 16; ++r) acc[r] = (32 * tj + crow(r, hh) < row) ? acc[r] : 0.f;
            st_tile(SL(0), acc, ti, tj, l31, hh);
            acc = (f32x16){};
#pragma unroll
            for (int s = 0; s < 4; ++s) acc = __builtin_amdgcn_mfma_f32_32x32x16_bf16(tj ? bK1[s] : bK0[s], aA[s], acc, 0, 0, 0);
#pragma unroll
            for (int r = 0; r < 16; ++r) acc[r] = (32 * tj + crow(r, hh) < row) ? acc[r] : 0.f;
            st_tile(SL(2), acc, ti, tj, l31, hh);
            acc = (f32x16){};
#pragma unroll
            for (int s = 0; s < 4; ++s) acc = __builtin_amdgcn_mfma_f32_32x32x16_bf16(bB[s], aR[s], acc, 0, 0, 0);
#pragma unroll
            for (int r = 0; r < 16; ++r) acc[r] = (32 * tj + crow(r, hh) <= row) ? acc[r] : 0.f;
            st_tile(SL(1), acc, ti, tj, l31, hh);
            f32x16 ak0 = {}, ak1 = {};
#pragma unroll
            for (int s = 0; s < 4; ++s) ak0 = __builtin_amdgcn_mfma_f32_32x32x16_bf16(bK0[s], aR[s], ak0, 0, 0, 0);
#pragma unroll
            for (int r = 0; r < 16; ++r) ak0[r] = (crow(r, hh) <= row) ? ak0[r] : 0.f;
            y2p = (f32x16){};
            mm32_acc(y2p, ak0, SL(7), 0, 32 * tj, lane);
            if (ti) {
#pragma unroll
                for (int s = 0; s < 4; ++s) ak1 = __builtin_amdgcn_mfma_f32_32x32x16_bf16(bK1[s], aR[s], ak1, 0, 0, 0);
#pragma unroll
                for (int r = 0; r < 16; ++r) ak1[r] = (32 + crow(r, hh) <= row) ? ak1[r] : 0.f;
                mm32_acc(y2p, ak1, SL(7), 32, 32 * tj, lane);
            }
            dp = (f32x16){};
            mm_acc<true, false>(dp, SL(7), SL(6), ti, tj, lane);
#pragma unroll
            for (int g = 0; g < 4; ++g) rtw[g] = *(const LAS u32x2*)(SL(3) + sw_el(row, 32 * tj + 8 * g + 4 * hh));
        }
        LDS_BAR();
        if (lw == 0) {
            f32x16 Q0, Q1, T0, T1;
            ld_tile(Q0, SL(0), 0, 0, l31, hh); ld_tile(Q1, SL(0), 1, 1, l31, hh);
#pragma unroll
            for (int r = 0; r < 16; ++r) { const float idn = (crow(r, hh) == l31) ? 1.f : 0.f; T0[r] = Q0[r] + idn; T1[r] = Q1[r] + idn; }
            { f32x16 S0 = {}, S1 = {}; mm32_acc(S0, Q0, SL(0), 0, 0, lane); mm32_acc(S1, Q1, SL(0), 32, 32, lane); Q0 = S0; Q1 = S1; }
#pragma unroll
            for (int k = 1; k <= 4; ++k) {
                st_tile(SL(3), Q0, 0, 0, l31, hh); st_tile(SL(3), Q1, 1, 1, l31, hh);
                const bf16x8 b00 = frag_col_perm(SL(3), 0, 0, lane), b01 = frag_col_perm(SL(3), 16, 0, lane);
                const bf16x8 b10 = frag_col_perm(SL(3), 32, 32, lane), b11 = frag_col_perm(SL(3), 48, 32, lane);
                const bf16x8 t00 = pack8(T0, 0), t01 = pack8(T0, 1), t10 = pack8(T1, 0), t11 = pack8(T1, 1);
                T0 = __builtin_amdgcn_mfma_f32_32x32x16_bf16(b00, t00, T0, 0, 0, 0); T1 = __builtin_amdgcn_mfma_f32_32x32x16_bf16(b10, t10, T1, 0, 0, 0);
                T0 = __builtin_amdgcn_mfma_f32_32x32x16_bf16(b01, t01, T0, 0, 0, 0); T1 = __builtin_amdgcn_mfma_f32_32x32x16_bf16(b11, t11, T1, 0, 0, 0);
                if (k < 4) {
                    const bf16x8 q00 = pack8(Q0, 0), q01 = pack8(Q0, 1), q10 = pack8(Q1, 0), q11 = pack8(Q1, 1);
                    f32x16 S0 = {}, S1 = {};
                    S0 = __builtin_amdgcn_mfma_f32_32x32x16_bf16(b00, q00, S0, 0, 0, 0); S1 = __builtin_amdgcn_mfma_f32_32x32x16_bf16(b10, q10, S1, 0, 0, 0);
                    S0 = __builtin_amdgcn_mfma_f32_32x32x16_bf16(b01, q01, S0, 0, 0, 0); S1 = __builtin_amdgcn_mfma_f32_32x32x16_bf16(b11, q11, S1, 0, 0, 0);
                    Q0 = S0; Q1 = S1;
                }
            }
            st_tile(SL(3), T0, 0, 0, l31, hh); st_tile(SL(3), T1, 1, 1, l31, hh);
            { const f32x16 z = {}; st_tile(SL(3), z, 0, 1, l31, hh); }
            f32x16 Mx = {};
#pragma unroll
            for (int s = 0; s < 2; ++s) { const int k0 = 16 * s + 8 * hh;
                Mx = __builtin_amdgcn_mfma_f32_32x32x16_bf16(frag_col(SL(3), k0, 0, lane), frag_row(SL(0), 32 + l31, k0), Mx, 0, 0, 0); }
            st_tile(SL(3), Mx, 1, 0, l31, hh);
            f32x16 T21 = {};
            mm32_acc(T21, T1, SL(3), 32, 0, lane);
            st_tile(SL(3), T21, 1, 0, l31, hh);
        } else if (lw == 3) {
            f32x16 x0 = {}, x1 = {};
#pragma unroll
            for (int s = 0; s < 2; ++s) { const int k0 = 16 * s + 8 * hh; const bf16x8 a = frag_row(SL(2), l31, k0);
                x0 = __builtin_amdgcn_mfma_f32_32x32x16_bf16(frag_col(SL(7), k0, 0, lane), a, x0, 0, 0, 0);
                x1 = __builtin_amdgcn_mfma_f32_32x32x16_bf16(frag_col(SL(7), k0, 32, lane), a, x1, 0, 0, 0); }
            st_tile(SL(6), x0, 0, 0, l31, hh); st_tile(SL(6), x1, 0, 1, l31, hh);
        } else {
            f32x16 x = {}; mm_acc<false, false>(x, SL(2), SL(7), 1, lw - 1, lane); st_tile(SL(6), x, 1, lw - 1, l31, hh);
        }
        LDS_BAR();
        { f32x16 acc = {}; mm_acc<false, false>(acc, SL(3), SL(4), ti, tj, lane); st_tile(SL(0), acc, ti, tj, l31, hh);
          f32x16 a2 = {}; mm_acc<false, false>(a2, SL(3), SL(6), ti, tj, lane); st_tile(SL(2), a2, ti, tj, l31, hh); }
        LDS_BAR();
        {
            unsigned char* ob = (unsigned char*)p.out;
            { f32x16 acc;
#pragma unroll
              for (int g = 0; g < 4; ++g) { acc[4 * g] = bflo(rtw[g].x); acc[4 * g + 1] = bfhi(rtw[g].x); acc[4 * g + 2] = bflo(rtw[g].y); acc[4 * g + 3] = bfhi(rtw[g].y); }
              mm_acc<false, false>(acc, SL(1), SL(0), ti, tj, lane);
              st_native_global((bf16*)(ob + OUT_Y1) + (size_t)item * 4096, acc, ti * 2 + tj, lane); }
            { f32x16 g2 = {};
              mm_acc<true, false>(g2, SL(5), SL(0), ti, tj, lane);
              const float gm = gam[32 * ti + l31];
#pragma unroll
              for (int r = 0; r < 16; ++r) g2[r] = (g2[r] + ((32 * tj + crow(r, hh) == 32 * ti + l31) ? 1.f : 0.f)) * gm;
              st_native_global((bf16*)(ob + OUT_G) + (size_t)item * 4096, g2, ti * 2 + tj, lane); }
            { mm_acc<false, false>(y2p, SL(1), SL(2), ti, tj, lane);
              st_native_global((bf16*)(ob + OUT_Y2) + (size_t)item * 4096, y2p, tj * 2 + ti, lane); }
            { mm_acc<true, false>(dp, SL(2), SL(5), ti, tj, lane);
#pragma unroll
              for (int r = 0; r < 16; ++r) dp[r] *= gam[32 * tj + crow(r, hh)];
              st_native_global((bf16*)(ob + OUT_D) + (size_t)item * 4096, dp, tj * 2 + ti, lane); }
        }
    }
#undef SL
#undef LDS_BAR
#undef E1_FETCH
}

DI void phase5a(const Params& p) {
    const int tid = threadIdx.x, lane = tid & 63, wave = tid >> 6, l31 = lane & 31, hh = lane >> 5;
    if (blockIdx.x >= 16) return;
    const unsigned char* ob = (const unsigned char*)p.out;
    {
        const int chain = blockIdx.x * 8 + wave;
        f32x16 H[2][2];
#pragma unroll
        for (int a = 0; a < 2; ++a)
#pragma unroll
            for (int c2 = 0; c2 < 2; ++c2) H[a][c2] = (f32x16){};
        bf16x8 gf[2][2][2];
        { const bf16* Gp = (const bf16*)(ob + OUT_G) + (size_t)chain * 32 * 4096;
#pragma unroll
          for (int ti = 0; ti < 2; ++ti)
#pragma unroll
              for (int tk = 0; tk < 2; ++tk)
#pragma unroll
                  for (int s = 0; s < 2; ++s) gf[ti][tk][s] = *(const bf16x8*)(Gp + (ti * 2 + tk) * 1024 + 512 * s + lane * 8); }
        for (int c = 0; c < 32; ++c) {
            const size_t item = (size_t)chain * 32 + c;
            const bf16* Dn = (const bf16*)(ob + OUT_D) + item * 4096;
            bf16x8 gn[2][2][2];
            { const bf16* Gp = (const bf16*)(ob + OUT_G) + (item + (c < 31 ? 1 : 0)) * 4096;
#pragma unroll
              for (int ti = 0; ti < 2; ++ti)
#pragma unroll
                  for (int tk = 0; tk < 2; ++tk)
#pragma unroll
                      for (int s = 0; s < 2; ++s) gn[ti][tk][s] = *(const bf16x8*)(Gp + (ti * 2 + tk) * 1024 + 512 * s + lane * 8); }
            f32x16 Dv[2][2];
#pragma unroll
            for (int ti = 0; ti < 2; ++ti)
#pragma unroll
                for (int tj = 0; tj < 2; ++tj) ld_native_global(Dv[ti][tj], Dn, ti * 2 + tj, lane);
            bf16x8 hp[2][2][2];
            u32x4* hs = (u32x4*)((bf16*)(p.ws + WS_HS) + item * 4096);
#pragma unroll
            for (int tk = 0; tk < 2; ++tk)
#pragma unroll
                for (int tj = 0; tj < 2; ++tj)
#pragma unroll
                    for (int s = 0; s < 2; ++s) { hp[tk][tj][s] = pack8(H[tk][tj], s); hs[((tk * 2 + tj) * 2 + s) * 64 + lane] = __builtin_bit_cast(u32x4, hp[tk][tj][s]); }
#pragma unroll
            for (int ti = 0; ti < 2; ++ti)
#pragma unroll
                for (int tj = 0; tj < 2; ++tj) {
                    f32x16 acc = Dv[ti][tj];
#pragma unroll
                    for (int tk = 0; tk < 2; ++tk)
#pragma unroll
                        for (int s = 0; s < 2; ++s) acc = __builtin_amdgcn_mfma_f32_32x32x16_bf16(gf[ti][tk][s], hp[tk][tj][s], acc, 0, 0, 0);
                    H[ti][tj] = acc;
                }
#pragma unroll
            for (int ti = 0; ti < 2; ++ti)
#pragma unroll
                for (int tk = 0; tk < 2; ++tk)
#pragma unroll
                    for (int s = 0; s < 2; ++s) gf[ti][tk][s] = gn[ti][tk][s];
        }
    }
    asm volatile("s_waitcnt vmcnt(0)" ::: "memory");
    __syncthreads();
    if (tid == 0) { __builtin_amdgcn_fence(__ATOMIC_RELEASE, "agent"); asm volatile("s_waitcnt vmcnt(0)" ::: "memory");
        __hip_atomic_fetch_add((unsigned*)(p.ws + WS_CTL) + 12288, 1u, __ATOMIC_RELAXED, __HIP_MEMORY_SCOPE_AGENT); }
}
DI void phase5b(const Params& p, LAS unsigned char* lds) {
    const int tid0 = threadIdx.x, wave = __builtin_amdgcn_readfirstlane(tid0 >> 6);
    const bf16* cas = (const bf16*)(p.ws + WS_CAS); const bf16* cr = (const bf16*)(p.ws + WS_CR);
    const unsigned char* ob = (const unsigned char*)p.out;
    LAS float* Zl = (LAS float*)(lds + wave * 17408);
    LAS unsigned* qL = (LAS unsigned*)(lds + 8 * 17408);
    __syncthreads();
    if (tid0 == 0) { unsigned* done = (unsigned*)(p.ws + WS_CTL) + 12288; unsigned sp = 0;
        while (__hip_atomic_load(done, __ATOMIC_RELAXED, __HIP_MEMORY_SCOPE_AGENT) < 16u) { __builtin_amdgcn_s_sleep(4); if (++sp > (1u << 24)) break; }
        __builtin_amdgcn_fence(__ATOMIC_ACQUIRE, "agent"); asm volatile("s_waitcnt vmcnt(0)" ::: "memory"); }
    __syncthreads();
    unsigned* q5 = (unsigned*)(p.ws + WS_CTL) + 12352;
    for (;;) {
        if (tid0 == 0) qL[0] = atomicAdd(q5, 1u);
        __syncthreads();
        const unsigned qb = qL[0];
        __syncthreads();
        if (qb >= 512u) break;
        const int item = (int)qb * 8 + wave;
        int tid = tid0; asm volatile("" : "+v"(tid));
        const int lane = tid & 63, l31 = lane & 31, hh = lane >> 5;
        const int c = item & 31, h = (item >> 5) & 7, b = item >> 8;
        const bf16* Y1p = (const bf16*)(ob + OUT_Y1) + (size_t)item * 4096; const bf16* Y2n = (const bf16*)(ob + OUT_Y2) + (size_t)item * 4096;
        const u32x4* hs = (const u32x4*)((const bf16*)(p.ws + WS_HS) + (size_t)item * 4096);
        bf16x8 hp[2][2][2];
#pragma unroll
        for (int tk = 0; tk < 2; ++tk)
#pragma unroll
            for (int tj = 0; tj < 2; ++tj)
#pragma unroll
                for (int s = 0; s < 2; ++s) hp[tk][tj][s] = __builtin_bit_cast(bf16x8, hs[((tk * 2 + tj) * 2 + s) * 64 + lane]);
#pragma unroll
        for (int tt = 0; tt < 2; ++tt) {
            f32x16 Z[2];
#pragma unroll
            for (int vj = 0; vj < 2; ++vj) {
                ld_native_global(Z[vj], Y2n, vj * 2 + tt, lane);
#pragma unroll
                for (int tk = 0; tk < 2; ++tk)
#pragma unroll
                    for (int s = 0; s < 2; ++s) {
                        const bf16x8 bb = *(const bf16x8*)(Y1p + (tt * 2 + tk) * 1024 + 512 * s + lane * 8);
                        Z[vj] = __builtin_amdgcn_mfma_f32_32x32x16_bf16(hp[tk][vj][s], bb, Z[vj], 0, 0, 0);
                    }
            }
            float sum = 0.f;
#pragma unroll
            for (int vj = 0; vj < 2; ++vj)
#pragma unroll
                for (int r = 0; r < 16; ++r) sum += Z[vj][r];
            sum += __shfl_xor(sum, 32);
            const float mean = sum * (1.f / 64.f);
            float sq = 0.f;
#pragma unroll
            for (int vj = 0; vj < 2; ++vj)
#pragma unroll
                for (int r = 0; r < 16; ++r) { const float d = Z[vj][r] - mean; sq += d * d; }
            sq += __shfl_xor(sq, 32);
            const float rstd = rsqrtf(sq * (1.f / 64.f) + 64e-5f);
#pragma unroll
            for (int vj = 0; vj < 2; ++vj)
#pragma unroll
                for (int g = 0; g < 4; ++g)
                    *(LAS f32x4*)(Zl + (32 * tt + l31) * 68 + 32 * vj + 8 * g + 4 * hh) =
                        (f32x4){(Z[vj][4 * g] - mean) * rstd, (Z[vj][4 * g + 1] - mean) * rstd, (Z[vj][4 * g + 2] - mean) * rstd, (Z[vj][4 * g + 3] - mean) * rstd};
        }
        const int v8 = (lane & 7) * 8, col = h * 64 + v8;
        float mu[8], lw[8], lb[8];
#pragma unroll
        for (int i = 0; i < 8; ++i) { mu[i] = p.shift_mu[1024 + col + i]; lw[i] = p.ln_x_w[col + i]; lb[i] = p.ln_x_b[col + i]; }
#pragma unroll 2
        for (int ps = 0; ps < 8; ++ps) {
            const int t = ps * 8 + (lane >> 3); const size_t m = (size_t)b * SEQ + 64 * c + t; const bool hprev = (64 * c + t) > 0;
            float cu[8], pv[8], sg[8];
            unpack8(*(const u32x4*)(cas + m * LD_CAS + V0 + col), cu);
            if (hprev) unpack8(*(const u32x4*)(cas + (m - 1) * LD_CAS + V0 + col), pv); else {
#pragma unroll
                for (int i = 0; i < 8; ++i) pv[i] = 0.f; }
            unpack8(*(const u32x4*)(cr + m * LD_CR + BSILU0 + col), sg);
            const float bon = ((const float*)(p.ws + WS_BONUS))[m * 8 + h];
            const f32x4 z0 = *(const LAS f32x4*)(Zl + t * 68 + v8), z1 = *(const LAS f32x4*)(Zl + t * 68 + v8 + 4);
            const float zz[8] = {z0[0], z0[1], z0[2], z0[3], z1[0], z1[1], z1[2], z1[3]};
            float o[8];
#pragma unroll
            for (int i = 0; i < 8; ++i) { const float vsh = cu[i] + (pv[i] - cu[i]) * mu[i]; o[i] = (zz[i] * lw[i] + lb[i] + bon * vsh) * siluf_(sg[i]); }
            u32x4 w; w.x = pk2(o[0], o[1]); w.y = pk2(o[2], o[3]); w.z = pk2(o[4], o[5]); w.w = pk2(o[6], o[7]);
            *(u32x4*)((bf16*)(p.ws + WS_YB) + m * 512 + col) = w;
        }
    }
}

constexpr int A_STAGE = 81920, A_TILE = 8192;
DI int swz_off(int row, int chunk) { return row * 128 + ((chunk ^ ((row >> 1) & 7)) << 4); }
DI void attn_qk(f32x16& s0, f32x16& s1, const LAS unsigned char* kl, const bf16x8 (&qr)[4], const f32x16& cinit, int l31, int hh) {
#pragma unroll
    for (int d0 = 0; d0 < 4; ++d0) {
        const bf16x8 k0f = *(const LAS bf16x8*)(kl + swz_off(l31, 2 * d0 + hh));
        const bf16x8 k1f = *(const LAS bf16x8*)(kl + swz_off(32 + l31, 2 * d0 + hh));
        s0 = __builtin_amdgcn_mfma_f32_32x32x16_bf16(k0f, qr[d0], d0 == 0 ? cinit : s0, 0, 0, 0);
        s1 = __builtin_amdgcn_mfma_f32_32x32x16_bf16(k1f, qr[d0], d0 == 0 ? cinit : s1, 0, 0, 0);
    }
}
DI void attn_sv(f32x16& s0, f32x16& s1, const LAS unsigned char* vl, int key0, int tq, bool laneok, int tmin, const LAS float* bl, bool win, bool bound,
                float& m_run, float& l_run, f32x16 (&O)[2], int l31, int hh) {
    const bool far = (tmin - (key0 + 63)) >= 128;
    const bool fast = far && !bound;
    int dbase = tq - key0; asm volatile("" : "+v"(dbase));
    float rm = -1e30f, cb = 0.f;
    if (fast) {
        cb = bl[128];
#pragma unroll
        for (int r = 0; r < 16; ++r) rm = fmaxf(rm, fmaxf(s0[r], s1[r]));
        rm = laneok ? rm + cb : -1e30f;
    } else {
        const int dmax = win ? 512 : 0x7fffffff, dmin = bound ? 0 : -0x7fffffff;
#pragma unroll
        for (int r = 0; r < 16; ++r) {
            const int d0_ = dbase - crow(r, hh), d1_ = d0_ - 32;
            const bool v0 = laneok && d0_ >= dmin && d0_ < dmax, v1 = laneok && d1_ >= dmin && d1_ < dmax;
            const float b0 = bl[min(max(d0_, 0), 128)], b1 = bl[min(max(d1_, 0), 128)];
            s0[r] = v0 ? s0[r] + b0 : -1e30f; s1[r] = v1 ? s1[r] + b1 : -1e30f;
            rm = fmaxf(rm, fmaxf(s0[r], s1[r]));
        }
    }
    rm = fmaxf(rm, __shfl_xor(rm, 32));
    if (__any(rm > m_run + 8.f)) {
        const float m_new = fmaxf(m_run, rm), alpha = __builtin_amdgcn_exp2f(m_run - m_new);
        l_run *= alpha; m_run = m_new;
#pragma unroll
        for (int dt = 0; dt < 2; ++dt)
#pragma unroll
            for (int r = 0; r < 16; ++r) O[dt][r] *= alpha;
    }
    const float sh = m_run - cb;
    float rs = 0.f;
    if (fast) {
#pragma unroll
        for (int r = 0; r < 16; ++r) { s0[r] = __builtin_amdgcn_exp2f(s0[r] - sh); s1[r] = __builtin_amdgcn_exp2f(s1[r] - sh); rs += s0[r] + s1[r]; }
        if (!__all(laneok)) { if (!laneok) {
#pragma unroll
            for (int r = 0; r < 16; ++r) { s0[r] = 0.f; s1[r] = 0.f; }
            rs = 0.f; } }
    } else {
#pragma unroll
        for (int r = 0; r < 16; ++r) {
            s0[r] = (s0[r] > -1e29f) ? __builtin_amdgcn_exp2f(s0[r] - sh) : 0.f; s1[r] = (s1[r] > -1e29f) ? __builtin_amdgcn_exp2f(s1[r] - sh) : 0.f;
            rs += s0[r] + s1[r];
        }
    }
    rs += __shfl_xor(rs, 32);
    l_run += rs;
    const bf16x8 p00 = pack8(s0, 0), p01 = pack8(s0, 1), p10 = pack8(s1, 0), p11 = pack8(s1, 1);
#pragma unroll
    for (int dt = 0; dt < 2; ++dt) {
        const int d = 32 * dt + l31;
        O[dt] = __builtin_amdgcn_mfma_f32_32x32x16_bf16(*(const LAS bf16x8*)(vl + swz_off(d, 0 + hh)), p00, O[dt], 0, 0, 0);
        O[dt] = __builtin_amdgcn_mfma_f32_32x32x16_bf16(*(const LAS bf16x8*)(vl + swz_off(d, 2 + hh)), p01, O[dt], 0, 0, 0);
        O[dt] = __builtin_amdgcn_mfma_f32_32x32x16_bf16(*(const LAS bf16x8*)(vl + swz_off(d, 4 + hh)), p10, O[dt], 0, 0, 0);
        O[dt] = __builtin_amdgcn_mfma_f32_32x32x16_bf16(*(const LAS bf16x8*)(vl + swz_off(d, 6 + hh)), p11, O[dt], 0, 0, 0);
    }
}
DI void attn_sv_fast(f32x16& s0, f32x16& s1, const LAS unsigned char* vl, int key0, int tq, bool laneok, int tmin, const LAS float* bl, bool win, bool bound, float cb,
                     float& l_run, f32x16 (&O)[2], int l31, int hh) {
    const bool far = (tmin - (key0 + 63)) >= 128;
    float rs = 0.f;
    if (far && !bound) {
#pragma unroll
        for (int r = 0; r < 16; ++r) { s0[r] = __builtin_amdgcn_exp2f(s0[r]); s1[r] = __builtin_amdgcn_exp2f(s1[r]); }
        if (!__all(laneok)) {
#pragma unroll
            for (int r = 0; r < 16; ++r) { s0[r] = laneok ? s0[r] : 0.f; s1[r] = laneok ? s1[r] : 0.f; }
        }
    } else {
        int dbase = tq - key0; asm volatile("" : "+v"(dbase));
        const int dmax = win ? 512 : 0x7fffffff, dmin = bound ? 0 : -0x7fffffff;
        float b0[16], b1[16];
#pragma unroll
        for (int r = 0; r < 16; ++r) { const int d0_ = dbase - crow(r, hh), d1_ = d0_ - 32; b0[r] = bl[min(max(d0_, 0), 128)]; b1[r] = bl[min(max(d1_, 0), 128)]; }
#pragma unroll
        for (int r = 0; r < 16; ++r) asm volatile("" : "+v"(b0[r]), "+v"(b1[r]));
#pragma unroll
        for (int r = 0; r < 16; ++r) {
            const int d0_ = dbase - crow(r, hh), d1_ = d0_ - 32;
            const bool v0 = laneok && d0_ >= dmin && d0_ < dmax, v1 = laneok && d1_ >= dmin && d1_ < dmax;
            const float e0 = __builtin_amdgcn_exp2f(s0[r] + (b0[r] - cb)), e1 = __builtin_amdgcn_exp2f(s1[r] + (b1[r] - cb));
            s0[r] = v0 ? e0 : 0.f; s1[r] = v1 ? e1 : 0.f;
        }
    }
#pragma unroll
    for (int r = 0; r < 16; ++r) rs += s0[r] + s1[r];
    l_run += rs;
    const bf16x8 p00 = pack8(s0, 0), p01 = pack8(s0, 1), p10 = pack8(s1, 0), p11 = pack8(s1, 1);
#pragma unroll
    for (int dt = 0; dt < 2; ++dt) {
        const int d = 32 * dt + l31;
        O[dt] = __builtin_amdgcn_mfma_f32_32x32x16_bf16(*(const LAS bf16x8*)(vl + swz_off(d, 0 + hh)), p00, O[dt], 0, 0, 0);
        O[dt] = __builtin_amdgcn_mfma_f32_32x32x16_bf16(*(const LAS bf16x8*)(vl + swz_off(d, 2 + hh)), p01, O[dt], 0, 0, 0);
        O[dt] = __builtin_amdgcn_mfma_f32_32x32x16_bf16(*(const LAS bf16x8*)(vl + swz_off(d, 4 + hh)), p10, O[dt], 0, 0, 0);
        O[dt] = __builtin_amdgcn_mfma_f32_32x32x16_bf16(*(const LAS bf16x8*)(vl + swz_off(d, 6 + hh)), p11, O[dt], 0, 0, 0);
    }
}
DI float imp_sum(const LAS float* sL, const LAS float* cL, int q, int j) {
    float v = 0.f;
#pragma unroll
    for (int h4 = 0; h4 < 4; ++h4) { v += sL[(h4 * 64 + q) * 33 + j]; if (j > 0) v += cL[(h4 * 64 + q) * 33 + j]; }
    return v;
}
template <bool FAST>
DI void attn_stream(LAS unsigned char* lds, const bf16* ksel, const bf16* kwin, const bf16* vts, const bf16* vtw, unsigned U, unsigned mysel, int qt, int tq, int tmin,
                    const LAS float* bl, const bf16x8 (&qr)[4], const float (&g3)[3], LAS float* stash, f32x16 (&Ot)[2], int tid, int l31, int hh) {
    const int nsel = __builtin_popcount(U), w0 = qt > 8 ? qt - 8 : 0, ntile = nsel + (qt - w0 + 1);
    const int srow = tid >> 3, sch = tid & 7;
    unsigned rem = U;
    int jseq = 0;
    int jt = 0; bool wt = false;
#define NEXT_TILE() do { if (jseq < nsel) { jt = __builtin_ctz(rem); rem &= rem - 1; wt = false; } else { jt = w0 + (jseq - nsel); wt = true; } ++jseq; } while (0)
#define LOAD_TILE(KR, VR) do { KR = *(const u32x4*)((wt ? kwin : ksel) + (size_t)(64 * jt + srow) * LD_CAS + 8 * sch); \
                               VR = *(const u32x4*)((wt ? vtw : vts) + (size_t)jt * 4096 + srow * 64 + 8 * sch); } while (0)
    u32x4 kr0, vr0, kr1, vr1;
    NEXT_TILE(); int j0 = jt; bool wn0 = wt; LOAD_TILE(kr0, vr0);
    *(LAS u32x4*)(lds + A_STAGE + swz_off(srow, sch)) = kr0; *(LAS u32x4*)(lds + A_STAGE + 2 * A_TILE + swz_off(srow, sch)) = vr0;
    int j1 = 0; bool wn1 = false;
    if (ntile > 1) { NEXT_TILE(); j1 = jt; wn1 = wt; LOAD_TILE(kr0, vr0); }
    __syncthreads();
    float m_run = -1e30f, l_run = 0.f; f32x16 O[2]; O[0] = (f32x16){}; O[1] = (f32x16){};
    const float cbf = bl[128];
    f32x16 cinit;
#pragma unroll
    for (int r = 0; r < 16; ++r) cinit[r] = FAST ? cbf : 0.f;
#define TILE_ITER(I, KRA, VRA, KRB, VRB) do { \
        const int jc = j0; const bool wc = wn0; j0 = j1; wn0 = wn1; \
        if ((I) + 2 < ntile) { NEXT_TILE(); j1 = jt; wn1 = wt; LOAD_TILE(KRB, VRB); } \
        if ((I) == nsel) { if (FAST) l_run += __shfl_xor(l_run, 32); const float f_ = l_run > 0.f ? g3[1] / l_run : 0.f; \
            _Pragma("unroll") for (int dt = 0; dt < 2; ++dt) _Pragma("unroll") for (int r = 0; r < 16; ++r) { stash[(dt * 16 + r) * 64] += f_ * O[dt][r]; O[dt][r] = 0.f; } \
            m_run = -1e30f; l_run = 0.f; } \
        const LAS unsigned char* kl = lds + A_STAGE + ((I) & 1) * A_TILE; \
        const LAS unsigned char* vl = lds + A_STAGE + 2 * A_TILE + ((I) % 3) * A_TILE; \
        const bool ok_ = wc ? true : (bool)((mysel >> jc) & 1u); \
        if (__any(ok_)) { f32x16 s0, s1; attn_qk(s0, s1, kl, qr, cinit, l31, hh); \
            const bool bnd = wc ? (jc == qt || jc + 8 == qt) : (jc == qt); \
            if (FAST) attn_sv_fast(s0, s1, vl, 64 * jc, tq, ok_, tmin, bl, wc, bnd, cbf, l_run, O, l31, hh); \
            else attn_sv(s0, s1, vl, 64 * jc, tq, ok_, tmin, bl, wc, bnd, m_run, l_run, O, l31, hh); } \
        if ((I) + 1 < ntile) { *(LAS u32x4*)(lds + A_STAGE + (((I) + 1) & 1) * A_TILE + swz_off(srow, sch)) = KRA; \
                               *(LAS u32x4*)(lds + A_STAGE + 2 * A_TILE + (((I) + 1) % 3) * A_TILE + swz_off(srow, sch)) = VRA; } \
        asm volatile("s_waitcnt lgkmcnt(0)\n\ts_barrier" ::: "memory"); } while (0)
    for (int i = 0; i < ntile; i += 2) {
        TILE_ITER(i, kr0, vr0, kr1, vr1);
        if (i + 1 < ntile) TILE_ITER(i + 1, kr1, vr1, kr0, vr0);
    }
#undef TILE_ITER
#undef LOAD_TILE
#undef NEXT_TILE
    if (FAST) l_run += __shfl_xor(l_run, 32);
    const float f = l_run > 0.f ? g3[2] / l_run : 0.f;
#pragma unroll
    for (int dt = 0; dt < 2; ++dt)
#pragma unroll
        for (int r = 0; r < 16; ++r) Ot[dt][r] = stash[(dt * 16 + r) * 64] + f * O[dt][r];
}
DI void phase4(const Params& p, LAS unsigned char* lds) {
    const int tid0 = threadIdx.x, wave = __builtin_amdgcn_readfirstlane(tid0 >> 6);
    const int hp = wave & 3, qh = wave >> 2;
    const bf16* cas = (const bf16*)(p.ws + WS_CAS);
    LAS float* biasL = (LAS float*)lds;
    LAS float* sL = (LAS float*)(lds + 4608);
    LAS float* cL = (LAS float*)(lds + 4608 + 33792);
    LAS unsigned* selL = (LAS unsigned*)(lds + 4608 + 2 * 33792);
    LAS unsigned* uL = selL + 64;
    LAS float* impT = (LAS float*)(lds + 4608 + 2 * 33792 + 512);
    LAS float* auxL = (LAS float*)(lds + 81152);
    for (int i = tid0; i < 8 * 132; i += 512) biasL[i] = ((const float*)(p.ws + WS_BIAS))[i];
    if (tid0 == 0) uL[0] = 0u;
    __syncthreads();
    if (tid0 < 8) { float bm = 0.f; for (int d = 0; d <= 128; ++d) bm = fmaxf(bm, fabsf(biasL[tid0 * 132 + d])); auxL[tid0] = bm; }
    if (tid0 == 8 || tid0 == 9) { float gm = 0.f; for (int d = 0; d < 64; ++d) gm = fmaxf(gm, fabsf(p.k_norm_gain[(tid0 - 7) * 64 + d])); auxL[tid0] = gm; }
    if (tid0 == 10) { float gm = 0.f; for (int d = 0; d < 64; ++d) gm = fmaxf(gm, fabsf(p.q_norm_gain[d])); auxL[10] = gm; }
    __syncthreads();
    bool fastmode;
    { float bm = 0.f;
#pragma unroll
      for (int hq = 0; hq < 8; ++hq) bm = fmaxf(bm, auxL[hq]);
      fastmode = (8.1f * auxL[10] * QSCALE) * (8.1f * fmaxf(auxL[8], auxL[9])) + bm <= 96.f; }
    unsigned* qctr = (unsigned*)(p.ws + WS_CTL) + 8192 + 64 * (blockIdx.x & 7);
    for (;;) {
        if (tid0 == 0) uL[1] = atomicAdd(qctr, 1u);
        __syncthreads();
        const unsigned qi = uL[1];
        __syncthreads();
        if (qi >= 128u) break;
        int tid = tid0; asm volatile("" : "+v"(tid));
        const int lane = tid & 63, l31 = lane & 31, hh = lane >> 5;
        const int qt = 31 - (int)(qi & 31), bg = (blockIdx.x & 7) + 8 * (int)(qi >> 5);
        const int b = bg >> 1, g = bg & 1, head = g * 4 + hp, t0 = 64 * qt, tmin = t0 + 32 * qh, tq = tmin + l31;
        const size_t m = (size_t)b * SEQ + tq;
        const LAS float* bl = biasL + head * 132;
        bf16x8 qr[4];
#pragma unroll
        for (int d0 = 0; d0 < 4; ++d0) qr[d0] = *(const bf16x8*)(cas + m * LD_CAS + Q0 + head * 64 + 16 * d0 + 8 * hh);
        float g3[3];
#pragma unroll
        for (int br = 0; br < 3; ++br) g3[br] = sigmoidf_(bf2f(cas[m * LD_CAS + GATE0 + br * 8 + head]));
        f32x16 Ot[2]; Ot[0] = (f32x16){}; Ot[1] = (f32x16){};
        {
            const bf16* kcb = (const bf16*)(p.ws + WS_KC) + (size_t)bg * 128 * 64;
            const bf16* vcb = (const bf16*)(p.ws + WS_VCT) + (size_t)bg * 64 * 128;
            f32x16 sc[4];
#pragma unroll
            for (int kt = 0; kt < 4; ++kt) { sc[kt] = (f32x16){};
#pragma unroll
                for (int d0 = 0; d0 < 4; ++d0) sc[kt] = __builtin_amdgcn_mfma_f32_32x32x16_bf16(*(const bf16x8*)(kcb + (size_t)(32 * kt + l31) * 64 + 16 * d0 + 8 * hh), qr[d0], sc[kt], 0, 0, 0); }
            float mc = -1e30f;
#pragma unroll
            for (int kt = 0; kt < 4; ++kt) {
                float bv[16];
#pragma unroll
                for (int r = 0; r < 16; ++r) { const int n = 32 * kt + crow(r, hh), dist = tq - 16 * n - 31; bv[r] = bl[min(max(dist, 0), 128)]; }
#pragma unroll
                for (int r = 0; r < 16; ++r) asm volatile("" : "+v"(bv[r]));
#pragma unroll
                for (int r = 0; r < 16; ++r) { const int n = 32 * kt + crow(r, hh), dist = tq - 16 * n - 31; const bool ok = dist >= 0 && n < 127;
                    sc[kt][r] = ok ? sc[kt][r] + bv[r] : -1e30f; mc = fmaxf(mc, sc[kt][r]); }
            }
            mc = fmaxf(mc, __shfl_xor(mc, 32));
            float lc = 0.f;
#pragma unroll
            for (int kt = 0; kt < 4; ++kt)
#pragma unroll
                for (int r = 0; r < 16; ++r) { sc[kt][r] = (sc[kt][r] > -1e29f) ? __builtin_amdgcn_exp2f(sc[kt][r] - mc) : 0.f; lc += sc[kt][r]; }
            lc += __shfl_xor(lc, 32);
            const float inv = lc > 0.f ? 1.f / lc : 0.f;
            const int q = 32 * qh + l31;
#pragma unroll
            for (int kt = 0; kt < 4; ++kt) {
#pragma unroll
                for (int r = 0; r < 16; ++r) sc[kt][r] *= inv;
#pragma unroll
                for (int g4 = 0; g4 < 4; ++g4) { const int j = 8 * kt + 2 * g4 + hh;
                    sL[(hp * 64 + q) * 33 + j] = 2.f * (sc[kt][4 * g4] + sc[kt][4 * g4 + 1] + sc[kt][4 * g4 + 2]) + sc[kt][4 * g4 + 3];
                    cL[(hp * 64 + q) * 33 + j + 1] = sc[kt][4 * g4 + 3]; }
            }
            f32x16 oc[2]; oc[0] = (f32x16){}; oc[1] = (f32x16){};
#pragma unroll
            for (int dt = 0; dt < 2; ++dt)
#pragma unroll
                for (int kt = 0; kt < 4; ++kt)
#pragma unroll
                    for (int s = 0; s < 2; ++s)
                        oc[dt] = __builtin_amdgcn_mfma_f32_32x32x16_bf16(*(const bf16x8*)(vcb + (size_t)(32 * dt + l31) * 128 + 32 * kt + 16 * s + 8 * hh), pack8(sc[kt], s), oc[dt], 0, 0, 0);
#pragma unroll
            for (int dt = 0; dt < 2; ++dt)
#pragma unroll
                for (int r = 0; r < 16; ++r) Ot[dt][r] = g3[0] * oc[dt][r];
        }
        __syncthreads();
        {
            const int q = tid >> 3, sub = tid & 7;
            unsigned mask = 0u;
            if (qt < 16) mask = (2u << qt) - 1u;
            else {
#pragma unroll
                for (int i2 = 0; i2 < 4; ++i2) impT[q * 33 + sub + 8 * i2] = imp_sum(sL, cL, q, sub + 8 * i2);
                __syncthreads();
                float vj[4]; int rank[4];
#pragma unroll
                for (int i2 = 0; i2 < 4; ++i2) { vj[i2] = impT[q * 33 + sub + 8 * i2]; rank[i2] = 0; }
#pragma unroll 2
                for (int jj = 1; jj <= qt - 2; ++jj) {
                    const float vv = impT[q * 33 + jj];
#pragma unroll
                    for (int i2 = 0; i2 < 4; ++i2) { const int j = sub + 8 * i2;
                        rank[i2] += (int)((jj != j) & ((vv > vj[i2]) | ((vv == vj[i2]) & (jj < j)))); }
                }
#pragma unroll
                for (int i2 = 0; i2 < 4; ++i2) { const int j = sub + 8 * i2;
                    const bool forced = (j == 0) || (j == qt) || (j == qt - 1), cand = (j >= 1) && (j <= qt - 2);
                    if (forced || (cand && rank[i2] < 13)) mask |= 1u << j; }
                mask |= __shfl_xor(mask, 1); mask |= __shfl_xor(mask, 2); mask |= __shfl_xor(mask, 4);
            }
            if (sub == 0) { selL[q] = mask; __hip_atomic_fetch_or(uL, mask, __ATOMIC_RELAXED, __HIP_MEMORY_SCOPE_WORKGROUP); }
        }
        __syncthreads();
        const unsigned mysel = selL[32 * qh + l31], U = uL[0];
        LAS float* stash = (LAS float*)(lds + 4608 + wave * 8192) + lane;
#pragma unroll
        for (int dt = 0; dt < 2; ++dt)
#pragma unroll
            for (int r = 0; r < 16; ++r) stash[(dt * 16 + r) * 64] = Ot[dt][r];
        {
            const bf16* ksel = cas + (size_t)(b * SEQ) * LD_CAS + KS0 + g * 64; const bf16* kwin = cas + (size_t)(b * SEQ) * LD_CAS + KW0 + g * 64;
            const bf16* vts = (const bf16*)(p.ws + WS_VTS) + (size_t)bg * 32 * 4096; const bf16* vtw = (const bf16*)(p.ws + WS_VTW) + (size_t)bg * 32 * 4096;
            if (fastmode) attn_stream<true>(lds, ksel, kwin, vts, vtw, U, mysel, qt, tq, tmin, bl, qr, g3, stash, Ot, tid, l31, hh);
            else attn_stream<false>(lds, ksel, kwin, vts, vtw, U, mysel, qt, tq, tmin, bl, qr, g3, stash, Ot, tid, l31, hh);
        }
        __syncthreads();
#pragma unroll
        for (int dt = 0; dt < 2; ++dt)
#pragma unroll
            for (int g4 = 0; g4 < 4; ++g4) {
                const int col = head * 64 + 32 * dt + 8 * g4 + 4 * hh;
                const u32x2 aw = *(const u32x2*)(cas + m * LD_CAS + ASILU0 + col);
                u32x2 w; w.x = pk2(Ot[dt][4 * g4] * siluf_(bflo(aw.x)), Ot[dt][4 * g4 + 1] * siluf_(bfhi(aw.x)));
                w.y = pk2(Ot[dt][4 * g4 + 2] * siluf_(bflo(aw.y)), Ot[dt][4 * g4 + 3] * siluf_(bfhi(aw.y)));
                *(u32x2*)((bf16*)(p.ws + WS_YA) + m * 512 + col) = w;
            }
        if (tid == 0) uL[0] = 0u;
    }
}
DI void phase3(const Params& p, LAS unsigned char* lds) { phase3a(p, lds); phase3b(p, lds); phase3c(p, lds); }


#define XB_TMO      128
#define XB_XCNT(j)  (256  + 64 * (j))
#define XB_XSUB(j)  (1280 + 64 * (j))
#define XB_XGEN(j)  (2304 + 64 * (j))
#define XB_TOP      3328
#define XB_TOPGEN   3392
#define XCD_BAR_WORDS 3456
#define XB_SPIN_CAP (1u << 22)
DI unsigned xb_ld(unsigned* p)              { return __hip_atomic_load(p, __ATOMIC_RELAXED, __HIP_MEMORY_SCOPE_AGENT); }
DI unsigned xb_add(unsigned* p, unsigned v) { return __hip_atomic_fetch_add(p, v, __ATOMIC_RELAXED, __HIP_MEMORY_SCOPE_AGENT); }
DI unsigned xb_xcc_id() { return (unsigned)__builtin_amdgcn_s_getreg((3 << 11) | 20) & 0xFu; }
#define XB_SPIN(cond, bar) do { unsigned _sp = 0; while (cond) { __builtin_amdgcn_s_sleep(1); \
    if ((++_sp & 255u) == 0u) { if (xb_ld(&(bar)[XB_TMO])) break; if (_sp > XB_SPIN_CAP) { atomicAdd(&(bar)[XB_TMO], 1u); break; } } } } while (0)
struct XcdBarrier { unsigned* bar; unsigned x; volatile LAS unsigned* st; };
DI XcdBarrier xcd_barrier_post(unsigned* bar, volatile LAS unsigned* st) {
    XcdBarrier b; b.bar = bar; b.x = xb_xcc_id(); b.st = st;
    if (threadIdx.x == 0) (void)xb_add(&bar[XB_XCNT(b.x)], 1u);
    return b;
}
DI void xcd_barrier_complete(unsigned* bar, unsigned x, unsigned& nloc, unsigned& nx) {
    const unsigned G = gridDim.x * gridDim.y * gridDim.z;
    unsigned sum, cnt, mine, sp = 0u;
    for (;;) {
        sum = 0u; cnt = 0u; mine = 0u;
#pragma unroll
        for (unsigned j = 0; j < 16; ++j) { const unsigned c = xb_ld(&bar[XB_XCNT(j)]); sum += c; cnt += (c > 0u) ? 1u : 0u; mine = (j == x) ? c : mine; }
        if (sum == G) break;
        __builtin_amdgcn_s_sleep(1);
        if ((++sp & 255u) == 0u) { if (xb_ld(&bar[XB_TMO])) break; if (sp > XB_SPIN_CAP) { atomicAdd(&bar[XB_TMO], 1u); break; } }
    }
    nloc = mine > 0u ? mine : 1u; nx = cnt > 0u ? cnt : 1u;
}
DI void xcd_barrier(const XcdBarrier& b) {
    asm volatile("s_waitcnt vmcnt(0)" ::: "memory");
    __syncthreads();
    if (threadIdx.x == 0) {
        unsigned* bar = b.bar;
        __builtin_amdgcn_s_waitcnt(0);
        unsigned nloc = b.st[0], nx = b.st[1];
        if (nloc == 0u) { xcd_barrier_complete(bar, b.x, nloc, nx); b.st[0] = nloc; b.st[1] = nx; }
        const unsigned old = xb_add(&bar[XB_XSUB(b.x)], 1u);
        const unsigned gen = old / nloc;
        if (old + 1u == (gen + 1u) * nloc) {
            __builtin_amdgcn_fence(__ATOMIC_RELEASE, "agent");
            asm volatile("s_waitcnt vmcnt(0)" ::: "memory");
            const unsigned og = xb_add(&bar[XB_TOP], 1u);
            const unsigned tg = og / nx;
            if (og + 1u == (tg + 1u) * nx) xb_add(&bar[XB_TOPGEN], 1u);
            else XB_SPIN(xb_ld(&bar[XB_TOPGEN]) == tg, bar);
            __builtin_amdgcn_fence(__ATOMIC_ACQUIRE, "agent");
            xb_add(&bar[XB_XGEN(b.x)], 1u);
            asm volatile("s_waitcnt vmcnt(0)" ::: "memory");
        } else {
            XB_SPIN(xb_ld(&bar[XB_XGEN(b.x)]) == gen, bar);
            __builtin_amdgcn_fence(__ATOMIC_ACQUIRE, "agent");
            asm volatile("s_waitcnt vmcnt(0)" ::: "memory");
        }
    }
    __syncthreads();
}

__global__ void __launch_bounds__(512, 2) hybrid_fwd(Params p) {
    extern __shared__ __attribute__((aligned(16))) unsigned char lds_raw[];
    LAS unsigned char* lds = (LAS unsigned char*)lds_raw;
#if USE_CG_SYNC
    cg::grid_group grid = cg::this_grid();
#define GRID_BAR() grid.sync()
#else
    volatile LAS unsigned* bst = (volatile LAS unsigned*)(lds + LDS_BYTES - 64);
    if (threadIdx.x < 2) bst[threadIdx.x] = 0u;
    __syncthreads();
    const XcdBarrier xbar = xcd_barrier_post((unsigned*)(p.ws + WS_CTL) + 1024, bst);
#define GRID_BAR() xcd_barrier(xbar)
#endif
    const int lo = p.ph_lo, hi = p.ph_hi;
#ifdef ONLYP
#define IN(k) ((k) == ONLYP && lo <= (k) && (k) < hi)
#else
#define IN(k) (lo <= (k) && (k) < hi)
#endif
#define SEAM(k) do { if (IN(k) && IN((k) + 1)) GRID_BAR(); } while (0)
    unsigned char* ws = p.ws;
    if (IN(0)) { phase0(p, lds); }
    SEAM(0);
    if (IN(1)) { phase1(p, lds); phase0w(p, lds); }
    SEAM(1);
    if (IN(2)) {
        pg8::Gemm g{(const bf16*)((unsigned char*)p.out + OUT_H), (const bf16*)(ws + WS_WIN_T), MTOK, N_IN_PAD, DM, DM, DM};
        pg8::StaticOrder S; S.init(MTOK, N_IN_PAD, gridDim.x, blockIdx.x);
        EpiInProj E{(bf16*)(ws + WS_CAS), (bf16*)(ws + WS_CR)};
        pg8::gemm_phase<EpiInProj, pg8::StaticOrder>(lds, g, S, E);
    }
    SEAM(2);
    if (IN(3)) { phase3(p, lds); }
    SEAM(3);
    if (IN(4)) { phase5a(p); phase4(p, lds); __syncthreads(); phase5b(p, lds); }
    SEAM(5);
    if (IN(6)) {
        { pg8::Gemm g{(const bf16*)(ws + WS_YA), (const bf16*)(ws + WS_WA_T), MTOK, DM, 512, 512, 512};
          pg8::StaticOrder S; S.init(MTOK, DM, gridDim.x, blockIdx.x);
          EpiGate<0> E{(bf16*)(ws + WS_MERGED), (const bf16*)(ws + WS_CR)};
          pg8::gemm_phase<EpiGate<0>, pg8::StaticOrder>(lds, g, S, E); }
        { pg8::Gemm g{(const bf16*)(ws + WS_YB), (const bf16*)(ws + WS_WB_T), MTOK, DM, 512, 512, 512};
          pg8::StaticOrder S; S.init(MTOK, DM, gridDim.x, blockIdx.x);
          EpiGate<1> E{(bf16*)(ws + WS_MERGED), (const bf16*)(ws + WS_CR)};
          pg8::gemm_phase<EpiGate<1>, pg8::StaticOrder>(lds, g, S, E); }
    }
    SEAM(6);
    if (IN(7)) {
        pg8::Gemm g{(const bf16*)(ws + WS_MERGED), (const bf16*)(ws + WS_WO_T), MTOK, DM, DM, DM, DM};
        pg8::StaticOrder S; S.init(MTOK, DM, gridDim.x, blockIdx.x);
        EpiFinal E{p.x, (const float*)(ws + WS_MOD), p.out};
        pg8::gemm_phase<EpiFinal, pg8::StaticOrder>(lds, g, S, E);
    }
#undef IN
#undef SEAM
}

extern "C" void kernel_launch(void* const* d_in, const int* in_sizes, int n_in, void* d_out, int out_size, void* d_ws, size_t ws_size, hipStream_t stream) {
    static int grid = 0;
    if (grid == 0) {
        if (n_in != 28 || out_size != MTOK * DM || ws_size < WS_END) { fprintf(stderr, "kernel_launch: unexpected shapes (n_in %d out %d ws %zu)\n", n_in, out_size, ws_size); grid = -1; return; }
        int dev = 0, cus = 0, per_cu = 0;
        (void)hipGetDevice(&dev); (void)hipDeviceGetAttribute(&cus, hipDeviceAttributeMultiprocessorCount, dev);
        if (hipFuncSetAttribute((const void*)hybrid_fwd, hipFuncAttributeMaxDynamicSharedMemorySize, LDS_BYTES) != hipSuccess) { fprintf(stderr, "kernel_launch: hipFuncSetAttribute failed\n"); grid = -1; return; }
        if (hipOccupancyMaxActiveBlocksPerMultiprocessor(&per_cu, (const void*)hybrid_fwd, 512, LDS_BYTES) != hipSuccess || per_cu < 1) { fprintf(stderr, "kernel_launch: occupancy query says %d\n", per_cu); per_cu = 1; }
        (void)hipGetLastError();
        grid = cus * 1;
        if (grid <= 0) grid = 256;
    }
    if (grid < 0) return;
    (void)hipMemsetAsync((char*)d_ws + WS_CTL, 0, CTL_ZERO_BYTES, stream);
    Params p{};
    const float** pp = (const float**)&p;
    for (int i = 0; i < 28; ++i) pp[i] = (const float*)d_in[i];
    p.out = (float*)d_out; p.ws = (unsigned char*)d_ws;
#if MK_LAUNCHES == 1
    p.ph_lo = 0; p.ph_hi = 8;
    void* args[] = {&p};
    hipError_t e = hipLaunchCooperativeKernel((const void*)hybrid_fwd, dim3(grid), dim3(512), args, LDS_BYTES, stream);
    if (e != hipSuccess) fprintf(stderr, "cooperative launch failed: %s (grid %d)\n", hipGetErrorString(e), grid);
#else
    const int cuts[][2] = {{0, 1}, {1, 2}, {2, 3}, {3, 4}, {4, 5}, {5, 6}, {6, 7}, {7, 8}};
    for (int li = 0; li < 8; ++li) {
        p.ph_lo = cuts[li][0]; p.ph_hi = cuts[li][1];
        hipLaunchKernelGGL(hybrid_fwd, dim3(grid), dim3(512), LDS_BYTES, stream, p);
    }
#endif
}
```

```cpp
#include <hip/hip_runtime.h>
#include <hip/hip_cooperative_groups.h>
#include <cstdio>
#include <cstdint>
namespace cg = cooperative_groups;

#ifndef USE_CG_SYNC
#define USE_CG_SYNC 0
#endif
#ifndef MK_LAUNCHES
#define MK_LAUNCHES 1
#endif

#define DI __device__ __forceinline__
#define LAS __attribute__((address_space(3)))
typedef unsigned short bf16;
typedef short bf16x8 __attribute__((ext_vector_type(8)));
typedef short s16x4 __attribute__((ext_vector_type(4)));
typedef float f32x2 __attribute__((ext_vector_type(2)));
typedef float f32x4 __attribute__((ext_vector_type(4)));
typedef float f32x16 __attribute__((ext_vector_type(16)));
typedef unsigned u32x2 __attribute__((ext_vector_type(2)));
typedef unsigned u32x4 __attribute__((ext_vector_type(4)));
typedef __bf16 bf16x2_t __attribute__((ext_vector_type(2)));

namespace pg8 {
typedef unsigned short bf16_t;
constexpr int BM = 256, BK = 64, HALF = 128, HTB = HALF * BK * 2, STAGE_BYTES = 8 * HTB, NXCD = 8, WGM = 8;
__host__ __device__ __forceinline__ int lds_byte(int r, int c) { const int st = (r >> 4) * 2 + (c >> 5), rr = r & 15, cc = c & 31, ob = rr * 64 + cc * 2; return st * 1024 + (ob ^ (((ob >> 9) & 1) << 5)); }
__host__ __device__ __forceinline__ void stage_rc(int b, int& R, int& C) { const int st = b / 1024, sb = b % 1024, swz = sb ^ (((sb >> 9) & 1) << 5); R = (st >> 1) * 16 + swz / 64; C = (st & 1) * 32 + (swz % 64) / 2; }
__host__ __device__ __forceinline__ int perm32(int rho) { const int n = rho >> 4, i = rho & 15; return 8 * (i >> 2) + 4 * n + (i & 3); }
struct Unit { int pm, pn; };
struct Gemm { const bf16_t* A; const bf16_t* Bt; int M, N, K, lda, ldb; };
struct StaticOrder {
    int nM, nN, nwg, G, c;
    __host__ __device__ void init(int M, int N, int G_, int c_) { nM = M / BM; nN = N / BM; nwg = nM * nN; G = G_; c = c_; }
    __host__ __device__ bool next(int i, Unit& u) const {
        const long L = (long)i * G + c; if (L >= nwg) return false;
        int wgid = (int)L; { const int q = nwg / NXCD, r = nwg % NXCD, xcd = wgid % NXCD, off = wgid / NXCD; wgid = (xcd < r ? xcd * (q + 1) : r * (q + 1) + (xcd - r) * q) + off; }
        const int nig = WGM * nN, gid = wgid / nig, fm = gid * WGM, gsz = (nM - fm) < WGM ? (nM - fm) : WGM;
        u.pm = fm + ((wgid % nig) % gsz); u.pn = (wgid % nig) / gsz; return true;
    }
};
__device__ __forceinline__ unsigned cvt_pk_bf16(float lo, float hi) { unsigned r; asm volatile("v_cvt_pk_bf16_f32 %0, %1, %2" : "=v"(r) : "v"(lo), "v"(hi)); return r; }

template <class Epi, class Sched, bool ALIGN_EPI = true, bool SP2 = true>
__device__ __forceinline__ void gemm_phase(LAS unsigned char* lds, const Gemm g, const Sched& S, const Epi& E) {
    const int tid = threadIdx.x, wid = __builtin_amdgcn_readfirstlane(tid >> 6), lane = tid & 63, wr = wid >> 2, wc = wid & 3, fr = lane & 15, fq = lane >> 4;
    const int K = g.K, nt = K / BK;
    unsigned voffA[2], voffB[2];
#pragma unroll
    for (int i = 0; i < 2; ++i) { int R, C; stage_rc(tid * 16 + i * 8192, R, C); const int Rb = Epi::PERM ? ((R & ~31) + perm32(R & 31)) : R;
        voffA[i] = (unsigned)(R * g.lda + C) * 2u; voffB[i] = (unsigned)(Rb * g.ldb + C) * 2u; }
    const size_t kstep = (size_t)(BK * 2);
    const size_t hstepA = (size_t)HALF * g.lda * 2, hstepB = (size_t)HALF * g.ldb * 2;
    const size_t tstepA = 2 * hstepA, tstepB = 2 * hstepB;
    const unsigned ldsw = (unsigned)wid * 1024u;
    const int aoff = lds_byte(wr * 64 + fr, fq * 8), boff = lds_byte(wc * 32 + fr, fq * 8);
#define PG8_SA(b, h) (((b) * 2 + (h)) * HTB)
#define PG8_SB(b, h) ((4 + (b) * 2 + (h)) * HTB)
#define PG8_STAGE(bufoff, gbase, voff) do { _Pragma("unroll") for (int _i = 0; _i < 2; ++_i) \
        __builtin_amdgcn_global_load_lds((const unsigned*)((const char*)(gbase) + (voff)[_i]), (LAS unsigned*)(lds + (bufoff) + ldsw + _i * 8192), 16, 0, 0); } while (0)
#define PG8_LDA(dst, b, h) do { _Pragma("unroll") for (int m = 0; m < 4; ++m) _Pragma("unroll") for (int k = 0; k < 2; ++k) dst[m][k] = *(const LAS bf16x8*)(lds + PG8_SA(b, h) + aoff + m * 2048 + k * 1024); } while (0)
#define PG8_LDB(dst, b, h) do { _Pragma("unroll") for (int n = 0; n < 2; ++n) _Pragma("unroll") for (int k = 0; k < 2; ++k) dst[n][k] = *(const LAS bf16x8*)(lds + PG8_SB(b, h) + boff + n * 2048 + k * 1024); } while (0)
#define PG8_MMA(ai, bj, At, Bt) do { __builtin_amdgcn_s_setprio(1); _Pragma("unroll") for (int m = 0; m < 4; ++m) _Pragma("unroll") for (int n = 0; n < 2; ++n) _Pragma("unroll") for (int k = 0; k < 2; ++k) \
        acc[ai][bj][m][n] = __builtin_amdgcn_mfma_f32_16x16x32_bf16(Bt[n][k], At[m][k], acc[ai][bj][m][n], 0, 0, 0); __builtin_amdgcn_s_setprio(0); } while (0)
#define PG8_WAIT_V(n) asm volatile("s_waitcnt vmcnt(" #n ")" ::: "memory")
#define PG8_WAIT_L(n) asm volatile("s_waitcnt lgkmcnt(" #n ")" ::: "memory")
#define PG8_BAR __builtin_amdgcn_s_barrier()
#define PG8_SCHED __builtin_amdgcn_sched_barrier(0)
    Unit cur, nxt; int ui = 0;
    if (!S.next(0, cur)) return;
    f32x4 acc[2][2][4][2];
#pragma unroll
    for (int a = 0; a < 2; ++a)
#pragma unroll
        for (int b = 0; b < 2; ++b)
#pragma unroll
            for (int m = 0; m < 4; ++m)
#pragma unroll
                for (int n = 0; n < 2; ++n) acc[a][b][m][n] = (f32x4){0.f, 0.f, 0.f, 0.f};
    bf16x8 At[4][2], B0[2][2], B1[2][2];
    const char* cA = (const char*)g.A + (size_t)cur.pm * tstepA; const char* cB = (const char*)g.Bt + (size_t)cur.pn * tstepB;
    if constexpr (SP2) {
        PG8_STAGE(PG8_SB(0, 0), cB, voffB); PG8_STAGE(PG8_SB(0, 1), cB + hstepB, voffB); PG8_STAGE(PG8_SA(0, 0), cA, voffA); PG8_STAGE(PG8_SA(0, 1), cA + hstepA, voffA);
        if (wr == 1) PG8_BAR;
        PG8_WAIT_V(2); PG8_BAR;
        PG8_STAGE(PG8_SB(1, 0), cB + kstep, voffB); PG8_STAGE(PG8_SA(1, 0), cA + kstep, voffA); PG8_STAGE(PG8_SB(1, 1), cB + hstepB + kstep, voffB);
        PG8_WAIT_V(6); PG8_BAR;
    } else {
        PG8_STAGE(PG8_SB(0, 0), cB, voffB); PG8_STAGE(PG8_SA(0, 0), cA, voffA); PG8_STAGE(PG8_SB(0, 1), cB + hstepB, voffB); PG8_STAGE(PG8_SA(0, 1), cA + hstepA, voffA);
        if (wr == 1) PG8_BAR;
        PG8_WAIT_V(4); PG8_BAR;
        PG8_STAGE(PG8_SB(1, 0), cB + kstep, voffB); PG8_STAGE(PG8_SA(1, 0), cA + kstep, voffA); PG8_STAGE(PG8_SB(1, 1), cB + hstepB + kstep, voffB);
        PG8_WAIT_V(6); PG8_BAR;
    }
    for (;;) {
        const bool has_next = S.next(ui + 1, nxt);
        const char* nA = has_next ? (const char*)g.A + (size_t)nxt.pm * tstepA : cA; const char* nB = has_next ? (const char*)g.Bt + (size_t)nxt.pn * tstepB : cB;
        for (int t = 0; t < nt; t += 2) {
            const bool last = (t == nt - 2);
            const char* a1 = cA + (size_t)(t + 1) * kstep;
            const char* a2 = last ? nA : cA + (size_t)(t + 2) * kstep; const char* b2 = last ? nB : cB + (size_t)(t + 2) * kstep;
            const char* a3 = a2 + kstep; const char* b3 = b2 + kstep;
            if constexpr (SP2) {
            PG8_LDB(B0, 0, 0); PG8_LDB(B1, 0, 1); PG8_SCHED; PG8_LDA(At, 0, 0); PG8_STAGE(PG8_SA(1, 1), a1 + hstepA, voffA);
            PG8_WAIT_V(8); PG8_WAIT_L(0); PG8_BAR; PG8_MMA(0, 0, At, B0); PG8_MMA(0, 1, At, B1); PG8_BAR; PG8_SCHED;
            PG8_LDA(At, 0, 1); PG8_STAGE(PG8_SB(0, 0), b2, voffB); PG8_STAGE(PG8_SB(0, 1), b2 + hstepB, voffB); PG8_STAGE(PG8_SA(0, 0), a2, voffA);
            PG8_WAIT_V(8); PG8_WAIT_L(0); PG8_BAR; PG8_MMA(1, 0, At, B0); PG8_MMA(1, 1, At, B1); PG8_BAR; PG8_SCHED;
            PG8_LDB(B0, 1, 0); PG8_LDB(B1, 1, 1); PG8_SCHED; PG8_LDA(At, 1, 0); PG8_STAGE(PG8_SA(0, 1), a2 + hstepA, voffA);
            PG8_WAIT_V(8); PG8_WAIT_L(0); PG8_BAR; PG8_MMA(0, 0, At, B0); PG8_MMA(0, 1, At, B1); PG8_BAR; PG8_SCHED;
            PG8_LDA(At, 1, 1); PG8_STAGE(PG8_SB(1, 0), b3, voffB); PG8_STAGE(PG8_SB(1, 1), b3 + hstepB, voffB); PG8_STAGE(PG8_SA(1, 0), a3, voffA);
            PG8_WAIT_V(8); PG8_WAIT_L(0); PG8_BAR; PG8_MMA(1, 0, At, B0); PG8_MMA(1, 1, At, B1); PG8_BAR; PG8_SCHED;
            } else {
            PG8_LDB(B0, 0, 0); PG8_SCHED; PG8_LDA(At, 0, 0); PG8_STAGE(PG8_SA(1, 1), a1 + hstepA, voffA);
            PG8_WAIT_L(8); PG8_BAR; PG8_WAIT_L(0); PG8_MMA(0, 0, At, B0); PG8_BAR; PG8_SCHED;
            PG8_LDB(B1, 0, 1); PG8_STAGE(PG8_SB(0, 0), b2, voffB);
            PG8_BAR; PG8_WAIT_L(0); PG8_MMA(0, 1, At, B1); PG8_BAR;
            PG8_LDA(At, 0, 1); PG8_STAGE(PG8_SA(0, 0), a2, voffA);
            PG8_BAR; PG8_WAIT_L(0); PG8_MMA(1, 0, At, B0); PG8_BAR; PG8_SCHED;
            PG8_STAGE(PG8_SB(0, 1), b2 + hstepB, voffB);
            PG8_WAIT_V(6); PG8_BAR; PG8_MMA(1, 1, At, B1); PG8_BAR;
            PG8_LDB(B0, 1, 0); PG8_SCHED; PG8_LDA(At, 1, 0); PG8_STAGE(PG8_SA(0, 1), a2 + hstepA, voffA);
            PG8_WAIT_L(8); PG8_BAR; PG8_WAIT_L(0); PG8_MMA(0, 0, At, B0); PG8_BAR; PG8_SCHED;
            PG8_LDB(B1, 1, 1); PG8_STAGE(PG8_SB(1, 0), b3, voffB);
            PG8_BAR; PG8_WAIT_L(0); PG8_MMA(0, 1, At, B1); PG8_BAR;
            PG8_LDA(At, 1, 1); PG8_STAGE(PG8_SA(1, 0), a3, voffA);
            PG8_BAR; PG8_WAIT_L(0); PG8_MMA(1, 0, At, B0); PG8_BAR; PG8_SCHED;
            PG8_STAGE(PG8_SB(1, 1), b3 + hstepB, voffB);
            PG8_WAIT_V(6); PG8_BAR; PG8_MMA(1, 1, At, B1); PG8_BAR;
            }
        }
        if constexpr (ALIGN_EPI) { if (wr == 0) PG8_BAR; }
        E(acc, cur, wr, wc, fr, fq);
        if (!has_next) break;
#pragma unroll
        for (int a = 0; a < 2; ++a)
#pragma unroll
            for (int b = 0; b < 2; ++b)
#pragma unroll
                for (int m = 0; m < 4; ++m)
#pragma unroll
                    for (int n = 0; n < 2; ++n) acc[a][b][m][n] = (f32x4){0.f, 0.f, 0.f, 0.f};
        cur = nxt; cA = nA; cB = nB; ++ui;
        if constexpr (ALIGN_EPI) { if (wr == 1) PG8_BAR; }
    }
    PG8_WAIT_V(0);
    if constexpr (!ALIGN_EPI) { if (wr == 0) PG8_BAR; }
    PG8_BAR;
#undef PG8_SA
#undef PG8_SB
#undef PG8_STAGE
#undef PG8_LDA
#undef PG8_LDB
#undef PG8_MMA
#undef PG8_WAIT_V
#undef PG8_WAIT_L
#undef PG8_BAR
#undef PG8_SCHED
}
}

constexpr int NB = 16, SEQ = 2048, DM = 1024, MTOK = NB * SEQ;
constexpr int LD_CAS = 3584, LD_CR = 2560, N_IN_PAD = 6144, N_IN = 6040;
constexpr int Q0 = 0, KC0 = 512, VC0 = 640, KS0 = 768, VS0 = 896, KW0 = 1024, VW0 = 1152, GATE0 = 1280, ASILU0 = 1304;
constexpr int SH0 = 1816, R0 = SH0, K0 = SH0 + 512, V0 = SH0 + 1024, WD0 = SH0 + 1536, AD0 = SH0 + 1600, CAS_USED = 3480;
constexpr int BSILU0 = 0, MA0 = 512, MB0 = 1536;
constexpr float LOG2E = 1.4426950408889634f;
constexpr float QSCALE = 0.125f * LOG2E;

constexpr size_t MiB = 1u << 20;
constexpr size_t WS_CTL = 0, CTL_ZERO_BYTES = 64 * 1024;
constexpr size_t WS_MOD = 256 * 1024;
constexpr size_t WS_POSB = 512 * 1024;
constexpr size_t WS_BIAS = 520 * 1024;
constexpr size_t WS_WA_T = 2 * MiB, WS_WB_T = 3 * MiB;
constexpr size_t WS_WO_T = 4 * MiB;
constexpr size_t WS_W1K_T = 6 * MiB, WS_W1V_T = 7 * MiB;
constexpr size_t WS_W2K_T = 8 * MiB, WS_W2V_T = 8 * MiB + 64 * 1024;
constexpr size_t WS_WLW_T = 8 * MiB + 128 * 1024, WS_WLA_T = 8 * MiB + 192 * 1024;
constexpr size_t WS_KC = 9 * MiB;
constexpr size_t WS_VCT = 9 * MiB + 512 * 1024;
constexpr size_t WS_BONUS = 10 * MiB;
constexpr size_t WS_DUMMY = 11 * MiB;
constexpr size_t WS_VTS = 12 * MiB, WS_VTW = 20 * MiB;
constexpr size_t WS_CAS = 28 * MiB;
constexpr size_t WS_CR = 252 * MiB;
constexpr size_t WS_YA = 412 * MiB, WS_YB = 444 * MiB;
constexpr size_t WS_WIN_T = 476 * MiB;
constexpr size_t WS_HS = 476 * MiB;
constexpr size_t WS_MERGED = WS_CAS;
constexpr size_t WS_END = 508 * MiB;
constexpr size_t OUT_H = 0;
constexpr size_t OUT_G = 0, OUT_Y1 = 32 * MiB, OUT_D = 64 * MiB, OUT_Y2 = 96 * MiB;

constexpr int LDS_BYTES = 147456;

struct Params {
    const float *x, *c, *w_ada, *b_ada, *norm_gain, *w_in, *q_norm_gain, *k_norm_gain, *cmp_pos_k, *cmp_pos_v,
        *cmp_k_w1, *cmp_k_w2, *cmp_v_w1, *cmp_v_w2, *rel_bias, *shift_mu, *w0, *w_lora_up, *a0, *a_lora_up,
        *k_k, *k_a, *r_k, *ln_x_w, *ln_x_b, *w_out_a, *w_out_b, *w_o;
    float* out; unsigned char* ws;
    int ph_lo, ph_hi;
};

DI unsigned f2bf(float f) { unsigned u = __builtin_bit_cast(unsigned, f); return (u + 0x7fffu + ((u >> 16) & 1u)) >> 16; }
DI float bf2f(unsigned h) { return __builtin_bit_cast(float, h << 16); }
DI unsigned pk2(float lo, float hi) { f32x2 v = {lo, hi}; bf16x2_t b = __builtin_convertvector(v, bf16x2_t); return __builtin_bit_cast(unsigned, b); }
DI float bflo(unsigned w) { return __builtin_bit_cast(float, w << 16); }
DI float bfhi(unsigned w) { return __builtin_bit_cast(float, w & 0xffff0000u); }
DI float sigmoidf_(float x) { return __builtin_amdgcn_rcpf(1.f + __expf(-x)); }
DI float siluf_(float x) { return x * __builtin_amdgcn_rcpf(1.f + __expf(-x)); }
DI int crow(int r, int hh) { return (r & 3) + 8 * (r >> 2) + 4 * hh; }
DI int pos16_of_key(int k16) { return 8 * ((k16 >> 2) & 1) + 4 * (k16 >> 3) + (k16 & 3); }
DI int key16_of_pos(int p16) { const int hh = p16 >> 3, j = p16 & 7; return 8 * (j >> 2) + 4 * hh + (j & 3); }
DI float wave_sum(float v) {
#pragma unroll
    for (int o = 1; o < 64; o <<= 1) v += __shfl_xor(v, o);
    return v;
}
DI void unpack8(u32x4 w, float* f) { f[0] = bflo(w.x); f[1] = bfhi(w.x); f[2] = bflo(w.y); f[3] = bfhi(w.y); f[4] = bflo(w.z); f[5] = bfhi(w.z); f[6] = bflo(w.w); f[7] = bfhi(w.w); }
typedef short v4i16_t __attribute__((ext_vector_type(4)));
DI s16x4 tr_read(const LAS bf16* p) { return __builtin_bit_cast(s16x4, __builtin_amdgcn_ds_read_tr16_b64_v4i16((LAS v4i16_t*)p)); }

__device__ const unsigned char T5_BUCKET[129] = {
    0, 1, 2, 3, 4, 5, 6, 7, 8, 9, 10, 11, 12, 13, 14, 15, 16, 16, 16, 17, 17, 18, 18, 18, 19, 19, 19, 20, 20, 20, 20, 21, 21, 21, 21, 22, 22, 22, 22, 22, 23, 23, 23, 23, 23, 23, 24, 24, 24, 24, 24, 24, 25, 25, 25, 25, 25, 25, 25, 26, 26, 26, 26, 26, 26, 26, 26, 27, 27, 27, 27, 27, 27, 27, 27, 27, 27, 28, 28, 28, 28, 28, 28, 28, 28, 28, 28, 29, 29, 29, 29, 29, 29, 29, 29, 29, 29, 29, 29, 30, 30, 30, 30, 30, 30, 30, 30, 30, 30, 30, 30, 30, 30, 31, 31, 31, 31, 31, 31, 31, 31, 31, 31, 31, 31, 31, 31, 31, 31};

template <class F> DI void transpose_item(const float* W, int K, int N, bf16* WT, F rowmap, LAS float* scr, int item, int lane) {
    const int nblk = (N + 63) / 64, kb = item / nblk, nb = item % nblk, k0 = 64 * kb, n0 = 64 * nb;
    const int n4 = (lane & 15) * 4;
    const bool inb = n0 + n4 < N; const int ncl = inb ? n0 + n4 : N - 4;
    f32x4 vv[16];
#pragma unroll
    for (int i = 0; i < 16; ++i) vv[i] = *(const f32x4*)(W + (size_t)(k0 + 4 * i + (lane >> 4)) * N + ncl);
#pragma unroll
    for (int i = 0; i < 16; ++i) asm volatile("" : "+v"(vv[i]));
#pragma unroll
    for (int i = 0; i < 16; ++i) { const int kk = 4 * i + (lane >> 4);
        const f32x4 v = inb ? vv[i] : (f32x4){0.f, 0.f, 0.f, 0.f};
        LAS float* d = scr + kk * 65 + n4; d[0] = v[0]; d[1] = v[1]; d[2] = v[2]; d[3] = v[3]; }
    asm volatile("s_waitcnt lgkmcnt(0)" ::: "memory");
    const int c = lane & 7;
#pragma unroll
    for (int j = 0; j < 8; ++j) { const int nl = (lane >> 3) + 8 * j, n = n0 + nl; const LAS float* s = scr + (8 * c) * 65 + nl;
        u32x4 o; o.x = pk2(s[0 * 65], s[1 * 65]); o.y = pk2(s[2 * 65], s[3 * 65]); o.z = pk2(s[4 * 65], s[5 * 65]); o.w = pk2(s[6 * 65], s[7 * 65]);
        if (n < N) *(u32x4*)(WT + (size_t)rowmap(n) * K + k0 + 8 * c) = o; }
    asm volatile("s_waitcnt lgkmcnt(0)" ::: "memory");
}

DI void phase0w(const Params& p, LAS unsigned char* lds) {
    const int tid = threadIdx.x, lane = tid & 63, wave = __builtin_amdgcn_readfirstlane(tid >> 6);
    const int gw = blockIdx.x * 8 + wave, NGW = gridDim.x * 8;
    unsigned char* ws = p.ws;
    {
        LAS float* scr = (LAS float*)(lds + wave * 16640);
        constexpr int I_IN = 16 * 95, I_OA = 8 * 16, I_OB = 8 * 16, I_O = 16 * 16, I_W1 = 32 * 4, I_W2 = 4 * 1, I_L = 1 * 8;
        constexpr int NIT = I_IN + I_OA + I_OB + I_O + 2 * I_W1 + 2 * I_W2 + 2 * I_L;
        auto ident = [](int n) { return n; };
        auto inmap = [](int n) { return n < CAS_USED ? n : n + (LD_CAS - CAS_USED); };
        for (int it = gw; it < NIT; it += NGW) {
            int r = it;
            if (r < I_IN) { transpose_item(p.w_in, DM, N_IN, (bf16*)(ws + WS_WIN_T), inmap, scr, r, lane); continue; } r -= I_IN;
            if (r < I_OA) { transpose_item(p.w_out_a, 512, DM, (bf16*)(ws + WS_WA_T), ident, scr, r, lane); continue; } r -= I_OA;
            if (r < I_OB) { transpose_item(p.w_out_b, 512, DM, (bf16*)(ws + WS_WB_T), ident, scr, r, lane); continue; } r -= I_OB;
            if (r < I_O) { transpose_item(p.w_o, DM, DM, (bf16*)(ws + WS_WO_T), ident, scr, r, lane); continue; } r -= I_O;
            if (r < I_W1) { transpose_item(p.cmp_k_w1, 2048, 256, (bf16*)(ws + WS_W1K_T), ident, scr, r, lane); continue; } r -= I_W1;
            if (r < I_W1) { transpose_item(p.cmp_v_w1, 2048, 256, (bf16*)(ws + WS_W1V_T), ident, scr, r, lane); continue; } r -= I_W1;
            if (r < I_W2) { transpose_item(p.cmp_k_w2, 256, 64, (bf16*)(ws + WS_W2K_T), ident, scr, r, lane); continue; } r -= I_W2;
            if (r < I_W2) { transpose_item(p.cmp_v_w2, 256, 64, (bf16*)(ws + WS_W2V_T), ident, scr, r, lane); continue; } r -= I_W2;
            if (r < I_L) { transpose_item(p.w_lora_up, 64, 512, (bf16*)(ws + WS_WLW_T), ident, scr, r, lane); continue; } r -= I_L;
            transpose_item(p.a_lora_up, 64, 512, (bf16*)(ws + WS_WLA_T), ident, scr, r, lane);
        }
    }
    {
        u32x4* z = (u32x4*)(ws + WS_WIN_T + (size_t)CAS_USED * DM * 2);
        const int n16 = (LD_CAS - CAS_USED) * DM * 2 / 16;
        for (int i = blockIdx.x * 512 + tid; i < n16; i += gridDim.x * 512) z[i] = (u32x4){0u, 0u, 0u, 0u};
    }
    __syncthreads();
}
constexpr size_t WS_MODP = 1 * MiB;
DI void phase0(const Params& p, LAS unsigned char* lds) {
    const int tid = threadIdx.x, lane = tid & 63, wave = __builtin_amdgcn_readfirstlane(tid >> 6);
    unsigned char* ws = p.ws;
    LAS float* red = (LAS float*)lds;
    LAS float* sc = (LAS float*)(lds + 32768);
    for (int task = blockIdx.x; task < 201; task += gridDim.x) {
        if (task < 192) {
            const int cg = task % 48, kq = task / 48;
            for (int i = tid; i < 16 * 256; i += 512) sc[i] = siluf_(p.c[(i >> 8) * 1024 + kq * 256 + (i & 255)]);
            __syncthreads();
            const int col = cg * 64 + lane;
            float acc[16];
#pragma unroll
            for (int b = 0; b < 16; ++b) acc[b] = 0.f;
#pragma unroll 4
            for (int kk = 0; kk < 32; ++kk) { const int kl = wave * 32 + kk; const float wv = p.w_ada[(size_t)(kq * 256 + kl) * 3072 + col];
#pragma unroll
                for (int b = 0; b < 16; ++b) acc[b] += sc[b * 256 + kl] * wv; }
#pragma unroll
            for (int b = 0; b < 16; ++b) red[(wave * 16 + b) * 64 + lane] = acc[b];
            __syncthreads();
            for (int o = tid; o < 1024; o += 512) { const int b = o >> 6, l = o & 63; float s = 0.f;
#pragma unroll
                for (int w = 0; w < 8; ++w) s += red[(w * 16 + b) * 64 + l];
                ((float*)(ws + WS_MODP))[(kq * 16 + b) * 3072 + cg * 64 + l] = s; }
            __syncthreads();
        } else if (task < 200) {
            const int t2 = task - 192, which = t2 >> 2, col = (t2 & 3) * 64 + lane;
            const float* pos = which ? p.cmp_pos_v : p.cmp_pos_k; const float* w1 = which ? p.cmp_v_w1 : p.cmp_k_w1;
            float a = 0.f;
#pragma unroll 4
            for (int kk = 0; kk < 256; ++kk) { const int k = wave * 256 + kk; a += pos[k] * w1[(size_t)k * 256 + col]; }
            red[wave * 64 + lane] = a;
            __syncthreads();
            if (tid < 64) { float s = 0.f;
#pragma unroll
                for (int w = 0; w < 8; ++w) s += red[w * 64 + tid];
                ((float*)(ws + WS_POSB))[which * 256 + (t2 & 3) * 64 + tid] = s; }
            __syncthreads();
        } else {
            for (int i = tid; i < 8 * 129; i += 512) { const int h = i / 129, d = i % 129; ((float*)(ws + WS_BIAS))[h * 132 + d] = p.rel_bias[T5_BUCKET[d] * 8 + h] * LOG2E; }
        }
    }
}

DI void phase1(const Params& p, LAS unsigned char* lds) {
    const int tid = threadIdx.x, lane = tid & 63, wave = tid >> 6;
    bf16* hb = (bf16*)((unsigned char*)p.out + OUT_H);
    LAS float* modL = (LAS float*)lds;
    for (int rb = blockIdx.x; rb < MTOK / 128; rb += gridDim.x) {
        const int b = rb >> 4;
        __syncthreads();
        for (int col = tid; col < 3072; col += 512) { float s = p.b_ada[col];
#pragma unroll
            for (int kq = 0; kq < 4; ++kq) s += ((const float*)(p.ws + WS_MODP))[(kq * 16 + b) * 3072 + col];
            modL[col] = s; if ((rb & 15) == 0) ((float*)(p.ws + WS_MOD))[b * 3072 + col] = s; }
        __syncthreads();
        f32x4 gq[4];
#pragma unroll
        for (int j = 0; j < 4; ++j) gq[j] = *(const f32x4*)(p.norm_gain + 4 * lane + 256 * j);
        for (int r = wave; r < 128; r += 8) {
            const int m = rb * 128 + r;
            const f32x4* xr = (const f32x4*)(p.x + (size_t)m * DM) + lane;
            f32x4 v[4]; float s = 0.f;
#pragma unroll
            for (int j = 0; j < 4; ++j) { v[j] = xr[64 * j]; s += (v[j].x * v[j].x + v[j].y * v[j].y) + (v[j].z * v[j].z + v[j].w * v[j].w); }
            const float rinv = rsqrtf(wave_sum(s) * (1.f / DM) + 1e-6f);
            u32x2* o8 = (u32x2*)(hb + (size_t)m * DM) + lane;
#pragma unroll
            for (int j = 0; j < 4; ++j) {
                const int k = 4 * lane + 256 * j;
                const f32x4 g = gq[j], sh = *(const LAS f32x4*)(modL + k), scl = *(const LAS f32x4*)(modL + 1024 + k);
                f32x4 h = v[j] * rinv * g * (scl + 1.f) + sh;
                u32x2 o; o.x = pk2(h.x, h.y); o.y = pk2(h.z, h.w); o8[64 * j] = o;
            }
        }
    }
    __syncthreads();
}

struct EpiInProj {
    static constexpr bool PERM = true;
    bf16* cas; bf16* cr;
    DI void operator()(const f32x4 (&acc)[2][2][4][2], const pg8::Unit& u, int wr, int wc, int fr, int fq) const {
        const int row0 = u.pm * 256 + wr * 64 + fr;
        bf16* base; int ldc, colt;
        if (u.pn < 14) { base = cas; ldc = LD_CAS; colt = u.pn * 256; } else { base = cr; ldc = LD_CR; colt = (u.pn - 14) * 256; }
        const int col0 = colt + wc * 32 + 8 * fq;
#pragma unroll
        for (int ai = 0; ai < 2; ++ai)
#pragma unroll
            for (int m = 0; m < 4; ++m) { bf16* rowp = base + (size_t)(row0 + ai * 128 + m * 16) * ldc + col0;
#pragma unroll
                for (int bj = 0; bj < 2; ++bj) { const f32x4 v0 = acc[ai][bj][m][0], v1 = acc[ai][bj][m][1];
                    u32x4 w; w.x = pk2(v0[0], v0[1]); w.y = pk2(v0[2], v0[3]); w.z = pk2(v1[0], v1[1]); w.w = pk2(v1[2], v1[3]);
                    *(u32x4*)(rowp + bj * 128) = w; } }
    }
};
template <int WHICH> struct EpiGate {
    static constexpr bool PERM = true;
    bf16* merged; const bf16* cr;
    DI void operator()(const f32x4 (&acc)[2][2][4][2], const pg8::Unit& u, int wr, int wc, int fr, int fq) const {
        const int row0 = u.pm * 256 + wr * 64 + fr, col0 = u.pn * 256 + wc * 32 + 8 * fq;
#pragma unroll
        for (int ai = 0; ai < 2; ++ai)
#pragma unroll
            for (int mp2 = 0; mp2 < 2; ++mp2) {
                u32x4 gw[2][2], ow[2][2];
#pragma unroll
                for (int m2 = 0; m2 < 2; ++m2)
#pragma unroll
                    for (int bj = 0; bj < 2; ++bj) { const size_t row = (size_t)(row0 + ai * 128 + (2 * mp2 + m2) * 16); const int col = col0 + bj * 128;
                        gw[m2][bj] = *(const u32x4*)(cr + row * LD_CR + (WHICH ? MB0 : MA0) + col);
                        if (WHICH) ow[m2][bj] = *(const u32x4*)(merged + row * DM + col); }
#pragma unroll
                for (int m2 = 0; m2 < 2; ++m2)
#pragma unroll
                    for (int bj = 0; bj < 2; ++bj) { asm volatile("" : "+v"(gw[m2][bj])); if (WHICH) asm volatile("" : "+v"(ow[m2][bj])); }
#pragma unroll
                for (int m2 = 0; m2 < 2; ++m2)
#pragma unroll
                    for (int bj = 0; bj < 2; ++bj) { const int m = 2 * mp2 + m2; const size_t row = (size_t)(row0 + ai * 128 + m * 16); const int col = col0 + bj * 128;
                        float gl[8]; unpack8(gw[m2][bj], gl);
                        const f32x4 v0 = acc[ai][bj][m][0], v1 = acc[ai][bj][m][1];
                        float r[8] = {v0[0], v0[1], v0[2], v0[3], v1[0], v1[1], v1[2], v1[3]};
                        if (WHICH) { float old[8]; unpack8(ow[m2][bj], old);
#pragma unroll
                            for (int i = 0; i < 8; ++i) r[i] = old[i] + sigmoidf_(gl[i]) * r[i]; }
                        else {
#pragma unroll
                            for (int i = 0; i < 8; ++i) r[i] = sigmoidf_(gl[i]) * r[i]; }
                        u32x4 w; w.x = pk2(r[0], r[1]); w.y = pk2(r[2], r[3]); w.z = pk2(r[4], r[5]); w.w = pk2(r[6], r[7]);
                        *(u32x4*)(merged + row * DM + col) = w; }
            }
    }
};
struct EpiFinal {
    static constexpr bool PERM = false;
    const float* x; const float* mod; float* out;
    DI void operator()(const f32x4 (&acc)[2][2][4][2], const pg8::Unit& u, int wr, int wc, int fr, int fq) const {
        const int row0 = u.pm * 256 + wr * 64 + fr, col0 = u.pn * 256 + wc * 32 + 4 * fq;
        const int b = (u.pm * 256) >> 11;
        f32x4 gv[2][2];
#pragma unroll
        for (int bj = 0; bj < 2; ++bj)
#pragma unroll
            for (int n = 0; n < 2; ++n) gv[bj][n] = *(const f32x4*)(mod + b * 3072 + 2048 + col0 + bj * 128 + n * 16);
#pragma unroll
        for (int ai = 0; ai < 2; ++ai)
#pragma unroll
            for (int mp = 0; mp < 2; ++mp) {
                f32x4 xv[2][2][2];
#pragma unroll
                for (int m2 = 0; m2 < 2; ++m2)
#pragma unroll
                    for (int bj = 0; bj < 2; ++bj)
#pragma unroll
                        for (int n = 0; n < 2; ++n) xv[m2][bj][n] = *(const f32x4*)(x + (size_t)(row0 + ai * 128 + (2 * mp + m2) * 16) * DM + col0 + bj * 128 + n * 16);
#pragma unroll
                for (int m2 = 0; m2 < 2; ++m2)
#pragma unroll
                    for (int bj = 0; bj < 2; ++bj)
#pragma unroll
                        for (int n = 0; n < 2; ++n) asm volatile("" : "+v"(xv[m2][bj][n]));
#pragma unroll
                for (int m2 = 0; m2 < 2; ++m2)
#pragma unroll
                    for (int bj = 0; bj < 2; ++bj)
#pragma unroll
                        for (int n = 0; n < 2; ++n)
                            *(f32x4*)(out + (size_t)(row0 + ai * 128 + (2 * mp + m2) * 16) * DM + col0 + bj * 128 + n * 16) = xv[m2][bj][n] + gv[bj][n] * acc[ai][bj][2 * mp + m2][n];
            }
    }
};

DI void phase3a(const Params& p, LAS unsigned char* lds) {
    const int tid = threadIdx.x, lane = tid & 63, wave = tid >> 6;
    const int gw = blockIdx.x * 8 + wave, NGW = gridDim.x * 8;
    bf16* cas = (bf16*)(p.ws + WS_CAS);
    {
        float gq[8], gk[8];
        const int dq = (8 * lane) & 63;
#pragma unroll
        for (int i = 0; i < 8; ++i) gq[i] = p.q_norm_gain[dq + i] * QSCALE;
        const int kr = (lane < 16) ? 1 : 2, dk = (8 * lane) & 63;
#pragma unroll
        for (int i = 0; i < 8; ++i) gk[i] = p.k_norm_gain[kr * 64 + dk + i];
        const int kcol = (lane < 16) ? (KS0 + 8 * lane) : (KW0 + 8 * (lane & 15));
        for (int m0 = gw * 4; m0 < MTOK; m0 += NGW * 4) {
            u32x4 qw[4], kw[4];
#pragma unroll
            for (int u = 0; u < 4; ++u) { bf16* row = cas + (size_t)(m0 + u) * LD_CAS;
                qw[u] = *(const u32x4*)(row + Q0 + 8 * lane);
                kw[u] = (lane < 32) ? *(const u32x4*)(row + kcol) : (u32x4){0u, 0u, 0u, 0u}; }
#pragma unroll
            for (int u = 0; u < 4; ++u) {
                bf16* row = cas + (size_t)(m0 + u) * LD_CAS;
                float q[8], k[8]; unpack8(qw[u], q); unpack8(kw[u], k);
                float sq = 0.f, sk = 0.f;
#pragma unroll
                for (int i = 0; i < 8; ++i) { sq += q[i] * q[i]; sk += k[i] * k[i]; }
#pragma unroll
                for (int o = 1; o < 8; o <<= 1) { sq += __shfl_xor(sq, o); sk += __shfl_xor(sk, o); }
                const float rq = rsqrtf(sq * (1.f / 64.f) + 1e-6f), rk = rsqrtf(sk * (1.f / 64.f) + 1e-6f);
#pragma unroll
                for (int i = 0; i < 8; ++i) { q[i] *= rq * gq[i]; k[i] *= rk * gk[i]; }
                u32x4 o; o.x = pk2(q[0], q[1]); o.y = pk2(q[2], q[3]); o.z = pk2(q[4], q[5]); o.w = pk2(q[6], q[7]);
                *(u32x4*)(row + Q0 + 8 * lane) = o;
                if (lane < 32) { u32x4 o2; o2.x = pk2(k[0], k[1]); o2.y = pk2(k[2], k[3]); o2.z = pk2(k[4], k[5]); o2.w = pk2(k[6], k[7]); *(u32x4*)(row + kcol) = o2; }
            }
        }
    }
    {
        LAS bf16* tile = (LAS bf16*)lds;
        for (int it = blockIdx.x; it < 2048; it += gridDim.x) {
            const int which = it >> 10, bg = (it >> 5) & 31, j = it & 31, b = bg >> 1, g = bg & 1;
            const int key = tid >> 3, ch = tid & 7;
            __syncthreads();
            *(LAS u32x4*)(tile + key * 72 + 8 * ch) = *(const u32x4*)(cas + (size_t)(b * SEQ + 64 * j + key) * LD_CAS + (which ? VW0 : VS0) + g * 64 + 8 * ch);
            __syncthreads();
            const int d = tid >> 3, pc = tid & 7;
            unsigned short v[8];
#pragma unroll
            for (int i = 0; i < 8; ++i) { const int pos = 8 * pc + i, k2 = (pos & ~15) | key16_of_pos(pos & 15); v[i] = tile[k2 * 72 + d]; }
            u32x4 o; o.x = v[0] | ((unsigned)v[1] << 16); o.y = v[2] | ((unsigned)v[3] << 16); o.z = v[4] | ((unsigned)v[5] << 16); o.w = v[6] | ((unsigned)v[7] << 16);
            bf16* vt = (bf16*)(p.ws + (which ? WS_VTW : WS_VTS)) + ((size_t)(bg * 32 + j) * 64 + d) * 64 + 8 * pc;
            *(u32x4*)vt = o;
        }
        __syncthreads();
    }
}

DI float gelu_tanh(float x) { const float u = 0.7978845608028654f * (x + 0.044715f * x * x * x); const float t = 1.f - 2.f * __builtin_amdgcn_rcpf(__expf(2.f * u) + 1.f); return 0.5f * x * (1.f + t); }
DI void phase3b(const Params& p, LAS unsigned char* lds) {
    const int tid = threadIdx.x, lane = tid & 63, wave = __builtin_amdgcn_readfirstlane(tid >> 6), l31 = lane & 31, hh = lane >> 5;
    const bf16* cas = (const bf16*)(p.ws + WS_CAS);
    LAS bf16* h1 = (LAS bf16*)lds;
    LAS float* o2 = (LAS float*)(lds + 32 * 264 * 2);
    LAS unsigned char* xs = lds + 32768;
    float kgain[8];
#pragma unroll
    for (int i = 0; i < 8; ++i) kgain[i] = p.k_norm_gain[(tid & 7) * 8 + i];
    for (int it = blockIdx.x; it < 256; it += gridDim.x) {
        const int which = it >> 7, bg = (it >> 2) & 31, rq = it & 3, b = bg >> 1, g = bg & 1;
        {
            const bf16* xsrc = cas + (size_t)(b * SEQ) * LD_CAS + (which ? VC0 : KC0) + g * 64;
            for (int i = tid; i < 528 * 8; i += 512) { const int tr = i >> 3, ch = i & 7; int tok = 512 * rq + tr; tok = tok < SEQ ? tok : SEQ - 1;
                *(LAS u32x4*)(xs + tr * 128 + ((ch ^ ((tr >> 4) & 7)) << 4)) = *(const u32x4*)(xsrc + (size_t)tok * LD_CAS + 8 * ch); }
        }
        __syncthreads();
        const bf16* brow = (const bf16*)(p.ws + (which ? WS_W1V_T : WS_W1K_T)) + (size_t)(32 * wave + l31) * 2048 + 8 * hh;
        f32x16 acc = {};
#pragma unroll 16
        for (int s = 0; s < 128; ++s) {
            const int kk = 16 * s, tr = 16 * l31 + (kk >> 6), ch = ((kk & 63) >> 3) + hh;
            const bf16x8 a = *(const LAS bf16x8*)(xs + tr * 128 + ((ch ^ ((tr >> 4) & 7)) << 4));
            const bf16x8 bb = *(const bf16x8*)(brow + kk);
            acc = __builtin_amdgcn_mfma_f32_32x32x16_bf16(a, bb, acc, 0, 0, 0);
        }
        const float pb = ((const float*)(p.ws + WS_POSB))[which * 256 + 32 * wave + l31];
        __syncthreads();
#pragma unroll
        for (int r = 0; r < 16; ++r) h1[crow(r, hh) * 264 + 32 * wave + l31] = (bf16)f2bf(gelu_tanh(acc[r] + pb));
        __syncthreads();
        if (wave < 2) {
            const bf16* b2 = (const bf16*)(p.ws + (which ? WS_W2V_T : WS_W2K_T)) + (size_t)(32 * wave + l31) * 256 + 8 * hh;
            f32x16 a2 = {};
#pragma unroll
            for (int s = 0; s < 16; ++s) {
                const bf16x8 a = *(const LAS bf16x8*)(h1 + l31 * 264 + 16 * s + 8 * hh);
                const bf16x8 bb = *(const bf16x8*)(b2 + 16 * s);
                a2 = __builtin_amdgcn_mfma_f32_32x32x16_bf16(a, bb, a2, 0, 0, 0);
            }
#pragma unroll
            for (int r = 0; r < 16; ++r) o2[crow(r, hh) * 65 + 32 * wave + l31] = a2[r];
        }
        __syncthreads();
        if (tid < 256) {
            const int nl = tid >> 3, e8 = (tid & 7) * 8, nn = 32 * rq + nl;
            float v[8]; float ss = 0.f;
#pragma unroll
            for (int i = 0; i < 8; ++i) { v[i] = o2[nl * 65 + e8 + i]; ss += v[i] * v[i]; }
            if (which == 0) {
#pragma unroll
                for (int o = 1; o < 8; o <<= 1) ss += __shfl_xor(ss, o);
                const float rinv = rsqrtf(ss * (1.f / 64.f) + 1e-6f);
#pragma unroll
                for (int i = 0; i < 8; ++i) v[i] = (nn < 127) ? v[i] * rinv * kgain[i] : 0.f;
                u32x4 o; o.x = pk2(v[0], v[1]); o.y = pk2(v[2], v[3]); o.z = pk2(v[4], v[5]); o.w = pk2(v[6], v[7]);
                *(u32x4*)((bf16*)(p.ws + WS_KC) + (size_t)(bg * 128 + nn) * 64 + e8) = o;
            } else {
                const int pos = (nn & ~15) | pos16_of_key(nn & 15);
                bf16* vct = (bf16*)(p.ws + WS_VCT) + (size_t)bg * 64 * 128 + pos;
#pragma unroll
                for (int i = 0; i < 8; ++i) vct[(size_t)(e8 + i) * 128] = (bf16)f2bf((nn < 127) ? v[i] : 0.f);
            }
        }
        __syncthreads();
    }
}

constexpr int SLOTB = 8192;
DI int sw_el(int row, int col) { return row * 64 + ((((col >> 3) ^ (row & 7)) << 3) | (col & 7)); }
DI int swf_el(int row, int col) { return row * 64 + ((((col >> 2) ^ (row & 15)) << 2) | (col & 3)); }
DI bf16x8 frag_row(const LAS bf16* Mx, int row, int kc) { return *(const LAS bf16x8*)(Mx + sw_el(row, kc)); }
DI bf16x8 frag_col(const LAS bf16* Mx, int k0, int colbase, int lane) {
    const int i16 = lane & 15, q = i16 >> 2, pp = i16 & 3, blk = (lane >> 4) & 1, col = colbase + 16 * blk + 4 * pp;
    const s16x4 lo = tr_read(Mx + sw_el(k0 + q, col)), hi = tr_read(Mx + sw_el(k0 + 4 + q, col));
    return __builtin_shufflevector(lo, hi, 0, 1, 2, 3, 4, 5, 6, 7);
}
template <bool TA, bool TB> DI void mm_acc(f32x16& acc, const LAS bf16* A, const LAS bf16* Bm, int ti, int tj, int lane) {
    const int l31 = lane & 31, hh = lane >> 5;
#pragma unroll
    for (int s = 0; s < 4; ++s) {
        const int k0 = 16 * s + 8 * hh;
        bf16x8 x, y;
        if (TB) x = frag_row(Bm, 32 * tj + l31, k0); else x = frag_col(Bm, k0, 32 * tj, lane);
        if (TA) y = frag_col(A, k0, 32 * ti, lane); else y = frag_row(A, 32 * ti + l31, k0);
        acc = __builtin_amdgcn_mfma_f32_32x32x16_bf16(x, y, acc, 0, 0, 0);
    }
}
DI void ld_tile(f32x16& acc, const LAS bf16* Mx, int ti, int tj, int l31, int hh) {
#pragma unroll
    for (int g = 0; g < 4; ++g) { const u32x2 w = *(const LAS u32x2*)(Mx + sw_el(32 * ti + l31, 32 * tj + 8 * g + 4 * hh));
        acc[4 * g] = bflo(w.x); acc[4 * g + 1] = bfhi(w.x); acc[4 * g + 2] = bflo(w.y); acc[4 * g + 3] = bfhi(w.y); }
}
DI void st_tile(LAS bf16* Mx, const f32x16& acc, int ti, int tj, int l31, int hh) {
#pragma unroll
    for (int g = 0; g < 4; ++g) { u32x2 w; w.x = pk2(acc[4 * g], acc[4 * g + 1]); w.y = pk2(acc[4 * g + 2], acc[4 * g + 3]);
        *(LAS u32x2*)(Mx + sw_el(32 * ti + l31, 32 * tj + 8 * g + 4 * hh)) = w; }
}
DI void st_native_global(bf16* Tm, const f32x16& acc, int tile, int lane) {
    u32x4 a, b;
    a.x = pk2(acc[0], acc[1]); a.y = pk2(acc[2], acc[3]); a.z = pk2(acc[4], acc[5]); a.w = pk2(acc[6], acc[7]);
    b.x = pk2(acc[8], acc[9]); b.y = pk2(acc[10], acc[11]); b.z = pk2(acc[12], acc[13]); b.w = pk2(acc[14], acc[15]);
    u32x4* d = (u32x4*)(Tm + (size_t)tile * 1024 + lane * 8); d[0] = a; d[64] = b;
}
DI void ld_native_global(f32x16& acc, const bf16* Tm, int tile, int lane) {
    const u32x4* d = (const u32x4*)(Tm + (size_t)tile * 1024 + lane * 8); const u32x4 a = d[0], b = d[64];
    acc[0] = bflo(a.x); acc[1] = bfhi(a.x); acc[2] = bflo(a.y); acc[3] = bfhi(a.y); acc[4] = bflo(a.z); acc[5] = bfhi(a.z); acc[6] = bflo(a.w); acc[7] = bfhi(a.w);
    acc[8] = bflo(b.x); acc[9] = bfhi(b.x); acc[10] = bflo(b.y); acc[11] = bfhi(b.y); acc[12] = bflo(b.z); acc[13] = bfhi(b.z); acc[14] = bflo(b.w); acc[15] = bfhi(b.w);
}
DI bf16x8 pack8(const f32x16& x, int s) {
    u32x4 w; w.x = pk2(x[8 * s], x[8 * s + 1]); w.y = pk2(x[8 * s + 2], x[8 * s + 3]); w.z = pk2(x[8 * s + 4], x[8 * s + 5]); w.w = pk2(x[8 * s + 6], x[8 * s + 7]);
    return __builtin_bit_cast(bf16x8, w);
}
DI bf16x8 frag_col_perm(const LAS bf16* Mx, int kb16, int colbase, int lane) {
    const int i16 = lane & 15, q = i16 >> 2, pp = i16 & 3, blk = (lane >> 4) & 1, hh = lane >> 5, col = colbase + 16 * blk + 4 * pp;
    const s16x4 lo = tr_read(Mx + sw_el(kb16 + 4 * hh + q, col)), hi = tr_read(Mx + sw_el(kb16 + 8 + 4 * hh + q, col));
    return __builtin_shufflevector(lo, hi, 0, 1, 2, 3, 4, 5, 6, 7);
}
DI void mm32_acc(f32x16& C, const f32x16& A, const LAS bf16* Bm, int kb, int colbase, int lane) {
    const bf16x8 a0 = pack8(A, 0), a1 = pack8(A, 1);
    C = __builtin_amdgcn_mfma_f32_32x32x16_bf16(frag_col_perm(Bm, kb, colbase, lane), a0, C, 0, 0, 0);
    C = __builtin_amdgcn_mfma_f32_32x32x16_bf16(frag_col_perm(Bm, kb + 16, colbase, lane), a1, C, 0, 0, 0);
}
DI u32x4 pack8f(const float* v) { u32x4 o; o.x = pk2(v[0], v[1]); o.y = pk2(v[2], v[3]); o.z = pk2(v[4], v[5]); o.w = pk2(v[6], v[7]); return o; }

DI void phase3c(const Params& p, LAS unsigned char* lds) {
    const int tid0 = threadIdx.x, wave = __builtin_amdgcn_readfirstlane(tid0 >> 6);
    const int half = wave >> 2, lw = wave & 3, ti = (lw >> 1) & 1, tj = lw & 1;
    const bf16* cas = (const bf16*)(p.ws + WS_CAS);
    LAS unsigned char* hb = lds + half * 65536;
#define SL(i) ((LAS bf16*)(hb + (i) * SLOTB))
    LAS float* F1 = (LAS float*)(hb);
    LAS float* F2 = (LAS float*)(hb + 2 * SLOTB);
    LAS float* gam = (LAS float*)(lds + 131072) + half * 64;
    LAS float* tot = (LAS float*)(lds + 131072 + 512) + half * 256;
    LAS float* parL = (LAS float*)(lds + 131072 + 512 + 2048) + half * 640;
    int par_h = -1;
#define LDS_BAR() asm volatile("s_waitcnt lgkmcnt(0)\n\ts_barrier" ::: "memory")
    u32x4 nwd[2], nad[2], npw[2], npa[2];
#define E1_FETCH(PR) do { const int it_ = 2 * (PR) + half; const int c_ = it_ & 31; const size_t me_ = (size_t)(it_ >> 8) * SEQ + 64 * c_ + ((tid0 & 255) >> 2); \
        const bool hp_ = (64 * c_ + ((tid0 & 255) >> 2)) > 0; const int j16_ = (tid0 & 3) * 16; \
        _Pragma("unroll") for (int sp = 0; sp < 2; ++sp) { \
            nwd[sp] = *(const u32x4*)(cas + me_ * LD_CAS + WD0 + j16_ + 8 * sp); nad[sp] = *(const u32x4*)(cas + me_ * LD_CAS + AD0 + j16_ + 8 * sp); \
            npw[sp] = *(const u32x4*)(cas + (me_ - (hp_ ? 1 : 0)) * LD_CAS + WD0 + j16_ + 8 * sp); npa[sp] = *(const u32x4*)(cas + (me_ - (hp_ ? 1 : 0)) * LD_CAS + AD0 + j16_ + 8 * sp); } } while (0)
    unsigned pf0 = 0u, pf1 = 0u;
    if ((int)blockIdx.x < 2048) E1_FETCH((int)blockIdx.x);
#pragma unroll
    for (int k = 0; k < 8; ++k) *(u32x4*)(p.ws + WS_DUMMY + (size_t)k * 8192 + tid0 * 16) = (u32x4){0u, 0u, 0u, 0u};
    for (int pr = blockIdx.x; pr < 2048; pr += gridDim.x) {
        int tid = tid0; asm volatile("" : "+v"(tid));
        const int lane = tid & 63, l31 = lane & 31, hh = lane >> 5, ltid = tid & 255;
        const int item = 2 * pr + half;
        const int c = item & 31, h = (item >> 5) & 7, b = item >> 8;
        const size_t m0 = (size_t)b * SEQ + 64 * c;
        const int te = ltid >> 2, c16 = (ltid & 3) * 16; const size_t me = m0 + te; const bool hpv = (64 * c + te) > 0;
        if (h != par_h) {
            par_h = h;
            for (int i = ltid; i < 640; i += 256) { const int rw = i >> 6, cc = i & 63; float v;
                if (rw == 0) v = p.w0[h * 64 + cc]; else if (rw == 1) v = p.a0[h * 64 + cc]; else if (rw == 2) v = p.k_k[h * 64 + cc]; else if (rw == 3) v = p.k_a[h * 64 + cc];
                else if (rw == 4) v = p.r_k[h * 64 + cc]; else if (rw < 8) v = p.shift_mu[(rw - 5) * 512 + h * 64 + cc]; else v = p.shift_mu[1536 + (rw - 8) * 64 + cc];
                parL[i] = v; }
            LDS_BAR();
        }
        u32x4 gk[2], gr[2], gv[2], gkp[2], grp[2], gvp[2];
#pragma unroll
        for (int sp = 0; sp < 2; ++sp) { const int hc8 = h * 64 + c16 + 8 * sp;
            gk[sp] = *(const u32x4*)(cas + me * LD_CAS + K0 + hc8); gr[sp] = *(const u32x4*)(cas + me * LD_CAS + R0 + hc8); gv[sp] = *(const u32x4*)(cas + me * LD_CAS + V0 + hc8);
            const size_t mp = me - (hpv ? 1 : 0);
            gkp[sp] = *(const u32x4*)(cas + mp * LD_CAS + K0 + hc8); grp[sp] = *(const u32x4*)(cas + mp * LD_CAS + R0 + hc8); gvp[sp] = *(const u32x4*)(cas + mp * LD_CAS + V0 + hc8); }
        bf16x8 wfr[2][4];
#pragma unroll
        for (int pd = 0; pd < 2; ++pd) { const bf16* wt = (const bf16*)(p.ws + (pd ? WS_WLA_T : WS_WLW_T)) + (size_t)(h * 64 + 32 * tj + l31) * 64;
#pragma unroll
            for (int s = 0; s < 4; ++s) wfr[pd][s] = *(const bf16x8*)(wt + 16 * s + 8 * hh); }
#pragma unroll
        for (int sp = 0; sp < 2; ++sp) {
            const int j8 = c16 + 8 * sp;
            float wd[8], ad[8], pw[8], pa[8];
            asm volatile("" : "+v"(npw[sp]), "+v"(npa[sp]));
            unpack8(nwd[sp], wd); unpack8(nad[sp], ad); unpack8(hpv ? npw[sp] : (u32x4){0u, 0u, 0u, 0u}, pw); unpack8(hpv ? npa[sp] : (u32x4){0u, 0u, 0u, 0u}, pa);
#pragma unroll
            for (int i = 0; i < 8; ++i) { const float x = wd[i] + (pw[i] - wd[i]) * parL[512 + j8 + i]; const float e2 = __expf(2.f * x); wd[i] = 1.f - 2.f * __builtin_amdgcn_rcpf(e2 + 1.f);
                ad[i] = ad[i] + (pa[i] - ad[i]) * parL[576 + j8 + i]; }
            *(LAS u32x4*)(SL(6) + sw_el(te, j8)) = pack8f(wd);
            *(LAS u32x4*)(SL(7) + sw_el(te, j8)) = pack8f(ad);
        }
        E1_FETCH(min(pr + (int)gridDim.x, 2047));
        LDS_BAR();
#pragma unroll
        for (int pd = 0; pd < 2; ++pd) {
            const LAS bf16* Am = pd ? SL(7) : SL(6);
            f32x16 acc = {};
#pragma unroll
            for (int s = 0; s < 4; ++s) { const int k0 = 16 * s + 8 * hh;
                const bf16x8 y = frag_row(Am, 32 * ti + l31, k0);
                acc = __builtin_amdgcn_mfma_f32_32x32x16_bf16(wfr[pd][s], y, acc, 0, 0, 0); }
            LAS float* F = pd ? F2 : F1;
#pragma unroll
            for (int g = 0; g < 4; ++g) *(LAS f32x4*)(F + swf_el(32 * ti + l31, 32 * tj + 8 * g + 4 * hh)) = (f32x4){acc[4 * g], acc[4 * g + 1], acc[4 * g + 2], acc[4 * g + 3]};
        }
        LDS_BAR();
        asm volatile("" :: "v"(pf0), "v"(pf1));
        float lw16[16], av16[16], bv16[16], km16[16], rs16[16];
        {
            float kraw[16], icl[16]; float ss = 0.f, bon = 0.f;
#pragma unroll
            for (int sp = 0; sp < 2; ++sp) {
                const int c8 = c16 + 8 * sp, hc8 = h * 64 + c8;
                float kc_[8], kp_[8], rc_[8], rp_[8], vc_[8], vp_[8];
                asm volatile("" : "+v"(gkp[sp]), "+v"(grp[sp]), "+v"(gvp[sp]));
                const u32x4 z4 = {0u, 0u, 0u, 0u};
                unpack8(gk[sp], kc_); unpack8(gr[sp], rc_); unpack8(gv[sp], vc_); unpack8(hpv ? gkp[sp] : z4, kp_); unpack8(hpv ? grp[sp] : z4, rp_); unpack8(hpv ? gvp[sp] : z4, vp_);
                const f32x4 z0 = *(const LAS f32x4*)(F1 + swf_el(te, c8)), z1 = *(const LAS f32x4*)(F1 + swf_el(te, c8 + 4));
                const f32x4 a0_ = *(const LAS f32x4*)(F2 + swf_el(te, c8)), a1_ = *(const LAS f32x4*)(F2 + swf_el(te, c8 + 4));
                const float zz[8] = {z0[0], z0[1], z0[2], z0[3], z1[0], z1[1], z1[2], z1[3]}, ap[8] = {a0_[0], a0_[1], a0_[2], a0_[3], a1_[0], a1_[1], a1_[2], a1_[3]};
                float vs[8];
#pragma unroll
                for (int i = 0; i < 8; ++i) {
                    const int e = 8 * sp + i;
                    const int pc = c8 + i;
                    const float ks = kc_[i] + (kp_[i] - kc_[i]) * parL[384 + pc];
                    rs16[e] = rc_[i] + (rp_[i] - rc_[i]) * parL[320 + pc];
                    vs[i] = vc_[i] + (vp_[i] - vc_[i]) * parL[448 + pc];
                    const float nz = -(parL[pc] + zz[i]), spv = nz > 20.f ? nz : __logf(1.f + __expf(nz));
                    lw16[e] = -__expf(-spv - 0.5f);
                    icl[e] = sigmoidf_(parL[64 + pc] + ap[i]);
                    kraw[e] = ks * parL[128 + pc]; ss += kraw[e] * kraw[e];
                    km16[e] = ks * (1.f + (icl[e] - 1.f) * parL[192 + pc]);
                    bon += rs16[e] * km16[e] * parL[256 + pc];
                }
                *(LAS u32x4*)(SL(7) + sw_el(te, c8)) = pack8f(vs);
            }
            ss += __shfl_xor(ss, 1); ss += __shfl_xor(ss, 2); bon += __shfl_xor(bon, 1); bon += __shfl_xor(bon, 2);
            const float rn = rsqrtf(fmaxf(ss, 1e-24f));
#pragma unroll
            for (int e = 0; e < 16; ++e) { const float kk = kraw[e] * rn; av16[e] = -kk; bv16[e] = kk * icl[e]; }
#pragma unroll
            for (int q4 = 0; q4 < 4; ++q4) *(LAS f32x4*)(F1 + swf_el(te, c16 + 4 * q4)) = (f32x4){lw16[4 * q4], lw16[4 * q4 + 1], lw16[4 * q4 + 2], lw16[4 * q4 + 3]};
            if ((ltid & 3) == 0) ((float*)(p.ws + WS_BONUS))[me * 8 + h] = bon;
        }
        LDS_BAR();
        {
            const int cc = ltid & 63, tq = ltid >> 6;
            float L[16]; L[0] = F1[swf_el(16 * tq, cc)];
#pragma unroll
            for (int i = 1; i < 16; ++i) L[i] = L[i - 1] + F1[swf_el(16 * tq + i, cc)];
            tot[tq * 64 + cc] = L[15];
            LDS_BAR();
            float off = 0.f;
            for (int q = 0; q < tq; ++q) off += tot[q * 64 + cc];
#pragma unroll
            for (int i = 0; i < 16; ++i) F1[swf_el(16 * tq + i, cc)] = off + L[i];
            if (tq == 3) gam[cc] = __expf(off + L[15]);
        }
        LDS_BAR();
        {
            float Lt[16];
#pragma unroll
            for (int q4 = 0; q4 < 4; ++q4) { const f32x4 a = *(const LAS f32x4*)(F1 + swf_el(te, c16 + 4 * q4)); Lt[4 * q4] = a[0]; Lt[4 * q4 + 1] = a[1]; Lt[4 * q4 + 2] = a[2]; Lt[4 * q4 + 3] = a[3]; }
#pragma unroll
            for (int sp = 0; sp < 2; ++sp) {
                float oa[8], ob[8], ok[8], orr[8];
#pragma unroll
                for (int i = 0; i < 8; ++i) { const int e = 8 * sp + i; const float ep = __expf(Lt[e]), en = __builtin_amdgcn_rcpf(ep), e3 = __expf(Lt[e] - lw16[e]);
                    oa[i] = av16[e] * e3; ob[i] = bv16[e] * en; ok[i] = km16[e] * en; orr[i] = rs16[e] * ep; }
                *(LAS u32x4*)(SL(4) + sw_el(te, c16 + 8 * sp)) = pack8f(oa);
                *(LAS u32x4*)(SL(5) + sw_el(te, c16 + 8 * sp)) = pack8f(ob);
                *(LAS u32x4*)(SL(6) + sw_el(te, c16 + 8 * sp)) = pack8f(ok);
                *(LAS u32x4*)(SL(3) + sw_el(te, c16 + 8 * sp)) = pack8f(orr);
            }
        }
        LDS_BAR();
        { const int itn = 2 * min(pr + (int)gridDim.x, 2047) + half; const int w3 = ltid & 3;
          const bf16* rowp = cas + ((size_t)(itn >> 8) * SEQ + 64 * (itn & 31) + te) * LD_CAS + (w3 == 1 ? R0 : w3 == 2 ? V0 : K0) + ((itn >> 5) & 7) * 64;
          pf0 = *(const unsigned*)rowp; pf1 = *(const unsigned*)(rowp + 56); }
        u32x2 rtw[4]; f32x16 y2p, dp;
        {
            const int row = 32 * ti + l31;
            bf16x8 aA[4], aR[4], bB[4], bK0[4], bK1[4];
#pragma unroll
            for (int s = 0; s < 4; ++s) { const int k0 = 16 * s + 8 * hh;
                aA[s] = frag_row(SL(4), row, k0); aR[s] = frag_row(SL(3), row, k0); bB[s] = frag_row(SL(5), 32 * tj + l31, k0);
                bK0[s] = frag_row(SL(6), l31, k0); bK1[s] = frag_row(SL(6), 32 + l31, k0); }
            f32x16 acc = {};
#pragma unroll
            for (int s = 0; s < 4; ++s) acc = __builtin_amdgcn_mfma_f32_32x32x16_bf16(bB[s], aA[s], acc, 0, 0, 0);
#pragma unroll
            for (int r = 0; r < 16; ++r) acc[r] = (32 * tj + crow(r, hh) < row) ? acc[r] : 0.f;
            st_tile(SL(0), acc, ti, tj, l31, hh);
            acc = (f32x16){};
#pragma unroll
            for (int s = 0; s < 4; ++s) acc = __builtin_amdgcn_mfma_f32_32x32x16_bf16(tj ? bK1[s] : bK0[s], aA[s], acc, 0, 0, 0);
#pragma unroll
            for (int r = 0; r < 16; ++r) acc[r] = (32 * tj + crow(r, hh) < row) ? acc[r] : 0.f;
            st_tile(SL(2), acc, ti, tj, l31, hh);
            acc = (f32x16){};
#pragma unroll
            for (int s = 0; s < 4; ++s) acc = __builtin_amdgcn_mfma_f32_32x32x16_bf16(bB[s], aR[s], acc, 0, 0, 0);
#pragma unroll
            for (int r = 0; r < 16; ++r) acc[r] = (32 * tj + crow(r, hh) <= row) ? acc[r] : 0.f;
            st_tile(SL(1), acc, ti, tj, l31, hh);
            f32x16 ak0 = {}, ak1 = {};
#pragma unroll
            for (int s = 0; s < 4; ++s) ak0 = __builtin_amdgcn_mfma_f32_32x32x16_bf16(bK0[s], aR[s], ak0, 0, 0, 0);
#pragma unroll
            for (int r = 0; r < 16; ++r) ak0[r] = (crow(r, hh) <= row) ? ak0[r] : 0.f;
            y2p = (f32x16){};
            mm32_acc(y2p, ak0, SL(7), 0, 32 * tj, lane);
            if (ti) {
#pragma unroll
                for (int s = 0; s < 4; ++s) ak1 = __builtin_amdgcn_mfma_f32_32x32x16_bf16(bK1[s], aR[s], ak1, 0, 0, 0);
#pragma unroll
                for (int r = 0; r < 16; ++r) ak1[r] = (32 + crow(r, hh) <= row) ? ak1[r] : 0.f;
                mm32_acc(y2p, ak1, SL(7), 32, 32 * tj, lane);
            }
            dp = (f32x16){};
            mm_acc<true, false>(dp, SL(7), SL(6), ti, tj, lane);
#pragma unroll
            for (int g = 0; g < 4; ++g) rtw[g] = *(const LAS u32x2*)(SL(3) + sw_el(row, 32 * tj + 8 * g + 4 * hh));
        }
        LDS_BAR();
        if (lw == 0) {
            f32x16 Q0, Q1, T0, T1;
            ld_tile(Q0, SL(0), 0, 0, l31, hh); ld_tile(Q1, SL(0), 1, 1, l31, hh);
#pragma unroll
            for (int r = 0; r < 16; ++r) { const float idn = (crow(r, hh) == l31) ? 1.f : 0.f; T0[r] = Q0[r] + idn; T1[r] = Q1[r] + idn; }
            { f32x16 S0 = {}, S1 = {}; mm32_acc(S0, Q0, SL(0), 0, 0, lane); mm32_acc(S1, Q1, SL(0), 32, 32, lane); Q0 = S0; Q1 = S1; }
#pragma unroll
            for (int k = 1; k <= 4; ++k) {
                st_tile(SL(3), Q0, 0, 0, l31, hh); st_tile(SL(3), Q1, 1, 1, l31, hh);
                const bf16x8 b00 = frag_col_perm(SL(3), 0, 0, lane), b01 = frag_col_perm(SL(3), 16, 0, lane);
                const bf16x8 b10 = frag_col_perm(SL(3), 32, 32, lane), b11 = frag_col_perm(SL(3), 48, 32, lane);
                const bf16x8 t00 = pack8(T0, 0), t01 = pack8(T0, 1), t10 = pack8(T1, 0), t11 = pack8(T1, 1);
                T0 = __builtin_amdgcn_mfma_f32_32x32x16_bf16(b00, t00, T0, 0, 0, 0); T1 = __builtin_amdgcn_mfma_f32_32x32x16_bf16(b10, t10, T1, 0, 0, 0);
                T0 = __builtin_amdgcn_mfma_f32_32x32x16_bf16(b01, t01, T0, 0, 0, 0); T1 = __builtin_amdgcn_mfma_f32_32x32x16_bf16(b11, t11, T1, 0, 0, 0);
                if (k < 4) {
                    const bf16x8 q00 = pack8(Q0, 0), q01 = pack8(Q0, 1), q10 = pack8(Q1, 0), q11 = pack8(Q1, 1);
                    f32x16 S0 = {}, S1 = {};
                    S0 = __builtin_amdgcn_mfma_f32_32x32x16_bf16(b00, q00, S0, 0, 0, 0); S1 = __builtin_amdgcn_mfma_f32_32x32x16_bf16(b10, q10, S1, 0, 0, 0);
                    S0 = __builtin_amdgcn_mfma_f32_32x32x16_bf16(b01, q01, S0, 0, 0, 0); S1 = __builtin_amdgcn_mfma_f32_32x32x16_bf16(b11, q11, S1, 0, 0, 0);
                    Q0 = S0; Q1 = S1;
                }
            }
            st_tile(SL(3), T0, 0, 0, l31, hh); st_tile(SL(3), T1, 1, 1, l31, hh);
            { const f32x16 z = {}; st_tile(SL(3), z, 0, 1, l31, hh); }
            f32x16 Mx = {};
#pragma unroll
            for (int s = 0; s < 2; ++s) { const int k0 = 16 * s + 8 * hh;
                Mx = __builtin_amdgcn_mfma_f32_32x32x16_bf16(frag_col(SL(3), k0, 0, lane), frag_row(SL(0), 32 + l31, k0), Mx, 0, 0, 0); }
            st_tile(SL(3), Mx, 1, 0, l31, hh);
            f32x16 T21 = {};
            mm32_acc(T21, T1, SL(3), 32, 0, lane);
            st_tile(SL(3), T21, 1, 0, l31, hh);
        } else if (lw == 3) {
            f32x16 x0 = {}, x1 = {};
#pragma unroll
            for (int s = 0; s < 2; ++s) { const int k0 = 16 * s + 8 * hh; const bf16x8 a = frag_row(SL(2), l31, k0);
                x0 = __builtin_amdgcn_mfma_f32_32x32x16_bf16(frag_col(SL(7), k0, 0, lane), a, x0, 0, 0, 0);
                x1 = __builtin_amdgcn_mfma_f32_32x32x16_bf16(frag_col(SL(7), k0, 32, lane), a, x1, 0, 0, 0); }
            st_tile(SL(6), x0, 0, 0, l31, hh); st_tile(SL(6), x1, 0, 1, l31, hh);
        } else {
            f32x16 x = {}; mm_acc<false, false>(x, SL(2), SL(7), 1, lw - 1, lane); st_tile(SL(6), x, 1, lw - 1, l31, hh);
        }
        LDS_BAR();
        { f32x16 acc = {}; mm_acc<false, false>(acc, SL(3), SL(4), ti, tj, lane); st_tile(SL(0), acc, ti, tj, l31, hh);
          f32x16 a2 = {}; mm_acc<false, false>(a2, SL(3), SL(6), ti, tj, lane); st_tile(SL(2), a2, ti, tj, l31, hh); }
        LDS_BAR();
        {
            unsigned char* ob = (unsigned char*)p.out;
            { f32x16 acc;
#pragma unroll
              for (int g = 0; g < 4; ++g) { acc[4 * g] = bflo(rtw[g].x); acc[4 * g + 1] = bfhi(rtw[g].x); acc[4 * g + 2] = bflo(rtw[g].y); acc[4 * g + 3] = bfhi(rtw[g].y); }
              mm_acc<false, false>(acc, SL(1), SL(0), ti, tj, lane);
              st_native_global((bf16*)(ob + OUT_Y1) + (size_t)item * 4096, acc, ti * 2 + tj, lane); }
            { f32x16 g2 = {};
              mm_acc<true, false>(g2, SL(5), SL(0), ti, tj, lane);
              const float gm = gam[32 * ti + l31];
#pragma unroll
              for (int r = 0; r < 16; ++r) g2[r] = (g2[r] + ((32 * tj + crow(r, hh) == 32 * ti + l31) ? 1.f : 0.f)) * gm;
              st_native_global((bf16*)(ob + OUT_G) + (size_t)item * 4096, g2, ti * 2 + tj, lane); }
            { mm_acc<false, false>(y2p, SL(1), SL(2), ti, tj, lane);
              st_native_global((bf16*)(ob + OUT_Y2) + (size_t)item * 4096, y2p, tj * 2 + ti, lane); }
            { mm_acc<true, false>(dp, SL(2), SL(5), ti, tj, lane);
#pragma unroll
              for (int r = 0; r < 16; ++r) dp[r] *= gam[32 * tj + crow(r, hh)];
              st_native_global((bf16*)(ob + OUT_D) + (size_t)item * 4096, dp, tj * 2 + ti, lane); }
        }
    }
#undef SL
#undef LDS_BAR
#undef E1_FETCH
}

DI void phase5a(const Params& p) {
    const int tid = threadIdx.x, lane = tid & 63, wave = tid >> 6, l31 = lane & 31, hh = lane >> 5;
    if (blockIdx.x >= 16) return;
    const unsigned char* ob = (const unsigned char*)p.out;
    {
        const int chain = blockIdx.x * 8 + wave;
        f32x16 H[2][2];
#pragma unroll
        for (int a = 0; a < 2; ++a)
#pragma unroll
            for (int c2 = 0; c2 < 2; ++c2) H[a][c2] = (f32x16){};
        bf16x8 gf[2][2][2];
        { const bf16* Gp = (const bf16*)(ob + OUT_G) + (size_t)chain * 32 * 4096;
#pragma unroll
          for (int ti = 0; ti < 2; ++ti)
#pragma unroll
              for (int tk = 0; tk < 2; ++tk)
#pragma unroll
                  for (int s = 0; s < 2; ++s) gf[ti][tk][s] = *(const bf16x8*)(Gp + (ti * 2 + tk) * 1024 + 512 * s + lane * 8); }
        for (int c = 0; c < 32; ++c) {
            const size_t item = (size_t)chain * 32 + c;
            const bf16* Dn = (const bf16*)(ob + OUT_D) + item * 4096;
            bf16x8 gn[2][2][2];
            { const bf16* Gp = (const bf16*)(ob + OUT_G) + (item + (c < 31 ? 1 : 0)) * 4096;
#pragma unroll
              for (int ti = 0; ti < 2; ++ti)
#pragma unroll
                  for (int tk = 0; tk < 2; ++tk)
#pragma unroll
                      for (int s = 0; s < 2; ++s) gn[ti][tk][s] = *(const bf16x8*)(Gp + (ti * 2 + tk) * 1024 + 512 * s + lane * 8); }
            f32x16 Dv[2][2];
#pragma unroll
            for (int ti = 0; ti < 2; ++ti)
#pragma unroll
                for (int tj = 0; tj < 2; ++tj) ld_native_global(Dv[ti][tj], Dn, ti * 2 + tj, lane);
            bf16x8 hp[2][2][2];
            u32x4* hs = (u32x4*)((bf16*)(p.ws + WS_HS) + item * 4096);
#pragma unroll
            for (int tk = 0; tk < 2; ++tk)
#pragma unroll
                for (int tj = 0; tj < 2; ++tj)
#pragma unroll
                    for (int s = 0; s < 2; ++s) { hp[tk][tj][s] = pack8(H[tk][tj], s); hs[((tk * 2 + tj) * 2 + s) * 64 + lane] = __builtin_bit_cast(u32x4, hp[tk][tj][s]); }
#pragma unroll
            for (int ti = 0; ti < 2; ++ti)
#pragma unroll
                for (int tj = 0; tj < 2; ++tj) {
                    f32x16 acc = Dv[ti][tj];
#pragma unroll
                    for (int tk = 0; tk < 2; ++tk)
#pragma unroll
                        for (int s = 0; s < 2; ++s) acc = __builtin_amdgcn_mfma_f32_32x32x16_bf16(gf[ti][tk][s], hp[tk][tj][s], acc, 0, 0, 0);
                    H[ti][tj] = acc;
                }
#pragma unroll
            for (int ti = 0; ti < 2; ++ti)
#pragma unroll
                for (int tk = 0; tk < 2; ++tk)
#pragma unroll
                    for (int s = 0; s < 2; ++s) gf[ti][tk][s] = gn[ti][tk][s];
        }
    }
    asm volatile("s_waitcnt vmcnt(0)" ::: "memory");
    __syncthreads();
    if (tid == 0) { __builtin_amdgcn_fence(__ATOMIC_RELEASE, "agent"); asm volatile("s_waitcnt vmcnt(0)" ::: "memory");
        __hip_atomic_fetch_add((unsigned*)(p.ws + WS_CTL) + 12288, 1u, __ATOMIC_RELAXED, __HIP_MEMORY_SCOPE_AGENT); }
}
DI void phase5b(const Params& p, LAS unsigned char* lds) {
    const int tid0 = threadIdx.x, wave = __builtin_amdgcn_readfirstlane(tid0 >> 6);
    const bf16* cas = (const bf16*)(p.ws + WS_CAS); const bf16* cr = (const bf16*)(p.ws + WS_CR);
    const unsigned char* ob = (const unsigned char*)p.out;
    LAS float* Zl = (LAS float*)(lds + wave * 17408);
    LAS unsigned* qL = (LAS unsigned*)(lds + 8 * 17408);
    __syncthreads();
    if (tid0 == 0) { unsigned* done = (unsigned*)(p.ws + WS_CTL) + 12288; unsigned sp = 0;
        while (__hip_atomic_load(done, __ATOMIC_RELAXED, __HIP_MEMORY_SCOPE_AGENT) < 16u) { __builtin_amdgcn_s_sleep(4); if (++sp > (1u << 24)) break; }
        __builtin_amdgcn_fence(__ATOMIC_ACQUIRE, "agent"); asm volatile("s_waitcnt vmcnt(0)" ::: "memory"); }
    __syncthreads();
    unsigned* q5 = (unsigned*)(p.ws + WS_CTL) + 12352;
    for (;;) {
        if (tid0 == 0) qL[0] = atomicAdd(q5, 1u);
        __syncthreads();
        const unsigned qb = qL[0];
        __syncthreads();
        if (qb >= 512u) break;
        const int item = (int)qb * 8 + wave;
        int tid = tid0; asm volatile("" : "+v"(tid));
        const int lane = tid & 63, l31 = lane & 31, hh = lane >> 5;
        const int c = item & 31, h = (item >> 5) & 7, b = item >> 8;
        const bf16* Y1p = (const bf16*)(ob + OUT_Y1) + (size_t)item * 4096; const bf16* Y2n = (const bf16*)(ob + OUT_Y2) + (size_t)item * 4096;
        const u32x4* hs = (const u32x4*)((const bf16*)(p.ws + WS_HS) + (size_t)item * 4096);
        bf16x8 hp[2][2][2];
#pragma unroll
        for (int tk = 0; tk < 2; ++tk)
#pragma unroll
            for (int tj = 0; tj < 2; ++tj)
#pragma unroll
                for (int s = 0; s < 2; ++s) hp[tk][tj][s] = __builtin_bit_cast(bf16x8, hs[((tk * 2 + tj) * 2 + s) * 64 + lane]);
#pragma unroll
        for (int tt = 0; tt < 2; ++tt) {
            f32x16 Z[2];
#pragma unroll
            for (int vj = 0; vj < 2; ++vj) {
                ld_native_global(Z[vj], Y2n, vj * 2 + tt, lane);
#pragma unroll
                for (int tk = 0; tk < 2; ++tk)
#pragma unroll
                    for (int s = 0; s < 2; ++s) {
                        const bf16x8 bb = *(const bf16x8*)(Y1p + (tt * 2 + tk) * 1024 + 512 * s + lane * 8);
                        Z[vj] = __builtin_amdgcn_mfma_f32_32x32x16_bf16(hp[tk][vj][s], bb, Z[vj], 0, 0, 0);
                    }
            }
            float sum = 0.f;
#pragma unroll
            for (int vj = 0; vj < 2; ++vj)
#pragma unroll
                for (int r = 0; r < 16; ++r) sum += Z[vj][r];
            sum += __shfl_xor(sum, 32);
            const float mean = sum * (1.f / 64.f);
            float sq = 0.f;
#pragma unroll
            for (int vj = 0; vj < 2; ++vj)
#pragma unroll
                for (int r = 0; r < 16; ++r) { const float d = Z[vj][r] - mean; sq += d * d; }
            sq += __shfl_xor(sq, 32);
            const float rstd = rsqrtf(sq * (1.f / 64.f) + 64e-5f);
#pragma unroll
            for (int vj = 0; vj < 2; ++vj)
#pragma unroll
                for (int g = 0; g < 4; ++g)
                    *(LAS f32x4*)(Zl + (32 * tt + l31) * 68 + 32 * vj + 8 * g + 4 * hh) =
                        (f32x4){(Z[vj][4 * g] - mean) * rstd, (Z[vj][4 * g + 1] - mean) * rstd, (Z[vj][4 * g + 2] - mean) * rstd, (Z[vj][4 * g + 3] - mean) * rstd};
        }
        const int v8 = (lane & 7) * 8, col = h * 64 + v8;
        float mu[8], lw[8], lb[8];
#pragma unroll
        for (int i = 0; i < 8; ++i) { mu[i] = p.shift_mu[1024 + col + i]; lw[i] = p.ln_x_w[col + i]; lb[i] = p.ln_x_b[col + i]; }
#pragma unroll
        for (int pb = 0; pb < 2; ++pb) {
            u32x4 cw[4], pw[4], sw[4]; float bn[4];
#pragma unroll
            for (int q = 0; q < 4; ++q) { const int t = (4 * pb + q) * 8 + (lane >> 3); const size_t m = (size_t)b * SEQ + 64 * c + t; const bool hprev = (64 * c + t) > 0;
                cw[q] = *(const u32x4*)(cas + m * LD_CAS + V0 + col); pw[q] = *(const u32x4*)(cas + (m - (hprev ? 1 : 0)) * LD_CAS + V0 + col);
                sw[q] = *(const u32x4*)(cr + m * LD_CR + BSILU0 + col); bn[q] = ((const float*)(p.ws + WS_BONUS))[m * 8 + h]; }
#pragma unroll
            for (int q = 0; q < 4; ++q) asm volatile("" : "+v"(cw[q]), "+v"(pw[q]), "+v"(sw[q]), "+v"(bn[q]));
#pragma unroll
            for (int q = 0; q < 4; ++q) { const int t = (4 * pb + q) * 8 + (lane >> 3); const size_t m = (size_t)b * SEQ + 64 * c + t; const bool hprev = (64 * c + t) > 0;
                float cu[8], pv[8], sg[8];
                unpack8(cw[q], cu); unpack8(hprev ? pw[q] : (u32x4){0u, 0u, 0u, 0u}, pv); unpack8(sw[q], sg);
                const float bon = bn[q];
                const f32x4 z0 = *(const LAS f32x4*)(Zl + t * 68 + v8), z1 = *(const LAS f32x4*)(Zl + t * 68 + v8 + 4);
                const float zz[8] = {z0[0], z0[1], z0[2], z0[3], z1[0], z1[1], z1[2], z1[3]};
                float o[8];
#pragma unroll
                for (int i = 0; i < 8; ++i) { const float vsh = cu[i] + (pv[i] - cu[i]) * mu[i]; o[i] = (zz[i] * lw[i] + lb[i] + bon * vsh) * siluf_(sg[i]); }
                u32x4 w; w.x = pk2(o[0], o[1]); w.y = pk2(o[2], o[3]); w.z = pk2(o[4], o[5]); w.w = pk2(o[6], o[7]);
                *(u32x4*)((bf16*)(p.ws + WS_YB) + m * 512 + col) = w; }
        }
    }
}

constexpr int A_STAGE = 81920, A_TILE = 8192;
DI int swz_off(int row, int chunk) { return row * 128 + ((chunk ^ ((row >> 1) & 7)) << 4); }
DI void attn_qk(f32x16& s0, f32x16& s1, const LAS unsigned char* kl, const bf16x8 (&qr)[4], const f32x16& cinit, int l31, int hh) {
#pragma unroll
    for (int d0 = 0; d0 < 4; ++d0) {
        const bf16x8 k0f = *(const LAS bf16x8*)(kl + swz_off(l31, 2 * d0 + hh));
        const bf16x8 k1f = *(const LAS bf16x8*)(kl + swz_off(32 + l31, 2 * d0 + hh));
        s0 = __builtin_amdgcn_mfma_f32_32x32x16_bf16(k0f, qr[d0], d0 == 0 ? cinit : s0, 0, 0, 0);
        s1 = __builtin_amdgcn_mfma_f32_32x32x16_bf16(k1f, qr[d0], d0 == 0 ? cinit : s1, 0, 0, 0);
    }
}
DI void attn_sv(f32x16& s0, f32x16& s1, const LAS unsigned char* vl, int key0, int tq, bool laneok, int tmin, const LAS float* bl, bool win, bool bound,
                float& m_run, float& l_run, f32x16 (&O)[2], int l31, int hh) {
    const bool far = (tmin - (key0 + 63)) >= 128;
    const bool fast = far && !bound;
    int dbase = tq - key0; asm volatile("" : "+v"(dbase));
    float rm = -1e30f, cb = 0.f;
    if (fast) {
        cb = bl[128];
#pragma unroll
        for (int r = 0; r < 16; ++r) rm = fmaxf(rm, fmaxf(s0[r], s1[r]));
        rm = laneok ? rm + cb : -1e30f;
    } else {
        const int dmax = win ? 512 : 0x7fffffff, dmin = bound ? 0 : -0x7fffffff;
#pragma unroll
        for (int r = 0; r < 16; ++r) {
            const int d0_ = dbase - crow(r, hh), d1_ = d0_ - 32;
            const bool v0 = laneok && d0_ >= dmin && d0_ < dmax, v1 = laneok && d1_ >= dmin && d1_ < dmax;
            const float b0 = bl[min(max(d0_, 0), 128)], b1 = bl[min(max(d1_, 0), 128)];
            s0[r] = v0 ? s0[r] + b0 : -1e30f; s1[r] = v1 ? s1[r] + b1 : -1e30f;
            rm = fmaxf(rm, fmaxf(s0[r], s1[r]));
        }
    }
    rm = fmaxf(rm, __shfl_xor(rm, 32));
    if (__any(rm > m_run + 8.f)) {
        const float m_new = fmaxf(m_run, rm), alpha = __builtin_amdgcn_exp2f(m_run - m_new);
        l_run *= alpha; m_run = m_new;
#pragma unroll
        for (int dt = 0; dt < 2; ++dt)
#pragma unroll
            for (int r = 0; r < 16; ++r) O[dt][r] *= alpha;
    }
    const float sh = m_run - cb;
    float rs = 0.f;
    if (fast) {
#pragma unroll
        for (int r = 0; r < 16; ++r) { s0[r] = __builtin_amdgcn_exp2f(s0[r] - sh); s1[r] = __builtin_amdgcn_exp2f(s1[r] - sh); rs += s0[r] + s1[r]; }
        if (!__all(laneok)) { if (!laneok) {
#pragma unroll
            for (int r = 0; r < 16; ++r) { s0[r] = 0.f; s1[r] = 0.f; }
            rs = 0.f; } }
    } else {
#pragma unroll
        for (int r = 0; r < 16; ++r) {
            s0[r] = (s0[r] > -1e29f) ? __builtin_amdgcn_exp2f(s0[r] - sh) : 0.f; s1[r] = (s1[r] > -1e29f) ? __builtin_amdgcn_exp2f(s1[r] - sh) : 0.f;
            rs += s0[r] + s1[r];
        }
    }
    rs += __shfl_xor(rs, 32);
    l_run += rs;
    const bf16x8 p00 = pack8(s0, 0), p01 = pack8(s0, 1), p10 = pack8(s1, 0), p11 = pack8(s1, 1);
#pragma unroll
    for (int dt = 0; dt < 2; ++dt) {
        const int d = 32 * dt + l31;
        O[dt] = __builtin_amdgcn_mfma_f32_32x32x16_bf16(*(const LAS bf16x8*)(vl + swz_off(d, 0 + hh)), p00, O[dt], 0, 0, 0);
        O[dt] = __builtin_amdgcn_mfma_f32_32x32x16_bf16(*(const LAS bf16x8*)(vl + swz_off(d, 2 + hh)), p01, O[dt], 0, 0, 0);
        O[dt] = __builtin_amdgcn_mfma_f32_32x32x16_bf16(*(const LAS bf16x8*)(vl + swz_off(d, 4 + hh)), p10, O[dt], 0, 0, 0);
        O[dt] = __builtin_amdgcn_mfma_f32_32x32x16_bf16(*(const LAS bf16x8*)(vl + swz_off(d, 6 + hh)), p11, O[dt], 0, 0, 0);
    }
}
DI void attn_sv_fast(f32x16& s0, f32x16& s1, const LAS unsigned char* vl, int key0, int tq, bool laneok, int tmin, const LAS float* bl, bool win, bool bound, float cb,
                     float& l_run, f32x16 (&O)[2], int l31, int hh) {
    const bool far = (tmin - (key0 + 63)) >= 128;
    float rs = 0.f;
    if (far && !bound) {
#pragma unroll
        for (int r = 0; r < 16; ++r) { s0[r] = __builtin_amdgcn_exp2f(s0[r]); s1[r] = __builtin_amdgcn_exp2f(s1[r]); }
        if (!__all(laneok)) {
#pragma unroll
            for (int r = 0; r < 16; ++r) { s0[r] = laneok ? s0[r] : 0.f; s1[r] = laneok ? s1[r] : 0.f; }
        }
    } else {
        int dbase = tq - key0; asm volatile("" : "+v"(dbase));
        const int dmax = win ? 512 : 0x7fffffff, dmin = bound ? 0 : -0x7fffffff;
        float b0[16], b1[16];
#pragma unroll
        for (int r = 0; r < 16; ++r) { const int d0_ = dbase - crow(r, hh), d1_ = d0_ - 32; b0[r] = bl[min(max(d0_, 0), 128)]; b1[r] = bl[min(max(d1_, 0), 128)]; }
#pragma unroll
        for (int r = 0; r < 16; ++r) asm volatile("" : "+v"(b0[r]), "+v"(b1[r]));
#pragma unroll
        for (int r = 0; r < 16; ++r) {
            const int d0_ = dbase - crow(r, hh), d1_ = d0_ - 32;
            const bool v0 = laneok && d0_ >= dmin && d0_ < dmax, v1 = laneok && d1_ >= dmin && d1_ < dmax;
            const float e0 = __builtin_amdgcn_exp2f(s0[r] + (b0[r] - cb)), e1 = __builtin_amdgcn_exp2f(s1[r] + (b1[r] - cb));
            s0[r] = v0 ? e0 : 0.f; s1[r] = v1 ? e1 : 0.f;
        }
    }
#pragma unroll
    for (int r = 0; r < 16; ++r) rs += s0[r] + s1[r];
    l_run += rs;
    const bf16x8 p00 = pack8(s0, 0), p01 = pack8(s0, 1), p10 = pack8(s1, 0), p11 = pack8(s1, 1);
#pragma unroll
    for (int dt = 0; dt < 2; ++dt) {
        const int d = 32 * dt + l31;
        O[dt] = __builtin_amdgcn_mfma_f32_32x32x16_bf16(*(const LAS bf16x8*)(vl + swz_off(d, 0 + hh)), p00, O[dt], 0, 0, 0);
        O[dt] = __builtin_amdgcn_mfma_f32_32x32x16_bf16(*(const LAS bf16x8*)(vl + swz_off(d, 2 + hh)), p01, O[dt], 0, 0, 0);
        O[dt] = __builtin_amdgcn_mfma_f32_32x32x16_bf16(*(const LAS bf16x8*)(vl + swz_off(d, 4 + hh)), p10, O[dt], 0, 0, 0);
        O[dt] = __builtin_amdgcn_mfma_f32_32x32x16_bf16(*(const LAS bf16x8*)(vl + swz_off(d, 6 + hh)), p11, O[dt], 0, 0, 0);
    }
}
DI float imp_sum(const LAS float* sL, const LAS float* cL, int q, int j) {
    float v = 0.f;
#pragma unroll
    for (int h4 = 0; h4 < 4; ++h4) { v += sL[(h4 * 64 + q) * 33 + j]; if (j > 0) v += cL[(h4 * 64 + q) * 33 + j]; }
    return v;
}
template <bool FAST>
DI void attn_stream(LAS unsigned char* lds, const bf16* ksel, const bf16* kwin, const bf16* vts, const bf16* vtw, unsigned U, unsigned mysel, int qt, int tq, int tmin,
                    const LAS float* bl, const bf16x8 (&qr)[4], const float (&g3)[3], LAS float* stash, f32x16 (&Ot)[2], int tid, int l31, int hh) {
    const int nsel = __builtin_popcount(U), w0 = qt > 8 ? qt - 8 : 0, ntile = nsel + (qt - w0 + 1);
    const int srow = tid >> 3, sch = tid & 7;
    unsigned rem = U;
    int jseq = 0;
    int jt = 0; bool wt = false;
#define NEXT_TILE() do { if (jseq < nsel) { jt = __builtin_ctz(rem); rem &= rem - 1; wt = false; } else { jt = w0 + (jseq - nsel); wt = true; } ++jseq; } while (0)
#define LOAD_TILE(KR, VR) do { KR = *(const u32x4*)((wt ? kwin : ksel) + (size_t)(64 * jt + srow) * LD_CAS + 8 * sch); \
                               VR = *(const u32x4*)((wt ? vtw : vts) + (size_t)jt * 4096 + srow * 64 + 8 * sch); } while (0)
    u32x4 kr0, vr0, kr1, vr1;
    NEXT_TILE(); int j0 = jt; bool wn0 = wt; LOAD_TILE(kr0, vr0);
    *(LAS u32x4*)(lds + A_STAGE + swz_off(srow, sch)) = kr0; *(LAS u32x4*)(lds + A_STAGE + 2 * A_TILE + swz_off(srow, sch)) = vr0;
    int j1 = 0; bool wn1 = false;
    if (ntile > 1) { NEXT_TILE(); j1 = jt; wn1 = wt; LOAD_TILE(kr0, vr0); }
    __syncthreads();
    float m_run = -1e30f, l_run = 0.f; f32x16 O[2]; O[0] = (f32x16){}; O[1] = (f32x16){};
    const float cbf = bl[128];
    f32x16 cinit;
#pragma unroll
    for (int r = 0; r < 16; ++r) cinit[r] = FAST ? cbf : 0.f;
#define TILE_ITER(I, KRA, VRA, KRB, VRB) do { \
        const int jc = j0; const bool wc = wn0; j0 = j1; wn0 = wn1; \
        if ((I) + 2 < ntile) { NEXT_TILE(); j1 = jt; wn1 = wt; LOAD_TILE(KRB, VRB); } \
        if ((I) == nsel) { if (FAST) l_run += __shfl_xor(l_run, 32); const float f_ = l_run > 0.f ? g3[1] / l_run : 0.f; \
            _Pragma("unroll") for (int dt = 0; dt < 2; ++dt) _Pragma("unroll") for (int r = 0; r < 16; ++r) { stash[(dt * 16 + r) * 64] += f_ * O[dt][r]; O[dt][r] = 0.f; } \
            m_run = -1e30f; l_run = 0.f; } \
        const LAS unsigned char* kl = lds + A_STAGE + ((I) & 1) * A_TILE; \
        const LAS unsigned char* vl = lds + A_STAGE + 2 * A_TILE + ((I) % 3) * A_TILE; \
        const bool ok_ = wc ? true : (bool)((mysel >> jc) & 1u); \
        if (__any(ok_)) { f32x16 s0, s1; attn_qk(s0, s1, kl, qr, cinit, l31, hh); \
            const bool bnd = wc ? (jc == qt || jc + 8 == qt) : (jc == qt); \
            if (FAST) attn_sv_fast(s0, s1, vl, 64 * jc, tq, ok_, tmin, bl, wc, bnd, cbf, l_run, O, l31, hh); \
            else attn_sv(s0, s1, vl, 64 * jc, tq, ok_, tmin, bl, wc, bnd, m_run, l_run, O, l31, hh); } \
        if ((I) + 1 < ntile) { *(LAS u32x4*)(lds + A_STAGE + (((I) + 1) & 1) * A_TILE + swz_off(srow, sch)) = KRA; \
                               *(LAS u32x4*)(lds + A_STAGE + 2 * A_TILE + (((I) + 1) % 3) * A_TILE + swz_off(srow, sch)) = VRA; } \
        asm volatile("s_waitcnt lgkmcnt(0)\n\ts_barrier" ::: "memory"); } while (0)
    for (int i = 0; i < ntile; i += 2) {
        TILE_ITER(i, kr0, vr0, kr1, vr1);
        if (i + 1 < ntile) TILE_ITER(i + 1, kr1, vr1, kr0, vr0);
    }
#undef TILE_ITER
#undef LOAD_TILE
#undef NEXT_TILE
    if (FAST) l_run += __shfl_xor(l_run, 32);
    const float f = l_run > 0.f ? g3[2] / l_run : 0.f;
#pragma unroll
    for (int dt = 0; dt < 2; ++dt)
#pragma unroll
        for (int r = 0; r < 16; ++r) Ot[dt][r] = stash[(dt * 16 + r) * 64] + f * O[dt][r];
}
DI void phase4(const Params& p, LAS unsigned char* lds) {
    const int tid0 = threadIdx.x, wave = __builtin_amdgcn_readfirstlane(tid0 >> 6);
    const int hp = wave & 3, qh = wave >> 2;
    const bf16* cas = (const bf16*)(p.ws + WS_CAS);
    LAS float* biasL = (LAS float*)lds;
    LAS float* sL = (LAS float*)(lds + 4608);
    LAS float* cL = (LAS float*)(lds + 4608 + 33792);
    LAS unsigned* selL = (LAS unsigned*)(lds + 4608 + 2 * 33792);
    LAS unsigned* uL = selL + 64;
    LAS float* impT = (LAS float*)(lds + 4608 + 2 * 33792 + 512);
    LAS float* auxL = (LAS float*)(lds + 81152);
    for (int i = tid0; i < 8 * 132; i += 512) biasL[i] = ((const float*)(p.ws + WS_BIAS))[i];
    if (tid0 == 0) uL[0] = 0u;
    __syncthreads();
    if (tid0 < 8) { float bm = 0.f; for (int d = 0; d <= 128; ++d) bm = fmaxf(bm, fabsf(biasL[tid0 * 132 + d])); auxL[tid0] = bm; }
    if (tid0 == 8 || tid0 == 9) { float gm = 0.f; for (int d = 0; d < 64; ++d) gm = fmaxf(gm, fabsf(p.k_norm_gain[(tid0 - 7) * 64 + d])); auxL[tid0] = gm; }
    if (tid0 == 10) { float gm = 0.f; for (int d = 0; d < 64; ++d) gm = fmaxf(gm, fabsf(p.q_norm_gain[d])); auxL[10] = gm; }
    __syncthreads();
    bool fastmode;
    { float bm = 0.f;
#pragma unroll
      for (int hq = 0; hq < 8; ++hq) bm = fmaxf(bm, auxL[hq]);
      fastmode = (8.1f * auxL[10] * QSCALE) * (8.1f * fmaxf(auxL[8], auxL[9])) + bm <= 96.f; }
    unsigned* qctr = (unsigned*)(p.ws + WS_CTL) + 8192 + 64 * (blockIdx.x & 7);
    for (;;) {
        if (tid0 == 0) uL[1] = atomicAdd(qctr, 1u);
        __syncthreads();
        const unsigned qi = uL[1];
        __syncthreads();
        if (qi >= 128u) break;
        int tid = tid0; asm volatile("" : "+v"(tid));
        const int lane = tid & 63, l31 = lane & 31, hh = lane >> 5;
        const int qt = 31 - (int)(qi & 31), bg = (blockIdx.x & 7) + 8 * (int)(qi >> 5);
        const int b = bg >> 1, g = bg & 1, head = g * 4 + hp, t0 = 64 * qt, tmin = t0 + 32 * qh, tq = tmin + l31;
        const size_t m = (size_t)b * SEQ + tq;
        const LAS float* bl = biasL + head * 132;
        bf16x8 qr[4];
#pragma unroll
        for (int d0 = 0; d0 < 4; ++d0) qr[d0] = *(const bf16x8*)(cas + m * LD_CAS + Q0 + head * 64 + 16 * d0 + 8 * hh);
        float g3[3];
#pragma unroll
        for (int br = 0; br < 3; ++br) g3[br] = sigmoidf_(bf2f(cas[m * LD_CAS + GATE0 + br * 8 + head]));
        f32x16 Ot[2]; Ot[0] = (f32x16){}; Ot[1] = (f32x16){};
        {
            const bf16* kcb = (const bf16*)(p.ws + WS_KC) + (size_t)bg * 128 * 64;
            const bf16* vcb = (const bf16*)(p.ws + WS_VCT) + (size_t)bg * 64 * 128;
            f32x16 sc[4];
#pragma unroll
            for (int kt = 0; kt < 4; ++kt) { sc[kt] = (f32x16){};
#pragma unroll
                for (int d0 = 0; d0 < 4; ++d0) sc[kt] = __builtin_amdgcn_mfma_f32_32x32x16_bf16(*(const bf16x8*)(kcb + (size_t)(32 * kt + l31) * 64 + 16 * d0 + 8 * hh), qr[d0], sc[kt], 0, 0, 0); }
            float mc = -1e30f;
#pragma unroll
            for (int kt = 0; kt < 4; ++kt) {
                float bv[16];
#pragma unroll
                for (int r = 0; r < 16; ++r) { const int n = 32 * kt + crow(r, hh), dist = tq - 16 * n - 31; bv[r] = bl[min(max(dist, 0), 128)]; }
#pragma unroll
                for (int r = 0; r < 16; ++r) asm volatile("" : "+v"(bv[r]));
#pragma unroll
                for (int r = 0; r < 16; ++r) { const int n = 32 * kt + crow(r, hh), dist = tq - 16 * n - 31; const bool ok = dist >= 0 && n < 127;
                    sc[kt][r] = ok ? sc[kt][r] + bv[r] : -1e30f; mc = fmaxf(mc, sc[kt][r]); }
            }
            mc = fmaxf(mc, __shfl_xor(mc, 32));
            float lc = 0.f;
#pragma unroll
            for (int kt = 0; kt < 4; ++kt)
#pragma unroll
                for (int r = 0; r < 16; ++r) { sc[kt][r] = (sc[kt][r] > -1e29f) ? __builtin_amdgcn_exp2f(sc[kt][r] - mc) : 0.f; lc += sc[kt][r]; }
            lc += __shfl_xor(lc, 32);
            const float inv = lc > 0.f ? 1.f / lc : 0.f;
            const int q = 32 * qh + l31;
#pragma unroll
            for (int kt = 0; kt < 4; ++kt) {
#pragma unroll
                for (int r = 0; r < 16; ++r) sc[kt][r] *= inv;
#pragma unroll
                for (int g4 = 0; g4 < 4; ++g4) { const int j = 8 * kt + 2 * g4 + hh;
                    sL[(hp * 64 + q) * 33 + j] = 2.f * (sc[kt][4 * g4] + sc[kt][4 * g4 + 1] + sc[kt][4 * g4 + 2]) + sc[kt][4 * g4 + 3];
                    cL[(hp * 64 + q) * 33 + j + 1] = sc[kt][4 * g4 + 3]; }
            }
            f32x16 oc[2]; oc[0] = (f32x16){}; oc[1] = (f32x16){};
#pragma unroll
            for (int dt = 0; dt < 2; ++dt)
#pragma unroll
                for (int kt = 0; kt < 4; ++kt)
#pragma unroll
                    for (int s = 0; s < 2; ++s)
                        oc[dt] = __builtin_amdgcn_mfma_f32_32x32x16_bf16(*(const bf16x8*)(vcb + (size_t)(32 * dt + l31) * 128 + 32 * kt + 16 * s + 8 * hh), pack8(sc[kt], s), oc[dt], 0, 0, 0);
#pragma unroll
            for (int dt = 0; dt < 2; ++dt)
#pragma unroll
                for (int r = 0; r < 16; ++r) Ot[dt][r] = g3[0] * oc[dt][r];
        }
        __syncthreads();
        {
            const int q = tid >> 3, sub = tid & 7;
            unsigned mask = 0u;
            if (qt < 16) mask = (2u << qt) - 1u;
            else {
#pragma unroll
                for (int i2 = 0; i2 < 4; ++i2) impT[q * 33 + sub + 8 * i2] = imp_sum(sL, cL, q, sub + 8 * i2);
                __syncthreads();
                float vj[4]; int rank[4];
#pragma unroll
                for (int i2 = 0; i2 < 4; ++i2) { vj[i2] = impT[q * 33 + sub + 8 * i2]; rank[i2] = 0; }
#pragma unroll 2
                for (int jj = 1; jj <= qt - 2; ++jj) {
                    const float vv = impT[q * 33 + jj];
#pragma unroll
                    for (int i2 = 0; i2 < 4; ++i2) { const int j = sub + 8 * i2;
                        rank[i2] += (int)((jj != j) & ((vv > vj[i2]) | ((vv == vj[i2]) & (jj < j)))); }
                }
#pragma unroll
                for (int i2 = 0; i2 < 4; ++i2) { const int j = sub + 8 * i2;
                    const bool forced = (j == 0) || (j == qt) || (j == qt - 1), cand = (j >= 1) && (j <= qt - 2);
                    if (forced || (cand && rank[i2] < 13)) mask |= 1u << j; }
                mask |= __shfl_xor(mask, 1); mask |= __shfl_xor(mask, 2); mask |= __shfl_xor(mask, 4);
            }
            if (sub == 0) { selL[q] = mask; __hip_atomic_fetch_or(uL, mask, __ATOMIC_RELAXED, __HIP_MEMORY_SCOPE_WORKGROUP); }
        }
        __syncthreads();
        const unsigned mysel = selL[32 * qh + l31], U = uL[0];
        LAS float* stash = (LAS float*)(lds + 4608 + wave * 8192) + lane;
#pragma unroll
        for (int dt = 0; dt < 2; ++dt)
#pragma unroll
            for (int r = 0; r < 16; ++r) stash[(dt * 16 + r) * 64] = Ot[dt][r];
        {
            const bf16* ksel = cas + (size_t)(b * SEQ) * LD_CAS + KS0 + g * 64; const bf16* kwin = cas + (size_t)(b * SEQ) * LD_CAS + KW0 + g * 64;
            const bf16* vts = (const bf16*)(p.ws + WS_VTS) + (size_t)bg * 32 * 4096; const bf16* vtw = (const bf16*)(p.ws + WS_VTW) + (size_t)bg * 32 * 4096;
            if (fastmode) attn_stream<true>(lds, ksel, kwin, vts, vtw, U, mysel, qt, tq, tmin, bl, qr, g3, stash, Ot, tid, l31, hh);
            else attn_stream<false>(lds, ksel, kwin, vts, vtw, U, mysel, qt, tq, tmin, bl, qr, g3, stash, Ot, tid, l31, hh);
        }
        u32x2 aw[2][4];
#pragma unroll
        for (int dt = 0; dt < 2; ++dt)
#pragma unroll
            for (int g4 = 0; g4 < 4; ++g4) aw[dt][g4] = *(const u32x2*)(cas + m * LD_CAS + ASILU0 + head * 64 + 32 * dt + 8 * g4 + 4 * hh);
        asm volatile("s_waitcnt lgkmcnt(0)\n\ts_barrier" ::: "memory");
#pragma unroll
        for (int dt = 0; dt < 2; ++dt)
#pragma unroll
            for (int g4 = 0; g4 < 4; ++g4) asm volatile("" : "+v"(aw[dt][g4]));
#pragma unroll
        for (int dt = 0; dt < 2; ++dt)
#pragma unroll
            for (int g4 = 0; g4 < 4; ++g4) {
                const int col = head * 64 + 32 * dt + 8 * g4 + 4 * hh;
                u32x2 w; w.x = pk2(Ot[dt][4 * g4] * siluf_(bflo(aw[dt][g4].x)), Ot[dt][4 * g4 + 1] * siluf_(bfhi(aw[dt][g4].x)));
                w.y = pk2(Ot[dt][4 * g4 + 2] * siluf_(bflo(aw[dt][g4].y)), Ot[dt][4 * g4 + 3] * siluf_(bfhi(aw[dt][g4].y)));
                *(u32x2*)((bf16*)(p.ws + WS_YA) + m * 512 + col) = w;
            }
        if (tid == 0) uL[0] = 0u;
    }
}
DI void phase3(const Params& p, LAS unsigned char* lds) { phase3a(p, lds); phase3b(p, lds); phase3c(p, lds); }


#define XB_TMO      128
#define XB_XCNT(j)  (256  + 64 * (j))
#define XB_XSUB(j)  (1280 + 64 * (j))
#define XB_XGEN(j)  (2304 + 64 * (j))
#define XB_TOP      3328
#define XB_TOPGEN   3392
#define XCD_BAR_WORDS 3456
#define XB_SPIN_CAP (1u << 22)
DI unsigned xb_ld(unsigned* p)              { return __hip_atomic_load(p, __ATOMIC_RELAXED, __HIP_MEMORY_SCOPE_AGENT); }
DI unsigned xb_add(unsigned* p, unsigned v) { return __hip_atomic_fetch_add(p, v, __ATOMIC_RELAXED, __HIP_MEMORY_SCOPE_AGENT); }
DI unsigned xb_xcc_id() { return (unsigned)__builtin_amdgcn_s_getreg((3 << 11) | 20) & 0xFu; }
#define XB_SPIN(cond, bar) do { unsigned _sp = 0; while (cond) { __builtin_amdgcn_s_sleep(1); \
    if ((++_sp & 255u) == 0u) { if (xb_ld(&(bar)[XB_TMO])) break; if (_sp > XB_SPIN_CAP) { atomicAdd(&(bar)[XB_TMO], 1u); break; } } } } while (0)
struct XcdBarrier { unsigned* bar; unsigned x; volatile LAS unsigned* st; };
DI XcdBarrier xcd_barrier_post(unsigned* bar, volatile LAS unsigned* st) {
    XcdBarrier b; b.bar = bar; b.x = xb_xcc_id(); b.st = st;
    if (threadIdx.x == 0) (void)xb_add(&bar[XB_XCNT(b.x)], 1u);
    return b;
}
DI void xcd_barrier_complete(unsigned* bar, unsigned x, unsigned& nloc, unsigned& nx) {
    const unsigned G = gridDim.x * gridDim.y * gridDim.z;
    unsigned sum, cnt, mine, sp = 0u;
    for (;;) {
        sum = 0u; cnt = 0u; mine = 0u;
#pragma unroll
        for (unsigned j = 0; j < 16; ++j) { const unsigned c = xb_ld(&bar[XB_XCNT(j)]); sum += c; cnt += (c > 0u) ? 1u : 0u; mine = (j == x) ? c : mine; }
        if (sum == G) break;
        __builtin_amdgcn_s_sleep(1);
        if ((++sp & 255u) == 0u) { if (xb_ld(&bar[XB_TMO])) break; if (sp > XB_SPIN_CAP) { atomicAdd(&bar[XB_TMO], 1u); break; } }
    }
    nloc = mine > 0u ? mine : 1u; nx = cnt > 0u ? cnt : 1u;
}
DI void xcd_barrier(const XcdBarrier& b) {
    asm volatile("s_waitcnt vmcnt(0)" ::: "memory");
    __syncthreads();
    if (threadIdx.x == 0) {
        unsigned* bar = b.bar;
        __builtin_amdgcn_s_waitcnt(0);
        unsigned nloc = b.st[0], nx = b.st[1];
        if (nloc == 0u) { xcd_barrier_complete(bar, b.x, nloc, nx); b.st[0] = nloc; b.st[1] = nx; }
        const unsigned old = xb_add(&bar[XB_XSUB(b.x)], 1u);
        const unsigned gen = old / nloc;
        if (old + 1u == (gen + 1u) * nloc) {
            __builtin_amdgcn_fence(__ATOMIC_RELEASE, "agent");
            asm volatile("s_waitcnt vmcnt(0)" ::: "memory");
            const unsigned og = xb_add(&bar[XB_TOP], 1u);
            const unsigned tg = og / nx;
            if (og + 1u == (tg + 1u) * nx) xb_add(&bar[XB_TOPGEN], 1u);
            else XB_SPIN(xb_ld(&bar[XB_TOPGEN]) == tg, bar);
            __builtin_amdgcn_fence(__ATOMIC_ACQUIRE, "agent");
            xb_add(&bar[XB_XGEN(b.x)], 1u);
            asm volatile("s_waitcnt vmcnt(0)" ::: "memory");
        } else {
            XB_SPIN(xb_ld(&bar[XB_XGEN(b.x)]) == gen, bar);
            __builtin_amdgcn_fence(__ATOMIC_ACQUIRE, "agent");
            asm volatile("s_waitcnt vmcnt(0)" ::: "memory");
        }
    }
    __syncthreads();
}

__global__ void __launch_bounds__(512, 2) hybrid_fwd(Params p) {
    extern __shared__ __attribute__((aligned(16))) unsigned char lds_raw[];
    LAS unsigned char* lds = (LAS unsigned char*)lds_raw;
#if USE_CG_SYNC
    cg::grid_group grid = cg::this_grid();
#define GRID_BAR() grid.sync()
#else
    volatile LAS unsigned* bst = (volatile LAS unsigned*)(lds + LDS_BYTES - 64);
    if (threadIdx.x < 2) bst[threadIdx.x] = 0u;
    __syncthreads();
    const XcdBarrier xbar = xcd_barrier_post((unsigned*)(p.ws + WS_CTL) + 1024, bst);
#define GRID_BAR() xcd_barrier(xbar)
#endif
    const int lo = p.ph_lo, hi = p.ph_hi;
#ifdef ONLYP
#define IN(k) ((k) == ONLYP && lo <= (k) && (k) < hi)
#else
#define IN(k) (lo <= (k) && (k) < hi)
#endif
#define SEAM(k) do { if (IN(k) && IN((k) + 1)) GRID_BAR(); } while (0)
    unsigned char* ws = p.ws;
    if (IN(0)) { phase0(p, lds); }
    SEAM(0);
    if (IN(1)) { phase1(p, lds); phase0w(p, lds); }
    SEAM(1);
    if (IN(2)) {
        pg8::Gemm g{(const bf16*)((unsigned char*)p.out + OUT_H), (const bf16*)(ws + WS_WIN_T), MTOK, N_IN_PAD, DM, DM, DM};
        pg8::StaticOrder S; S.init(MTOK, N_IN_PAD, gridDim.x, blockIdx.x);
        EpiInProj E{(bf16*)(ws + WS_CAS), (bf16*)(ws + WS_CR)};
        pg8::gemm_phase<EpiInProj, pg8::StaticOrder>(lds, g, S, E);
    }
    SEAM(2);
    if (IN(3)) { phase3(p, lds); }
    SEAM(3);
    if (IN(4)) { phase5a(p); phase4(p, lds); __syncthreads(); phase5b(p, lds); }
    SEAM(5);
    if (IN(6)) {
        { pg8::Gemm g{(const bf16*)(ws + WS_YA), (const bf16*)(ws + WS_WA_T), MTOK, DM, 512, 512, 512};
          pg8::StaticOrder S; S.init(MTOK, DM, gridDim.x, blockIdx.x);
          EpiGate<0> E{(bf16*)(ws + WS_MERGED), (const bf16*)(ws + WS_CR)};
          pg8::gemm_phase<EpiGate<0>, pg8::StaticOrder>(lds, g, S, E); }
        { pg8::Gemm g{(const bf16*)(ws + WS_YB), (const bf16*)(ws + WS_WB_T), MTOK, DM, 512, 512, 512};
          pg8::StaticOrder S; S.init(MTOK, DM, gridDim.x, blockIdx.x);
          EpiGate<1> E{(bf16*)(ws + WS_MERGED), (const bf16*)(ws + WS_CR)};
          pg8::gemm_phase<EpiGate<1>, pg8::StaticOrder>(lds, g, S, E); }
    }
    SEAM(6);
    if (IN(7)) {
        pg8::Gemm g{(const bf16*)(ws + WS_MERGED), (const bf16*)(ws + WS_WO_T), MTOK, DM, DM, DM, DM};
        pg8::StaticOrder S; S.init(MTOK, DM, gridDim.x, blockIdx.x);
        EpiFinal E{p.x, (const float*)(ws + WS_MOD), p.out};
        pg8::gemm_phase<EpiFinal, pg8::StaticOrder>(lds, g, S, E);
    }
#undef IN
#undef SEAM
}

extern "C" void kernel_launch(void* const* d_in, const int* in_sizes, int n_in, void* d_out, int out_size, void* d_ws, size_t ws_size, hipStream_t stream) {
    static int grid = 0;
    if (grid == 0) {
        if (n_in != 28 || out_size != MTOK * DM || ws_size < WS_END) { fprintf(stderr, "kernel_launch: unexpected shapes (n_in %d out %d ws %zu)\n", n_in, out_size, ws_size); grid = -1; return; }
        int dev = 0, cus = 0, per_cu = 0;
        (void)hipGetDevice(&dev); (void)hipDeviceGetAttribute(&cus, hipDeviceAttributeMultiprocessorCount, dev);
        if (hipFuncSetAttribute((const void*)hybrid_fwd, hipFuncAttributeMaxDynamicSharedMemorySize, LDS_BYTES) != hipSuccess) { fprintf(stderr, "kernel_launch: hipFuncSetAttribute failed\n"); grid = -1; return; }
        if (hipOccupancyMaxActiveBlocksPerMultiprocessor(&per_cu, (const void*)hybrid_fwd, 512, LDS_BYTES) != hipSuccess || per_cu < 1) { fprintf(stderr, "kernel_launch: occupancy query says %d\n", per_cu); per_cu = 1; }
        (void)hipGetLastError();
        grid = cus * 1;
        if (grid <= 0) grid = 256;
    }
    if (grid < 0) return;
    (void)hipMemsetAsync((char*)d_ws + WS_CTL, 0, CTL_ZERO_BYTES, stream);
    Params p{};
    const float** pp = (const float**)&p;
    for (int i = 0; i < 28; ++i) pp[i] = (const float*)d_in[i];
    p.out = (float*)d_out; p.ws = (unsigned char*)d_ws;
#if MK_LAUNCHES == 1
    p.ph_lo = 0; p.ph_hi = 8;
    void* args[] = {&p};
    hipError_t e = hipLaunchCooperativeKernel((const void*)hybrid_fwd, dim3(grid), dim3(512), args, LDS_BYTES, stream);
    if (e != hipSuccess) fprintf(stderr, "cooperative launch failed: %s (grid %d)\n", hipGetErrorString(e), grid);
#else
    const int cuts[][2] = {{0, 1}, {1, 2}, {2, 3}, {3, 4}, {4, 5}, {5, 6}, {6, 7}, {7, 8}};
    for (int li = 0; li < 8; ++li) {
        p.ph_lo = cuts[li][0]; p.ph_hi = cuts[li][1];
        hipLaunchKernelGGL(hybrid_fwd, dim3(grid), dim3(512), LDS_BYTES, stream, p);
    }
#endif
}
```

```cpp
#include <hip/hip_runtime.h>
#include <hip/hip_cooperative_groups.h>
#include <cstdio>
#include <cstdint>
namespace cg = cooperative_groups;

#ifndef USE_CG_SYNC
#define USE_CG_SYNC 0
#endif
#ifndef MK_LAUNCHES
#define MK_LAUNCHES 1
#endif

#define DI __device__ __forceinline__
#define LAS __attribute__((address_space(3)))
typedef unsigned short bf16;
typedef short bf16x8 __attribute__((ext_vector_type(8)));
typedef short s16x4 __attribute__((ext_vector_type(4)));
typedef float f32x2 __attribute__((ext_vector_type(2)));
typedef float f32x4 __attribute__((ext_vector_type(4)));
typedef float f32x16 __attribute__((ext_vector_type(16)));
typedef unsigned u32x2 __attribute__((ext_vector_type(2)));
typedef unsigned u32x4 __attribute__((ext_vector_type(4)));
typedef __bf16 bf16x2_t __attribute__((ext_vector_type(2)));

namespace pg8 {
typedef unsigned short bf16_t;
constexpr int BM = 256, BK = 64, HALF = 128, HTB = HALF * BK * 2, STAGE_BYTES = 8 * HTB, NXCD = 8, WGM = 8;
__host__ __device__ __forceinline__ int lds_byte(int r, int c) { const int st = (r >> 4) * 2 + (c >> 5), rr = r & 15, cc = c & 31, ob = rr * 64 + cc * 2; return st * 1024 + (ob ^ (((ob >> 9) & 1) << 5)); }
__host__ __device__ __forceinline__ void stage_rc(int b, int& R, int& C) { const int st = b / 1024, sb = b % 1024, swz = sb ^ (((sb >> 9) & 1) << 5); R = (st >> 1) * 16 + swz / 64; C = (st & 1) * 32 + (swz % 64) / 2; }
__host__ __device__ __forceinline__ int perm32(int rho) { const int n = rho >> 4, i = rho & 15; return 8 * (i >> 2) + 4 * n + (i & 3); }
struct Unit { int pm, pn; };
struct Gemm { const bf16_t* A; const bf16_t* Bt; int M, N, K, lda, ldb; };
struct StaticOrder {
    int nM, nN, nwg, G, c;
    __host__ __device__ void init(int M, int N, int G_, int c_) { nM = M / BM; nN = N / BM; nwg = nM * nN; G = G_; c = c_; }
    __host__ __device__ bool next(int i, Unit& u) const {
        const long L = (long)i * G + c; if (L >= nwg) return false;
        int wgid = (int)L; { const int q = nwg / NXCD, r = nwg % NXCD, xcd = wgid % NXCD, off = wgid / NXCD; wgid = (xcd < r ? xcd * (q + 1) : r * (q + 1) + (xcd - r) * q) + off; }
        const int nig = WGM * nN, gid = wgid / nig, fm = gid * WGM, gsz = (nM - fm) < WGM ? (nM - fm) : WGM;
        u.pm = fm + ((wgid % nig) % gsz); u.pn = (wgid % nig) / gsz; return true;
    }
};
__device__ __forceinline__ unsigned cvt_pk_bf16(float lo, float hi) { unsigned r; asm volatile("v_cvt_pk_bf16_f32 %0, %1, %2" : "=v"(r) : "v"(lo), "v"(hi)); return r; }

template <class Epi, class Sched, bool ALIGN_EPI = true, bool SP2 = true>
__device__ __forceinline__ void gemm_phase(LAS unsigned char* lds, const Gemm g, const Sched& S, const Epi& E) {
    const int tid = threadIdx.x, wid = __builtin_amdgcn_readfirstlane(tid >> 6), lane = tid & 63, wr = wid >> 2, wc = wid & 3, fr = lane & 15, fq = lane >> 4;
    const int K = g.K, nt = K / BK;
    unsigned voffA[2], voffB[2];
#pragma unroll
    for (int i = 0; i < 2; ++i) { int R, C; stage_rc(tid * 16 + i * 8192, R, C); const int Rb = Epi::PERM ? ((R & ~31) + perm32(R & 31)) : R;
        voffA[i] = (unsigned)(R * g.lda + C) * 2u; voffB[i] = (unsigned)(Rb * g.ldb + C) * 2u; }
    const size_t kstep = (size_t)(BK * 2);
    const size_t hstepA = (size_t)HALF * g.lda * 2, hstepB = (size_t)HALF * g.ldb * 2;
    const size_t tstepA = 2 * hstepA, tstepB = 2 * hstepB;
    const unsigned ldsw = (unsigned)wid * 1024u;
    const int aoff = lds_byte(wr * 64 + fr, fq * 8), boff = lds_byte(wc * 32 + fr, fq * 8);
#define PG8_SA(b, h) (((b) * 2 + (h)) * HTB)
#define PG8_SB(b, h) ((4 + (b) * 2 + (h)) * HTB)
#define PG8_STAGE(bufoff, gbase, voff) do { _Pragma("unroll") for (int _i = 0; _i < 2; ++_i) \
        __builtin_amdgcn_global_load_lds((const unsigned*)((const char*)(gbase) + (voff)[_i]), (LAS unsigned*)(lds + (bufoff) + ldsw + _i * 8192), 16, 0, 0); } while (0)
#define PG8_LDA(dst, b, h) do { _Pragma("unroll") for (int m = 0; m < 4; ++m) _Pragma("unroll") for (int k = 0; k < 2; ++k) dst[m][k] = *(const LAS bf16x8*)(lds + PG8_SA(b, h) + aoff + m * 2048 + k * 1024); } while (0)
#define PG8_LDB(dst, b, h) do { _Pragma("unroll") for (int n = 0; n < 2; ++n) _Pragma("unroll") for (int k = 0; k < 2; ++k) dst[n][k] = *(const LAS bf16x8*)(lds + PG8_SB(b, h) + boff + n * 2048 + k * 1024); } while (0)
#define PG8_MMA(ai, bj, At, Bt) do { __builtin_amdgcn_s_setprio(1); _Pragma("unroll") for (int m = 0; m < 4; ++m) _Pragma("unroll") for (int n = 0; n < 2; ++n) _Pragma("unroll") for (int k = 0; k < 2; ++k) \
        acc[ai][bj][m][n] = __builtin_amdgcn_mfma_f32_16x16x32_bf16(Bt[n][k], At[m][k], acc[ai][bj][m][n], 0, 0, 0); __builtin_amdgcn_s_setprio(0); } while (0)
#define PG8_WAIT_V(n) asm volatile("s_waitcnt vmcnt(" #n ")" ::: "memory")
#define PG8_WAIT_L(n) asm volatile("s_waitcnt lgkmcnt(" #n ")" ::: "memory")
#define PG8_BAR __builtin_amdgcn_s_barrier()
#define PG8_SCHED __builtin_amdgcn_sched_barrier(0)
    Unit cur, nxt; int ui = 0;
    if (!S.next(0, cur)) return;
    f32x4 acc[2][2][4][2];
#pragma unroll
    for (int a = 0; a < 2; ++a)
#pragma unroll
        for (int b = 0; b < 2; ++b)
#pragma unroll
            for (int m = 0; m < 4; ++m)
#pragma unroll
                for (int n = 0; n < 2; ++n) acc[a][b][m][n] = (f32x4){0.f, 0.f, 0.f, 0.f};
    bf16x8 At[4][2], B0[2][2], B1[2][2];
    const char* cA = (const char*)g.A + (size_t)cur.pm * tstepA; const char* cB = (const char*)g.Bt + (size_t)cur.pn * tstepB;
    if constexpr (SP2) {
        PG8_STAGE(PG8_SB(0, 0), cB, voffB); PG8_STAGE(PG8_SB(0, 1), cB + hstepB, voffB); PG8_STAGE(PG8_SA(0, 0), cA, voffA); PG8_STAGE(PG8_SA(0, 1), cA + hstepA, voffA);
        if (wr == 1) PG8_BAR;
        PG8_WAIT_V(2); PG8_BAR;
        PG8_STAGE(PG8_SB(1, 0), cB + kstep, voffB); PG8_STAGE(PG8_SA(1, 0), cA + kstep, voffA); PG8_STAGE(PG8_SB(1, 1), cB + hstepB + kstep, voffB);
        PG8_WAIT_V(6); PG8_BAR;
    } else {
        PG8_STAGE(PG8_SB(0, 0), cB, voffB); PG8_STAGE(PG8_SA(0, 0), cA, voffA); PG8_STAGE(PG8_SB(0, 1), cB + hstepB, voffB); PG8_STAGE(PG8_SA(0, 1), cA + hstepA, voffA);
        if (wr == 1) PG8_BAR;
        PG8_WAIT_V(4); PG8_BAR;
        PG8_STAGE(PG8_SB(1, 0), cB + kstep, voffB); PG8_STAGE(PG8_SA(1, 0), cA + kstep, voffA); PG8_STAGE(PG8_SB(1, 1), cB + hstepB + kstep, voffB);
        PG8_WAIT_V(6); PG8_BAR;
    }
    for (;;) {
        const bool has_next = S.next(ui + 1, nxt);
        const char* nA = has_next ? (const char*)g.A + (size_t)nxt.pm * tstepA : cA; const char* nB = has_next ? (const char*)g.Bt + (size_t)nxt.pn * tstepB : cB;
        for (int t = 0; t < nt; t += 2) {
            const bool last = (t == nt - 2);
            const char* a1 = cA + (size_t)(t + 1) * kstep;
            const char* a2 = last ? nA : cA + (size_t)(t + 2) * kstep; const char* b2 = last ? nB : cB + (size_t)(t + 2) * kstep;
            const char* a3 = a2 + kstep; const char* b3 = b2 + kstep;
            if constexpr (SP2) {
            PG8_LDB(B0, 0, 0); PG8_LDB(B1, 0, 1); PG8_SCHED; PG8_LDA(At, 0, 0); PG8_STAGE(PG8_SA(1, 1), a1 + hstepA, voffA);
            PG8_WAIT_V(8); PG8_WAIT_L(0); PG8_BAR; PG8_MMA(0, 0, At, B0); PG8_MMA(0, 1, At, B1); PG8_BAR; PG8_SCHED;
            PG8_LDA(At, 0, 1); PG8_STAGE(PG8_SB(0, 0), b2, voffB); PG8_STAGE(PG8_SB(0, 1), b2 + hstepB, voffB); PG8_STAGE(PG8_SA(0, 0), a2, voffA);
            PG8_WAIT_V(8); PG8_WAIT_L(0); PG8_BAR; PG8_MMA(1, 0, At, B0); PG8_MMA(1, 1, At, B1); PG8_BAR; PG8_SCHED;
            PG8_LDB(B0, 1, 0); PG8_LDB(B1, 1, 1); PG8_SCHED; PG8_LDA(At, 1, 0); PG8_STAGE(PG8_SA(0, 1), a2 + hstepA, voffA);
            PG8_WAIT_V(8); PG8_WAIT_L(0); PG8_BAR; PG8_MMA(0, 0, At, B0); PG8_MMA(0, 1, At, B1); PG8_BAR; PG8_SCHED;
            PG8_LDA(At, 1, 1); PG8_STAGE(PG8_SB(1, 0), b3, voffB); PG8_STAGE(PG8_SB(1, 1), b3 + hstepB, voffB); PG8_STAGE(PG8_SA(1, 0), a3, voffA);
            PG8_WAIT_V(8); PG8_WAIT_L(0); PG8_BAR; PG8_MMA(1, 0, At, B0); PG8_MMA(1, 1, At, B1); PG8_BAR; PG8_SCHED;
            } else {
            PG8_LDB(B0, 0, 0); PG8_SCHED; PG8_LDA(At, 0, 0); PG8_STAGE(PG8_SA(1, 1), a1 + hstepA, voffA);
            PG8_WAIT_L(8); PG8_BAR; PG8_WAIT_L(0); PG8_MMA(0, 0, At, B0); PG8_BAR; PG8_SCHED;
            PG8_LDB(B1, 0, 1); PG8_STAGE(PG8_SB(0, 0), b2, voffB);
            PG8_BAR; PG8_WAIT_L(0); PG8_MMA(0, 1, At, B1); PG8_BAR;
            PG8_LDA(At, 0, 1); PG8_STAGE(PG8_SA(0, 0), a2, voffA);
            PG8_BAR; PG8_WAIT_L(0); PG8_MMA(1, 0, At, B0); PG8_BAR; PG8_SCHED;
            PG8_STAGE(PG8_SB(0, 1), b2 + hstepB, voffB);
            PG8_WAIT_V(6); PG8_BAR; PG8_MMA(1, 1, At, B1); PG8_BAR;
            PG8_LDB(B0, 1, 0); PG8_SCHED; PG8_LDA(At, 1, 0); PG8_STAGE(PG8_SA(0, 1), a2 + hstepA, voffA);
            PG8_WAIT_L(8); PG8_BAR; PG8_WAIT_L(0); PG8_MMA(0, 0, At, B0); PG8_BAR; PG8_SCHED;
            PG8_LDB(B1, 1, 1); PG8_STAGE(PG8_SB(1, 0), b3, voffB);
            PG8_BAR; PG8_WAIT_L(0); PG8_MMA(0, 1, At, B1); PG8_BAR;
            PG8_LDA(At, 1, 1); PG8_STAGE(PG8_SA(1, 0), a3, voffA);
            PG8_BAR; PG8_WAIT_L(0); PG8_MMA(1, 0, At, B0); PG8_BAR; PG8_SCHED;
            PG8_STAGE(PG8_SB(1, 1), b3 + hstepB, voffB);
            PG8_WAIT_V(6); PG8_BAR; PG8_MMA(1, 1, At, B1); PG8_BAR;
            }
        }
        if constexpr (ALIGN_EPI) { if (wr == 0) PG8_BAR; }
        E(acc, cur, wr, wc, fr, fq);
        if (!has_next) break;
#pragma unroll
        for (int a = 0; a < 2; ++a)
#pragma unroll
            for (int b = 0; b < 2; ++b)
#pragma unroll
                for (int m = 0; m < 4; ++m)
#pragma unroll
                    for (int n = 0; n < 2; ++n) acc[a][b][m][n] = (f32x4){0.f, 0.f, 0.f, 0.f};
        cur = nxt; cA = nA; cB = nB; ++ui;
        if constexpr (ALIGN_EPI) { if (wr == 1) PG8_BAR; }
    }
    PG8_WAIT_V(0);
    if constexpr (!ALIGN_EPI) { if (wr == 0) PG8_BAR; }
    PG8_BAR;
#undef PG8_SA
#undef PG8_SB
#undef PG8_STAGE
#undef PG8_LDA
#undef PG8_LDB
#undef PG8_MMA
#undef PG8_WAIT_V
#undef PG8_WAIT_L
#undef PG8_BAR
#undef PG8_SCHED
}
}

constexpr int NB = 16, SEQ = 2048, DM = 1024, MTOK = NB * SEQ;
constexpr int LD_CAS = 3584, LD_CR = 2560, N_IN_PAD = 6144, N_IN = 6040;
constexpr int Q0 = 0, KC0 = 512, VC0 = 640, KS0 = 768, VS0 = 896, KW0 = 1024, VW0 = 1152, GATE0 = 1280, ASILU0 = 1304;
constexpr int SH0 = 1816, R0 = SH0, K0 = SH0 + 512, V0 = SH0 + 1024, WD0 = SH0 + 1536, AD0 = SH0 + 1600, CAS_USED = 3480;
constexpr int BSILU0 = 0, MA0 = 512, MB0 = 1536;
constexpr float LOG2E = 1.4426950408889634f;
constexpr float QSCALE = 0.125f * LOG2E;

constexpr size_t MiB = 1u << 20;
constexpr size_t WS_CTL = 0, CTL_ZERO_BYTES = 64 * 1024;
constexpr size_t WS_MOD = 256 * 1024;
constexpr size_t WS_POSB = 512 * 1024;
constexpr size_t WS_BIAS = 520 * 1024;
constexpr size_t WS_WA_T = 2 * MiB, WS_WB_T = 3 * MiB;
constexpr size_t WS_WO_T = 4 * MiB;
constexpr size_t WS_W1K_T = 6 * MiB, WS_W1V_T = 7 * MiB;
constexpr size_t WS_W2K_T = 8 * MiB, WS_W2V_T = 8 * MiB + 64 * 1024;
constexpr size_t WS_WLW_T = 8 * MiB + 128 * 1024, WS_WLA_T = 8 * MiB + 192 * 1024;
constexpr size_t WS_KC = 9 * MiB;
constexpr size_t WS_VCT = 9 * MiB + 512 * 1024;
constexpr size_t WS_BONUS = 10 * MiB;
constexpr size_t WS_DUMMY = 11 * MiB;
constexpr size_t WS_VTS = 12 * MiB, WS_VTW = 20 * MiB;
constexpr size_t WS_CAS = 28 * MiB;
constexpr size_t WS_CR = 252 * MiB;
constexpr size_t WS_YA = 412 * MiB, WS_YB = 444 * MiB;
constexpr size_t WS_WIN_T = 476 * MiB;
constexpr size_t WS_HS = 476 * MiB;
constexpr size_t WS_MERGED = WS_CAS;
constexpr size_t WS_END = 508 * MiB;
constexpr size_t OUT_H = 0;
constexpr size_t OUT_G = 0, OUT_Y1 = 32 * MiB, OUT_D = 64 * MiB, OUT_Y2 = 96 * MiB;

constexpr int LDS_BYTES = 147456;

struct Params {
    const float *x, *c, *w_ada, *b_ada, *norm_gain, *w_in, *q_norm_gain, *k_norm_gain, *cmp_pos_k, *cmp_pos_v,
        *cmp_k_w1, *cmp_k_w2, *cmp_v_w1, *cmp_v_w2, *rel_bias, *shift_mu, *w0, *w_lora_up, *a0, *a_lora_up,
        *k_k, *k_a, *r_k, *ln_x_w, *ln_x_b, *w_out_a, *w_out_b, *w_o;
    float* out; unsigned char* ws;
    int ph_lo, ph_hi;
};

DI unsigned f2bf(float f) { unsigned u = __builtin_bit_cast(unsigned, f); return (u + 0x7fffu + ((u >> 16) & 1u)) >> 16; }
DI float bf2f(unsigned h) { return __builtin_bit_cast(float, h << 16); }
DI unsigned pk2(float lo, float hi) { f32x2 v = {lo, hi}; bf16x2_t b = __builtin_convertvector(v, bf16x2_t); return __builtin_bit_cast(unsigned, b); }
DI float bflo(unsigned w) { return __builtin_bit_cast(float, w << 16); }
DI float bfhi(unsigned w) { return __builtin_bit_cast(float, w & 0xffff0000u); }
DI float sigmoidf_(float x) { return __builtin_amdgcn_rcpf(1.f + __expf(-x)); }
DI float siluf_(float x) { return x * __builtin_amdgcn_rcpf(1.f + __expf(-x)); }
DI int crow(int r, int hh) { return (r & 3) + 8 * (r >> 2) + 4 * hh; }
DI int pos16_of_key(int k16) { return 8 * ((k16 >> 2) & 1) + 4 * (k16 >> 3) + (k16 & 3); }
DI int key16_of_pos(int p16) { const int hh = p16 >> 3, j = p16 & 7; return 8 * (j >> 2) + 4 * hh + (j & 3); }
DI float wave_sum(float v) {
#pragma unroll
    for (int o = 1; o < 64; o <<= 1) v += __shfl_xor(v, o);
    return v;
}
DI void unpack8(u32x4 w, float* f) { f[0] = bflo(w.x); f[1] = bfhi(w.x); f[2] = bflo(w.y); f[3] = bfhi(w.y); f[4] = bflo(w.z); f[5] = bfhi(w.z); f[6] = bflo(w.w); f[7] = bfhi(w.w); }
typedef short v4i16_t __attribute__((ext_vector_type(4)));
DI s16x4 tr_read(const LAS bf16* p) { return __builtin_bit_cast(s16x4, __builtin_amdgcn_ds_read_tr16_b64_v4i16((LAS v4i16_t*)p)); }

__device__ const unsigned char T5_BUCKET[129] = {
    0, 1, 2, 3, 4, 5, 6, 7, 8, 9, 10, 11, 12, 13, 14, 15, 16, 16, 16, 17, 17, 18, 18, 18, 19, 19, 19, 20, 20, 20, 20, 21, 21, 21, 21, 22, 22, 22, 22, 22, 23, 23, 23, 23, 23, 23, 24, 24, 24, 24, 24, 24, 25, 25, 25, 25, 25, 25, 25, 26, 26, 26, 26, 26, 26, 26, 26, 27, 27, 27, 27, 27, 27, 27, 27, 27, 27, 28, 28, 28, 28, 28, 28, 28, 28, 28, 28, 29, 29, 29, 29, 29, 29, 29, 29, 29, 29, 29, 29, 30, 30, 30, 30, 30, 30, 30, 30, 30, 30, 30, 30, 30, 30, 31, 31, 31, 31, 31, 31, 31, 31, 31, 31, 31, 31, 31, 31, 31, 31};

template <class F> DI void transpose_item(const float* W, int K, int N, bf16* WT, F rowmap, LAS float* scr, int item, int lane) {
    const int nblk = (N + 63) / 64, kb = item / nblk, nb = item % nblk, k0 = 64 * kb, n0 = 64 * nb;
    const int n4 = (lane & 15) * 4;
    const bool inb = n0 + n4 < N; const int ncl = inb ? n0 + n4 : N - 4;
    f32x4 vv[16];
#pragma unroll
    for (int i = 0; i < 16; ++i) vv[i] = *(const f32x4*)(W + (size_t)(k0 + 4 * i + (lane >> 4)) * N + ncl);
#pragma unroll
    for (int i = 0; i < 16; ++i) asm volatile("" : "+v"(vv[i]));
#pragma unroll
    for (int i = 0; i < 16; ++i) { const int kk = 4 * i + (lane >> 4);
        const f32x4 v = inb ? vv[i] : (f32x4){0.f, 0.f, 0.f, 0.f};
        LAS float* d = scr + kk * 65 + n4; d[0] = v[0]; d[1] = v[1]; d[2] = v[2]; d[3] = v[3]; }
    asm volatile("s_waitcnt lgkmcnt(0)" ::: "memory");
    const int c = lane & 7;
#pragma unroll
    for (int j = 0; j < 8; ++j) { const int nl = (lane >> 3) + 8 * j, n = n0 + nl; const LAS float* s = scr + (8 * c) * 65 + nl;
        u32x4 o; o.x = pk2(s[0 * 65], s[1 * 65]); o.y = pk2(s[2 * 65], s[3 * 65]); o.z = pk2(s[4 * 65], s[5 * 65]); o.w = pk2(s[6 * 65], s[7 * 65]);
        if (n < N) *(u32x4*)(WT + (size_t)rowmap(n) * K + k0 + 8 * c) = o; }
    asm volatile("s_waitcnt lgkmcnt(0)" ::: "memory");
}

DI void phase0w(const Params& p, LAS unsigned char* lds) {
    const int tid = threadIdx.x, lane = tid & 63, wave = __builtin_amdgcn_readfirstlane(tid >> 6);
    const int gw = blockIdx.x * 8 + wave, NGW = gridDim.x * 8;
    unsigned char* ws = p.ws;
    {
        LAS float* scr = (LAS float*)(lds + wave * 16640);
        constexpr int I_IN = 16 * 95, I_OA = 8 * 16, I_OB = 8 * 16, I_O = 16 * 16, I_W1 = 32 * 4, I_W2 = 4 * 1, I_L = 1 * 8;
        constexpr int NIT = I_IN + I_OA + I_OB + I_O + 2 * I_W1 + 2 * I_W2 + 2 * I_L;
        auto ident = [](int n) { return n; };
        auto inmap = [](int n) { return n < CAS_USED ? n : n + (LD_CAS - CAS_USED); };
        for (int it = gw; it < NIT; it += NGW) {
            int r = it;
            if (r < I_IN) { transpose_item(p.w_in, DM, N_IN, (bf16*)(ws + WS_WIN_T), inmap, scr, r, lane); continue; } r -= I_IN;
            if (r < I_OA) { transpose_item(p.w_out_a, 512, DM, (bf16*)(ws + WS_WA_T), ident, scr, r, lane); continue; } r -= I_OA;
            if (r < I_OB) { transpose_item(p.w_out_b, 512, DM, (bf16*)(ws + WS_WB_T), ident, scr, r, lane); continue; } r -= I_OB;
            if (r < I_O) { transpose_item(p.w_o, DM, DM, (bf16*)(ws + WS_WO_T), ident, scr, r, lane); continue; } r -= I_O;
            if (r < I_W1) { transpose_item(p.cmp_k_w1, 2048, 256, (bf16*)(ws + WS_W1K_T), ident, scr, r, lane); continue; } r -= I_W1;
            if (r < I_W1) { transpose_item(p.cmp_v_w1, 2048, 256, (bf16*)(ws + WS_W1V_T), ident, scr, r, lane); continue; } r -= I_W1;
            if (r < I_W2) { transpose_item(p.cmp_k_w2, 256, 64, (bf16*)(ws + WS_W2K_T), ident, scr, r, lane); continue; } r -= I_W2;
            if (r < I_W2) { transpose_item(p.cmp_v_w2, 256, 64, (bf16*)(ws + WS_W2V_T), ident, scr, r, lane); continue; } r -= I_W2;
            if (r < I_L) { transpose_item(p.w_lora_up, 64, 512, (bf16*)(ws + WS_WLW_T), ident, scr, r, lane); continue; } r -= I_L;
            transpose_item(p.a_lora_up, 64, 512, (bf16*)(ws + WS_WLA_T), ident, scr, r, lane);
        }
    }
    {
        u32x4* z = (u32x4*)(ws + WS_WIN_T + (size_t)CAS_USED * DM * 2);
        const int n16 = (LD_CAS - CAS_USED) * DM * 2 / 16;
        for (int i = blockIdx.x * 512 + tid; i < n16; i += gridDim.x * 512) z[i] = (u32x4){0u, 0u, 0u, 0u};
    }
    __syncthreads();
}
constexpr size_t WS_MODP = 1 * MiB;
DI void phase0(const Params& p, LAS unsigned char* lds) {
    const int tid = threadIdx.x, lane = tid & 63, wave = __builtin_amdgcn_readfirstlane(tid >> 6);
    unsigned char* ws = p.ws;
    LAS float* red = (LAS float*)lds;
    LAS float* sc = (LAS float*)(lds + 32768);
    for (int task = blockIdx.x; task < 201; task += gridDim.x) {
        if (task < 192) {
            const int cg = task % 48, kq = task / 48;
            for (int i = tid; i < 16 * 256; i += 512) sc[i] = siluf_(p.c[(i >> 8) * 1024 + kq * 256 + (i & 255)]);
            __syncthreads();
            const int col = cg * 64 + lane;
            float acc[16];
#pragma unroll
            for (int b = 0; b < 16; ++b) acc[b] = 0.f;
#pragma unroll 4
            for (int kk = 0; kk < 32; ++kk) { const int kl = wave * 32 + kk; const float wv = p.w_ada[(size_t)(kq * 256 + kl) * 3072 + col];
#pragma unroll
                for (int b = 0; b < 16; ++b) acc[b] += sc[b * 256 + kl] * wv; }
#pragma unroll
            for (int b = 0; b < 16; ++b) red[(wave * 16 + b) * 64 + lane] = acc[b];
            __syncthreads();
            for (int o = tid; o < 1024; o += 512) { const int b = o >> 6, l = o & 63; float s = 0.f;
#pragma unroll
                for (int w = 0; w < 8; ++w) s += red[(w * 16 + b) * 64 + l];
                ((float*)(ws + WS_MODP))[(kq * 16 + b) * 3072 + cg * 64 + l] = s; }
            __syncthreads();
        } else if (task < 200) {
            const int t2 = task - 192, which = t2 >> 2, col = (t2 & 3) * 64 + lane;
            const float* pos = which ? p.cmp_pos_v : p.cmp_pos_k; const float* w1 = which ? p.cmp_v_w1 : p.cmp_k_w1;
            float a = 0.f;
#pragma unroll 4
            for (int kk = 0; kk < 256; ++kk) { const int k = wave * 256 + kk; a += pos[k] * w1[(size_t)k * 256 + col]; }
            red[wave * 64 + lane] = a;
            __syncthreads();
            if (tid < 64) { float s = 0.f;
#pragma unroll
                for (int w = 0; w < 8; ++w) s += red[w * 64 + tid];
                ((float*)(ws + WS_POSB))[which * 256 + (t2 & 3) * 64 + tid] = s; }
            __syncthreads();
        } else {
            for (int i = tid; i < 8 * 129; i += 512) { const int h = i / 129, d = i % 129; ((float*)(ws + WS_BIAS))[h * 132 + d] = p.rel_bias[T5_BUCKET[d] * 8 + h] * LOG2E; }
        }
    }
}

DI void phase1(const Params& p, LAS unsigned char* lds) {
    const int tid = threadIdx.x, lane = tid & 63, wave = tid >> 6;
    bf16* hb = (bf16*)((unsigned char*)p.out + OUT_H);
    LAS float* modL = (LAS float*)lds;
    for (int rb = blockIdx.x; rb < MTOK / 128; rb += gridDim.x) {
        const int b = rb >> 4;
        __syncthreads();
        for (int col = tid; col < 3072; col += 512) { float s = p.b_ada[col];
#pragma unroll
            for (int kq = 0; kq < 4; ++kq) s += ((const float*)(p.ws + WS_MODP))[(kq * 16 + b) * 3072 + col];
            modL[col] = s; if ((rb & 15) == 0) ((float*)(p.ws + WS_MOD))[b * 3072 + col] = s; }
        __syncthreads();
        f32x4 gq[4];
#pragma unroll
        for (int j = 0; j < 4; ++j) gq[j] = *(const f32x4*)(p.norm_gain + 4 * lane + 256 * j);
        for (int r = wave; r < 128; r += 8) {
            const int m = rb * 128 + r;
            const f32x4* xr = (const f32x4*)(p.x + (size_t)m * DM) + lane;
            f32x4 v[4]; float s = 0.f;
#pragma unroll
            for (int j = 0; j < 4; ++j) { v[j] = xr[64 * j]; s += (v[j].x * v[j].x + v[j].y * v[j].y) + (v[j].z * v[j].z + v[j].w * v[j].w); }
            const float rinv = rsqrtf(wave_sum(s) * (1.f / DM) + 1e-6f);
            u32x2* o8 = (u32x2*)(hb + (size_t)m * DM) + lane;
#pragma unroll
            for (int j = 0; j < 4; ++j) {
                const int k = 4 * lane + 256 * j;
                const f32x4 g = gq[j], sh = *(const LAS f32x4*)(modL + k), scl = *(const LAS f32x4*)(modL + 1024 + k);
                f32x4 h = v[j] * rinv * g * (scl + 1.f) + sh;
                u32x2 o; o.x = pk2(h.x, h.y); o.y = pk2(h.z, h.w); o8[64 * j] = o;
            }
        }
    }
    __syncthreads();
}

struct EpiInProj {
    static constexpr bool PERM = true;
    bf16* cas; bf16* cr;
    DI void operator()(const f32x4 (&acc)[2][2][4][2], const pg8::Unit& u, int wr, int wc, int fr, int fq) const {
        const int row0 = u.pm * 256 + wr * 64 + fr;
        bf16* base; int ldc, colt;
        if (u.pn < 14) { base = cas; ldc = LD_CAS; colt = u.pn * 256; } else { base = cr; ldc = LD_CR; colt = (u.pn - 14) * 256; }
        const int col0 = colt + wc * 32 + 8 * fq;
#pragma unroll
        for (int ai = 0; ai < 2; ++ai)
#pragma unroll
            for (int m = 0; m < 4; ++m) { bf16* rowp = base + (size_t)(row0 + ai * 128 + m * 16) * ldc + col0;
#pragma unroll
                for (int bj = 0; bj < 2; ++bj) { const f32x4 v0 = acc[ai][bj][m][0], v1 = acc[ai][bj][m][1];
                    u32x4 w; w.x = pk2(v0[0], v0[1]); w.y = pk2(v0[2], v0[3]); w.z = pk2(v1[0], v1[1]); w.w = pk2(v1[2], v1[3]);
                    *(u32x4*)(rowp + bj * 128) = w; } }
    }
};
template <int WHICH> struct EpiGate {
    static constexpr bool PERM = true;
    bf16* merged; const bf16* cr;
    DI void operator()(const f32x4 (&acc)[2][2][4][2], const pg8::Unit& u, int wr, int wc, int fr, int fq) const {
        const int row0 = u.pm * 256 + wr * 64 + fr, col0 = u.pn * 256 + wc * 32 + 8 * fq;
#pragma unroll
        for (int ai = 0; ai < 2; ++ai)
#pragma unroll
            for (int mp2 = 0; mp2 < 2; ++mp2) {
                u32x4 gw[2][2], ow[2][2];
#pragma unroll
                for (int m2 = 0; m2 < 2; ++m2)
#pragma unroll
                    for (int bj = 0; bj < 2; ++bj) { const size_t row = (size_t)(row0 + ai * 128 + (2 * mp2 + m2) * 16); const int col = col0 + bj * 128;
                        gw[m2][bj] = *(const u32x4*)(cr + row * LD_CR + (WHICH ? MB0 : MA0) + col);
                        if (WHICH) ow[m2][bj] = *(const u32x4*)(merged + row * DM + col); }
#pragma unroll
                for (int m2 = 0; m2 < 2; ++m2)
#pragma unroll
                    for (int bj = 0; bj < 2; ++bj) { asm volatile("" : "+v"(gw[m2][bj])); if (WHICH) asm volatile("" : "+v"(ow[m2][bj])); }
#pragma unroll
                for (int m2 = 0; m2 < 2; ++m2)
#pragma unroll
                    for (int bj = 0; bj < 2; ++bj) { const int m = 2 * mp2 + m2; const size_t row = (size_t)(row0 + ai * 128 + m * 16); const int col = col0 + bj * 128;
                        float gl[8]; unpack8(gw[m2][bj], gl);
                        const f32x4 v0 = acc[ai][bj][m][0], v1 = acc[ai][bj][m][1];
                        float r[8] = {v0[0], v0[1], v0[2], v0[3], v1[0], v1[1], v1[2], v1[3]};
                        if (WHICH) { float old[8]; unpack8(ow[m2][bj], old);
#pragma unroll
                            for (int i = 0; i < 8; ++i) r[i] = old[i] + sigmoidf_(gl[i]) * r[i]; }
                        else {
#pragma unroll
                            for (int i = 0; i < 8; ++i) r[i] = sigmoidf_(gl[i]) * r[i]; }
                        u32x4 w; w.x = pk2(r[0], r[1]); w.y = pk2(r[2], r[3]); w.z = pk2(r[4], r[5]); w.w = pk2(r[6], r[7]);
                        *(u32x4*)(merged + row * DM + col) = w; }
            }
    }
};
struct EpiFinal {
    static constexpr bool PERM = false;
    const float* x; const float* mod; float* out;
    DI void operator()(const f32x4 (&acc)[2][2][4][2], const pg8::Unit& u, int wr, int wc, int fr, int fq) const {
        const int row0 = u.pm * 256 + wr * 64 + fr, col0 = u.pn * 256 + wc * 32 + 4 * fq;
        const int b = (u.pm * 256) >> 11;
        f32x4 gv[2][2];
#pragma unroll
        for (int bj = 0; bj < 2; ++bj)
#pragma unroll
            for (int n = 0; n < 2; ++n) gv[bj][n] = *(const f32x4*)(mod + b * 3072 + 2048 + col0 + bj * 128 + n * 16);
#pragma unroll
        for (int ai = 0; ai < 2; ++ai)
#pragma unroll
            for (int mp = 0; mp < 2; ++mp) {
                f32x4 xv[2][2][2];
#pragma unroll
                for (int m2 = 0; m2 < 2; ++m2)
#pragma unroll
                    for (int bj = 0; bj < 2; ++bj)
#pragma unroll
                        for (int n = 0; n < 2; ++n) xv[m2][bj][n] = *(const f32x4*)(x + (size_t)(row0 + ai * 128 + (2 * mp + m2) * 16) * DM + col0 + bj * 128 + n * 16);
#pragma unroll
                for (int m2 = 0; m2 < 2; ++m2)
#pragma unroll
                    for (int bj = 0; bj < 2; ++bj)
#pragma unroll
                        for (int n = 0; n < 2; ++n) asm volatile("" : "+v"(xv[m2][bj][n]));
#pragma unroll
                for (int m2 = 0; m2 < 2; ++m2)
#pragma unroll
                    for (int bj = 0; bj < 2; ++bj)
#pragma unroll
                        for (int n = 0; n < 2; ++n)
                            *(f32x4*)(out + (size_t)(row0 + ai * 128 + (2 * mp + m2) * 16) * DM + col0 + bj * 128 + n * 16) = xv[m2][bj][n] + gv[bj][n] * acc[ai][bj][2 * mp + m2][n];
            }
    }
};

DI void phase3a(const Params& p, LAS unsigned char* lds) {
    const int tid = threadIdx.x, lane = tid & 63, wave = tid >> 6;
    const int gw = blockIdx.x * 8 + wave, NGW = gridDim.x * 8;
    bf16* cas = (bf16*)(p.ws + WS_CAS);
    {
        float gq[8], gk[8];
        const int dq = (8 * lane) & 63;
#pragma unroll
        for (int i = 0; i < 8; ++i) gq[i] = p.q_norm_gain[dq + i] * QSCALE;
        const int kr = (lane < 16) ? 1 : 2, dk = (8 * lane) & 63;
#pragma unroll
        for (int i = 0; i < 8; ++i) gk[i] = p.k_norm_gain[kr * 64 + dk + i];
        const int kcol = (lane < 16) ? (KS0 + 8 * lane) : (KW0 + 8 * (lane & 15));
        for (int m0 = gw * 4; m0 < MTOK; m0 += NGW * 4) {
            u32x4 qw[4], kw[4];
#pragma unroll
            for (int u = 0; u < 4; ++u) { bf16* row = cas + (size_t)(m0 + u) * LD_CAS;
                qw[u] = *(const u32x4*)(row + Q0 + 8 * lane);
                kw[u] = (lane < 32) ? *(const u32x4*)(row + kcol) : (u32x4){0u, 0u, 0u, 0u}; }
#pragma unroll
            for (int u = 0; u < 4; ++u) {
                bf16* row = cas + (size_t)(m0 + u) * LD_CAS;
                float q[8], k[8]; unpack8(qw[u], q); unpack8(kw[u], k);
                float sq = 0.f, sk = 0.f;
#pragma unroll
                for (int i = 0; i < 8; ++i) { sq += q[i] * q[i]; sk += k[i] * k[i]; }
#pragma unroll
                for (int o = 1; o < 8; o <<= 1) { sq += __shfl_xor(sq, o); sk += __shfl_xor(sk, o); }
                const float rq = rsqrtf(sq * (1.f / 64.f) + 1e-6f), rk = rsqrtf(sk * (1.f / 64.f) + 1e-6f);
#pragma unroll
                for (int i = 0; i < 8; ++i) { q[i] *= rq * gq[i]; k[i] *= rk * gk[i]; }
                u32x4 o; o.x = pk2(q[0], q[1]); o.y = pk2(q[2], q[3]); o.z = pk2(q[4], q[5]); o.w = pk2(q[6], q[7]);
                *(u32x4*)(row + Q0 + 8 * lane) = o;
                if (lane < 32) { u32x4 o2; o2.x = pk2(k[0], k[1]); o2.y = pk2(k[2], k[3]); o2.z = pk2(k[4], k[5]); o2.w = pk2(k[6], k[7]); *(u32x4*)(row + kcol) = o2; }
            }
        }
    }
    {
        LAS bf16* tile = (LAS bf16*)lds;
        for (int it = blockIdx.x; it < 2048; it += gridDim.x) {
            const int which = it >> 10, bg = (it >> 5) & 31, j = it & 31, b = bg >> 1, g = bg & 1;
            const int key = tid >> 3, ch = tid & 7;
            __syncthreads();
            *(LAS u32x4*)(tile + key * 72 + 8 * ch) = *(const u32x4*)(cas + (size_t)(b * SEQ + 64 * j + key) * LD_CAS + (which ? VW0 : VS0) + g * 64 + 8 * ch);
            __syncthreads();
            const int d = tid >> 3, pc = tid & 7;
            unsigned short v[8];
#pragma unroll
            for (int i = 0; i < 8; ++i) { const int pos = 8 * pc + i, k2 = (pos & ~15) | key16_of_pos(pos & 15); v[i] = tile[k2 * 72 + d]; }
            u32x4 o; o.x = v[0] | ((unsigned)v[1] << 16); o.y = v[2] | ((unsigned)v[3] << 16); o.z = v[4] | ((unsigned)v[5] << 16); o.w = v[6] | ((unsigned)v[7] << 16);
            bf16* vt = (bf16*)(p.ws + (which ? WS_VTW : WS_VTS)) + ((size_t)(bg * 32 + j) * 64 + d) * 64 + 8 * pc;
            *(u32x4*)vt = o;
        }
        __syncthreads();
    }
}

DI float gelu_tanh(float x) { const float u = 0.7978845608028654f * (x + 0.044715f * x * x * x); const float t = 1.f - 2.f * __builtin_amdgcn_rcpf(__expf(2.f * u) + 1.f); return 0.5f * x * (1.f + t); }
DI void phase3b(const Params& p, LAS unsigned char* lds) {
    const int tid = threadIdx.x, lane = tid & 63, wave = __builtin_amdgcn_readfirstlane(tid >> 6), l31 = lane & 31, hh = lane >> 5;
    const bf16* cas = (const bf16*)(p.ws + WS_CAS);
    LAS bf16* h1 = (LAS bf16*)lds;
    LAS float* o2 = (LAS float*)(lds + 32 * 264 * 2);
    LAS unsigned char* xs = lds + 32768;
    float kgain[8];
#pragma unroll
    for (int i = 0; i < 8; ++i) kgain[i] = p.k_norm_gain[(tid & 7) * 8 + i];
    for (int it = blockIdx.x; it < 256; it += gridDim.x) {
        const int which = it >> 7, bg = (it >> 2) & 31, rq = it & 3, b = bg >> 1, g = bg & 1;
        {
            const bf16* xsrc = cas + (size_t)(b * SEQ) * LD_CAS + (which ? VC0 : KC0) + g * 64;
            u32x4 stg[9];
#pragma unroll
            for (int k = 0; k < 9; ++k) { const int i = min(tid + 512 * k, 528 * 8 - 1); const int tr = i >> 3, ch = i & 7; int tok = 512 * rq + tr; tok = tok < SEQ ? tok : SEQ - 1;
                stg[k] = *(const u32x4*)(xsrc + (size_t)tok * LD_CAS + 8 * ch); }
#pragma unroll
            for (int k = 0; k < 9; ++k) asm volatile("" : "+v"(stg[k]));
#pragma unroll
            for (int k = 0; k < 9; ++k) { const int i = tid + 512 * k; const int tr = i >> 3, ch = i & 7;
                if (i < 528 * 8) *(LAS u32x4*)(xs + tr * 128 + ((ch ^ ((tr >> 4) & 7)) << 4)) = stg[k]; }
        }
        __syncthreads();
        const bf16* brow = (const bf16*)(p.ws + (which ? WS_W1V_T : WS_W1K_T)) + (size_t)(32 * wave + l31) * 2048 + 8 * hh;
        f32x16 acc = {};
#pragma unroll 16
        for (int s = 0; s < 128; ++s) {
            const int kk = 16 * s, tr = 16 * l31 + (kk >> 6), ch = ((kk & 63) >> 3) + hh;
            const bf16x8 a = *(const LAS bf16x8*)(xs + tr * 128 + ((ch ^ ((tr >> 4) & 7)) << 4));
            const bf16x8 bb = *(const bf16x8*)(brow + kk);
            acc = __builtin_amdgcn_mfma_f32_32x32x16_bf16(a, bb, acc, 0, 0, 0);
        }
        const float pb = ((const float*)(p.ws + WS_POSB))[which * 256 + 32 * wave + l31];
        __syncthreads();
#pragma unroll
        for (int r = 0; r < 16; ++r) h1[crow(r, hh) * 264 + 32 * wave + l31] = (bf16)f2bf(gelu_tanh(acc[r] + pb));
        __syncthreads();
        if (wave < 2) {
            const bf16* b2 = (const bf16*)(p.ws + (which ? WS_W2V_T : WS_W2K_T)) + (size_t)(32 * wave + l31) * 256 + 8 * hh;
            f32x16 a2 = {};
#pragma unroll
            for (int s = 0; s < 16; ++s) {
                const bf16x8 a = *(const LAS bf16x8*)(h1 + l31 * 264 + 16 * s + 8 * hh);
                const bf16x8 bb = *(const bf16x8*)(b2 + 16 * s);
                a2 = __builtin_amdgcn_mfma_f32_32x32x16_bf16(a, bb, a2, 0, 0, 0);
            }
#pragma unroll
            for (int r = 0; r < 16; ++r) o2[crow(r, hh) * 65 + 32 * wave + l31] = a2[r];
        }
        __syncthreads();
        if (tid < 256) {
            const int nl = tid >> 3, e8 = (tid & 7) * 8, nn = 32 * rq + nl;
            float v[8]; float ss = 0.f;
#pragma unroll
            for (int i = 0; i < 8; ++i) { v[i] = o2[nl * 65 + e8 + i]; ss += v[i] * v[i]; }
            if (which == 0) {
#pragma unroll
                for (int o = 1; o < 8; o <<= 1) ss += __shfl_xor(ss, o);
                const float rinv = rsqrtf(ss * (1.f / 64.f) + 1e-6f);
#pragma unroll
                for (int i = 0; i < 8; ++i) v[i] = (nn < 127) ? v[i] * rinv * kgain[i] : 0.f;
                u32x4 o; o.x = pk2(v[0], v[1]); o.y = pk2(v[2], v[3]); o.z = pk2(v[4], v[5]); o.w = pk2(v[6], v[7]);
                *(u32x4*)((bf16*)(p.ws + WS_KC) + (size_t)(bg * 128 + nn) * 64 + e8) = o;
            } else {
                const int pos = (nn & ~15) | pos16_of_key(nn & 15);
                bf16* vct = (bf16*)(p.ws + WS_VCT) + (size_t)bg * 64 * 128 + pos;
#pragma unroll
                for (int i = 0; i < 8; ++i) vct[(size_t)(e8 + i) * 128] = (bf16)f2bf((nn < 127) ? v[i] : 0.f);
            }
        }
        __syncthreads();
    }
}

constexpr int SLOTB = 8192;
DI int sw_el(int row, int col) { return row * 64 + ((((col >> 3) ^ (row & 7)) << 3) | (col & 7)); }
DI int swf_el(int row, int col) { return row * 64 + ((((col >> 2) ^ (row & 15)) << 2) | (col & 3)); }
DI bf16x8 frag_row(const LAS bf16* Mx, int row, int kc) { return *(const LAS bf16x8*)(Mx + sw_el(row, kc)); }
DI bf16x8 frag_col(const LAS bf16* Mx, int k0, int colbase, int lane) {
    const int i16 = lane & 15, q = i16 >> 2, pp = i16 & 3, blk = (lane >> 4) & 1, col = colbase + 16 * blk + 4 * pp;
    const s16x4 lo = tr_read(Mx + sw_el(k0 + q, col)), hi = tr_read(Mx + sw_el(k0 + 4 + q, col));
    return __builtin_shufflevector(lo, hi, 0, 1, 2, 3, 4, 5, 6, 7);
}
template <bool TA, bool TB> DI void mm_acc(f32x16& acc, const LAS bf16* A, const LAS bf16* Bm, int ti, int tj, int lane) {
    const int l31 = lane & 31, hh = lane >> 5;
#pragma unroll
    for (int s = 0; s < 4; ++s) {
        const int k0 = 16 * s + 8 * hh;
        bf16x8 x, y;
        if (TB) x = frag_row(Bm, 32 * tj + l31, k0); else x = frag_col(Bm, k0, 32 * tj, lane);
        if (TA) y = frag_col(A, k0, 32 * ti, lane); else y = frag_row(A, 32 * ti + l31, k0);
        acc = __builtin_amdgcn_mfma_f32_32x32x16_bf16(x, y, acc, 0, 0, 0);
    }
}
DI void ld_tile(f32x16& acc, const LAS bf16* Mx, int ti, int tj, int l31, int hh) {
#pragma unroll
    for (int g = 0; g < 4; ++g) { const u32x2 w = *(const LAS u32x2*)(Mx + sw_el(32 * ti + l31, 32 * tj + 8 * g + 4 * hh));
        acc[4 * g] = bflo(w.x); acc[4 * g + 1] = bfhi(w.x); acc[4 * g + 2] = bflo(w.y); acc[4 * g + 3] = bfhi(w.y); }
}
DI void st_tile(LAS bf16* Mx, const f32x16& acc, int ti, int tj, int l31, int hh) {
#pragma unroll
    for (int g = 0; g < 4; ++g) { u32x2 w; w.x = pk2(acc[4 * g], acc[4 * g + 1]); w.y = pk2(acc[4 * g + 2], acc[4 * g + 3]);
        *(LAS u32x2*)(Mx + sw_el(32 * ti + l31, 32 * tj + 8 * g + 4 * hh)) = w; }
}
DI void st_native_global(bf16* Tm, const f32x16& acc, int tile, int lane) {
    u32x4 a, b;
    a.x = pk2(acc[0], acc[1]); a.y = pk2(acc[2], acc[3]); a.z = pk2(acc[4], acc[5]); a.w = pk2(acc[6], acc[7]);
    b.x = pk2(acc[8], acc[9]); b.y = pk2(acc[10], acc[11]); b.z = pk2(acc[12], acc[13]); b.w = pk2(acc[14], acc[15]);
    u32x4* d = (u32x4*)(Tm + (size_t)tile * 1024 + lane * 8); d[0] = a; d[64] = b;
}
DI void ld_native_global(f32x16& acc, const bf16* Tm, int tile, int lane) {
    const u32x4* d = (const u32x4*)(Tm + (size_t)tile * 1024 + lane * 8); const u32x4 a = d[0], b = d[64];
    acc[0] = bflo(a.x); acc[1] = bfhi(a.x); acc[2] = bflo(a.y); acc[3] = bfhi(a.y); acc[4] = bflo(a.z); acc[5] = bfhi(a.z); acc[6] = bflo(a.w); acc[7] = bfhi(a.w);
    acc[8] = bflo(b.x); acc[9] = bfhi(b.x); acc[10] = bflo(b.y); acc[11] = bfhi(b.y); acc[12] = bflo(b.z); acc[13] = bfhi(b.z); acc[14] = bflo(b.w); acc[15] = bfhi(b.w);
}
DI bf16x8 pack8(const f32x16& x, int s) {
    u32x4 w; w.x = pk2(x[8 * s], x[8 * s + 1]); w.y = pk2(x[8 * s + 2], x[8 * s + 3]); w.z = pk2(x[8 * s + 4], x[8 * s + 5]); w.w = pk2(x[8 * s + 6], x[8 * s + 7]);
    return __builtin_bit_cast(bf16x8, w);
}
DI bf16x8 frag_col_perm(const LAS bf16* Mx, int kb16, int colbase, int lane) {
    const int i16 = lane & 15, q = i16 >> 2, pp = i16 & 3, blk = (lane >> 4) & 1, hh = lane >> 5, col = colbase + 16 * blk + 4 * pp;
    const s16x4 lo = tr_read(Mx + sw_el(kb16 + 4 * hh + q, col)), hi = tr_read(Mx + sw_el(kb16 + 8 + 4 * hh + q, col));
    return __builtin_shufflevector(lo, hi, 0, 1, 2, 3, 4, 5, 6, 7);
}
DI void mm32_acc(f32x16& C, const f32x16& A, const LAS bf16* Bm, int kb, int colbase, int lane) {
    const bf16x8 a0 = pack8(A, 0), a1 = pack8(A, 1);
    C = __builtin_amdgcn_mfma_f32_32x32x16_bf16(frag_col_perm(Bm, kb, colbase, lane), a0, C, 0, 0, 0);
    C = __builtin_amdgcn_mfma_f32_32x32x16_bf16(frag_col_perm(Bm, kb + 16, colbase, lane), a1, C, 0, 0, 0);
}
DI u32x4 pack8f(const float* v) { u32x4 o; o.x = pk2(v[0], v[1]); o.y = pk2(v[2], v[3]); o.z = pk2(v[4], v[5]); o.w = pk2(v[6], v[7]); return o; }

DI void phase3c(const Params& p, LAS unsigned char* lds) {
    const int tid0 = threadIdx.x, wave = __builtin_amdgcn_readfirstlane(tid0 >> 6);
    const int half = wave >> 2, lw = wave & 3, ti = (lw >> 1) & 1, tj = lw & 1;
    const bf16* cas = (const bf16*)(p.ws + WS_CAS);
    LAS unsigned char* hb = lds + half * 65536;
#define SL(i) ((LAS bf16*)(hb + (i) * SLOTB))
    LAS float* F1 = (LAS float*)(hb);
    LAS float* F2 = (LAS float*)(hb + 2 * SLOTB);
    LAS float* gam = (LAS float*)(lds + 131072) + half * 64;
    LAS float* tot = (LAS float*)(lds + 131072 + 512) + half * 256;
    LAS float* parL = (LAS float*)(lds + 131072 + 512 + 2048) + half * 640;
    int par_h = -1;
#define LDS_BAR() asm volatile("s_waitcnt lgkmcnt(0)\n\ts_barrier" ::: "memory")
    u32x4 nwd[2], nad[2], npw[2], npa[2];
#define E1_FETCH(PR) do { const int it_ = 2 * (PR) + half; const int c_ = it_ & 31; const size_t me_ = (size_t)(it_ >> 8) * SEQ + 64 * c_ + ((tid0 & 255) >> 2); \
        const bool hp_ = (64 * c_ + ((tid0 & 255) >> 2)) > 0; const int j16_ = (tid0 & 3) * 16; \
        _Pragma("unroll") for (int sp = 0; sp < 2; ++sp) { \
            nwd[sp] = *(const u32x4*)(cas + me_ * LD_CAS + WD0 + j16_ + 8 * sp); nad[sp] = *(const u32x4*)(cas + me_ * LD_CAS + AD0 + j16_ + 8 * sp); \
            npw[sp] = *(const u32x4*)(cas + (me_ - (hp_ ? 1 : 0)) * LD_CAS + WD0 + j16_ + 8 * sp); npa[sp] = *(const u32x4*)(cas + (me_ - (hp_ ? 1 : 0)) * LD_CAS + AD0 + j16_ + 8 * sp); } } while (0)
    unsigned pf0 = 0u, pf1 = 0u;
    if ((int)blockIdx.x < 2048) E1_FETCH((int)blockIdx.x);
#pragma unroll
    for (int k = 0; k < 8; ++k) *(u32x4*)(p.ws + WS_DUMMY + (size_t)k * 8192 + tid0 * 16) = (u32x4){0u, 0u, 0u, 0u};
    for (int pr = blockIdx.x; pr < 2048; pr += gridDim.x) {
        int tid = tid0; asm volatile("" : "+v"(tid));
        const int lane = tid & 63, l31 = lane & 31, hh = lane >> 5, ltid = tid & 255;
        const int item = 2 * pr + half;
        const int c = item & 31, h = (item >> 5) & 7, b = item >> 8;
        const size_t m0 = (size_t)b * SEQ + 64 * c;
        const int te = ltid >> 2, c16 = (ltid & 3) * 16; const size_t me = m0 + te; const bool hpv = (64 * c + te) > 0;
        if (h != par_h) {
            par_h = h;
            for (int i = ltid; i < 640; i += 256) { const int rw = i >> 6, cc = i & 63; float v;
                if (rw == 0) v = p.w0[h * 64 + cc]; else if (rw == 1) v = p.a0[h * 64 + cc]; else if (rw == 2) v = p.k_k[h * 64 + cc]; else if (rw == 3) v = p.k_a[h * 64 + cc];
                else if (rw == 4) v = p.r_k[h * 64 + cc]; else if (rw < 8) v = p.shift_mu[(rw - 5) * 512 + h * 64 + cc]; else v = p.shift_mu[1536 + (rw - 8) * 64 + cc];
                parL[i] = v; }
            LDS_BAR();
        }
        u32x4 gk[2], gr[2], gv[2], gkp[2], grp[2], gvp[2];
#pragma unroll
        for (int sp = 0; sp < 2; ++sp) { const int hc8 = h * 64 + c16 + 8 * sp;
            gk[sp] = *(const u32x4*)(cas + me * LD_CAS + K0 + hc8); gr[sp] = *(const u32x4*)(cas + me * LD_CAS + R0 + hc8); gv[sp] = *(const u32x4*)(cas + me * LD_CAS + V0 + hc8);
            const size_t mp = me - (hpv ? 1 : 0);
            gkp[sp] = *(const u32x4*)(cas + mp * LD_CAS + K0 + hc8); grp[sp] = *(const u32x4*)(cas + mp * LD_CAS + R0 + hc8); gvp[sp] = *(const u32x4*)(cas + mp * LD_CAS + V0 + hc8); }
        bf16x8 wfr[2][4];
#pragma unroll
        for (int pd = 0; pd < 2; ++pd) { const bf16* wt = (const bf16*)(p.ws + (pd ? WS_WLA_T : WS_WLW_T)) + (size_t)(h * 64 + 32 * tj + l31) * 64;
#pragma unroll
            for (int s = 0; s < 4; ++s) wfr[pd][s] = *(const bf16x8*)(wt + 16 * s + 8 * hh); }
#pragma unroll
        for (int sp = 0; sp < 2; ++sp) {
            const int j8 = c16 + 8 * sp;
            float wd[8], ad[8], pw[8], pa[8];
            asm volatile("" : "+v"(npw[sp]), "+v"(npa[sp]));
            unpack8(nwd[sp], wd); unpack8(nad[sp], ad); unpack8(hpv ? npw[sp] : (u32x4){0u, 0u, 0u, 0u}, pw); unpack8(hpv ? npa[sp] : (u32x4){0u, 0u, 0u, 0u}, pa);
#pragma unroll
            for (int i = 0; i < 8; ++i) { const float x = wd[i] + (pw[i] - wd[i]) * parL[512 + j8 + i]; const float e2 = __expf(2.f * x); wd[i] = 1.f - 2.f * __builtin_amdgcn_rcpf(e2 + 1.f);
                ad[i] = ad[i] + (pa[i] - ad[i]) * parL[576 + j8 + i]; }
            *(LAS u32x4*)(SL(6) + sw_el(te, j8)) = pack8f(wd);
            *(LAS u32x4*)(SL(7) + sw_el(te, j8)) = pack8f(ad);
        }
        E1_FETCH(min(pr + (int)gridDim.x, 2047));
        LDS_BAR();
#pragma unroll
        for (int pd = 0; pd < 2; ++pd) {
            const LAS bf16* Am = pd ? SL(7) : SL(6);
            f32x16 acc = {};
#pragma unroll
            for (int s = 0; s < 4; ++s) { const int k0 = 16 * s + 8 * hh;
                const bf16x8 y = frag_row(Am, 32 * ti + l31, k0);
                acc = __builtin_amdgcn_mfma_f32_32x32x16_bf16(wfr[pd][s], y, acc, 0, 0, 0); }
            LAS float* F = pd ? F2 : F1;
#pragma unroll
            for (int g = 0; g < 4; ++g) *(LAS f32x4*)(F + swf_el(32 * ti + l31, 32 * tj + 8 * g + 4 * hh)) = (f32x4){acc[4 * g], acc[4 * g + 1], acc[4 * g + 2], acc[4 * g + 3]};
        }
        LDS_BAR();
        asm volatile("" :: "v"(pf0), "v"(pf1));
        float lw16[16], av16[16], bv16[16], km16[16], rs16[16];
        {
            float kraw[16], icl[16]; float ss = 0.f, bon = 0.f;
#pragma unroll
            for (int sp = 0; sp < 2; ++sp) {
                const int c8 = c16 + 8 * sp, hc8 = h * 64 + c8;
                float kc_[8], kp_[8], rc_[8], rp_[8], vc_[8], vp_[8];
                asm volatile("" : "+v"(gkp[sp]), "+v"(grp[sp]), "+v"(gvp[sp]));
                const u32x4 z4 = {0u, 0u, 0u, 0u};
                unpack8(gk[sp], kc_); unpack8(gr[sp], rc_); unpack8(gv[sp], vc_); unpack8(hpv ? gkp[sp] : z4, kp_); unpack8(hpv ? grp[sp] : z4, rp_); unpack8(hpv ? gvp[sp] : z4, vp_);
                const f32x4 z0 = *(const LAS f32x4*)(F1 + swf_el(te, c8)), z1 = *(const LAS f32x4*)(F1 + swf_el(te, c8 + 4));
                const f32x4 a0_ = *(const LAS f32x4*)(F2 + swf_el(te, c8)), a1_ = *(const LAS f32x4*)(F2 + swf_el(te, c8 + 4));
                const float zz[8] = {z0[0], z0[1], z0[2], z0[3], z1[0], z1[1], z1[2], z1[3]}, ap[8] = {a0_[0], a0_[1], a0_[2], a0_[3], a1_[0], a1_[1], a1_[2], a1_[3]};
                float vs[8];
#pragma unroll
                for (int i = 0; i < 8; ++i) {
                    const int e = 8 * sp + i;
                    const int pc = c8 + i;
                    const float ks = kc_[i] + (kp_[i] - kc_[i]) * parL[384 + pc];
                    rs16[e] = rc_[i] + (rp_[i] - rc_[i]) * parL[320 + pc];
                    vs[i] = vc_[i] + (vp_[i] - vc_[i]) * parL[448 + pc];
                    const float nz = -(parL[pc] + zz[i]), spv = nz > 20.f ? nz : __logf(1.f + __expf(nz));
                    lw16[e] = -__expf(-spv - 0.5f);
                    icl[e] = sigmoidf_(parL[64 + pc] + ap[i]);
                    kraw[e] = ks * parL[128 + pc]; ss += kraw[e] * kraw[e];
                    km16[e] = ks * (1.f + (icl[e] - 1.f) * parL[192 + pc]);
                    bon += rs16[e] * km16[e] * parL[256 + pc];
                }
                *(LAS u32x4*)(SL(7) + sw_el(te, c8)) = pack8f(vs);
            }
            ss += __shfl_xor(ss, 1); ss += __shfl_xor(ss, 2); bon += __shfl_xor(bon, 1); bon += __shfl_xor(bon, 2);
            const float rn = rsqrtf(fmaxf(ss, 1e-24f));
#pragma unroll
            for (int e = 0; e < 16; ++e) { const float kk = kraw[e] * rn; av16[e] = -kk; bv16[e] = kk * icl[e]; }
#pragma unroll
            for (int q4 = 0; q4 < 4; ++q4) *(LAS f32x4*)(F1 + swf_el(te, c16 + 4 * q4)) = (f32x4){lw16[4 * q4], lw16[4 * q4 + 1], lw16[4 * q4 + 2], lw16[4 * q4 + 3]};
            if ((ltid & 3) == 0) ((float*)(p.ws + WS_BONUS))[me * 8 + h] = bon;
        }
        LDS_BAR();
        {
            const int cc = ltid & 63, tq = ltid >> 6;
            float L[16]; L[0] = F1[swf_el(16 * tq, cc)];
#pragma unroll
            for (int i = 1; i < 16; ++i) L[i] = L[i - 1] + F1[swf_el(16 * tq + i, cc)];
            tot[tq * 64 + cc] = L[15];
            LDS_BAR();
            float off = 0.f;
            for (int q = 0; q < tq; ++q) off += tot[q * 64 + cc];
#pragma unroll
            for (int i = 0; i < 16; ++i) F1[swf_el(16 * tq + i, cc)] = off + L[i];
            if (tq == 3) gam[cc] = __expf(off + L[15]);
        }
        LDS_BAR();
        {
            float Lt[16];
#pragma unroll
            for (int q4 = 0; q4 < 4; ++q4) { const f32x4 a = *(const LAS f32x4*)(F1 + swf_el(te, c16 + 4 * q4)); Lt[4 * q4] = a[0]; Lt[4 * q4 + 1] = a[1]; Lt[4 * q4 + 2] = a[2]; Lt[4 * q4 + 3] = a[3]; }
#pragma unroll
            for (int sp = 0; sp < 2; ++sp) {
                float oa[8], ob[8], ok[8], orr[8];
#pragma unroll
                for (int i = 0; i < 8; ++i) { const int e = 8 * sp + i; const float ep = __expf(Lt[e]), en = __builtin_amdgcn_rcpf(ep), e3 = __expf(Lt[e] - lw16[e]);
                    oa[i] = av16[e] * e3; ob[i] = bv16[e] * en; ok[i] = km16[e] * en; orr[i] = rs16[e] * ep; }
                *(LAS u32x4*)(SL(4) + sw_el(te, c16 + 8 * sp)) = pack8f(oa);
                *(LAS u32x4*)(SL(5) + sw_el(te, c16 + 8 * sp)) = pack8f(ob);
                *(LAS u32x4*)(SL(6) + sw_el(te, c16 + 8 * sp)) = pack8f(ok);
                *(LAS u32x4*)(SL(3) + sw_el(te, c16 + 8 * sp)) = pack8f(orr);
            }
        }
        LDS_BAR();
        { const int itn = 2 * min(pr + (int)gridDim.x, 2047) + half; const int w3 = ltid & 3;
          const bf16* rowp = cas + ((size_t)(itn >> 8) * SEQ + 64 * (itn & 31) + te) * LD_CAS + (w3 == 1 ? R0 : w3 == 2 ? V0 : K0) + ((itn >> 5) & 7) * 64;
          pf0 = *(const unsigned*)rowp; pf1 = *(const unsigned*)(rowp + 56); }
        u32x2 rtw[4]; f32x16 y2p, dp;
        {
            const int row = 32 * ti + l31;
            bf16x8 aA[4], aR[4], bB[4], bK0[4], bK1[4];
#pragma unroll
            for (int s = 0; s < 4; ++s) { const int k0 = 16 * s + 8 * hh;
                aA[s] = frag_row(SL(4), row, k0); aR[s] = frag_row(SL(3), row, k0); bB[s] = frag_row(SL(5), 32 * tj + l31, k0);
                bK0[s] = frag_row(SL(6), l31, k0); bK1[s] = frag_row(SL(6), 32 + l31, k0); }
            f32x16 acc = {};
#pragma unroll
            for (int s = 0; s < 4; ++s) acc = __builtin_amdgcn_mfma_f32_32x32x16_bf16(bB[s], aA[s], acc, 0, 0, 0);
#pragma unroll
            for (int r = 0; r < 16; ++r) acc[r] = (32 * tj + crow(r, hh) < row) ? acc[r] : 0.f;
            st_tile(SL(0), acc, ti, tj, l31, hh);
            acc = (f32x16){};
#pragma unroll
            for (int s = 0; s < 4; ++s) acc = __builtin_amdgcn_mfma_f32_32x32x16_bf16(tj ? bK1[s] : bK0[s], aA[s], acc, 0, 0, 0);
#pragma unroll
            for (int r = 0; r < 16; ++r) acc[r] = (32 * tj + crow(r, hh) < row) ? acc[r] : 0.f;
            st_tile(SL(2), acc, ti, tj, l31, hh);
            acc = (f32x16){};
#pragma unroll
            for (int s = 0; s < 4; ++s) acc = __builtin_amdgcn_mfma_f32_32x32x16_bf16(bB[s], aR[s], acc, 0, 0, 0);
#pragma unroll
            for (int r = 0; r < 16; ++r) acc[r] = (32 * tj + crow(r, hh) <= row) ? acc[r] : 0.f;
            st_tile(SL(1), acc, ti, tj, l31, hh);
            f32x16 ak0 = {}, ak1 = {};
#pragma unroll
            for (int s = 0; s < 4; ++s) ak0 = __builtin_amdgcn_mfma_f32_32x32x16_bf16(bK0[s], aR[s], ak0, 0, 0, 0);
#pragma unroll
            for (int r = 0; r < 16; ++r) ak0[r] = (crow(r, hh) <= row) ? ak0[r] : 0.f;
            y2p = (f32x16){};
            mm32_acc(y2p, ak0, SL(7), 0, 32 * tj, lane);
            if (ti) {
#pragma unroll
                for (int s = 0; s < 4; ++s) ak1 = __builtin_amdgcn_mfma_f32_32x32x16_bf16(bK1[s], aR[s], ak1, 0, 0, 0);
#pragma unroll
                for (int r = 0; r < 16; ++r) ak1[r] = (32 + crow(r, hh) <= row) ? ak1[r] : 0.f;
                mm32_acc(y2p, ak1, SL(7), 32, 32 * tj, lane);
            }
            dp = (f32x16){};
            mm_acc<true, false>(dp, SL(7), SL(6), ti, tj, lane);
#pragma unroll
            for (int g = 0; g < 4; ++g) rtw[g] = *(const LAS u32x2*)(SL(3) + sw_el(row, 32 * tj + 8 * g + 4 * hh));
        }
        LDS_BAR();
        if (lw == 0) {
            f32x16 Q0, Q1, T0, T1;
            ld_tile(Q0, SL(0), 0, 0, l31, hh); ld_tile(Q1, SL(0), 1, 1, l31, hh);
#pragma unroll
            for (int r = 0; r < 16; ++r) { const float idn = (crow(r, hh) == l31) ? 1.f : 0.f; T0[r] = Q0[r] + idn; T1[r] = Q1[r] + idn; }
            { f32x16 S0 = {}, S1 = {}; mm32_acc(S0, Q0, SL(0), 0, 0, lane); mm32_acc(S1, Q1, SL(0), 32, 32, lane); Q0 = S0; Q1 = S1; }
#pragma unroll
            for (int k = 1; k <= 4; ++k) {
                st_tile(SL(3), Q0, 0, 0, l31, hh); st_tile(SL(3), Q1, 1, 1, l31, hh);
                const bf16x8 b00 = frag_col_perm(SL(3), 0, 0, lane), b01 = frag_col_perm(SL(3), 16, 0, lane);
                const bf16x8 b10 = frag_col_perm(SL(3), 32, 32, lane), b11 = frag_col_perm(SL(3), 48, 32, lane);
                const bf16x8 t00 = pack8(T0, 0), t01 = pack8(T0, 1), t10 = pack8(T1, 0), t11 = pack8(T1, 1);
                T0 = __builtin_amdgcn_mfma_f32_32x32x16_bf16(b00, t00, T0, 0, 0, 0); T1 = __builtin_amdgcn_mfma_f32_32x32x16_bf16(b10, t10, T1, 0, 0, 0);
                T0 = __builtin_amdgcn_mfma_f32_32x32x16_bf16(b01, t01, T0, 0, 0, 0); T1 = __builtin_amdgcn_mfma_f32_32x32x16_bf16(b11, t11, T1, 0, 0, 0);
                if (k < 4) {
                    const bf16x8 q00 = pack8(Q0, 0), q01 = pack8(Q0, 1), q10 = pack8(Q1, 0), q11 = pack8(Q1, 1);
                    f32x16 S0 = {}, S1 = {};
                    S0 = __builtin_amdgcn_mfma_f32_32x32x16_bf16(b00, q00, S0, 0, 0, 0); S1 = __builtin_amdgcn_mfma_f32_32x32x16_bf16(b10, q10, S1, 0, 0, 0);
                    S0 = __builtin_amdgcn_mfma_f32_32x32x16_bf16(b01, q01, S0, 0, 0, 0); S1 = __builtin_amdgcn_mfma_f32_32x32x16_bf16(b11, q11, S1, 0, 0, 0);
                    Q0 = S0; Q1 = S1;
                }
            }
            st_tile(SL(3), T0, 0, 0, l31, hh); st_tile(SL(3), T1, 1, 1, l31, hh);
            { const f32x16 z = {}; st_tile(SL(3), z, 0, 1, l31, hh); }
            f32x16 Mx = {};
#pragma unroll
            for (int s = 0; s < 2; ++s) { const int k0 = 16 * s + 8 * hh;
                Mx = __builtin_amdgcn_mfma_f32_32x32x16_bf16(frag_col(SL(3), k0, 0, lane), frag_row(SL(0), 32 + l31, k0), Mx, 0, 0, 0); }
            st_tile(SL(3), Mx, 1, 0, l31, hh);
            f32x16 T21 = {};
            mm32_acc(T21, T1, SL(3), 32, 0, lane);
            st_tile(SL(3), T21, 1, 0, l31, hh);
        } else if (lw == 3) {
            f32x16 x0 = {}, x1 = {};
#pragma unroll
            for (int s = 0; s < 2; ++s) { const int k0 = 16 * s + 8 * hh; const bf16x8 a = frag_row(SL(2), l31, k0);
                x0 = __builtin_amdgcn_mfma_f32_32x32x16_bf16(frag_col(SL(7), k0, 0, lane), a, x0, 0, 0, 0);
                x1 = __builtin_amdgcn_mfma_f32_32x32x16_bf16(frag_col(SL(7), k0, 32, lane), a, x1, 0, 0, 0); }
            st_tile(SL(6), x0, 0, 0, l31, hh); st_tile(SL(6), x1, 0, 1, l31, hh);
        } else {
            f32x16 x = {}; mm_acc<false, false>(x, SL(2), SL(7), 1, lw - 1, lane); st_tile(SL(6), x, 1, lw - 1, l31, hh);
        }
        LDS_BAR();
        { f32x16 acc = {}; mm_acc<false, false>(acc, SL(3), SL(4), ti, tj, lane); st_tile(SL(0), acc, ti, tj, l31, hh);
          f32x16 a2 = {}; mm_acc<false, false>(a2, SL(3), SL(6), ti, tj, lane); st_tile(SL(2), a2, ti, tj, l31, hh); }
        LDS_BAR();
        {
            unsigned char* ob = (unsigned char*)p.out;
            { f32x16 acc;
#pragma unroll
              for (int g = 0; g < 4; ++g) { acc[4 * g] = bflo(rtw[g].x); acc[4 * g + 1] = bfhi(rtw[g].x); acc[4 * g + 2] = bflo(rtw[g].y); acc[4 * g + 3] = bfhi(rtw[g].y); }
              mm_acc<false, false>(acc, SL(1), SL(0), ti, tj, lane);
              st_native_global((bf16*)(ob + OUT_Y1) + (size_t)item * 4096, acc, ti * 2 + tj, lane); }
            { f32x16 g2 = {};
              mm_acc<true, false>(g2, SL(5), SL(0), ti, tj, lane);
              const float gm = gam[32 * ti + l31];
#pragma unroll
              for (int r = 0; r < 16; ++r) g2[r] = (g2[r] + ((32 * tj + crow(r, hh) == 32 * ti + l31) ? 1.f : 0.f)) * gm;
              st_native_global((bf16*)(ob + OUT_G) + (size_t)item * 4096, g2, ti * 2 + tj, lane); }
            { mm_acc<false, false>(y2p, SL(1), SL(2), ti, tj, lane);
              st_native_global((bf16*)(ob + OUT_Y2) + (size_t)item * 4096, y2p, tj * 2 + ti, lane); }
            { mm_acc<true, false>(dp, SL(2), SL(5), ti, tj, lane);
#pragma unroll
              for (int r = 0; r < 16; ++r) dp[r] *= gam[32 * tj + crow(r, hh)];
              st_native_global((bf16*)(ob + OUT_D) + (size_t)item * 4096, dp, tj * 2 + ti, lane); }
        }
    }
#undef SL
#undef LDS_BAR
#undef E1_FETCH
}

DI void phase5a(const Params& p) {
    const int tid = threadIdx.x, lane = tid & 63, wave = tid >> 6, l31 = lane & 31, hh = lane >> 5;
    if (blockIdx.x >= 16) return;
    const unsigned char* ob = (const unsigned char*)p.out;
    {
        const int chain = blockIdx.x * 8 + wave;
        f32x16 H[2][2];
#pragma unroll
        for (int a = 0; a < 2; ++a)
#pragma unroll
            for (int c2 = 0; c2 < 2; ++c2) H[a][c2] = (f32x16){};
        bf16x8 gf[2][2][2];
        { const bf16* Gp = (const bf16*)(ob + OUT_G) + (size_t)chain * 32 * 4096;
#pragma unroll
          for (int ti = 0; ti < 2; ++ti)
#pragma unroll
              for (int tk = 0; tk < 2; ++tk)
#pragma unroll
                  for (int s = 0; s < 2; ++s) gf[ti][tk][s] = *(const bf16x8*)(Gp + (ti * 2 + tk) * 1024 + 512 * s + lane * 8); }
        for (int c = 0; c < 32; ++c) {
            const size_t item = (size_t)chain * 32 + c;
            const bf16* Dn = (const bf16*)(ob + OUT_D) + item * 4096;
            bf16x8 gn[2][2][2];
            { const bf16* Gp = (const bf16*)(ob + OUT_G) + (item + (c < 31 ? 1 : 0)) * 4096;
#pragma unroll
              for (int ti = 0; ti < 2; ++ti)
#pragma unroll
                  for (int tk = 0; tk < 2; ++tk)
#pragma unroll
                      for (int s = 0; s < 2; ++s) gn[ti][tk][s] = *(const bf16x8*)(Gp + (ti * 2 + tk) * 1024 + 512 * s + lane * 8); }
            f32x16 Dv[2][2];
#pragma unroll
            for (int ti = 0; ti < 2; ++ti)
#pragma unroll
                for (int tj = 0; tj < 2; ++tj) ld_native_global(Dv[ti][tj], Dn, ti * 2 + tj, lane);
            bf16x8 hp[2][2][2];
            u32x4* hs = (u32x4*)((bf16*)(p.ws + WS_HS) + item * 4096);
#pragma unroll
            for (int tk = 0; tk < 2; ++tk)
#pragma unroll
                for (int tj = 0; tj < 2; ++tj)
#pragma unroll
                    for (int s = 0; s < 2; ++s) { hp[tk][tj][s] = pack8(H[tk][tj], s); hs[((tk * 2 + tj) * 2 + s) * 64 + lane] = __builtin_bit_cast(u32x4, hp[tk][tj][s]); }
#pragma unroll
            for (int ti = 0; ti < 2; ++ti)
#pragma unroll
                for (int tj = 0; tj < 2; ++tj) {
                    f32x16 acc = Dv[ti][tj];
#pragma unroll
                    for (int tk = 0; tk < 2; ++tk)
#pragma unroll
                        for (int s = 0; s < 2; ++s) acc = __builtin_amdgcn_mfma_f32_32x32x16_bf16(gf[ti][tk][s], hp[tk][tj][s], acc, 0, 0, 0);
                    H[ti][tj] = acc;
                }
#pragma unroll
            for (int ti = 0; ti < 2; ++ti)
#pragma unroll
                for (int tk = 0; tk < 2; ++tk)
#pragma unroll
                    for (int s = 0; s < 2; ++s) gf[ti][tk][s] = gn[ti][tk][s];
        }
    }
    asm volatile("s_waitcnt vmcnt(0)" ::: "memory");
    __syncthreads();
    if (tid == 0) { __builtin_amdgcn_fence(__ATOMIC_RELEASE, "agent"); asm volatile("s_waitcnt vmcnt(0)" ::: "memory");
        __hip_atomic_fetch_add((unsigned*)(p.ws + WS_CTL) + 12288, 1u, __ATOMIC_RELAXED, __HIP_MEMORY_SCOPE_AGENT); }
}
DI void phase5b(const Params& p, LAS unsigned char* lds) {
    const int tid0 = threadIdx.x, wave = __builtin_amdgcn_readfirstlane(tid0 >> 6);
    const bf16* cas = (const bf16*)(p.ws + WS_CAS); const bf16* cr = (const bf16*)(p.ws + WS_CR);
    const unsigned char* ob = (const unsigned char*)p.out;
    LAS float* Zl = (LAS float*)(lds + wave * 17408);
    LAS unsigned* qL = (LAS unsigned*)(lds + 8 * 17408);
    __syncthreads();
    if (tid0 == 0) { unsigned* done = (unsigned*)(p.ws + WS_CTL) + 12288; unsigned sp = 0;
        while (__hip_atomic_load(done, __ATOMIC_RELAXED, __HIP_MEMORY_SCOPE_AGENT) < 16u) { __builtin_amdgcn_s_sleep(4); if (++sp > (1u << 24)) break; }
        __builtin_amdgcn_fence(__ATOMIC_ACQUIRE, "agent"); asm volatile("s_waitcnt vmcnt(0)" ::: "memory"); }
    __syncthreads();
    unsigned* q5 = (unsigned*)(p.ws + WS_CTL) + 12352;
    for (;;) {
        if (tid0 == 0) qL[0] = atomicAdd(q5, 1u);
        __syncthreads();
        const unsigned qb = qL[0];
        __syncthreads();
        if (qb >= 512u) break;
        const int item = (int)qb * 8 + wave;
        int tid = tid0; asm volatile("" : "+v"(tid));
        const int lane = tid & 63, l31 = lane & 31, hh = lane >> 5;
        const int c = item & 31, h = (item >> 5) & 7, b = item >> 8;
        const bf16* Y1p = (const bf16*)(ob + OUT_Y1) + (size_t)item * 4096; const bf16* Y2n = (const bf16*)(ob + OUT_Y2) + (size_t)item * 4096;
        const u32x4* hs = (const u32x4*)((const bf16*)(p.ws + WS_HS) + (size_t)item * 4096);
        bf16x8 hp[2][2][2];
#pragma unroll
        for (int tk = 0; tk < 2; ++tk)
#pragma unroll
            for (int tj = 0; tj < 2; ++tj)
#pragma unroll
                for (int s = 0; s < 2; ++s) hp[tk][tj][s] = __builtin_bit_cast(bf16x8, hs[((tk * 2 + tj) * 2 + s) * 64 + lane]);
#pragma unroll
        for (int tt = 0; tt < 2; ++tt) {
            f32x16 Z[2];
#pragma unroll
            for (int vj = 0; vj < 2; ++vj) {
                ld_native_global(Z[vj], Y2n, vj * 2 + tt, lane);
#pragma unroll
                for (int tk = 0; tk < 2; ++tk)
#pragma unroll
                    for (int s = 0; s < 2; ++s) {
                        const bf16x8 bb = *(const bf16x8*)(Y1p + (tt * 2 + tk) * 1024 + 512 * s + lane * 8);
                        Z[vj] = __builtin_amdgcn_mfma_f32_32x32x16_bf16(hp[tk][vj][s], bb, Z[vj], 0, 0, 0);
                    }
            }
            float sum = 0.f;
#pragma unroll
            for (int vj = 0; vj < 2; ++vj)
#pragma unroll
                for (int r = 0; r < 16; ++r) sum += Z[vj][r];
            sum += __shfl_xor(sum, 32);
            const float mean = sum * (1.f / 64.f);
            float sq = 0.f;
#pragma unroll
            for (int vj = 0; vj < 2; ++vj)
#pragma unroll
                for (int r = 0; r < 16; ++r) { const float d = Z[vj][r] - mean; sq += d * d; }
            sq += __shfl_xor(sq, 32);
            const float rstd = rsqrtf(sq * (1.f / 64.f) + 64e-5f);
#pragma unroll
            for (int vj = 0; vj < 2; ++vj)
#pragma unroll
                for (int g = 0; g < 4; ++g)
                    *(LAS f32x4*)(Zl + (32 * tt + l31) * 68 + 32 * vj + 8 * g + 4 * hh) =
                        (f32x4){(Z[vj][4 * g] - mean) * rstd, (Z[vj][4 * g + 1] - mean) * rstd, (Z[vj][4 * g + 2] - mean) * rstd, (Z[vj][4 * g + 3] - mean) * rstd};
        }
        const int v8 = (lane & 7) * 8, col = h * 64 + v8;
        float mu[8], lw[8], lb[8];
#pragma unroll
        for (int i = 0; i < 8; ++i) { mu[i] = p.shift_mu[1024 + col + i]; lw[i] = p.ln_x_w[col + i]; lb[i] = p.ln_x_b[col + i]; }
#pragma unroll
        for (int pb = 0; pb < 2; ++pb) {
            u32x4 cw[4], pw[4], sw[4]; float bn[4];
#pragma unroll
            for (int q = 0; q < 4; ++q) { const int t = (4 * pb + q) * 8 + (lane >> 3); const size_t m = (size_t)b * SEQ + 64 * c + t; const bool hprev = (64 * c + t) > 0;
                cw[q] = *(const u32x4*)(cas + m * LD_CAS + V0 + col); pw[q] = *(const u32x4*)(cas + (m - (hprev ? 1 : 0)) * LD_CAS + V0 + col);
                sw[q] = *(const u32x4*)(cr + m * LD_CR + BSILU0 + col); bn[q] = ((const float*)(p.ws + WS_BONUS))[m * 8 + h]; }
#pragma unroll
            for (int q = 0; q < 4; ++q) asm volatile("" : "+v"(cw[q]), "+v"(pw[q]), "+v"(sw[q]), "+v"(bn[q]));
#pragma unroll
            for (int q = 0; q < 4; ++q) { const int t = (4 * pb + q) * 8 + (lane >> 3); const size_t m = (size_t)b * SEQ + 64 * c + t; const bool hprev = (64 * c + t) > 0;
                float cu[8], pv[8], sg[8];
                unpack8(cw[q], cu); unpack8(hprev ? pw[q] : (u32x4){0u, 0u, 0u, 0u}, pv); unpack8(sw[q], sg);
                const float bon = bn[q];
                const f32x4 z0 = *(const LAS f32x4*)(Zl + t * 68 + v8), z1 = *(const LAS f32x4*)(Zl + t * 68 + v8 + 4);
                const float zz[8] = {z0[0], z0[1], z0[2], z0[3], z1[0], z1[1], z1[2], z1[3]};
                float o[8];
#pragma unroll
                for (int i = 0; i < 8; ++i) { const float vsh = cu[i] + (pv[i] - cu[i]) * mu[i]; o[i] = (zz[i] * lw[i] + lb[i] + bon * vsh) * siluf_(sg[i]); }
                u32x4 w; w.x = pk2(o[0], o[1]); w.y = pk2(o[2], o[3]); w.z = pk2(o[4], o[5]); w.w = pk2(o[6], o[7]);
                *(u32x4*)((bf16*)(p.ws + WS_YB) + m * 512 + col) = w; }
        }
    }
}

constexpr int A_STAGE = 81920, A_TILE = 8192;
DI int swz_off(int row, int chunk) { return row * 128 + ((chunk ^ ((row >> 1) & 7)) << 4); }
DI void attn_qk(f32x16& s0, f32x16& s1, const LAS unsigned char* kl, const bf16x8 (&qr)[4], const f32x16& cinit, int l31, int hh) {
#pragma unroll
    for (int d0 = 0; d0 < 4; ++d0) {
        const bf16x8 k0f = *(const LAS bf16x8*)(kl + swz_off(l31, 2 * d0 + hh));
        const bf16x8 k1f = *(const LAS bf16x8*)(kl + swz_off(32 + l31, 2 * d0 + hh));
        s0 = __builtin_amdgcn_mfma_f32_32x32x16_bf16(k0f, qr[d0], d0 == 0 ? cinit : s0, 0, 0, 0);
        s1 = __builtin_amdgcn_mfma_f32_32x32x16_bf16(k1f, qr[d0], d0 == 0 ? cinit : s1, 0, 0, 0);
    }
}
DI void attn_sv(f32x16& s0, f32x16& s1, const LAS unsigned char* vl, int key0, int tq, bool laneok, int tmin, const LAS float* bl, bool win, bool bound,
                float& m_run, float& l_run, f32x16 (&O)[2], int l31, int hh) {
    const bool far = (tmin - (key0 + 63)) >= 128;
    const bool fast = far && !bound;
    int dbase = tq - key0; asm volatile("" : "+v"(dbase));
    float rm = -1e30f, cb = 0.f;
    if (fast) {
        cb = bl[128];
#pragma unroll
        for (int r = 0; r < 16; ++r) rm = fmaxf(rm, fmaxf(s0[r], s1[r]));
        rm = laneok ? rm + cb : -1e30f;
    } else {
        const int dmax = win ? 512 : 0x7fffffff, dmin = bound ? 0 : -0x7fffffff;
#pragma unroll
        for (int r = 0; r < 16; ++r) {
            const int d0_ = dbase - crow(r, hh), d1_ = d0_ - 32;
            const bool v0 = laneok && d0_ >= dmin && d0_ < dmax, v1 = laneok && d1_ >= dmin && d1_ < dmax;
            const float b0 = bl[min(max(d0_, 0), 128)], b1 = bl[min(max(d1_, 0), 128)];
            s0[r] = v0 ? s0[r] + b0 : -1e30f; s1[r] = v1 ? s1[r] + b1 : -1e30f;
            rm = fmaxf(rm, fmaxf(s0[r], s1[r]));
        }
    }
    rm = fmaxf(rm, __shfl_xor(rm, 32));
    if (__any(rm > m_run + 8.f)) {
        const float m_new = fmaxf(m_run, rm), alpha = __builtin_amdgcn_exp2f(m_run - m_new);
        l_run *= alpha; m_run = m_new;
#pragma unroll
        for (int dt = 0; dt < 2; ++dt)
#pragma unroll
            for (int r = 0; r < 16; ++r) O[dt][r] *= alpha;
    }
    const float sh = m_run - cb;
    float rs = 0.f;
    if (fast) {
#pragma unroll
        for (int r = 0; r < 16; ++r) { s0[r] = __builtin_amdgcn_exp2f(s0[r] - sh); s1[r] = __builtin_amdgcn_exp2f(s1[r] - sh); rs += s0[r] + s1[r]; }
        if (!__all(laneok)) { if (!laneok) {
#pragma unroll
            for (int r = 0; r < 16; ++r) { s0[r] = 0.f; s1[r] = 0.f; }
            rs = 0.f; } }
    } else {
#pragma unroll
        for (int r = 0; r < 16; ++r) {
            s0[r] = (s0[r] > -1e29f) ? __builtin_amdgcn_exp2f(s0[r] - sh) : 0.f; s1[r] = (s1[r] > -1e29f) ? __builtin_amdgcn_exp2f(s1[r] - sh) : 0.f;
            rs += s0[r] + s1[r];
        }
    }
    rs += __shfl_xor(rs, 32);
    l_run += rs;
    const bf16x8 p00 = pack8(s0, 0), p01 = pack8(s0, 1), p10 = pack8(s1, 0), p11 = pack8(s1, 1);
#pragma unroll
    for (int dt = 0; dt < 2; ++dt) {
        const int d = 32 * dt + l31;
        O[dt] = __builtin_amdgcn_mfma_f32_32x32x16_bf16(*(const LAS bf16x8*)(vl + swz_off(d, 0 + hh)), p00, O[dt], 0, 0, 0);
        O[dt] = __builtin_amdgcn_mfma_f32_32x32x16_bf16(*(const LAS bf16x8*)(vl + swz_off(d, 2 + hh)), p01, O[dt], 0, 0, 0);
        O[dt] = __builtin_amdgcn_mfma_f32_32x32x16_bf16(*(const LAS bf16x8*)(vl + swz_off(d, 4 + hh)), p10, O[dt], 0, 0, 0);
        O[dt] = __builtin_amdgcn_mfma_f32_32x32x16_bf16(*(const LAS bf16x8*)(vl + swz_off(d, 6 + hh)), p11, O[dt], 0, 0, 0);
    }
}
DI void attn_sv_fast(f32x16& s0, f32x16& s1, const LAS unsigned char* vl, int key0, int tq, bool laneok, int tmin, const LAS float* bl, bool win, bool bound, float cb,
                     float& l_run, f32x16 (&O)[2], int l31, int hh) {
    const bool far = (tmin - (key0 + 63)) >= 128;
    float rs = 0.f;
    if (far && !bound) {
#pragma unroll
        for (int r = 0; r < 16; ++r) { s0[r] = __builtin_amdgcn_exp2f(s0[r]); s1[r] = __builtin_amdgcn_exp2f(s1[r]); }
        if (!__all(laneok)) {
#pragma unroll
            for (int r = 0; r < 16; ++r) { s0[r] = laneok ? s0[r] : 0.f; s1[r] = laneok ? s1[r] : 0.f; }
        }
    } else {
        int dbase = tq - key0; asm volatile("" : "+v"(dbase));
        const int dmax = win ? 512 : 0x7fffffff, dmin = bound ? 0 : -0x7fffffff;
        float b0[16], b1[16];
#pragma unroll
        for (int r = 0; r < 16; ++r) { const int d0_ = dbase - crow(r, hh), d1_ = d0_ - 32; b0[r] = bl[min(max(d0_, 0), 128)]; b1[r] = bl[min(max(d1_, 0), 128)]; }
#pragma unroll
        for (int r = 0; r < 16; ++r) asm volatile("" : "+v"(b0[r]), "+v"(b1[r]));
#pragma unroll
        for (int r = 0; r < 16; ++r) {
            const int d0_ = dbase - crow(r, hh), d1_ = d0_ - 32;
            const bool v0 = laneok && d0_ >= dmin && d0_ < dmax, v1 = laneok && d1_ >= dmin && d1_ < dmax;
            const float e0 = __builtin_amdgcn_exp2f(s0[r] + (b0[r] - cb)), e1 = __builtin_amdgcn_exp2f(s1[r] + (b1[r] - cb));
            s0[r] = v0 ? e0 : 0.f; s1[r] = v1 ? e1 : 0.f;
        }
    }
#pragma unroll
    for (int r = 0; r < 16; ++r) rs += s0[r] + s1[r];
    l_run += rs;
    const bf16x8 p00 = pack8(s0, 0), p01 = pack8(s0, 1), p10 = pack8(s1, 0), p11 = pack8(s1, 1);
#pragma unroll
    for (int dt = 0; dt < 2; ++dt) {
        const int d = 32 * dt + l31;
        O[dt] = __builtin_amdgcn_mfma_f32_32x32x16_bf16(*(const LAS bf16x8*)(vl + swz_off(d, 0 + hh)), p00, O[dt], 0, 0, 0);
        O[dt] = __builtin_amdgcn_mfma_f32_32x32x16_bf16(*(const LAS bf16x8*)(vl + swz_off(d, 2 + hh)), p01, O[dt], 0, 0, 0);
        O[dt] = __builtin_amdgcn_mfma_f32_32x32x16_bf16(*(const LAS bf16x8*)(vl + swz_off(d, 4 + hh)), p10, O[dt], 0, 0, 0);
        O[dt] = __builtin_amdgcn_mfma_f32_32x32x16_bf16(*(const LAS bf16x8*)(vl + swz_off(d, 6 + hh)), p11, O[dt], 0, 0, 0);
    }
}
DI float imp_sum(const LAS float* sL, const LAS float* cL, int q, int j) {
    float v = 0.f;
#pragma unroll
    for (int h4 = 0; h4 < 4; ++h4) { v += sL[(h4 * 64 + q) * 33 + j]; if (j > 0) v += cL[(h4 * 64 + q) * 33 + j]; }
    return v;
}
template <bool FAST>
DI void attn_stream(LAS unsigned char* lds, const bf16* ksel, const bf16* kwin, const bf16* vts, const bf16* vtw, unsigned U, unsigned mysel, int qt, int tq, int tmin,
                    const LAS float* bl, const bf16x8 (&qr)[4], const float (&g3)[3], LAS float* stash, f32x16 (&Ot)[2], int tid, int l31, int hh) {
    const int nsel = __builtin_popcount(U), w0 = qt > 8 ? qt - 8 : 0, ntile = nsel + (qt - w0 + 1);
    const int srow = tid >> 3, sch = tid & 7;
    unsigned rem = U;
    int jseq = 0;
    int jt = 0; bool wt = false;
#define NEXT_TILE() do { if (jseq < nsel) { jt = __builtin_ctz(rem); rem &= rem - 1; wt = false; } else { jt = w0 + (jseq - nsel); wt = true; } ++jseq; } while (0)
#define LOAD_TILE(KR, VR) do { KR = *(const u32x4*)((wt ? kwin : ksel) + (size_t)(64 * jt + srow) * LD_CAS + 8 * sch); \
                               VR = *(const u32x4*)((wt ? vtw : vts) + (size_t)jt * 4096 + srow * 64 + 8 * sch); } while (0)
    u32x4 kr0, vr0, kr1, vr1;
    NEXT_TILE(); int j0 = jt; bool wn0 = wt; LOAD_TILE(kr0, vr0);
    *(LAS u32x4*)(lds + A_STAGE + swz_off(srow, sch)) = kr0; *(LAS u32x4*)(lds + A_STAGE + 2 * A_TILE + swz_off(srow, sch)) = vr0;
    int j1 = 0; bool wn1 = false;
    if (ntile > 1) { NEXT_TILE(); j1 = jt; wn1 = wt; LOAD_TILE(kr0, vr0); }
    __syncthreads();
    float m_run = -1e30f, l_run = 0.f; f32x16 O[2]; O[0] = (f32x16){}; O[1] = (f32x16){};
    const float cbf = bl[128];
    f32x16 cinit;
#pragma unroll
    for (int r = 0; r < 16; ++r) cinit[r] = FAST ? cbf : 0.f;
#define TILE_ITER(I, KRA, VRA, KRB, VRB) do { \
        const int jc = j0; const bool wc = wn0; j0 = j1; wn0 = wn1; \
        if ((I) + 2 < ntile) { NEXT_TILE(); j1 = jt; wn1 = wt; LOAD_TILE(KRB, VRB); } \
        if ((I) == nsel) { if (FAST) l_run += __shfl_xor(l_run, 32); const float f_ = l_run > 0.f ? g3[1] / l_run : 0.f; \
            _Pragma("unroll") for (int dt = 0; dt < 2; ++dt) _Pragma("unroll") for (int r = 0; r < 16; ++r) { stash[(dt * 16 + r) * 64] += f_ * O[dt][r]; O[dt][r] = 0.f; } \
            m_run = -1e30f; l_run = 0.f; } \
        const LAS unsigned char* kl = lds + A_STAGE + ((I) & 1) * A_TILE; \
        const LAS unsigned char* vl = lds + A_STAGE + 2 * A_TILE + ((I) % 3) * A_TILE; \
        const bool ok_ = wc ? true : (bool)((mysel >> jc) & 1u); \
        if (__any(ok_)) { f32x16 s0, s1; attn_qk(s0, s1, kl, qr, cinit, l31, hh); \
            const bool bnd = wc ? (jc == qt || jc + 8 == qt) : (jc == qt); \
            if (FAST) attn_sv_fast(s0, s1, vl, 64 * jc, tq, ok_, tmin, bl, wc, bnd, cbf, l_run, O, l31, hh); \
            else attn_sv(s0, s1, vl, 64 * jc, tq, ok_, tmin, bl, wc, bnd, m_run, l_run, O, l31, hh); } \
        if ((I) + 1 < ntile) { *(LAS u32x4*)(lds + A_STAGE + (((I) + 1) & 1) * A_TILE + swz_off(srow, sch)) = KRA; \
                               *(LAS u32x4*)(lds + A_STAGE + 2 * A_TILE + (((I) + 1) % 3) * A_TILE + swz_off(srow, sch)) = VRA; } \
        asm volatile("s_waitcnt lgkmcnt(0)\n\ts_barrier" ::: "memory"); } while (0)
    for (int i = 0; i < ntile; i += 2) {
        TILE_ITER(i, kr0, vr0, kr1, vr1);
        if (i + 1 < ntile) TILE_ITER(i + 1, kr1, vr1, kr0, vr0);
    }
#undef TILE_ITER
#undef LOAD_TILE
#undef NEXT_TILE
    if (FAST) l_run += __shfl_xor(l_run, 32);
    const float f = l_run > 0.f ? g3[2] / l_run : 0.f;
#pragma unroll
    for (int dt = 0; dt < 2; ++dt)
#pragma unroll
        for (int r = 0; r < 16; ++r) Ot[dt][r] = stash[(dt * 16 + r) * 64] + f * O[dt][r];
}
DI void phase4(const Params& p, LAS unsigned char* lds) {
    const int tid0 = threadIdx.x, wave = __builtin_amdgcn_readfirstlane(tid0 >> 6);
    const int hp = wave & 3, qh = wave >> 2;
    const bf16* cas = (const bf16*)(p.ws + WS_CAS);
    LAS float* biasL = (LAS float*)lds;
    LAS float* sL = (LAS float*)(lds + 4608);
    LAS float* cL = (LAS float*)(lds + 4608 + 33792);
    LAS unsigned* selL = (LAS unsigned*)(lds + 4608 + 2 * 33792);
    LAS unsigned* uL = selL + 64;
    LAS float* impT = (LAS float*)(lds + 4608 + 2 * 33792 + 512);
    LAS float* auxL = (LAS float*)(lds + 81152);
    for (int i = tid0; i < 8 * 132; i += 512) biasL[i] = ((const float*)(p.ws + WS_BIAS))[i];
    if (tid0 == 0) uL[0] = 0u;
    __syncthreads();
    {
        const int ln = tid0 & 63;
        float bm = fmaxf(fabsf(biasL[wave * 132 + ln]), fabsf(biasL[wave * 132 + 64 + ln]));
        if (ln == 0) bm = fmaxf(bm, fabsf(biasL[wave * 132 + 128]));
        const float* gp = wave == 2 ? p.q_norm_gain : p.k_norm_gain + ((wave & 1) + 1) * 64;
        float gm = fabsf(gp[ln]);
#pragma unroll
        for (int o = 32; o >= 1; o >>= 1) { bm = fmaxf(bm, __shfl_xor(bm, o)); gm = fmaxf(gm, __shfl_xor(gm, o)); }
        if (ln == 0) { auxL[wave] = bm; if (wave < 3) auxL[8 + wave] = gm; }
    }
    __syncthreads();
    bool fastmode;
    { float bm = 0.f;
#pragma unroll
      for (int hq = 0; hq < 8; ++hq) bm = fmaxf(bm, auxL[hq]);
      fastmode = (8.1f * auxL[10] * QSCALE) * (8.1f * fmaxf(auxL[8], auxL[9])) + bm <= 96.f; }
    unsigned* qctr = (unsigned*)(p.ws + WS_CTL) + 8192 + 64 * (blockIdx.x & 7);
    for (;;) {
        if (tid0 == 0) uL[1] = atomicAdd(qctr, 1u);
        __syncthreads();
        const unsigned qi = uL[1];
        __syncthreads();
        if (qi >= 128u) break;
        int tid = tid0; asm volatile("" : "+v"(tid));
        const int lane = tid & 63, l31 = lane & 31, hh = lane >> 5;
        const int qt = 31 - (int)(qi & 31), bg = (blockIdx.x & 7) + 8 * (int)(qi >> 5);
        const int b = bg >> 1, g = bg & 1, head = g * 4 + hp, t0 = 64 * qt, tmin = t0 + 32 * qh, tq = tmin + l31;
        const size_t m = (size_t)b * SEQ + tq;
        const LAS float* bl = biasL + head * 132;
        bf16x8 qr[4];
#pragma unroll
        for (int d0 = 0; d0 < 4; ++d0) qr[d0] = *(const bf16x8*)(cas + m * LD_CAS + Q0 + head * 64 + 16 * d0 + 8 * hh);
        float g3[3];
#pragma unroll
        for (int br = 0; br < 3; ++br) g3[br] = sigmoidf_(bf2f(cas[m * LD_CAS + GATE0 + br * 8 + head]));
        f32x16 Ot[2]; Ot[0] = (f32x16){}; Ot[1] = (f32x16){};
        {
            const bf16* kcb = (const bf16*)(p.ws + WS_KC) + (size_t)bg * 128 * 64;
            const bf16* vcb = (const bf16*)(p.ws + WS_VCT) + (size_t)bg * 64 * 128;
            f32x16 sc[4];
#pragma unroll
            for (int kt = 0; kt < 4; ++kt) { sc[kt] = (f32x16){};
#pragma unroll
                for (int d0 = 0; d0 < 4; ++d0) sc[kt] = __builtin_amdgcn_mfma_f32_32x32x16_bf16(*(const bf16x8*)(kcb + (size_t)(32 * kt + l31) * 64 + 16 * d0 + 8 * hh), qr[d0], sc[kt], 0, 0, 0); }
            float mc = -1e30f;
#pragma unroll
            for (int kt = 0; kt < 4; ++kt) {
                float bv[16];
#pragma unroll
                for (int r = 0; r < 16; ++r) { const int n = 32 * kt + crow(r, hh), dist = tq - 16 * n - 31; bv[r] = bl[min(max(dist, 0), 128)]; }
#pragma unroll
                for (int r = 0; r < 16; ++r) asm volatile("" : "+v"(bv[r]));
#pragma unroll
                for (int r = 0; r < 16; ++r) { const int n = 32 * kt + crow(r, hh), dist = tq - 16 * n - 31; const bool ok = dist >= 0 && n < 127;
                    sc[kt][r] = ok ? sc[kt][r] + bv[r] : -1e30f; mc = fmaxf(mc, sc[kt][r]); }
            }
            mc = fmaxf(mc, __shfl_xor(mc, 32));
            float lc = 0.f;
#pragma unroll
            for (int kt = 0; kt < 4; ++kt)
#pragma unroll
                for (int r = 0; r < 16; ++r) { sc[kt][r] = (sc[kt][r] > -1e29f) ? __builtin_amdgcn_exp2f(sc[kt][r] - mc) : 0.f; lc += sc[kt][r]; }
            lc += __shfl_xor(lc, 32);
            const float inv = lc > 0.f ? 1.f / lc : 0.f;
            const int q = 32 * qh + l31;
#pragma unroll
            for (int kt = 0; kt < 4; ++kt) {
#pragma unroll
                for (int r = 0; r < 16; ++r) sc[kt][r] *= inv;
#pragma unroll
                for (int g4 = 0; g4 < 4; ++g4) { const int j = 8 * kt + 2 * g4 + hh;
                    sL[(hp * 64 + q) * 33 + j] = 2.f * (sc[kt][4 * g4] + sc[kt][4 * g4 + 1] + sc[kt][4 * g4 + 2]) + sc[kt][4 * g4 + 3];
                    cL[(hp * 64 + q) * 33 + j + 1] = sc[kt][4 * g4 + 3]; }
            }
            f32x16 oc[2]; oc[0] = (f32x16){}; oc[1] = (f32x16){};
#pragma unroll
            for (int dt = 0; dt < 2; ++dt)
#pragma unroll
                for (int kt = 0; kt < 4; ++kt)
#pragma unroll
                    for (int s = 0; s < 2; ++s)
                        oc[dt] = __builtin_amdgcn_mfma_f32_32x32x16_bf16(*(const bf16x8*)(vcb + (size_t)(32 * dt + l31) * 128 + 32 * kt + 16 * s + 8 * hh), pack8(sc[kt], s), oc[dt], 0, 0, 0);
#pragma unroll
            for (int dt = 0; dt < 2; ++dt)
#pragma unroll
                for (int r = 0; r < 16; ++r) Ot[dt][r] = g3[0] * oc[dt][r];
        }
        __syncthreads();
        {
            const int q = tid >> 3, sub = tid & 7;
            unsigned mask = 0u;
            if (qt < 16) mask = (2u << qt) - 1u;
            else {
#pragma unroll
                for (int i2 = 0; i2 < 4; ++i2) impT[q * 33 + sub + 8 * i2] = imp_sum(sL, cL, q, sub + 8 * i2);
                __syncthreads();
                float vj[4]; int rank[4];
#pragma unroll
                for (int i2 = 0; i2 < 4; ++i2) { vj[i2] = impT[q * 33 + sub + 8 * i2]; rank[i2] = 0; }
#pragma unroll 2
                for (int jj = 1; jj <= qt - 2; ++jj) {
                    const float vv = impT[q * 33 + jj];
#pragma unroll
                    for (int i2 = 0; i2 < 4; ++i2) { const int j = sub + 8 * i2;
                        rank[i2] += (int)((jj != j) & ((vv > vj[i2]) | ((vv == vj[i2]) & (jj < j)))); }
                }
#pragma unroll
                for (int i2 = 0; i2 < 4; ++i2) { const int j = sub + 8 * i2;
                    const bool forced = (j == 0) || (j == qt) || (j == qt - 1), cand = (j >= 1) && (j <= qt - 2);
                    if (forced || (cand && rank[i2] < 13)) mask |= 1u << j; }
                mask |= __shfl_xor(mask, 1); mask |= __shfl_xor(mask, 2); mask |= __shfl_xor(mask, 4);
            }
            if (sub == 0) { selL[q] = mask; __hip_atomic_fetch_or(uL, mask, __ATOMIC_RELAXED, __HIP_MEMORY_SCOPE_WORKGROUP); }
        }
        __syncthreads();
        const unsigned mysel = selL[32 * qh + l31], U = uL[0];
        LAS float* stash = (LAS float*)(lds + 4608 + wave * 8192) + lane;
#pragma unroll
        for (int dt = 0; dt < 2; ++dt)
#pragma unroll
            for (int r = 0; r < 16; ++r) stash[(dt * 16 + r) * 64] = Ot[dt][r];
        {
            const bf16* ksel = cas + (size_t)(b * SEQ) * LD_CAS + KS0 + g * 64; const bf16* kwin = cas + (size_t)(b * SEQ) * LD_CAS + KW0 + g * 64;
            const bf16* vts = (const bf16*)(p.ws + WS_VTS) + (size_t)bg * 32 * 4096; const bf16* vtw = (const bf16*)(p.ws + WS_VTW) + (size_t)bg * 32 * 4096;
            if (fastmode) attn_stream<true>(lds, ksel, kwin, vts, vtw, U, mysel, qt, tq, tmin, bl, qr, g3, stash, Ot, tid, l31, hh);
            else attn_stream<false>(lds, ksel, kwin, vts, vtw, U, mysel, qt, tq, tmin, bl, qr, g3, stash, Ot, tid, l31, hh);
        }
        u32x2 aw[2][4];
#pragma unroll
        for (int dt = 0; dt < 2; ++dt)
#pragma unroll
            for (int g4 = 0; g4 < 4; ++g4) aw[dt][g4] = *(const u32x2*)(cas + m * LD_CAS + ASILU0 + head * 64 + 32 * dt + 8 * g4 + 4 * hh);
        asm volatile("s_waitcnt lgkmcnt(0)\n\ts_barrier" ::: "memory");
#pragma unroll
        for (int dt = 0; dt < 2; ++dt)
#pragma unroll
            for (int g4 = 0; g4 < 4; ++g4) asm volatile("" : "+v"(aw[dt][g4]));
#pragma unroll
        for (int dt = 0; dt < 2; ++dt)
#pragma unroll
            for (int g4 = 0; g4 < 4; ++g4) {
                const int col = head * 64 + 32 * dt + 8 * g4 + 4 * hh;
                u32x2 w; w.x = pk2(Ot[dt][4 * g4] * siluf_(bflo(aw[dt][g4].x)), Ot[dt][4 * g4 + 1] * siluf_(bfhi(aw[dt][g4].x)));
                w.y = pk2(Ot[dt][4 * g4 + 2] * siluf_(bflo(aw[dt][g4].y)), Ot[dt][4 * g4 + 3] * siluf_(bfhi(aw[dt][g4].y)));
                *(u32x2*)((bf16*)(p.ws + WS_YA) + m * 512 + col) = w;
            }
        if (tid == 0) uL[0] = 0u;
    }
}
DI void phase3(const Params& p, LAS unsigned char* lds) { phase3a(p, lds); phase3b(p, lds); phase3c(p, lds); }


#define XB_TMO      128
#define XB_XCNT(j)  (256  + 64 * (j))
#define XB_XSUB(j)  (1280 + 64 * (j))
#define XB_XGEN(j)  (2304 + 64 * (j))
#define XB_TOP      3328
#define XB_TOPGEN   3392
#define XCD_BAR_WORDS 3456
#define XB_SPIN_CAP (1u << 22)
DI unsigned xb_ld(unsigned* p)              { return __hip_atomic_load(p, __ATOMIC_RELAXED, __HIP_MEMORY_SCOPE_AGENT); }
DI unsigned xb_add(unsigned* p, unsigned v) { return __hip_atomic_fetch_add(p, v, __ATOMIC_RELAXED, __HIP_MEMORY_SCOPE_AGENT); }
DI unsigned xb_xcc_id() { return (unsigned)__builtin_amdgcn_s_getreg((3 << 11) | 20) & 0xFu; }
#define XB_SPIN(cond, bar) do { unsigned _sp = 0; while (cond) { __builtin_amdgcn_s_sleep(1); \
    if ((++_sp & 255u) == 0u) { if (xb_ld(&(bar)[XB_TMO])) break; if (_sp > XB_SPIN_CAP) { atomicAdd(&(bar)[XB_TMO], 1u); break; } } } } while (0)
struct XcdBarrier { unsigned* bar; unsigned x; volatile LAS unsigned* st; };
DI XcdBarrier xcd_barrier_post(unsigned* bar, volatile LAS unsigned* st) {
    XcdBarrier b; b.bar = bar; b.x = xb_xcc_id(); b.st = st;
    if (threadIdx.x == 0) (void)xb_add(&bar[XB_XCNT(b.x)], 1u);
    return b;
}
DI void xcd_barrier_complete(unsigned* bar, unsigned x, unsigned& nloc, unsigned& nx) {
    const unsigned G = gridDim.x * gridDim.y * gridDim.z;
    unsigned sum, cnt, mine, sp = 0u;
    for (;;) {
        sum = 0u; cnt = 0u; mine = 0u;
#pragma unroll
        for (unsigned j = 0; j < 16; ++j) { const unsigned c = xb_ld(&bar[XB_XCNT(j)]); sum += c; cnt += (c > 0u) ? 1u : 0u; mine = (j == x) ? c : mine; }
        if (sum == G) break;
        __builtin_amdgcn_s_sleep(1);
        if ((++sp & 255u) == 0u) { if (xb_ld(&bar[XB_TMO])) break; if (sp > XB_SPIN_CAP) { atomicAdd(&bar[XB_TMO], 1u); break; } }
    }
    nloc = mine > 0u ? mine : 1u; nx = cnt > 0u ? cnt : 1u;
}
DI void xcd_barrier(const XcdBarrier& b) {
    asm volatile("s_waitcnt vmcnt(0)" ::: "memory");
    __syncthreads();
    if (threadIdx.x == 0) {
        unsigned* bar = b.bar;
        __builtin_amdgcn_s_waitcnt(0);
        unsigned nloc = b.st[0], nx = b.st[1];
        if (nloc == 0u) { xcd_barrier_complete(bar, b.x, nloc, nx); b.st[0] = nloc; b.st[1] = nx; }
        const unsigned old = xb_add(&bar[XB_XSUB(b.x)], 1u);
        const unsigned gen = old / nloc;
        if (old + 1u == (gen + 1u) * nloc) {
            __builtin_amdgcn_fence(__ATOMIC_RELEASE, "agent");
            asm volatile("s_waitcnt vmcnt(0)" ::: "memory");
            const unsigned og = xb_add(&bar[XB_TOP], 1u);
            const unsigned tg = og / nx;
            if (og + 1u == (tg + 1u) * nx) xb_add(&bar[XB_TOPGEN], 1u);
            else XB_SPIN(xb_ld(&bar[XB_TOPGEN]) == tg, bar);
            __builtin_amdgcn_fence(__ATOMIC_ACQUIRE, "agent");
            xb_add(&bar[XB_XGEN(b.x)], 1u);
            asm volatile("s_waitcnt vmcnt(0)" ::: "memory");
        } else {
            XB_SPIN(xb_ld(&bar[XB_XGEN(b.x)]) == gen, bar);
            __builtin_amdgcn_fence(__ATOMIC_ACQUIRE, "agent");
            asm volatile("s_waitcnt vmcnt(0)" ::: "memory");
        }
    }
    __syncthreads();
}

__global__ void __launch_bounds__(512, 2) hybrid_fwd(Params p) {
    extern __shared__ __attribute__((aligned(16))) unsigned char lds_raw[];
    LAS unsigned char* lds = (LAS unsigned char*)lds_raw;
#if USE_CG_SYNC
    cg::grid_group grid = cg::this_grid();
#define GRID_BAR() grid.sync()
#else
    volatile LAS unsigned* bst = (volatile LAS unsigned*)(lds + LDS_BYTES - 64);
    if (threadIdx.x < 2) bst[threadIdx.x] = 0u;
    __syncthreads();
    const XcdBarrier xbar = xcd_barrier_post((unsigned*)(p.ws + WS_CTL) + 1024, bst);
#define GRID_BAR() xcd_barrier(xbar)
#endif
    const int lo = p.ph_lo, hi = p.ph_hi;
#ifdef ONLYP
#define IN(k) ((k) == ONLYP && lo <= (k) && (k) < hi)
#else
#define IN(k) (lo <= (k) && (k) < hi)
#endif
#define SEAM(k) do { if (IN(k) && IN((k) + 1)) GRID_BAR(); } while (0)
    unsigned char* ws = p.ws;
    if (IN(0)) { phase0(p, lds); }
    SEAM(0);
    if (IN(1)) { phase1(p, lds); phase0w(p, lds); }
    SEAM(1);
    if (IN(2)) {
        pg8::Gemm g{(const bf16*)((unsigned char*)p.out + OUT_H), (const bf16*)(ws + WS_WIN_T), MTOK, N_IN_PAD, DM, DM, DM};
        pg8::StaticOrder S; S.init(MTOK, N_IN_PAD, gridDim.x, blockIdx.x);
        EpiInProj E{(bf16*)(ws + WS_CAS), (bf16*)(ws + WS_CR)};
        pg8::gemm_phase<EpiInProj, pg8::StaticOrder>(lds, g, S, E);
    }
    SEAM(2);
    if (IN(3)) { phase3(p, lds); }
    SEAM(3);
    if (IN(4)) { phase5a(p); phase4(p, lds); __syncthreads(); phase5b(p, lds); }
    SEAM(5);
    if (IN(6)) {
        { pg8::Gemm g{(const bf16*)(ws + WS_YA), (const bf16*)(ws + WS_WA_T), MTOK, DM, 512, 512, 512};
          pg8::StaticOrder S; S.init(MTOK, DM, gridDim.x, blockIdx.x);
          EpiGate<0> E{(bf16*)(ws + WS_MERGED), (const bf16*)(ws + WS_CR)};
          pg8::gemm_phase<EpiGate<0>, pg8::StaticOrder>(lds, g, S, E); }
        { pg8::Gemm g{(const bf16*)(ws + WS_YB), (const bf16*)(ws + WS_WB_T), MTOK, DM, 512, 512, 512};
          pg8::StaticOrder S; S.init(MTOK, DM, gridDim.x, blockIdx.x);
          EpiGate<1> E{(bf16*)(ws + WS_MERGED), (const bf16*)(ws + WS_CR)};
          pg8::gemm_phase<EpiGate<1>, pg8::StaticOrder>(lds, g, S, E); }
    }
    SEAM(6);
    if (IN(7)) {
        pg8::Gemm g{(const bf16*)(ws + WS_MERGED), (const bf16*)(ws + WS_WO_T), MTOK, DM, DM, DM, DM};
        pg8::StaticOrder S; S.init(MTOK, DM, gridDim.x, blockIdx.x);
        EpiFinal E{p.x, (const float*)(ws + WS_MOD), p.out};
        pg8::gemm_phase<EpiFinal, pg8::StaticOrder>(lds, g, S, E);
    }
#undef IN
#undef SEAM
}

extern "C" void kernel_launch(void* const* d_in, const int* in_sizes, int n_in, void* d_out, int out_size, void* d_ws, size_t ws_size, hipStream_t stream) {
    static int grid = 0;
    if (grid == 0) {
        if (n_in != 28 || out_size != MTOK * DM || ws_size < WS_END) { fprintf(stderr, "kernel_launch: unexpected shapes (n_in %d out %d ws %zu)\n", n_in, out_size, ws_size); grid = -1; return; }
        int dev = 0, cus = 0, per_cu = 0;
        (void)hipGetDevice(&dev); (void)hipDeviceGetAttribute(&cus, hipDeviceAttributeMultiprocessorCount, dev);
        if (hipFuncSetAttribute((const void*)hybrid_fwd, hipFuncAttributeMaxDynamicSharedMemorySize, LDS_BYTES) != hipSuccess) { fprintf(stderr, "kernel_launch: hipFuncSetAttribute failed\n"); grid = -1; return; }
        if (hipOccupancyMaxActiveBlocksPerMultiprocessor(&per_cu, (const void*)hybrid_fwd, 512, LDS_BYTES) != hipSuccess || per_cu < 1) { fprintf(stderr, "kernel_launch: occupancy query says %d\n", per_cu); per_cu = 1; }
        (void)hipGetLastError();
        grid = cus * 1;
        if (grid <= 0) grid = 256;
    }
    if (grid < 0) return;
    (void)hipMemsetAsync((char*)d_ws + WS_CTL, 0, CTL_ZERO_BYTES, stream);
    Params p{};
    const float** pp = (const float**)&p;
    for (int i = 0; i < 28; ++i) pp[i] = (const float*)d_in[i];
    p.out = (float*)d_out; p.ws = (unsigned char*)d_ws;
#if MK_LAUNCHES == 1
    p.ph_lo = 0; p.ph_hi = 8;
    void* args[] = {&p};
    hipError_t e = hipLaunchCooperativeKernel((const void*)hybrid_fwd, dim3(grid), dim3(512), args, LDS_BYTES, stream);
    if (e != hipSuccess) fprintf(stderr, "cooperative launch failed: %s (grid %d)\n", hipGetErrorString(e), grid);
#else
    const int cuts[][2] = {{0, 1}, {1, 2}, {2, 3}, {3, 4}, {4, 5}, {5, 6}, {6, 7}, {7, 8}};
    for (int li = 0; li < 8; ++li) {
        p.ph_lo = cuts[li][0]; p.ph_hi = cuts[li][1];
        hipLaunchKernelGGL(hybrid_fwd, dim3(grid), dim3(512), LDS_BYTES, stream, p);
    }
#endif
}
```

```cpp
#include <hip/hip_runtime.h>
#include <hip/hip_cooperative_groups.h>
#include <cstdio>
#include <cstdint>
namespace cg = cooperative_groups;

#ifndef USE_CG_SYNC
#define USE_CG_SYNC 0
#endif
#ifndef MK_LAUNCHES
#define MK_LAUNCHES 1
#endif

#define DI __device__ __forceinline__
#define LAS __attribute__((address_space(3)))
typedef unsigned short bf16;
typedef short bf16x8 __attribute__((ext_vector_type(8)));
typedef short s16x4 __attribute__((ext_vector_type(4)));
typedef float f32x2 __attribute__((ext_vector_type(2)));
typedef float f32x4 __attribute__((ext_vector_type(4)));
typedef float f32x16 __attribute__((ext_vector_type(16)));
typedef unsigned u32x2 __attribute__((ext_vector_type(2)));
typedef unsigned u32x4 __attribute__((ext_vector_type(4)));
typedef __bf16 bf16x2_t __attribute__((ext_vector_type(2)));

namespace pg8 {
typedef unsigned short bf16_t;
constexpr int BM = 256, BK = 64, HALF = 128, HTB = HALF * BK * 2, STAGE_BYTES = 8 * HTB, NXCD = 8, WGM = 8;
__host__ __device__ __forceinline__ int lds_byte(int r, int c) { const int st = (r >> 4) * 2 + (c >> 5), rr = r & 15, cc = c & 31, ob = rr * 64 + cc * 2; return st * 1024 + (ob ^ (((ob >> 9) & 1) << 5)); }
__host__ __device__ __forceinline__ void stage_rc(int b, int& R, int& C) { const int st = b / 1024, sb = b % 1024, swz = sb ^ (((sb >> 9) & 1) << 5); R = (st >> 1) * 16 + swz / 64; C = (st & 1) * 32 + (swz % 64) / 2; }
__host__ __device__ __forceinline__ int perm32(int rho) { const int n = rho >> 4, i = rho & 15; return 8 * (i >> 2) + 4 * n + (i & 3); }
struct Unit { int pm, pn; };
struct Gemm { const bf16_t* A; const bf16_t* Bt; int M, N, K, lda, ldb; };
struct StaticOrder {
    int nM, nN, nwg, G, c;
    __host__ __device__ void init(int M, int N, int G_, int c_) { nM = M / BM; nN = N / BM; nwg = nM * nN; G = G_; c = c_; }
    __host__ __device__ bool next(int i, Unit& u) const {
        const long L = (long)i * G + c; if (L >= nwg) return false;
        int wgid = (int)L; { const int q = nwg / NXCD, r = nwg % NXCD, xcd = wgid % NXCD, off = wgid / NXCD; wgid = (xcd < r ? xcd * (q + 1) : r * (q + 1) + (xcd - r) * q) + off; }
        const int nig = WGM * nN, gid = wgid / nig, fm = gid * WGM, gsz = (nM - fm) < WGM ? (nM - fm) : WGM;
        u.pm = fm + ((wgid % nig) % gsz); u.pn = (wgid % nig) / gsz; return true;
    }
};
__device__ __forceinline__ unsigned cvt_pk_bf16(float lo, float hi) { unsigned r; asm volatile("v_cvt_pk_bf16_f32 %0, %1, %2" : "=v"(r) : "v"(lo), "v"(hi)); return r; }

template <class Epi, class Sched, bool ALIGN_EPI = true, bool SP2 = true>
__device__ __forceinline__ void gemm_phase(LAS unsigned char* lds, const Gemm g, const Sched& S, const Epi& E) {
    const int tid = threadIdx.x, wid = __builtin_amdgcn_readfirstlane(tid >> 6), lane = tid & 63, wr = wid >> 2, wc = wid & 3, fr = lane & 15, fq = lane >> 4;
    const int K = g.K, nt = K / BK;
    unsigned voffA[2], voffB[2];
#pragma unroll
    for (int i = 0; i < 2; ++i) { int R, C; stage_rc(tid * 16 + i * 8192, R, C); const int Rb = Epi::PERM ? ((R & ~31) + perm32(R & 31)) : R;
        voffA[i] = (unsigned)(R * g.lda + C) * 2u; voffB[i] = (unsigned)(Rb * g.ldb + C) * 2u; }
    const size_t kstep = (size_t)(BK * 2);
    const size_t hstepA = (size_t)HALF * g.lda * 2, hstepB = (size_t)HALF * g.ldb * 2;
    const size_t tstepA = 2 * hstepA, tstepB = 2 * hstepB;
    const unsigned ldsw = (unsigned)wid * 1024u;
    const int aoff = lds_byte(wr * 64 + fr, fq * 8), boff = lds_byte(wc * 32 + fr, fq * 8);
#define PG8_SA(b, h) (((b) * 2 + (h)) * HTB)
#define PG8_SB(b, h) ((4 + (b) * 2 + (h)) * HTB)
#define PG8_STAGE(bufoff, gbase, voff) do { _Pragma("unroll") for (int _i = 0; _i < 2; ++_i) \
        __builtin_amdgcn_global_load_lds((const unsigned*)((const char*)(gbase) + (voff)[_i]), (LAS unsigned*)(lds + (bufoff) + ldsw + _i * 8192), 16, 0, 0); } while (0)
#define PG8_LDA(dst, b, h) do { _Pragma("unroll") for (int m = 0; m < 4; ++m) _Pragma("unroll") for (int k = 0; k < 2; ++k) dst[m][k] = *(const LAS bf16x8*)(lds + PG8_SA(b, h) + aoff + m * 2048 + k * 1024); } while (0)
#define PG8_LDB(dst, b, h) do { _Pragma("unroll") for (int n = 0; n < 2; ++n) _Pragma("unroll") for (int k = 0; k < 2; ++k) dst[n][k] = *(const LAS bf16x8*)(lds + PG8_SB(b, h) + boff + n * 2048 + k * 1024); } while (0)
#define PG8_MMA(ai, bj, At, Bt) do { __builtin_amdgcn_s_setprio(1); _Pragma("unroll") for (int m = 0; m < 4; ++m) _Pragma("unroll") for (int n = 0; n < 2; ++n) _Pragma("unroll") for (int k = 0; k < 2; ++k) \
        acc[ai][bj][m][n] = __builtin_amdgcn_mfma_f32_16x16x32_bf16(Bt[n][k], At[m][k], acc[ai][bj][m][n], 0, 0, 0); __builtin_amdgcn_s_setprio(0); } while (0)
#define PG8_WAIT_V(n) asm volatile("s_waitcnt vmcnt(" #n ")" ::: "memory")
#define PG8_WAIT_L(n) asm volatile("s_waitcnt lgkmcnt(" #n ")" ::: "memory")
#define PG8_BAR __builtin_amdgcn_s_barrier()
#define PG8_SCHED __builtin_amdgcn_sched_barrier(0)
    Unit cur, nxt; int ui = 0;
    if (!S.next(0, cur)) return;
    f32x4 acc[2][2][4][2];
#pragma unroll
    for (int a = 0; a < 2; ++a)
#pragma unroll
        for (int b = 0; b < 2; ++b)
#pragma unroll
            for (int m = 0; m < 4; ++m)
#pragma unroll
                for (int n = 0; n < 2; ++n) acc[a][b][m][n] = (f32x4){0.f, 0.f, 0.f, 0.f};
    bf16x8 At[4][2], B0[2][2], B1[2][2];
    const char* cA = (const char*)g.A + (size_t)cur.pm * tstepA; const char* cB = (const char*)g.Bt + (size_t)cur.pn * tstepB;
    if constexpr (SP2) {
        PG8_STAGE(PG8_SB(0, 0), cB, voffB); PG8_STAGE(PG8_SB(0, 1), cB + hstepB, voffB); PG8_STAGE(PG8_SA(0, 0), cA, voffA); PG8_STAGE(PG8_SA(0, 1), cA + hstepA, voffA);
        if (wr == 1) PG8_BAR;
        PG8_WAIT_V(2); PG8_BAR;
        PG8_STAGE(PG8_SB(1, 0), cB + kstep, voffB); PG8_STAGE(PG8_SA(1, 0), cA + kstep, voffA); PG8_STAGE(PG8_SB(1, 1), cB + hstepB + kstep, voffB);
        PG8_WAIT_V(6); PG8_BAR;
    } else {
        PG8_STAGE(PG8_SB(0, 0), cB, voffB); PG8_STAGE(PG8_SA(0, 0), cA, voffA); PG8_STAGE(PG8_SB(0, 1), cB + hstepB, voffB); PG8_STAGE(PG8_SA(0, 1), cA + hstepA, voffA);
        if (wr == 1) PG8_BAR;
        PG8_WAIT_V(4); PG8_BAR;
        PG8_STAGE(PG8_SB(1, 0), cB + kstep, voffB); PG8_STAGE(PG8_SA(1, 0), cA + kstep, voffA); PG8_STAGE(PG8_SB(1, 1), cB + hstepB + kstep, voffB);
        PG8_WAIT_V(6); PG8_BAR;
    }
    for (;;) {
        const bool has_next = S.next(ui + 1, nxt);
        const char* nA = has_next ? (const char*)g.A + (size_t)nxt.pm * tstepA : cA; const char* nB = has_next ? (const char*)g.Bt + (size_t)nxt.pn * tstepB : cB;
        for (int t = 0; t < nt; t += 2) {
            const bool last = (t == nt - 2);
            const char* a1 = cA + (size_t)(t + 1) * kstep;
            const char* a2 = last ? nA : cA + (size_t)(t + 2) * kstep; const char* b2 = last ? nB : cB + (size_t)(t + 2) * kstep;
            const char* a3 = a2 + kstep; const char* b3 = b2 + kstep;
            if constexpr (SP2) {
            PG8_LDB(B0, 0, 0); PG8_LDB(B1, 0, 1); PG8_SCHED; PG8_LDA(At, 0, 0); PG8_STAGE(PG8_SA(1, 1), a1 + hstepA, voffA);
            PG8_WAIT_V(8); PG8_WAIT_L(0); PG8_BAR; PG8_MMA(0, 0, At, B0); PG8_MMA(0, 1, At, B1); PG8_BAR; PG8_SCHED;
            PG8_LDA(At, 0, 1); PG8_STAGE(PG8_SB(0, 0), b2, voffB); PG8_STAGE(PG8_SB(0, 1), b2 + hstepB, voffB); PG8_STAGE(PG8_SA(0, 0), a2, voffA);
            PG8_WAIT_V(8); PG8_WAIT_L(0); PG8_BAR; PG8_MMA(1, 0, At, B0); PG8_MMA(1, 1, At, B1); PG8_BAR; PG8_SCHED;
            PG8_LDB(B0, 1, 0); PG8_LDB(B1, 1, 1); PG8_SCHED; PG8_LDA(At, 1, 0); PG8_STAGE(PG8_SA(0, 1), a2 + hstepA, voffA);
            PG8_WAIT_V(8); PG8_WAIT_L(0); PG8_BAR; PG8_MMA(0, 0, At, B0); PG8_MMA(0, 1, At, B1); PG8_BAR; PG8_SCHED;
            PG8_LDA(At, 1, 1); PG8_STAGE(PG8_SB(1, 0), b3, voffB); PG8_STAGE(PG8_SB(1, 1), b3 + hstepB, voffB); PG8_STAGE(PG8_SA(1, 0), a3, voffA);
            PG8_WAIT_V(8); PG8_WAIT_L(0); PG8_BAR; PG8_MMA(1, 0, At, B0); PG8_MMA(1, 1, At, B1); PG8_BAR; PG8_SCHED;
            } else {
            PG8_LDB(B0, 0, 0); PG8_SCHED; PG8_LDA(At, 0, 0); PG8_STAGE(PG8_SA(1, 1), a1 + hstepA, voffA);
            PG8_WAIT_L(8); PG8_BAR; PG8_WAIT_L(0); PG8_MMA(0, 0, At, B0); PG8_BAR; PG8_SCHED;
            PG8_LDB(B1, 0, 1); PG8_STAGE(PG8_SB(0, 0), b2, voffB);
            PG8_BAR; PG8_WAIT_L(0); PG8_MMA(0, 1, At, B1); PG8_BAR;
            PG8_LDA(At, 0, 1); PG8_STAGE(PG8_SA(0, 0), a2, voffA);
            PG8_BAR; PG8_WAIT_L(0); PG8_MMA(1, 0, At, B0); PG8_BAR; PG8_SCHED;
            PG8_STAGE(PG8_SB(0, 1), b2 + hstepB, voffB);
            PG8_WAIT_V(6); PG8_BAR; PG8_MMA(1, 1, At, B1); PG8_BAR;
            PG8_LDB(B0, 1, 0); PG8_SCHED; PG8_LDA(At, 1, 0); PG8_STAGE(PG8_SA(0, 1), a2 + hstepA, voffA);
            PG8_WAIT_L(8); PG8_BAR; PG8_WAIT_L(0); PG8_MMA(0, 0, At, B0); PG8_BAR; PG8_SCHED;
            PG8_LDB(B1, 1, 1); PG8_STAGE(PG8_SB(1, 0), b3, voffB);
            PG8_BAR; PG8_WAIT_L(0); PG8_MMA(0, 1, At, B1); PG8_BAR;
            PG8_LDA(At, 1, 1); PG8_STAGE(PG8_SA(1, 0), a3, voffA);
            PG8_BAR; PG8_WAIT_L(0); PG8_MMA(1, 0, At, B0); PG8_BAR; PG8_SCHED;
            PG8_STAGE(PG8_SB(1, 1), b3 + hstepB, voffB);
            PG8_WAIT_V(6); PG8_BAR; PG8_MMA(1, 1, At, B1); PG8_BAR;
            }
        }
        if constexpr (ALIGN_EPI) { if (wr == 0) PG8_BAR; }
        E(acc, cur, wr, wc, fr, fq);
        if (!has_next) break;
#pragma unroll
        for (int a = 0; a < 2; ++a)
#pragma unroll
            for (int b = 0; b < 2; ++b)
#pragma unroll
                for (int m = 0; m < 4; ++m)
#pragma unroll
                    for (int n = 0; n < 2; ++n) acc[a][b][m][n] = (f32x4){0.f, 0.f, 0.f, 0.f};
        cur = nxt; cA = nA; cB = nB; ++ui;
        if constexpr (ALIGN_EPI) { if (wr == 1) PG8_BAR; }
    }
    PG8_WAIT_V(0);
    if constexpr (!ALIGN_EPI) { if (wr == 0) PG8_BAR; }
    PG8_BAR;
#undef PG8_SA
#undef PG8_SB
#undef PG8_STAGE
#undef PG8_LDA
#undef PG8_LDB
#undef PG8_MMA
#undef PG8_WAIT_V
#undef PG8_WAIT_L
#undef PG8_BAR
#undef PG8_SCHED
}
}

constexpr int NB = 16, SEQ = 2048, DM = 1024, MTOK = NB * SEQ;
constexpr int LD_CAS = 3584, LD_CR = 2560, N_IN_PAD = 6144, N_IN = 6040;
constexpr int Q0 = 0, KC0 = 512, VC0 = 640, KS0 = 768, VS0 = 896, KW0 = 1024, VW0 = 1152, GATE0 = 1280, ASILU0 = 1304;
constexpr int SH0 = 1816, R0 = SH0, K0 = SH0 + 512, V0 = SH0 + 1024, WD0 = SH0 + 1536, AD0 = SH0 + 1600, CAS_USED = 3480;
constexpr int BSILU0 = 0, MA0 = 512, MB0 = 1536;
constexpr float LOG2E = 1.4426950408889634f;
constexpr float QSCALE = 0.125f * LOG2E;

constexpr size_t MiB = 1u << 20;
constexpr size_t WS_CTL = 0, CTL_ZERO_BYTES = 64 * 1024;
constexpr size_t WS_MOD = 256 * 1024;
constexpr size_t WS_POSB = 512 * 1024;
constexpr size_t WS_BIAS = 520 * 1024;
constexpr size_t WS_WA_T = 2 * MiB, WS_WB_T = 3 * MiB;
constexpr size_t WS_WO_T = 4 * MiB;
constexpr size_t WS_W1K_T = 6 * MiB, WS_W1V_T = 7 * MiB;
constexpr size_t WS_W2K_T = 8 * MiB, WS_W2V_T = 8 * MiB + 64 * 1024;
constexpr size_t WS_WLW_T = 8 * MiB + 128 * 1024, WS_WLA_T = 8 * MiB + 192 * 1024;
constexpr size_t WS_KC = 9 * MiB;
constexpr size_t WS_VCT = 9 * MiB + 512 * 1024;
constexpr size_t WS_BONUS = 10 * MiB;
constexpr size_t WS_DUMMY = 11 * MiB;
constexpr size_t WS_VTS = 12 * MiB, WS_VTW = 20 * MiB;
constexpr size_t WS_CAS = 28 * MiB;
constexpr size_t WS_CR = 252 * MiB;
constexpr size_t WS_YA = 412 * MiB, WS_YB = 444 * MiB;
constexpr size_t WS_WIN_T = 476 * MiB;
constexpr size_t WS_HS = 476 * MiB;
constexpr size_t WS_MERGED = WS_CAS;
constexpr size_t WS_END = 508 * MiB;
constexpr size_t OUT_H = 0;
constexpr size_t OUT_G = 0, OUT_Y1 = 32 * MiB, OUT_D = 64 * MiB, OUT_Y2 = 96 * MiB;

constexpr int LDS_BYTES = 147456;

struct Params {
    const float *x, *c, *w_ada, *b_ada, *norm_gain, *w_in, *q_norm_gain, *k_norm_gain, *cmp_pos_k, *cmp_pos_v,
        *cmp_k_w1, *cmp_k_w2, *cmp_v_w1, *cmp_v_w2, *rel_bias, *shift_mu, *w0, *w_lora_up, *a0, *a_lora_up,
        *k_k, *k_a, *r_k, *ln_x_w, *ln_x_b, *w_out_a, *w_out_b, *w_o;
    float* out; unsigned char* ws;
    int ph_lo, ph_hi;
};

DI unsigned f2bf(float f) { unsigned u = __builtin_bit_cast(unsigned, f); return (u + 0x7fffu + ((u >> 16) & 1u)) >> 16; }
DI float bf2f(unsigned h) { return __builtin_bit_cast(float, h << 16); }
DI unsigned pk2(float lo, float hi) { f32x2 v = {lo, hi}; bf16x2_t b = __builtin_convertvector(v, bf16x2_t); return __builtin_bit_cast(unsigned, b); }
DI float bflo(unsigned w) { return __builtin_bit_cast(float, w << 16); }
DI float bfhi(unsigned w) { return __builtin_bit_cast(float, w & 0xffff0000u); }
DI float sigmoidf_(float x) { return __builtin_amdgcn_rcpf(1.f + __expf(-x)); }
DI float siluf_(float x) { return x * __builtin_amdgcn_rcpf(1.f + __expf(-x)); }
DI int crow(int r, int hh) { return (r & 3) + 8 * (r >> 2) + 4 * hh; }
DI int pos16_of_key(int k16) { return 8 * ((k16 >> 2) & 1) + 4 * (k16 >> 3) + (k16 & 3); }
DI int key16_of_pos(int p16) { const int hh = p16 >> 3, j = p16 & 7; return 8 * (j >> 2) + 4 * hh + (j & 3); }
DI float wave_sum(float v) {
#pragma unroll
    for (int o = 1; o < 64; o <<= 1) v += __shfl_xor(v, o);
    return v;
}
DI void unpack8(u32x4 w, float* f) { f[0] = bflo(w.x); f[1] = bfhi(w.x); f[2] = bflo(w.y); f[3] = bfhi(w.y); f[4] = bflo(w.z); f[5] = bfhi(w.z); f[6] = bflo(w.w); f[7] = bfhi(w.w); }
typedef short v4i16_t __attribute__((ext_vector_type(4)));
DI s16x4 tr_read(const LAS bf16* p) { return __builtin_bit_cast(s16x4, __builtin_amdgcn_ds_read_tr16_b64_v4i16((LAS v4i16_t*)p)); }

__device__ const unsigned char T5_BUCKET[129] = {
    0, 1, 2, 3, 4, 5, 6, 7, 8, 9, 10, 11, 12, 13, 14, 15, 16, 16, 16, 17, 17, 18, 18, 18, 19, 19, 19, 20, 20, 20, 20, 21, 21, 21, 21, 22, 22, 22, 22, 22, 23, 23, 23, 23, 23, 23, 24, 24, 24, 24, 24, 24, 25, 25, 25, 25, 25, 25, 25, 26, 26, 26, 26, 26, 26, 26, 26, 27, 27, 27, 27, 27, 27, 27, 27, 27, 27, 28, 28, 28, 28, 28, 28, 28, 28, 28, 28, 29, 29, 29, 29, 29, 29, 29, 29, 29, 29, 29, 29, 30, 30, 30, 30, 30, 30, 30, 30, 30, 30, 30, 30, 30, 30, 31, 31, 31, 31, 31, 31, 31, 31, 31, 31, 31, 31, 31, 31, 31, 31};

template <class F> DI void transpose_item(const float* W, int K, int N, bf16* WT, F rowmap, LAS float* scr, int item, int lane) {
    const int nblk = (N + 63) / 64, kb = item / nblk, nb = item % nblk, k0 = 64 * kb, n0 = 64 * nb;
    const int n4 = (lane & 15) * 4;
    const bool inb = n0 + n4 < N; const int ncl = inb ? n0 + n4 : N - 4;
    f32x4 vv[16];
#pragma unroll
    for (int i = 0; i < 16; ++i) vv[i] = *(const f32x4*)(W + (size_t)(k0 + 4 * i + (lane >> 4)) * N + ncl);
#pragma unroll
    for (int i = 0; i < 16; ++i) asm volatile("" : "+v"(vv[i]));
#pragma unroll
    for (int i = 0; i < 16; ++i) { const int kk = 4 * i + (lane >> 4);
        const f32x4 v = inb ? vv[i] : (f32x4){0.f, 0.f, 0.f, 0.f};
        LAS float* d = scr + kk * 65 + n4; d[0] = v[0]; d[1] = v[1]; d[2] = v[2]; d[3] = v[3]; }
    asm volatile("s_waitcnt lgkmcnt(0)" ::: "memory");
    const int c = lane & 7;
#pragma unroll
    for (int j = 0; j < 8; ++j) { const int nl = (lane >> 3) + 8 * j, n = n0 + nl; const LAS float* s = scr + (8 * c) * 65 + nl;
        u32x4 o; o.x = pk2(s[0 * 65], s[1 * 65]); o.y = pk2(s[2 * 65], s[3 * 65]); o.z = pk2(s[4 * 65], s[5 * 65]); o.w = pk2(s[6 * 65], s[7 * 65]);
        if (n < N) *(u32x4*)(WT + (size_t)rowmap(n) * K + k0 + 8 * c) = o; }
    asm volatile("s_waitcnt lgkmcnt(0)" ::: "memory");
}

DI void phase0w(const Params& p, LAS unsigned char* lds) {
    const int tid = threadIdx.x, lane = tid & 63, wave = __builtin_amdgcn_readfirstlane(tid >> 6);
    const int gw = blockIdx.x * 8 + wave, NGW = gridDim.x * 8;
    unsigned char* ws = p.ws;
    {
        LAS float* scr = (LAS float*)(lds + wave * 16640);
        constexpr int I_IN = 16 * 95, I_OA = 8 * 16, I_OB = 8 * 16, I_O = 16 * 16, I_W1 = 32 * 4, I_W2 = 4 * 1, I_L = 1 * 8;
        constexpr int NIT = I_IN + I_OA + I_OB + I_O + 2 * I_W1 + 2 * I_W2 + 2 * I_L;
        auto ident = [](int n) { return n; };
        auto inmap = [](int n) { return n < CAS_USED ? n : n + (LD_CAS - CAS_USED); };
        for (int it = gw; it < NIT; it += NGW) {
            int r = it;
            if (r < I_IN) { transpose_item(p.w_in, DM, N_IN, (bf16*)(ws + WS_WIN_T), inmap, scr, r, lane); continue; } r -= I_IN;
            if (r < I_OA) { transpose_item(p.w_out_a, 512, DM, (bf16*)(ws + WS_WA_T), ident, scr, r, lane); continue; } r -= I_OA;
            if (r < I_OB) { transpose_item(p.w_out_b, 512, DM, (bf16*)(ws + WS_WB_T), ident, scr, r, lane); continue; } r -= I_OB;
            if (r < I_O) { transpose_item(p.w_o, DM, DM, (bf16*)(ws + WS_WO_T), ident, scr, r, lane); continue; } r -= I_O;
            if (r < I_W1) { transpose_item(p.cmp_k_w1, 2048, 256, (bf16*)(ws + WS_W1K_T), ident, scr, r, lane); continue; } r -= I_W1;
            if (r < I_W1) { transpose_item(p.cmp_v_w1, 2048, 256, (bf16*)(ws + WS_W1V_T), ident, scr, r, lane); continue; } r -= I_W1;
            if (r < I_W2) { transpose_item(p.cmp_k_w2, 256, 64, (bf16*)(ws + WS_W2K_T), ident, scr, r, lane); continue; } r -= I_W2;
            if (r < I_W2) { transpose_item(p.cmp_v_w2, 256, 64, (bf16*)(ws + WS_W2V_T), ident, scr, r, lane); continue; } r -= I_W2;
            if (r < I_L) { transpose_item(p.w_lora_up, 64, 512, (bf16*)(ws + WS_WLW_T), ident, scr, r, lane); continue; } r -= I_L;
            transpose_item(p.a_lora_up, 64, 512, (bf16*)(ws + WS_WLA_T), ident, scr, r, lane);
        }
    }
    {
        u32x4* z = (u32x4*)(ws + WS_WIN_T + (size_t)CAS_USED * DM * 2);
        const int n16 = (LD_CAS - CAS_USED) * DM * 2 / 16;
        for (int i = blockIdx.x * 512 + tid; i < n16; i += gridDim.x * 512) z[i] = (u32x4){0u, 0u, 0u, 0u};
    }
    __syncthreads();
}
constexpr size_t WS_MODP = 1 * MiB;
DI void phase0(const Params& p, LAS unsigned char* lds) {
    const int tid = threadIdx.x, lane = tid & 63, wave = __builtin_amdgcn_readfirstlane(tid >> 6);
    unsigned char* ws = p.ws;
    LAS float* red = (LAS float*)lds;
    LAS float* sc = (LAS float*)(lds + 32768);
    for (int task = blockIdx.x; task < 201; task += gridDim.x) {
        if (task < 192) {
            const int cg = task % 48, kq = task / 48;
            { float cv[8];
#pragma unroll
              for (int k8 = 0; k8 < 8; ++k8) { const int i = tid + 512 * k8; cv[k8] = p.c[(i >> 8) * 1024 + kq * 256 + (i & 255)]; }
#pragma unroll
              for (int k8 = 0; k8 < 8; ++k8) sc[tid + 512 * k8] = siluf_(cv[k8]); }
            __syncthreads();
            const int col = cg * 64 + lane;
            float acc[16];
#pragma unroll
            for (int b = 0; b < 16; ++b) acc[b] = 0.f;
#pragma unroll 4
            for (int kk = 0; kk < 32; ++kk) { const int kl = wave * 32 + kk; const float wv = p.w_ada[(size_t)(kq * 256 + kl) * 3072 + col];
#pragma unroll
                for (int b = 0; b < 16; ++b) acc[b] += sc[b * 256 + kl] * wv; }
#pragma unroll
            for (int b = 0; b < 16; ++b) red[(wave * 16 + b) * 64 + lane] = acc[b];
            __syncthreads();
            for (int o = tid; o < 1024; o += 512) { const int b = o >> 6, l = o & 63; float s = 0.f;
#pragma unroll
                for (int w = 0; w < 8; ++w) s += red[(w * 16 + b) * 64 + l];
                ((float*)(ws + WS_MODP))[(kq * 16 + b) * 3072 + cg * 64 + l] = s; }
            __syncthreads();
        } else if (task < 200) {
            const int t2 = task - 192, which = t2 >> 2, col = (t2 & 3) * 64 + lane;
            const float* pos = which ? p.cmp_pos_v : p.cmp_pos_k; const float* w1 = which ? p.cmp_v_w1 : p.cmp_k_w1;
            float a = 0.f;
#pragma unroll 4
            for (int kk = 0; kk < 256; ++kk) { const int k = wave * 256 + kk; a += pos[k] * w1[(size_t)k * 256 + col]; }
            red[wave * 64 + lane] = a;
            __syncthreads();
            if (tid < 64) { float s = 0.f;
#pragma unroll
                for (int w = 0; w < 8; ++w) s += red[w * 64 + tid];
                ((float*)(ws + WS_POSB))[which * 256 + (t2 & 3) * 64 + tid] = s; }
            __syncthreads();
        } else {
            for (int i = tid; i < 8 * 129; i += 512) { const int h = i / 129, d = i % 129; ((float*)(ws + WS_BIAS))[h * 132 + d] = p.rel_bias[T5_BUCKET[d] * 8 + h] * LOG2E; }
        }
    }
}

DI void phase1(const Params& p, LAS unsigned char* lds) {
    const int tid = threadIdx.x, lane = tid & 63, wave = tid >> 6;
    bf16* hb = (bf16*)((unsigned char*)p.out + OUT_H);
    LAS float* modL = (LAS float*)lds;
    for (int rb = blockIdx.x; rb < MTOK / 128; rb += gridDim.x) {
        const int b = rb >> 4;
        __syncthreads();
        { float sv[6];
#pragma unroll
          for (int c6 = 0; c6 < 6; ++c6) { const int col = tid + 512 * c6; float s = p.b_ada[col];
#pragma unroll
              for (int kq = 0; kq < 4; ++kq) s += ((const float*)(p.ws + WS_MODP))[(kq * 16 + b) * 3072 + col];
              sv[c6] = s; }
#pragma unroll
          for (int c6 = 0; c6 < 6; ++c6) asm volatile("" : "+v"(sv[c6]));
#pragma unroll
          for (int c6 = 0; c6 < 6; ++c6) { const int col = tid + 512 * c6; modL[col] = sv[c6]; if ((rb & 15) == 0) ((float*)(p.ws + WS_MOD))[b * 3072 + col] = sv[c6]; } }
        __syncthreads();
        f32x4 gq[4];
#pragma unroll
        for (int j = 0; j < 4; ++j) gq[j] = *(const f32x4*)(p.norm_gain + 4 * lane + 256 * j);
        for (int r = wave; r < 128; r += 8) {
            const int m = rb * 128 + r;
            const f32x4* xr = (const f32x4*)(p.x + (size_t)m * DM) + lane;
            f32x4 v[4]; float s = 0.f;
#pragma unroll
            for (int j = 0; j < 4; ++j) { v[j] = xr[64 * j]; s += (v[j].x * v[j].x + v[j].y * v[j].y) + (v[j].z * v[j].z + v[j].w * v[j].w); }
            const float rinv = rsqrtf(wave_sum(s) * (1.f / DM) + 1e-6f);
            u32x2* o8 = (u32x2*)(hb + (size_t)m * DM) + lane;
#pragma unroll
            for (int j = 0; j < 4; ++j) {
                const int k = 4 * lane + 256 * j;
                const f32x4 g = gq[j], sh = *(const LAS f32x4*)(modL + k), scl = *(const LAS f32x4*)(modL + 1024 + k);
                f32x4 h = v[j] * rinv * g * (scl + 1.f) + sh;
                u32x2 o; o.x = pk2(h.x, h.y); o.y = pk2(h.z, h.w); o8[64 * j] = o;
            }
        }
    }
    __syncthreads();
}

struct EpiInProj {
    static constexpr bool PERM = true;
    bf16* cas; bf16* cr;
    DI void operator()(const f32x4 (&acc)[2][2][4][2], const pg8::Unit& u, int wr, int wc, int fr, int fq) const {
        const int row0 = u.pm * 256 + wr * 64 + fr;
        bf16* base; int ldc, colt;
        if (u.pn < 14) { base = cas; ldc = LD_CAS; colt = u.pn * 256; } else { base = cr; ldc = LD_CR; colt = (u.pn - 14) * 256; }
        const int col0 = colt + wc * 32 + 8 * fq;
#pragma unroll
        for (int ai = 0; ai < 2; ++ai)
#pragma unroll
            for (int m = 0; m < 4; ++m) { bf16* rowp = base + (size_t)(row0 + ai * 128 + m * 16) * ldc + col0;
#pragma unroll
                for (int bj = 0; bj < 2; ++bj) { const f32x4 v0 = acc[ai][bj][m][0], v1 = acc[ai][bj][m][1];
                    u32x4 w; w.x = pk2(v0[0], v0[1]); w.y = pk2(v0[2], v0[3]); w.z = pk2(v1[0], v1[1]); w.w = pk2(v1[2], v1[3]);
                    *(u32x4*)(rowp + bj * 128) = w; } }
    }
};
template <int WHICH> struct EpiGate {
    static constexpr bool PERM = true;
    bf16* merged; const bf16* cr;
    DI void operator()(const f32x4 (&acc)[2][2][4][2], const pg8::Unit& u, int wr, int wc, int fr, int fq) const {
        const int row0 = u.pm * 256 + wr * 64 + fr, col0 = u.pn * 256 + wc * 32 + 8 * fq;
#pragma unroll
        for (int ai = 0; ai < 2; ++ai)
#pragma unroll
            for (int mp2 = 0; mp2 < 2; ++mp2) {
                u32x4 gw[2][2], ow[2][2];
#pragma unroll
                for (int m2 = 0; m2 < 2; ++m2)
#pragma unroll
                    for (int bj = 0; bj < 2; ++bj) { const size_t row = (size_t)(row0 + ai * 128 + (2 * mp2 + m2) * 16); const int col = col0 + bj * 128;
                        gw[m2][bj] = *(const u32x4*)(cr + row * LD_CR + (WHICH ? MB0 : MA0) + col);
                        if (WHICH) ow[m2][bj] = *(const u32x4*)(merged + row * DM + col); }
#pragma unroll
                for (int m2 = 0; m2 < 2; ++m2)
#pragma unroll
                    for (int bj = 0; bj < 2; ++bj) { asm volatile("" : "+v"(gw[m2][bj])); if (WHICH) asm volatile("" : "+v"(ow[m2][bj])); }
#pragma unroll
                for (int m2 = 0; m2 < 2; ++m2)
#pragma unroll
                    for (int bj = 0; bj < 2; ++bj) { const int m = 2 * mp2 + m2; const size_t row = (size_t)(row0 + ai * 128 + m * 16); const int col = col0 + bj * 128;
                        float gl[8]; unpack8(gw[m2][bj], gl);
                        const f32x4 v0 = acc[ai][bj][m][0], v1 = acc[ai][bj][m][1];
                        float r[8] = {v0[0], v0[1], v0[2], v0[3], v1[0], v1[1], v1[2], v1[3]};
                        if (WHICH) { float old[8]; unpack8(ow[m2][bj], old);
#pragma unroll
                            for (int i = 0; i < 8; ++i) r[i] = old[i] + sigmoidf_(gl[i]) * r[i]; }
                        else {
#pragma unroll
                            for (int i = 0; i < 8; ++i) r[i] = sigmoidf_(gl[i]) * r[i]; }
                        u32x4 w; w.x = pk2(r[0], r[1]); w.y = pk2(r[2], r[3]); w.z = pk2(r[4], r[5]); w.w = pk2(r[6], r[7]);
                        *(u32x4*)(merged + row * DM + col) = w; }
            }
    }
};
struct EpiFinal {
    static constexpr bool PERM = false;
    const float* x; const float* mod; float* out;
    DI void operator()(const f32x4 (&acc)[2][2][4][2], const pg8::Unit& u, int wr, int wc, int fr, int fq) const {
        const int row0 = u.pm * 256 + wr * 64 + fr, col0 = u.pn * 256 + wc * 32 + 4 * fq;
        const int b = (u.pm * 256) >> 11;
        f32x4 gv[2][2];
#pragma unroll
        for (int bj = 0; bj < 2; ++bj)
#pragma unroll
            for (int n = 0; n < 2; ++n) gv[bj][n] = *(const f32x4*)(mod + b * 3072 + 2048 + col0 + bj * 128 + n * 16);
#pragma unroll
        for (int ai = 0; ai < 2; ++ai)
#pragma unroll
            for (int mp = 0; mp < 2; ++mp) {
                f32x4 xv[2][2][2];
#pragma unroll
                for (int m2 = 0; m2 < 2; ++m2)
#pragma unroll
                    for (int bj = 0; bj < 2; ++bj)
#pragma unroll
                        for (int n = 0; n < 2; ++n) xv[m2][bj][n] = *(const f32x4*)(x + (size_t)(row0 + ai * 128 + (2 * mp + m2) * 16) * DM + col0 + bj * 128 + n * 16);
#pragma unroll
                for (int m2 = 0; m2 < 2; ++m2)
#pragma unroll
                    for (int bj = 0; bj < 2; ++bj)
#pragma unroll
                        for (int n = 0; n < 2; ++n) asm volatile("" : "+v"(xv[m2][bj][n]));
#pragma unroll
                for (int m2 = 0; m2 < 2; ++m2)
#pragma unroll
                    for (int bj = 0; bj < 2; ++bj)
#pragma unroll
                        for (int n = 0; n < 2; ++n)
                            *(f32x4*)(out + (size_t)(row0 + ai * 128 + (2 * mp + m2) * 16) * DM + col0 + bj * 128 + n * 16) = xv[m2][bj][n] + gv[bj][n] * acc[ai][bj][2 * mp + m2][n];
            }
    }
};

DI void phase3a(const Params& p, LAS unsigned char* lds) {
    const int tid = threadIdx.x, lane = tid & 63, wave = tid >> 6;
    const int gw = blockIdx.x * 8 + wave, NGW = gridDim.x * 8;
    bf16* cas = (bf16*)(p.ws + WS_CAS);
    {
        float gq[8], gk[8];
        const int dq = (8 * lane) & 63;
#pragma unroll
        for (int i = 0; i < 8; ++i) gq[i] = p.q_norm_gain[dq + i] * QSCALE;
        const int kr = (lane < 16) ? 1 : 2, dk = (8 * lane) & 63;
#pragma unroll
        for (int i = 0; i < 8; ++i) gk[i] = p.k_norm_gain[kr * 64 + dk + i];
        const int kcol = (lane < 16) ? (KS0 + 8 * lane) : (KW0 + 8 * (lane & 15));
        for (int m0 = gw * 4; m0 < MTOK; m0 += NGW * 4) {
            u32x4 qw[4], kw[4];
#pragma unroll
            for (int u = 0; u < 4; ++u) { bf16* row = cas + (size_t)(m0 + u) * LD_CAS;
                qw[u] = *(const u32x4*)(row + Q0 + 8 * lane);
                kw[u] = (lane < 32) ? *(const u32x4*)(row + kcol) : (u32x4){0u, 0u, 0u, 0u}; }
#pragma unroll
            for (int u = 0; u < 4; ++u) {
                bf16* row = cas + (size_t)(m0 + u) * LD_CAS;
                float q[8], k[8]; unpack8(qw[u], q); unpack8(kw[u], k);
                float sq = 0.f, sk = 0.f;
#pragma unroll
                for (int i = 0; i < 8; ++i) { sq += q[i] * q[i]; sk += k[i] * k[i]; }
#pragma unroll
                for (int o = 1; o < 8; o <<= 1) { sq += __shfl_xor(sq, o); sk += __shfl_xor(sk, o); }
                const float rq = rsqrtf(sq * (1.f / 64.f) + 1e-6f), rk = rsqrtf(sk * (1.f / 64.f) + 1e-6f);
#pragma unroll
                for (int i = 0; i < 8; ++i) { q[i] *= rq * gq[i]; k[i] *= rk * gk[i]; }
                u32x4 o; o.x = pk2(q[0], q[1]); o.y = pk2(q[2], q[3]); o.z = pk2(q[4], q[5]); o.w = pk2(q[6], q[7]);
                *(u32x4*)(row + Q0 + 8 * lane) = o;
                if (lane < 32) { u32x4 o2; o2.x = pk2(k[0], k[1]); o2.y = pk2(k[2], k[3]); o2.z = pk2(k[4], k[5]); o2.w = pk2(k[6], k[7]); *(u32x4*)(row + kcol) = o2; }
            }
        }
    }
    {
        LAS bf16* tile = (LAS bf16*)lds;
        for (int it = blockIdx.x; it < 2048; it += gridDim.x) {
            const int which = it >> 10, bg = (it >> 5) & 31, j = it & 31, b = bg >> 1, g = bg & 1;
            const int key = tid >> 3, ch = tid & 7;
            __syncthreads();
            *(LAS u32x4*)(tile + key * 72 + 8 * ch) = *(const u32x4*)(cas + (size_t)(b * SEQ + 64 * j + key) * LD_CAS + (which ? VW0 : VS0) + g * 64 + 8 * ch);
            __syncthreads();
            const int d = tid >> 3, pc = tid & 7;
            unsigned short v[8];
#pragma unroll
            for (int i = 0; i < 8; ++i) { const int pos = 8 * pc + i, k2 = (pos & ~15) | key16_of_pos(pos & 15); v[i] = tile[k2 * 72 + d]; }
            u32x4 o; o.x = v[0] | ((unsigned)v[1] << 16); o.y = v[2] | ((unsigned)v[3] << 16); o.z = v[4] | ((unsigned)v[5] << 16); o.w = v[6] | ((unsigned)v[7] << 16);
            bf16* vt = (bf16*)(p.ws + (which ? WS_VTW : WS_VTS)) + ((size_t)(bg * 32 + j) * 64 + d) * 64 + 8 * pc;
            *(u32x4*)vt = o;
        }
        __syncthreads();
    }
}

DI float gelu_tanh(float x) { const float u = 0.7978845608028654f * (x + 0.044715f * x * x * x); const float t = 1.f - 2.f * __builtin_amdgcn_rcpf(__expf(2.f * u) + 1.f); return 0.5f * x * (1.f + t); }
DI void phase3b(const Params& p, LAS unsigned char* lds) {
    const int tid = threadIdx.x, lane = tid & 63, wave = __builtin_amdgcn_readfirstlane(tid >> 6), l31 = lane & 31, hh = lane >> 5;
    const bf16* cas = (const bf16*)(p.ws + WS_CAS);
    LAS bf16* h1 = (LAS bf16*)lds;
    LAS float* o2 = (LAS float*)(lds + 32 * 264 * 2);
    LAS unsigned char* xs = lds + 32768;
    float kgain[8];
#pragma unroll
    for (int i = 0; i < 8; ++i) kgain[i] = p.k_norm_gain[(tid & 7) * 8 + i];
    for (int it = blockIdx.x; it < 256; it += gridDim.x) {
        const int which = it >> 7, bg = (it >> 2) & 31, rq = it & 3, b = bg >> 1, g = bg & 1;
        {
            const bf16* xsrc = cas + (size_t)(b * SEQ) * LD_CAS + (which ? VC0 : KC0) + g * 64;
            u32x4 stg[9];
#pragma unroll
            for (int k = 0; k < 9; ++k) { const int i = min(tid + 512 * k, 528 * 8 - 1); const int tr = i >> 3, ch = i & 7; int tok = 512 * rq + tr; tok = tok < SEQ ? tok : SEQ - 1;
                stg[k] = *(const u32x4*)(xsrc + (size_t)tok * LD_CAS + 8 * ch); }
#pragma unroll
            for (int k = 0; k < 9; ++k) asm volatile("" : "+v"(stg[k]));
#pragma unroll
            for (int k = 0; k < 9; ++k) { const int i = tid + 512 * k; const int tr = i >> 3, ch = i & 7;
                if (i < 528 * 8) *(LAS u32x4*)(xs + tr * 128 + ((ch ^ ((tr >> 4) & 7)) << 4)) = stg[k]; }
        }
        __syncthreads();
        const bf16* brow = (const bf16*)(p.ws + (which ? WS_W1V_T : WS_W1K_T)) + (size_t)(32 * wave + l31) * 2048 + 8 * hh;
        f32x16 acc = {};
#pragma unroll 16
        for (int s = 0; s < 128; ++s) {
            const int kk = 16 * s, tr = 16 * l31 + (kk >> 6), ch = ((kk & 63) >> 3) + hh;
            const bf16x8 a = *(const LAS bf16x8*)(xs + tr * 128 + ((ch ^ ((tr >> 4) & 7)) << 4));
            const bf16x8 bb = *(const bf16x8*)(brow + kk);
            acc = __builtin_amdgcn_mfma_f32_32x32x16_bf16(a, bb, acc, 0, 0, 0);
        }
        const float pb = ((const float*)(p.ws + WS_POSB))[which * 256 + 32 * wave + l31];
        __syncthreads();
#pragma unroll
        for (int r = 0; r < 16; ++r) h1[crow(r, hh) * 264 + 32 * wave + l31] = (bf16)f2bf(gelu_tanh(acc[r] + pb));
        __syncthreads();
        if (wave < 2) {
            const bf16* b2 = (const bf16*)(p.ws + (which ? WS_W2V_T : WS_W2K_T)) + (size_t)(32 * wave + l31) * 256 + 8 * hh;
            f32x16 a2 = {};
#pragma unroll
            for (int s = 0; s < 16; ++s) {
                const bf16x8 a = *(const LAS bf16x8*)(h1 + l31 * 264 + 16 * s + 8 * hh);
                const bf16x8 bb = *(const bf16x8*)(b2 + 16 * s);
                a2 = __builtin_amdgcn_mfma_f32_32x32x16_bf16(a, bb, a2, 0, 0, 0);
            }
#pragma unroll
            for (int r = 0; r < 16; ++r) o2[crow(r, hh) * 65 + 32 * wave + l31] = a2[r];
        }
        __syncthreads();
        if (tid < 256) {
            const int nl = tid >> 3, e8 = (tid & 7) * 8, nn = 32 * rq + nl;
            float v[8]; float ss = 0.f;
#pragma unroll
            for (int i = 0; i < 8; ++i) { v[i] = o2[nl * 65 + e8 + i]; ss += v[i] * v[i]; }
            if (which == 0) {
#pragma unroll
                for (int o = 1; o < 8; o <<= 1) ss += __shfl_xor(ss, o);
                const float rinv = rsqrtf(ss * (1.f / 64.f) + 1e-6f);
#pragma unroll
                for (int i = 0; i < 8; ++i) v[i] = (nn < 127) ? v[i] * rinv * kgain[i] : 0.f;
                u32x4 o; o.x = pk2(v[0], v[1]); o.y = pk2(v[2], v[3]); o.z = pk2(v[4], v[5]); o.w = pk2(v[6], v[7]);
                *(u32x4*)((bf16*)(p.ws + WS_KC) + (size_t)(bg * 128 + nn) * 64 + e8) = o;
            } else {
                const int pos = (nn & ~15) | pos16_of_key(nn & 15);
                bf16* vct = (bf16*)(p.ws + WS_VCT) + (size_t)bg * 64 * 128 + pos;
#pragma unroll
                for (int i = 0; i < 8; ++i) vct[(size_t)(e8 + i) * 128] = (bf16)f2bf((nn < 127) ? v[i] : 0.f);
            }
        }
        __syncthreads();
    }
}

constexpr int SLOTB = 8192;
DI int sw_el(int row, int col) { return row * 64 + ((((col >> 3) ^ (row & 7)) << 3) | (col & 7)); }
DI int swf_el(int row, int col) { return row * 64 + ((((col >> 2) ^ (row & 15)) << 2) | (col & 3)); }
DI bf16x8 frag_row(const LAS bf16* Mx, int row, int kc) { return *(const LAS bf16x8*)(Mx + sw_el(row, kc)); }
DI bf16x8 frag_col(const LAS bf16* Mx, int k0, int colbase, int lane) {
    const int i16 = lane & 15, q = i16 >> 2, pp = i16 & 3, blk = (lane >> 4) & 1, col = colbase + 16 * blk + 4 * pp;
    const s16x4 lo = tr_read(Mx + sw_el(k0 + q, col)), hi = tr_read(Mx + sw_el(k0 + 4 + q, col));
    return __builtin_shufflevector(lo, hi, 0, 1, 2, 3, 4, 5, 6, 7);
}
template <bool TA, bool TB> DI void mm_acc(f32x16& acc, const LAS bf16* A, const LAS bf16* Bm, int ti, int tj, int lane) {
    const int l31 = lane & 31, hh = lane >> 5;
#pragma unroll
    for (int s = 0; s < 4; ++s) {
        const int k0 = 16 * s + 8 * hh;
        bf16x8 x, y;
        if (TB) x = frag_row(Bm, 32 * tj + l31, k0); else x = frag_col(Bm, k0, 32 * tj, lane);
        if (TA) y = frag_col(A, k0, 32 * ti, lane); else y = frag_row(A, 32 * ti + l31, k0);
        acc = __builtin_amdgcn_mfma_f32_32x32x16_bf16(x, y, acc, 0, 0, 0);
    }
}
DI void ld_tile(f32x16& acc, const LAS bf16* Mx, int ti, int tj, int l31, int hh) {
#pragma unroll
    for (int g = 0; g < 4; ++g) { const u32x2 w = *(const LAS u32x2*)(Mx + sw_el(32 * ti + l31, 32 * tj + 8 * g + 4 * hh));
        acc[4 * g] = bflo(w.x); acc[4 * g + 1] = bfhi(w.x); acc[4 * g + 2] = bflo(w.y); acc[4 * g + 3] = bfhi(w.y); }
}
DI void st_tile(LAS bf16* Mx, const f32x16& acc, int ti, int tj, int l31, int hh) {
#pragma unroll
    for (int g = 0; g < 4; ++g) { u32x2 w; w.x = pk2(acc[4 * g], acc[4 * g + 1]); w.y = pk2(acc[4 * g + 2], acc[4 * g + 3]);
        *(LAS u32x2*)(Mx + sw_el(32 * ti + l31, 32 * tj + 8 * g + 4 * hh)) = w; }
}
DI void st_native_global(bf16* Tm, const f32x16& acc, int tile, int lane) {
    u32x4 a, b;
    a.x = pk2(acc[0], acc[1]); a.y = pk2(acc[2], acc[3]); a.z = pk2(acc[4], acc[5]); a.w = pk2(acc[6], acc[7]);
    b.x = pk2(acc[8], acc[9]); b.y = pk2(acc[10], acc[11]); b.z = pk2(acc[12], acc[13]); b.w = pk2(acc[14], acc[15]);
    u32x4* d = (u32x4*)(Tm + (size_t)tile * 1024 + lane * 8); d[0] = a; d[64] = b;
}
DI void ld_native_global(f32x16& acc, const bf16* Tm, int tile, int lane) {
    const u32x4* d = (const u32x4*)(Tm + (size_t)tile * 1024 + lane * 8); const u32x4 a = d[0], b = d[64];
    acc[0] = bflo(a.x); acc[1] = bfhi(a.x); acc[2] = bflo(a.y); acc[3] = bfhi(a.y); acc[4] = bflo(a.z); acc[5] = bfhi(a.z); acc[6] = bflo(a.w); acc[7] = bfhi(a.w);
    acc[8] = bflo(b.x); acc[9] = bfhi(b.x); acc[10] = bflo(b.y); acc[11] = bfhi(b.y); acc[12] = bflo(b.z); acc[13] = bfhi(b.z); acc[14] = bflo(b.w); acc[15] = bfhi(b.w);
}
DI bf16x8 pack8(const f32x16& x, int s) {
    u32x4 w; w.x = pk2(x[8 * s], x[8 * s + 1]); w.y = pk2(x[8 * s + 2], x[8 * s + 3]); w.z = pk2(x[8 * s + 4], x[8 * s + 5]); w.w = pk2(x[8 * s + 6], x[8 * s + 7]);
    return __builtin_bit_cast(bf16x8, w);
}
DI bf16x8 frag_col_perm(const LAS bf16* Mx, int kb16, int colbase, int lane) {
    const int i16 = lane & 15, q = i16 >> 2, pp = i16 & 3, blk = (lane >> 4) & 1, hh = lane >> 5, col = colbase + 16 * blk + 4 * pp;
    const s16x4 lo = tr_read(Mx + sw_el(kb16 + 4 * hh + q, col)), hi = tr_read(Mx + sw_el(kb16 + 8 + 4 * hh + q, col));
    return __builtin_shufflevector(lo, hi, 0, 1, 2, 3, 4, 5, 6, 7);
}
DI void mm32_acc(f32x16& C, const f32x16& A, const LAS bf16* Bm, int kb, int colbase, int lane) {
    const bf16x8 a0 = pack8(A, 0), a1 = pack8(A, 1);
    C = __builtin_amdgcn_mfma_f32_32x32x16_bf16(frag_col_perm(Bm, kb, colbase, lane), a0, C, 0, 0, 0);
    C = __builtin_amdgcn_mfma_f32_32x32x16_bf16(frag_col_perm(Bm, kb + 16, colbase, lane), a1, C, 0, 0, 0);
}
DI u32x4 pack8f(const float* v) { u32x4 o; o.x = pk2(v[0], v[1]); o.y = pk2(v[2], v[3]); o.z = pk2(v[4], v[5]); o.w = pk2(v[6], v[7]); return o; }

DI void phase3c(const Params& p, LAS unsigned char* lds) {
    const int tid0 = threadIdx.x, wave = __builtin_amdgcn_readfirstlane(tid0 >> 6);
    const int half = wave >> 2, lw = wave & 3, ti = (lw >> 1) & 1, tj = lw & 1;
    const bf16* cas = (const bf16*)(p.ws + WS_CAS);
    LAS unsigned char* hb = lds + half * 65536;
#define SL(i) ((LAS bf16*)(hb + (i) * SLOTB))
    LAS float* F1 = (LAS float*)(hb);
    LAS float* F2 = (LAS float*)(hb + 2 * SLOTB);
    LAS float* gam = (LAS float*)(lds + 131072) + half * 64;
    LAS float* tot = (LAS float*)(lds + 131072 + 512) + half * 256;
    LAS float* parL = (LAS float*)(lds + 131072 + 512 + 2048) + half * 640;
    int par_h = -1;
#define LDS_BAR() asm volatile("s_waitcnt lgkmcnt(0)\n\ts_barrier" ::: "memory")
    u32x4 nwd[2], nad[2], npw[2], npa[2];
#define E1_FETCH(PR) do { const int it_ = 2 * (PR) + half; const int c_ = it_ & 31; const size_t me_ = (size_t)(it_ >> 8) * SEQ + 64 * c_ + ((tid0 & 255) >> 2); \
        const bool hp_ = (64 * c_ + ((tid0 & 255) >> 2)) > 0; const int j16_ = (tid0 & 3) * 16; \
        _Pragma("unroll") for (int sp = 0; sp < 2; ++sp) { \
            nwd[sp] = *(const u32x4*)(cas + me_ * LD_CAS + WD0 + j16_ + 8 * sp); nad[sp] = *(const u32x4*)(cas + me_ * LD_CAS + AD0 + j16_ + 8 * sp); \
            npw[sp] = *(const u32x4*)(cas + (me_ - (hp_ ? 1 : 0)) * LD_CAS + WD0 + j16_ + 8 * sp); npa[sp] = *(const u32x4*)(cas + (me_ - (hp_ ? 1 : 0)) * LD_CAS + AD0 + j16_ + 8 * sp); } } while (0)
    unsigned pf0 = 0u, pf1 = 0u;
    if ((int)blockIdx.x < 2048) E1_FETCH((int)blockIdx.x);
#pragma unroll
    for (int k = 0; k < 8; ++k) *(u32x4*)(p.ws + WS_DUMMY + (size_t)k * 8192 + tid0 * 16) = (u32x4){0u, 0u, 0u, 0u};
    for (int pr = blockIdx.x; pr < 2048; pr += gridDim.x) {
        int tid = tid0; asm volatile("" : "+v"(tid));
        const int lane = tid & 63, l31 = lane & 31, hh = lane >> 5, ltid = tid & 255;
        const int item = 2 * pr + half;
        const int c = item & 31, h = (item >> 5) & 7, b = item >> 8;
        const size_t m0 = (size_t)b * SEQ + 64 * c;
        const int te = ltid >> 2, c16 = (ltid & 3) * 16; const size_t me = m0 + te; const bool hpv = (64 * c + te) > 0;
        if (h != par_h) {
            par_h = h;
            for (int i = ltid; i < 640; i += 256) { const int rw = i >> 6, cc = i & 63; float v;
                if (rw == 0) v = p.w0[h * 64 + cc]; else if (rw == 1) v = p.a0[h * 64 + cc]; else if (rw == 2) v = p.k_k[h * 64 + cc]; else if (rw == 3) v = p.k_a[h * 64 + cc];
                else if (rw == 4) v = p.r_k[h * 64 + cc]; else if (rw < 8) v = p.shift_mu[(rw - 5) * 512 + h * 64 + cc]; else v = p.shift_mu[1536 + (rw - 8) * 64 + cc];
                parL[i] = v; }
            LDS_BAR();
        }
        u32x4 gk[2], gr[2], gv[2], gkp[2], grp[2], gvp[2];
#pragma unroll
        for (int sp = 0; sp < 2; ++sp) { const int hc8 = h * 64 + c16 + 8 * sp;
            gk[sp] = *(const u32x4*)(cas + me * LD_CAS + K0 + hc8); gr[sp] = *(const u32x4*)(cas + me * LD_CAS + R0 + hc8); gv[sp] = *(const u32x4*)(cas + me * LD_CAS + V0 + hc8);
            const size_t mp = me - (hpv ? 1 : 0);
            gkp[sp] = *(const u32x4*)(cas + mp * LD_CAS + K0 + hc8); grp[sp] = *(const u32x4*)(cas + mp * LD_CAS + R0 + hc8); gvp[sp] = *(const u32x4*)(cas + mp * LD_CAS + V0 + hc8); }
        bf16x8 wfr[2][4];
#pragma unroll
        for (int pd = 0; pd < 2; ++pd) { const bf16* wt = (const bf16*)(p.ws + (pd ? WS_WLA_T : WS_WLW_T)) + (size_t)(h * 64 + 32 * tj + l31) * 64;
#pragma unroll
            for (int s = 0; s < 4; ++s) wfr[pd][s] = *(const bf16x8*)(wt + 16 * s + 8 * hh); }
#pragma unroll
        for (int sp = 0; sp < 2; ++sp) {
            const int j8 = c16 + 8 * sp;
            float wd[8], ad[8], pw[8], pa[8];
            asm volatile("" : "+v"(npw[sp]), "+v"(npa[sp]));
            unpack8(nwd[sp], wd); unpack8(nad[sp], ad); unpack8(hpv ? npw[sp] : (u32x4){0u, 0u, 0u, 0u}, pw); unpack8(hpv ? npa[sp] : (u32x4){0u, 0u, 0u, 0u}, pa);
#pragma unroll
            for (int i = 0; i < 8; ++i) { const float x = wd[i] + (pw[i] - wd[i]) * parL[512 + j8 + i]; const float e2 = __expf(2.f * x); wd[i] = 1.f - 2.f * __builtin_amdgcn_rcpf(e2 + 1.f);
                ad[i] = ad[i] + (pa[i] - ad[i]) * parL[576 + j8 + i]; }
            *(LAS u32x4*)(SL(6) + sw_el(te, j8)) = pack8f(wd);
            *(LAS u32x4*)(SL(7) + sw_el(te, j8)) = pack8f(ad);
        }
        E1_FETCH(min(pr + (int)gridDim.x, 2047));
        LDS_BAR();
#pragma unroll
        for (int pd = 0; pd < 2; ++pd) {
            const LAS bf16* Am = pd ? SL(7) : SL(6);
            f32x16 acc = {};
#pragma unroll
            for (int s = 0; s < 4; ++s) { const int k0 = 16 * s + 8 * hh;
                const bf16x8 y = frag_row(Am, 32 * ti + l31, k0);
                acc = __builtin_amdgcn_mfma_f32_32x32x16_bf16(wfr[pd][s], y, acc, 0, 0, 0); }
            LAS float* F = pd ? F2 : F1;
#pragma unroll
            for (int g = 0; g < 4; ++g) *(LAS f32x4*)(F + swf_el(32 * ti + l31, 32 * tj + 8 * g + 4 * hh)) = (f32x4){acc[4 * g], acc[4 * g + 1], acc[4 * g + 2], acc[4 * g + 3]};
        }
        LDS_BAR();
        asm volatile("" :: "v"(pf0), "v"(pf1));
        float lw16[16], av16[16], bv16[16], km16[16], rs16[16];
        {
            float kraw[16], icl[16]; float ss = 0.f, bon = 0.f;
#pragma unroll
            for (int sp = 0; sp < 2; ++sp) {
                const int c8 = c16 + 8 * sp, hc8 = h * 64 + c8;
                float kc_[8], kp_[8], rc_[8], rp_[8], vc_[8], vp_[8];
                asm volatile("" : "+v"(gkp[sp]), "+v"(grp[sp]), "+v"(gvp[sp]));
                const u32x4 z4 = {0u, 0u, 0u, 0u};
                unpack8(gk[sp], kc_); unpack8(gr[sp], rc_); unpack8(gv[sp], vc_); unpack8(hpv ? gkp[sp] : z4, kp_); unpack8(hpv ? grp[sp] : z4, rp_); unpack8(hpv ? gvp[sp] : z4, vp_);
                const f32x4 z0 = *(const LAS f32x4*)(F1 + swf_el(te, c8)), z1 = *(const LAS f32x4*)(F1 + swf_el(te, c8 + 4));
                const f32x4 a0_ = *(const LAS f32x4*)(F2 + swf_el(te, c8)), a1_ = *(const LAS f32x4*)(F2 + swf_el(te, c8 + 4));
                const float zz[8] = {z0[0], z0[1], z0[2], z0[3], z1[0], z1[1], z1[2], z1[3]}, ap[8] = {a0_[0], a0_[1], a0_[2], a0_[3], a1_[0], a1_[1], a1_[2], a1_[3]};
                float vs[8];
#pragma unroll
                for (int i = 0; i < 8; ++i) {
                    const int e = 8 * sp + i;
                    const int pc = c8 + i;
                    const float ks = kc_[i] + (kp_[i] - kc_[i]) * parL[384 + pc];
                    rs16[e] = rc_[i] + (rp_[i] - rc_[i]) * parL[320 + pc];
                    vs[i] = vc_[i] + (vp_[i] - vc_[i]) * parL[448 + pc];
                    const float nz = -(parL[pc] + zz[i]), spv = nz > 20.f ? nz : __logf(1.f + __expf(nz));
                    lw16[e] = -__expf(-spv - 0.5f);
                    icl[e] = sigmoidf_(parL[64 + pc] + ap[i]);
                    kraw[e] = ks * parL[128 + pc]; ss += kraw[e] * kraw[e];
                    km16[e] = ks * (1.f + (icl[e] - 1.f) * parL[192 + pc]);
                    bon += rs16[e] * km16[e] * parL[256 + pc];
                }
                *(LAS u32x4*)(SL(7) + sw_el(te, c8)) = pack8f(vs);
            }
            ss += __shfl_xor(ss, 1); ss += __shfl_xor(ss, 2); bon += __shfl_xor(bon, 1); bon += __shfl_xor(bon, 2);
            const float rn = rsqrtf(fmaxf(ss, 1e-24f));
#pragma unroll
            for (int e = 0; e < 16; ++e) { const float kk = kraw[e] * rn; av16[e] = -kk; bv16[e] = kk * icl[e]; }
#pragma unroll
            for (int q4 = 0; q4 < 4; ++q4) *(LAS f32x4*)(F1 + swf_el(te, c16 + 4 * q4)) = (f32x4){lw16[4 * q4], lw16[4 * q4 + 1], lw16[4 * q4 + 2], lw16[4 * q4 + 3]};
            if ((ltid & 3) == 0) ((float*)(p.ws + WS_BONUS))[me * 8 + h] = bon;
        }
        LDS_BAR();
        {
            const int cc = ltid & 63, tq = ltid >> 6;
            float L[16]; L[0] = F1[swf_el(16 * tq, cc)];
#pragma unroll
            for (int i = 1; i < 16; ++i) L[i] = L[i - 1] + F1[swf_el(16 * tq + i, cc)];
            tot[tq * 64 + cc] = L[15];
            LDS_BAR();
            float off = 0.f;
            for (int q = 0; q < tq; ++q) off += tot[q * 64 + cc];
#pragma unroll
            for (int i = 0; i < 16; ++i) F1[swf_el(16 * tq + i, cc)] = off + L[i];
            if (tq == 3) gam[cc] = __expf(off + L[15]);
        }
        LDS_BAR();
        {
            float Lt[16];
#pragma unroll
            for (int q4 = 0; q4 < 4; ++q4) { const f32x4 a = *(const LAS f32x4*)(F1 + swf_el(te, c16 + 4 * q4)); Lt[4 * q4] = a[0]; Lt[4 * q4 + 1] = a[1]; Lt[4 * q4 + 2] = a[2]; Lt[4 * q4 + 3] = a[3]; }
#pragma unroll
            for (int sp = 0; sp < 2; ++sp) {
                float oa[8], ob[8], ok[8], orr[8];
#pragma unroll
                for (int i = 0; i < 8; ++i) { const int e = 8 * sp + i; const float ep = __expf(Lt[e]), en = __builtin_amdgcn_rcpf(ep), e3 = __expf(Lt[e] - lw16[e]);
                    oa[i] = av16[e] * e3; ob[i] = bv16[e] * en; ok[i] = km16[e] * en; orr[i] = rs16[e] * ep; }
                *(LAS u32x4*)(SL(4) + sw_el(te, c16 + 8 * sp)) = pack8f(oa);
                *(LAS u32x4*)(SL(5) + sw_el(te, c16 + 8 * sp)) = pack8f(ob);
                *(LAS u32x4*)(SL(6) + sw_el(te, c16 + 8 * sp)) = pack8f(ok);
                *(LAS u32x4*)(SL(3) + sw_el(te, c16 + 8 * sp)) = pack8f(orr);
            }
        }
        LDS_BAR();
        { const int itn = 2 * min(pr + (int)gridDim.x, 2047) + half; const int w3 = ltid & 3;
          const bf16* rowp = cas + ((size_t)(itn >> 8) * SEQ + 64 * (itn & 31) + te) * LD_CAS + (w3 == 1 ? R0 : w3 == 2 ? V0 : K0) + ((itn >> 5) & 7) * 64;
          pf0 = *(const unsigned*)rowp; pf1 = *(const unsigned*)(rowp + 56); }
        u32x2 rtw[4]; f32x16 y2p, dp;
        {
            const int row = 32 * ti + l31;
            bf16x8 aA[4], aR[4], bB[4], bK0[4], bK1[4];
#pragma unroll
            for (int s = 0; s < 4; ++s) { const int k0 = 16 * s + 8 * hh;
                aA[s] = frag_row(SL(4), row, k0); aR[s] = frag_row(SL(3), row, k0); bB[s] = frag_row(SL(5), 32 * tj + l31, k0);
                bK0[s] = frag_row(SL(6), l31, k0); bK1[s] = frag_row(SL(6), 32 + l31, k0); }
            f32x16 acc = {};
#pragma unroll
            for (int s = 0; s < 4; ++s) acc = __builtin_amdgcn_mfma_f32_32x32x16_bf16(bB[s], aA[s], acc, 0, 0, 0);
#pragma unroll
            for (int r = 0; r < 16; ++r) acc[r] = (32 * tj + crow(r, hh) < row) ? acc[r] : 0.f;
            st_tile(SL(0), acc, ti, tj, l31, hh);
            acc = (f32x16){};
#pragma unroll
            for (int s = 0; s < 4; ++s) acc = __builtin_amdgcn_mfma_f32_32x32x16_bf16(tj ? bK1[s] : bK0[s], aA[s], acc, 0, 0, 0);
#pragma unroll
            for (int r = 0; r < 16; ++r) acc[r] = (32 * tj + crow(r, hh) < row) ? acc[r] : 0.f;
            st_tile(SL(2), acc, ti, tj, l31, hh);
            acc = (f32x16){};
#pragma unroll
            for (int s = 0; s < 4; ++s) acc = __builtin_amdgcn_mfma_f32_32x32x16_bf16(bB[s], aR[s], acc, 0, 0, 0);
#pragma unroll
            for (int r = 0; r < 16; ++r) acc[r] = (32 * tj + crow(r, hh) <= row) ? acc[r] : 0.f;
            st_tile(SL(1), acc, ti, tj, l31, hh);
            f32x16 ak0 = {}, ak1 = {};
#pragma unroll
            for (int s = 0; s < 4; ++s) ak0 = __builtin_amdgcn_mfma_f32_32x32x16_bf16(bK0[s], aR[s], ak0, 0, 0, 0);
#pragma unroll
            for (int r = 0; r < 16; ++r) ak0[r] = (crow(r, hh) <= row) ? ak0[r] : 0.f;
            y2p = (f32x16){};
            mm32_acc(y2p, ak0, SL(7), 0, 32 * tj, lane);
            if (ti) {
#pragma unroll
                for (int s = 0; s < 4; ++s) ak1 = __builtin_amdgcn_mfma_f32_32x32x16_bf16(bK1[s], aR[s], ak1, 0, 0, 0);
#pragma unroll
                for (int r = 0; r < 16; ++r) ak1[r] = (32 + crow(r, hh) <= row) ? ak1[r] : 0.f;
                mm32_acc(y2p, ak1, SL(7), 32, 32 * tj, lane);
            }
            dp = (f32x16){};
            mm_acc<true, false>(dp, SL(7), SL(6), ti, tj, lane);
#pragma unroll
            for (int g = 0; g < 4; ++g) rtw[g] = *(const LAS u32x2*)(SL(3) + sw_el(row, 32 * tj + 8 * g + 4 * hh));
        }
        LDS_BAR();
        if (lw == 0) {
            f32x16 Q0, Q1, T0, T1;
            ld_tile(Q0, SL(0), 0, 0, l31, hh); ld_tile(Q1, SL(0), 1, 1, l31, hh);
#pragma unroll
            for (int r = 0; r < 16; ++r) { const float idn = (crow(r, hh) == l31) ? 1.f : 0.f; T0[r] = Q0[r] + idn; T1[r] = Q1[r] + idn; }
            { f32x16 S0 = {}, S1 = {}; mm32_acc(S0, Q0, SL(0), 0, 0, lane); mm32_acc(S1, Q1, SL(0), 32, 32, lane); Q0 = S0; Q1 = S1; }
#pragma unroll
            for (int k = 1; k <= 4; ++k) {
                st_tile(SL(3), Q0, 0, 0, l31, hh); st_tile(SL(3), Q1, 1, 1, l31, hh);
                const bf16x8 b00 = frag_col_perm(SL(3), 0, 0, lane), b01 = frag_col_perm(SL(3), 16, 0, lane);
                const bf16x8 b10 = frag_col_perm(SL(3), 32, 32, lane), b11 = frag_col_perm(SL(3), 48, 32, lane);
                const bf16x8 t00 = pack8(T0, 0), t01 = pack8(T0, 1), t10 = pack8(T1, 0), t11 = pack8(T1, 1);
                T0 = __builtin_amdgcn_mfma_f32_32x32x16_bf16(b00, t00, T0, 0, 0, 0); T1 = __builtin_amdgcn_mfma_f32_32x32x16_bf16(b10, t10, T1, 0, 0, 0);
                T0 = __builtin_amdgcn_mfma_f32_32x32x16_bf16(b01, t01, T0, 0, 0, 0); T1 = __builtin_amdgcn_mfma_f32_32x32x16_bf16(b11, t11, T1, 0, 0, 0);
                if (k < 4) {
                    const bf16x8 q00 = pack8(Q0, 0), q01 = pack8(Q0, 1), q10 = pack8(Q1, 0), q11 = pack8(Q1, 1);
                    f32x16 S0 = {}, S1 = {};
                    S0 = __builtin_amdgcn_mfma_f32_32x32x16_bf16(b00, q00, S0, 0, 0, 0); S1 = __builtin_amdgcn_mfma_f32_32x32x16_bf16(b10, q10, S1, 0, 0, 0);
                    S0 = __builtin_amdgcn_mfma_f32_32x32x16_bf16(b01, q01, S0, 0, 0, 0); S1 = __builtin_amdgcn_mfma_f32_32x32x16_bf16(b11, q11, S1, 0, 0, 0);
                    Q0 = S0; Q1 = S1;
                }
            }
            st_tile(SL(3), T0, 0, 0, l31, hh); st_tile(SL(3), T1, 1, 1, l31, hh);
            { const f32x16 z = {}; st_tile(SL(3), z, 0, 1, l31, hh); }
            f32x16 Mx = {};
#pragma unroll
            for (int s = 0; s < 2; ++s) { const int k0 = 16 * s + 8 * hh;
                Mx = __builtin_amdgcn_mfma_f32_32x32x16_bf16(frag_col(SL(3), k0, 0, lane), frag_row(SL(0), 32 + l31, k0), Mx, 0, 0, 0); }
            st_tile(SL(3), Mx, 1, 0, l31, hh);
            f32x16 T21 = {};
            mm32_acc(T21, T1, SL(3), 32, 0, lane);
            st_tile(SL(3), T21, 1, 0, l31, hh);
        } else if (lw == 3) {
            f32x16 x0 = {}, x1 = {};
#pragma unroll
            for (int s = 0; s < 2; ++s) { const int k0 = 16 * s + 8 * hh; const bf16x8 a = frag_row(SL(2), l31, k0);
                x0 = __builtin_amdgcn_mfma_f32_32x32x16_bf16(frag_col(SL(7), k0, 0, lane), a, x0, 0, 0, 0);
                x1 = __builtin_amdgcn_mfma_f32_32x32x16_bf16(frag_col(SL(7), k0, 32, lane), a, x1, 0, 0, 0); }
            st_tile(SL(6), x0, 0, 0, l31, hh); st_tile(SL(6), x1, 0, 1, l31, hh);
        } else {
            f32x16 x = {}; mm_acc<false, false>(x, SL(2), SL(7), 1, lw - 1, lane); st_tile(SL(6), x, 1, lw - 1, l31, hh);
        }
        LDS_BAR();
        { f32x16 acc = {}; mm_acc<false, false>(acc, SL(3), SL(4), ti, tj, lane); st_tile(SL(0), acc, ti, tj, l31, hh);
          f32x16 a2 = {}; mm_acc<false, false>(a2, SL(3), SL(6), ti, tj, lane); st_tile(SL(2), a2, ti, tj, l31, hh); }
        LDS_BAR();
        {
            unsigned char* ob = (unsigned char*)p.out;
            { f32x16 acc;
#pragma unroll
              for (int g = 0; g < 4; ++g) { acc[4 * g] = bflo(rtw[g].x); acc[4 * g + 1] = bfhi(rtw[g].x); acc[4 * g + 2] = bflo(rtw[g].y); acc[4 * g + 3] = bfhi(rtw[g].y); }
              mm_acc<false, false>(acc, SL(1), SL(0), ti, tj, lane);
              st_native_global((bf16*)(ob + OUT_Y1) + (size_t)item * 4096, acc, ti * 2 + tj, lane); }
            { f32x16 g2 = {};
              mm_acc<true, false>(g2, SL(5), SL(0), ti, tj, lane);
              const float gm = gam[32 * ti + l31];
#pragma unroll
              for (int r = 0; r < 16; ++r) g2[r] = (g2[r] + ((32 * tj + crow(r, hh) == 32 * ti + l31) ? 1.f : 0.f)) * gm;
              st_native_global((bf16*)(ob + OUT_G) + (size_t)item * 4096, g2, ti * 2 + tj, lane); }
            { mm_acc<false, false>(y2p, SL(1), SL(2), ti, tj, lane);
              st_native_global((bf16*)(ob + OUT_Y2) + (size_t)item * 4096, y2p, tj * 2 + ti, lane); }
            { mm_acc<true, false>(dp, SL(2), SL(5), ti, tj, lane);
#pragma unroll
              for (int r = 0; r < 16; ++r) dp[r] *= gam[32 * tj + crow(r, hh)];
              st_native_global((bf16*)(ob + OUT_D) + (size_t)item * 4096, dp, tj * 2 + ti, lane); }
        }
    }
#undef SL
#undef LDS_BAR
#undef E1_FETCH
}

DI void phase5a(const Params& p) {
    const int tid = threadIdx.x, lane = tid & 63, wave = tid >> 6, l31 = lane & 31, hh = lane >> 5;
    if (blockIdx.x >= 16) return;
    const unsigned char* ob = (const unsigned char*)p.out;
    {
        const int chain = blockIdx.x * 8 + wave;
        f32x16 H[2][2];
#pragma unroll
        for (int a = 0; a < 2; ++a)
#pragma unroll
            for (int c2 = 0; c2 < 2; ++c2) H[a][c2] = (f32x16){};
        bf16x8 gf[2][2][2];
        { const bf16* Gp = (const bf16*)(ob + OUT_G) + (size_t)chain * 32 * 4096;
#pragma unroll
          for (int ti = 0; ti < 2; ++ti)
#pragma unroll
              for (int tk = 0; tk < 2; ++tk)
#pragma unroll
                  for (int s = 0; s < 2; ++s) gf[ti][tk][s] = *(const bf16x8*)(Gp + (ti * 2 + tk) * 1024 + 512 * s + lane * 8); }
        for (int c = 0; c < 32; ++c) {
            const size_t item = (size_t)chain * 32 + c;
            const bf16* Dn = (const bf16*)(ob + OUT_D) + item * 4096;
            bf16x8 gn[2][2][2];
            { const bf16* Gp = (const bf16*)(ob + OUT_G) + (item + (c < 31 ? 1 : 0)) * 4096;
#pragma unroll
              for (int ti = 0; ti < 2; ++ti)
#pragma unroll
                  for (int tk = 0; tk < 2; ++tk)
#pragma unroll
                      for (int s = 0; s < 2; ++s) gn[ti][tk][s] = *(const bf16x8*)(Gp + (ti * 2 + tk) * 1024 + 512 * s + lane * 8); }
            f32x16 Dv[2][2];
#pragma unroll
            for (int ti = 0; ti < 2; ++ti)
#pragma unroll
                for (int tj = 0; tj < 2; ++tj) ld_native_global(Dv[ti][tj], Dn, ti * 2 + tj, lane);
            bf16x8 hp[2][2][2];
            u32x4* hs = (u32x4*)((bf16*)(p.ws + WS_HS) + item * 4096);
#pragma unroll
            for (int tk = 0; tk < 2; ++tk)
#pragma unroll
                for (int tj = 0; tj < 2; ++tj)
#pragma unroll
                    for (int s = 0; s < 2; ++s) { hp[tk][tj][s] = pack8(H[tk][tj], s); hs[((tk * 2 + tj) * 2 + s) * 64 + lane] = __builtin_bit_cast(u32x4, hp[tk][tj][s]); }
#pragma unroll
            for (int ti = 0; ti < 2; ++ti)
#pragma unroll
                for (int tj = 0; tj < 2; ++tj) {
                    f32x16 acc = Dv[ti][tj];
#pragma unroll
                    for (int tk = 0; tk < 2; ++tk)
#pragma unroll
                        for (int s = 0; s < 2; ++s) acc = __builtin_amdgcn_mfma_f32_32x32x16_bf16(gf[ti][tk][s], hp[tk][tj][s], acc, 0, 0, 0);
                    H[ti][tj] = acc;
                }
#pragma unroll
            for (int ti = 0; ti < 2; ++ti)
#pragma unroll
                for (int tk = 0; tk < 2; ++tk)
#pragma unroll
                    for (int s = 0; s < 2; ++s) gf[ti][tk][s] = gn[ti][tk][s];
        }
    }
    asm volatile("s_waitcnt vmcnt(0)" ::: "memory");
    __syncthreads();
    if (tid == 0) { __builtin_amdgcn_fence(__ATOMIC_RELEASE, "agent"); asm volatile("s_waitcnt vmcnt(0)" ::: "memory");
        __hip_atomic_fetch_add((unsigned*)(p.ws + WS_CTL) + 12288, 1u, __ATOMIC_RELAXED, __HIP_MEMORY_SCOPE_AGENT); }
}
DI void phase5b(const Params& p, LAS unsigned char* lds) {
    const int tid0 = threadIdx.x, wave = __builtin_amdgcn_readfirstlane(tid0 >> 6);
    const bf16* cas = (const bf16*)(p.ws + WS_CAS); const bf16* cr = (const bf16*)(p.ws + WS_CR);
    const unsigned char* ob = (const unsigned char*)p.out;
    LAS float* Zl = (LAS float*)(lds + wave * 17408);
    LAS unsigned* qL = (LAS unsigned*)(lds + 8 * 17408);
    __syncthreads();
    if (tid0 == 0) { unsigned* done = (unsigned*)(p.ws + WS_CTL) + 12288; unsigned sp = 0;
        while (__hip_atomic_load(done, __ATOMIC_RELAXED, __HIP_MEMORY_SCOPE_AGENT) < 16u) { __builtin_amdgcn_s_sleep(4); if (++sp > (1u << 24)) break; }
        __builtin_amdgcn_fence(__ATOMIC_ACQUIRE, "agent"); asm volatile("s_waitcnt vmcnt(0)" ::: "memory"); }
    __syncthreads();
    unsigned* q5 = (unsigned*)(p.ws + WS_CTL) + 12352;
    for (;;) {
        if (tid0 == 0) qL[0] = atomicAdd(q5, 1u);
        __syncthreads();
        const unsigned qb = qL[0];
        __syncthreads();
        if (qb >= 512u) break;
        const int item = (int)qb * 8 + wave;
        int tid = tid0; asm volatile("" : "+v"(tid));
        const int lane = tid & 63, l31 = lane & 31, hh = lane >> 5;
        const int c = item & 31, h = (item >> 5) & 7, b = item >> 8;
        const bf16* Y1p = (const bf16*)(ob + OUT_Y1) + (size_t)item * 4096; const bf16* Y2n = (const bf16*)(ob + OUT_Y2) + (size_t)item * 4096;
        const u32x4* hs = (const u32x4*)((const bf16*)(p.ws + WS_HS) + (size_t)item * 4096);
        bf16x8 hp[2][2][2];
#pragma unroll
        for (int tk = 0; tk < 2; ++tk)
#pragma unroll
            for (int tj = 0; tj < 2; ++tj)
#pragma unroll
                for (int s = 0; s < 2; ++s) hp[tk][tj][s] = __builtin_bit_cast(bf16x8, hs[((tk * 2 + tj) * 2 + s) * 64 + lane]);
#pragma unroll
        for (int tt = 0; tt < 2; ++tt) {
            f32x16 Z[2];
#pragma unroll
            for (int vj = 0; vj < 2; ++vj) {
                ld_native_global(Z[vj], Y2n, vj * 2 + tt, lane);
#pragma unroll
                for (int tk = 0; tk < 2; ++tk)
#pragma unroll
                    for (int s = 0; s < 2; ++s) {
                        const bf16x8 bb = *(const bf16x8*)(Y1p + (tt * 2 + tk) * 1024 + 512 * s + lane * 8);
                        Z[vj] = __builtin_amdgcn_mfma_f32_32x32x16_bf16(hp[tk][vj][s], bb, Z[vj], 0, 0, 0);
                    }
            }
            float sum = 0.f;
#pragma unroll
            for (int vj = 0; vj < 2; ++vj)
#pragma unroll
                for (int r = 0; r < 16; ++r) sum += Z[vj][r];
            sum += __shfl_xor(sum, 32);
            const float mean = sum * (1.f / 64.f);
            float sq = 0.f;
#pragma unroll
            for (int vj = 0; vj < 2; ++vj)
#pragma unroll
                for (int r = 0; r < 16; ++r) { const float d = Z[vj][r] - mean; sq += d * d; }
            sq += __shfl_xor(sq, 32);
            const float rstd = rsqrtf(sq * (1.f / 64.f) + 64e-5f);
#pragma unroll
            for (int vj = 0; vj < 2; ++vj)
#pragma unroll
                for (int g = 0; g < 4; ++g)
                    *(LAS f32x4*)(Zl + (32 * tt + l31) * 68 + 32 * vj + 8 * g + 4 * hh) =
                        (f32x4){(Z[vj][4 * g] - mean) * rstd, (Z[vj][4 * g + 1] - mean) * rstd, (Z[vj][4 * g + 2] - mean) * rstd, (Z[vj][4 * g + 3] - mean) * rstd};
        }
        const int v8 = (lane & 7) * 8, col = h * 64 + v8;
        float mu[8], lw[8], lb[8];
#pragma unroll
        for (int i = 0; i < 8; ++i) { mu[i] = p.shift_mu[1024 + col + i]; lw[i] = p.ln_x_w[col + i]; lb[i] = p.ln_x_b[col + i]; }
#pragma unroll
        for (int pb = 0; pb < 2; ++pb) {
            u32x4 cw[4], pw[4], sw[4]; float bn[4];
#pragma unroll
            for (int q = 0; q < 4; ++q) { const int t = (4 * pb + q) * 8 + (lane >> 3); const size_t m = (size_t)b * SEQ + 64 * c + t; const bool hprev = (64 * c + t) > 0;
                cw[q] = *(const u32x4*)(cas + m * LD_CAS + V0 + col); pw[q] = *(const u32x4*)(cas + (m - (hprev ? 1 : 0)) * LD_CAS + V0 + col);
                sw[q] = *(const u32x4*)(cr + m * LD_CR + BSILU0 + col); bn[q] = ((const float*)(p.ws + WS_BONUS))[m * 8 + h]; }
#pragma unroll
            for (int q = 0; q < 4; ++q) asm volatile("" : "+v"(cw[q]), "+v"(pw[q]), "+v"(sw[q]), "+v"(bn[q]));
#pragma unroll
            for (int q = 0; q < 4; ++q) { const int t = (4 * pb + q) * 8 + (lane >> 3); const size_t m = (size_t)b * SEQ + 64 * c + t; const bool hprev = (64 * c + t) > 0;
                float cu[8], pv[8], sg[8];
                unpack8(cw[q], cu); unpack8(hprev ? pw[q] : (u32x4){0u, 0u, 0u, 0u}, pv); unpack8(sw[q], sg);
                const float bon = bn[q];
                const f32x4 z0 = *(const LAS f32x4*)(Zl + t * 68 + v8), z1 = *(const LAS f32x4*)(Zl + t * 68 + v8 + 4);
                const float zz[8] = {z0[0], z0[1], z0[2], z0[3], z1[0], z1[1], z1[2], z1[3]};
                float o[8];
#pragma unroll
                for (int i = 0; i < 8; ++i) { const float vsh = cu[i] + (pv[i] - cu[i]) * mu[i]; o[i] = (zz[i] * lw[i] + lb[i] + bon * vsh) * siluf_(sg[i]); }
                u32x4 w; w.x = pk2(o[0], o[1]); w.y = pk2(o[2], o[3]); w.z = pk2(o[4], o[5]); w.w = pk2(o[6], o[7]);
                *(u32x4*)((bf16*)(p.ws + WS_YB) + m * 512 + col) = w; }
        }
    }
}

constexpr int A_STAGE = 81920, A_TILE = 8192;
DI int swz_off(int row, int chunk) { return row * 128 + ((chunk ^ ((row >> 1) & 7)) << 4); }
DI void attn_qk(f32x16& s0, f32x16& s1, const LAS unsigned char* kl, const bf16x8 (&qr)[4], const f32x16& cinit, int l31, int hh) {
#pragma unroll
    for (int d0 = 0; d0 < 4; ++d0) {
        const bf16x8 k0f = *(const LAS bf16x8*)(kl + swz_off(l31, 2 * d0 + hh));
        const bf16x8 k1f = *(const LAS bf16x8*)(kl + swz_off(32 + l31, 2 * d0 + hh));
        s0 = __builtin_amdgcn_mfma_f32_32x32x16_bf16(k0f, qr[d0], d0 == 0 ? cinit : s0, 0, 0, 0);
        s1 = __builtin_amdgcn_mfma_f32_32x32x16_bf16(k1f, qr[d0], d0 == 0 ? cinit : s1, 0, 0, 0);
    }
}
DI void attn_sv(f32x16& s0, f32x16& s1, const LAS unsigned char* vl, int key0, int tq, bool laneok, int tmin, const LAS float* bl, bool win, bool bound,
                float& m_run, float& l_run, f32x16 (&O)[2], int l31, int hh) {
    const bool far = (tmin - (key0 + 63)) >= 128;
    const bool fast = far && !bound;
    int dbase = tq - key0; asm volatile("" : "+v"(dbase));
    float rm = -1e30f, cb = 0.f;
    if (fast) {
        cb = bl[128];
#pragma unroll
        for (int r = 0; r < 16; ++r) rm = fmaxf(rm, fmaxf(s0[r], s1[r]));
        rm = laneok ? rm + cb : -1e30f;
    } else {
        const int dmax = win ? 512 : 0x7fffffff, dmin = bound ? 0 : -0x7fffffff;
#pragma unroll
        for (int r = 0; r < 16; ++r) {
            const int d0_ = dbase - crow(r, hh), d1_ = d0_ - 32;
            const bool v0 = laneok && d0_ >= dmin && d0_ < dmax, v1 = laneok && d1_ >= dmin && d1_ < dmax;
            const float b0 = bl[min(max(d0_, 0), 128)], b1 = bl[min(max(d1_, 0), 128)];
            s0[r] = v0 ? s0[r] + b0 : -1e30f; s1[r] = v1 ? s1[r] + b1 : -1e30f;
            rm = fmaxf(rm, fmaxf(s0[r], s1[r]));
        }
    }
    rm = fmaxf(rm, __shfl_xor(rm, 32));
    if (__any(rm > m_run + 8.f)) {
        const float m_new = fmaxf(m_run, rm), alpha = __builtin_amdgcn_exp2f(m_run - m_new);
        l_run *= alpha; m_run = m_new;
#pragma unroll
        for (int dt = 0; dt < 2; ++dt)
#pragma unroll
            for (int r = 0; r < 16; ++r) O[dt][r] *= alpha;
    }
    const float sh = m_run - cb;
    float rs = 0.f;
    if (fast) {
#pragma unroll
        for (int r = 0; r < 16; ++r) { s0[r] = __builtin_amdgcn_exp2f(s0[r] - sh); s1[r] = __builtin_amdgcn_exp2f(s1[r] - sh); rs += s0[r] + s1[r]; }
        if (!__all(laneok)) { if (!laneok) {
#pragma unroll
            for (int r = 0; r < 16; ++r) { s0[r] = 0.f; s1[r] = 0.f; }
            rs = 0.f; } }
    } else {
#pragma unroll
        for (int r = 0; r < 16; ++r) {
            s0[r] = (s0[r] > -1e29f) ? __builtin_amdgcn_exp2f(s0[r] - sh) : 0.f; s1[r] = (s1[r] > -1e29f) ? __builtin_amdgcn_exp2f(s1[r] - sh) : 0.f;
            rs += s0[r] + s1[r];
        }
    }
    rs += __shfl_xor(rs, 32);
    l_run += rs;
    const bf16x8 p00 = pack8(s0, 0), p01 = pack8(s0, 1), p10 = pack8(s1, 0), p11 = pack8(s1, 1);
#pragma unroll
    for (int dt = 0; dt < 2; ++dt) {
        const int d = 32 * dt + l31;
        O[dt] = __builtin_amdgcn_mfma_f32_32x32x16_bf16(*(const LAS bf16x8*)(vl + swz_off(d, 0 + hh)), p00, O[dt], 0, 0, 0);
        O[dt] = __builtin_amdgcn_mfma_f32_32x32x16_bf16(*(const LAS bf16x8*)(vl + swz_off(d, 2 + hh)), p01, O[dt], 0, 0, 0);
        O[dt] = __builtin_amdgcn_mfma_f32_32x32x16_bf16(*(const LAS bf16x8*)(vl + swz_off(d, 4 + hh)), p10, O[dt], 0, 0, 0);
        O[dt] = __builtin_amdgcn_mfma_f32_32x32x16_bf16(*(const LAS bf16x8*)(vl + swz_off(d, 6 + hh)), p11, O[dt], 0, 0, 0);
    }
}
DI void attn_sv_fast(f32x16& s0, f32x16& s1, const LAS unsigned char* vl, int key0, int tq, bool laneok, int tmin, const LAS float* bl, bool win, bool bound, float cb,
                     float& l_run, f32x16 (&O)[2], int l31, int hh) {
    const bool far = (tmin - (key0 + 63)) >= 128;
    float rs = 0.f;
    if (far && !bound) {
#pragma unroll
        for (int r = 0; r < 16; ++r) { s0[r] = __builtin_amdgcn_exp2f(s0[r]); s1[r] = __builtin_amdgcn_exp2f(s1[r]); }
        if (!__all(laneok)) {
#pragma unroll
            for (int r = 0; r < 16; ++r) { s0[r] = laneok ? s0[r] : 0.f; s1[r] = laneok ? s1[r] : 0.f; }
        }
    } else {
        int dbase = tq - key0; asm volatile("" : "+v"(dbase));
        const int dmax = win ? 512 : 0x7fffffff, dmin = bound ? 0 : -0x7fffffff;
        float b0[16], b1[16];
#pragma unroll
        for (int r = 0; r < 16; ++r) { const int d0_ = dbase - crow(r, hh), d1_ = d0_ - 32; b0[r] = bl[min(max(d0_, 0), 128)]; b1[r] = bl[min(max(d1_, 0), 128)]; }
#pragma unroll
        for (int r = 0; r < 16; ++r) asm volatile("" : "+v"(b0[r]), "+v"(b1[r]));
#pragma unroll
        for (int r = 0; r < 16; ++r) {
            const int d0_ = dbase - crow(r, hh), d1_ = d0_ - 32;
            const bool v0 = laneok && d0_ >= dmin && d0_ < dmax, v1 = laneok && d1_ >= dmin && d1_ < dmax;
            const float e0 = __builtin_amdgcn_exp2f(s0[r] + (b0[r] - cb)), e1 = __builtin_amdgcn_exp2f(s1[r] + (b1[r] - cb));
            s0[r] = v0 ? e0 : 0.f; s1[r] = v1 ? e1 : 0.f;
        }
    }
#pragma unroll
    for (int r = 0; r < 16; ++r) rs += s0[r] + s1[r];
    l_run += rs;
    const bf16x8 p00 = pack8(s0, 0), p01 = pack8(s0, 1), p10 = pack8(s1, 0), p11 = pack8(s1, 1);
#pragma unroll
    for (int dt = 0; dt < 2; ++dt) {
        const int d = 32 * dt + l31;
        O[dt] = __builtin_amdgcn_mfma_f32_32x32x16_bf16(*(const LAS bf16x8*)(vl + swz_off(d, 0 + hh)), p00, O[dt], 0, 0, 0);
        O[dt] = __builtin_amdgcn_mfma_f32_32x32x16_bf16(*(const LAS bf16x8*)(vl + swz_off(d, 2 + hh)), p01, O[dt], 0, 0, 0);
        O[dt] = __builtin_amdgcn_mfma_f32_32x32x16_bf16(*(const LAS bf16x8*)(vl + swz_off(d, 4 + hh)), p10, O[dt], 0, 0, 0);
        O[dt] = __builtin_amdgcn_mfma_f32_32x32x16_bf16(*(const LAS bf16x8*)(vl + swz_off(d, 6 + hh)), p11, O[dt], 0, 0, 0);
    }
}
DI float imp_sum(const LAS float* sL, const LAS float* cL, int q, int j) {
    float v = 0.f;
#pragma unroll
    for (int h4 = 0; h4 < 4; ++h4) { v += sL[(h4 * 64 + q) * 33 + j]; if (j > 0) v += cL[(h4 * 64 + q) * 33 + j]; }
    return v;
}
template <bool FAST>
DI void attn_stream(LAS unsigned char* lds, const bf16* ksel, const bf16* kwin, const bf16* vts, const bf16* vtw, unsigned U, unsigned mysel, int qt, int tq, int tmin,
                    const LAS float* bl, const bf16x8 (&qr)[4], const float (&g3)[3], LAS float* stash, f32x16 (&Ot)[2], int tid, int l31, int hh) {
    const int nsel = __builtin_popcount(U), w0 = qt > 8 ? qt - 8 : 0, ntile = nsel + (qt - w0 + 1);
    const int srow = tid >> 3, sch = tid & 7;
    unsigned rem = U;
    int jseq = 0;
    int jt = 0; bool wt = false;
#define NEXT_TILE() do { if (jseq < nsel) { jt = __builtin_ctz(rem); rem &= rem - 1; wt = false; } else { jt = w0 + (jseq - nsel); wt = true; } ++jseq; } while (0)
#define LOAD_TILE(KR, VR) do { KR = *(const u32x4*)((wt ? kwin : ksel) + (size_t)(64 * jt + srow) * LD_CAS + 8 * sch); \
                               VR = *(const u32x4*)((wt ? vtw : vts) + (size_t)jt * 4096 + srow * 64 + 8 * sch); } while (0)
    u32x4 kr0, vr0, kr1, vr1;
    NEXT_TILE(); int j0 = jt; bool wn0 = wt; LOAD_TILE(kr0, vr0);
    *(LAS u32x4*)(lds + A_STAGE + swz_off(srow, sch)) = kr0; *(LAS u32x4*)(lds + A_STAGE + 2 * A_TILE + swz_off(srow, sch)) = vr0;
    int j1 = 0; bool wn1 = false;
    if (ntile > 1) { NEXT_TILE(); j1 = jt; wn1 = wt; LOAD_TILE(kr0, vr0); }
    __syncthreads();
    float m_run = -1e30f, l_run = 0.f; f32x16 O[2]; O[0] = (f32x16){}; O[1] = (f32x16){};
    const float cbf = bl[128];
    f32x16 cinit;
#pragma unroll
    for (int r = 0; r < 16; ++r) cinit[r] = FAST ? cbf : 0.f;
#define TILE_ITER(I, KRA, VRA, KRB, VRB) do { \
        const int jc = j0; const bool wc = wn0; j0 = j1; wn0 = wn1; \
        if ((I) + 2 < ntile) { NEXT_TILE(); j1 = jt; wn1 = wt; LOAD_TILE(KRB, VRB); } \
        if ((I) == nsel) { if (FAST) l_run += __shfl_xor(l_run, 32); const float f_ = l_run > 0.f ? g3[1] / l_run : 0.f; \
            _Pragma("unroll") for (int dt = 0; dt < 2; ++dt) _Pragma("unroll") for (int r = 0; r < 16; ++r) { stash[(dt * 16 + r) * 64] += f_ * O[dt][r]; O[dt][r] = 0.f; } \
            m_run = -1e30f; l_run = 0.f; } \
        const LAS unsigned char* kl = lds + A_STAGE + ((I) & 1) * A_TILE; \
        const LAS unsigned char* vl = lds + A_STAGE + 2 * A_TILE + ((I) % 3) * A_TILE; \
        const bool ok_ = wc ? true : (bool)((mysel >> jc) & 1u); \
        if (__any(ok_)) { f32x16 s0, s1; attn_qk(s0, s1, kl, qr, cinit, l31, hh); \
            const bool bnd = wc ? (jc == qt || jc + 8 == qt) : (jc == qt); \
            if (FAST) attn_sv_fast(s0, s1, vl, 64 * jc, tq, ok_, tmin, bl, wc, bnd, cbf, l_run, O, l31, hh); \
            else attn_sv(s0, s1, vl, 64 * jc, tq, ok_, tmin, bl, wc, bnd, m_run, l_run, O, l31, hh); } \
        if ((I) + 1 < ntile) { *(LAS u32x4*)(lds + A_STAGE + (((I) + 1) & 1) * A_TILE + swz_off(srow, sch)) = KRA; \
                               *(LAS u32x4*)(lds + A_STAGE + 2 * A_TILE + (((I) + 1) % 3) * A_TILE + swz_off(srow, sch)) = VRA; } \
        asm volatile("s_waitcnt lgkmcnt(0)\n\ts_barrier" ::: "memory"); } while (0)
    for (int i = 0; i < ntile; i += 2) {
        TILE_ITER(i, kr0, vr0, kr1, vr1);
        if (i + 1 < ntile) TILE_ITER(i + 1, kr1, vr1, kr0, vr0);
    }
#undef TILE_ITER
#undef LOAD_TILE
#undef NEXT_TILE
    if (FAST) l_run += __shfl_xor(l_run, 32);
    const float f = l_run > 0.f ? g3[2] / l_run : 0.f;
#pragma unroll
    for (int dt = 0; dt < 2; ++dt)
#pragma unroll
        for (int r = 0; r < 16; ++r) Ot[dt][r] = stash[(dt * 16 + r) * 64] + f * O[dt][r];
}
DI void phase4(const Params& p, LAS unsigned char* lds) {
    const int tid0 = threadIdx.x, wave = __builtin_amdgcn_readfirstlane(tid0 >> 6);
    const int hp = wave & 3, qh = wave >> 2;
    const bf16* cas = (const bf16*)(p.ws + WS_CAS);
    LAS float* biasL = (LAS float*)lds;
    LAS float* sL = (LAS float*)(lds + 4608);
    LAS float* cL = (LAS float*)(lds + 4608 + 33792);
    LAS unsigned* selL = (LAS unsigned*)(lds + 4608 + 2 * 33792);
    LAS unsigned* uL = selL + 64;
    LAS float* impT = (LAS float*)(lds + 4608 + 2 * 33792 + 512);
    LAS float* auxL = (LAS float*)(lds + 81152);
    for (int i = tid0; i < 8 * 132; i += 512) biasL[i] = ((const float*)(p.ws + WS_BIAS))[i];
    if (tid0 == 0) uL[0] = 0u;
    __syncthreads();
    {
        const int ln = tid0 & 63;
        float bm = fmaxf(fabsf(biasL[wave * 132 + ln]), fabsf(biasL[wave * 132 + 64 + ln]));
        if (ln == 0) bm = fmaxf(bm, fabsf(biasL[wave * 132 + 128]));
        const float* gp = wave == 2 ? p.q_norm_gain : p.k_norm_gain + ((wave & 1) + 1) * 64;
        float gm = fabsf(gp[ln]);
#pragma unroll
        for (int o = 32; o >= 1; o >>= 1) { bm = fmaxf(bm, __shfl_xor(bm, o)); gm = fmaxf(gm, __shfl_xor(gm, o)); }
        if (ln == 0) { auxL[wave] = bm; if (wave < 3) auxL[8 + wave] = gm; }
    }
    __syncthreads();
    bool fastmode;
    { float bm = 0.f;
#pragma unroll
      for (int hq = 0; hq < 8; ++hq) bm = fmaxf(bm, auxL[hq]);
      fastmode = (8.1f * auxL[10] * QSCALE) * (8.1f * fmaxf(auxL[8], auxL[9])) + bm <= 96.f; }
    unsigned* qctr = (unsigned*)(p.ws + WS_CTL) + 8192 + 64 * (blockIdx.x & 7);
    for (;;) {
        if (tid0 == 0) uL[1] = atomicAdd(qctr, 1u);
        __syncthreads();
        const unsigned qi = uL[1];
        __syncthreads();
        if (qi >= 128u) break;
        int tid = tid0; asm volatile("" : "+v"(tid));
        const int lane = tid & 63, l31 = lane & 31, hh = lane >> 5;
        const int qt = 31 - (int)(qi & 31), bg = (blockIdx.x & 7) + 8 * (int)(qi >> 5);
        const int b = bg >> 1, g = bg & 1, head = g * 4 + hp, t0 = 64 * qt, tmin = t0 + 32 * qh, tq = tmin + l31;
        const size_t m = (size_t)b * SEQ + tq;
        const LAS float* bl = biasL + head * 132;
        bf16x8 qr[4];
#pragma unroll
        for (int d0 = 0; d0 < 4; ++d0) qr[d0] = *(const bf16x8*)(cas + m * LD_CAS + Q0 + head * 64 + 16 * d0 + 8 * hh);
        float g3[3];
#pragma unroll
        for (int br = 0; br < 3; ++br) g3[br] = sigmoidf_(bf2f(cas[m * LD_CAS + GATE0 + br * 8 + head]));
        f32x16 Ot[2]; Ot[0] = (f32x16){}; Ot[1] = (f32x16){};
        {
            const bf16* kcb = (const bf16*)(p.ws + WS_KC) + (size_t)bg * 128 * 64;
            const bf16* vcb = (const bf16*)(p.ws + WS_VCT) + (size_t)bg * 64 * 128;
            f32x16 sc[4];
#pragma unroll
            for (int kt = 0; kt < 4; ++kt) { sc[kt] = (f32x16){};
#pragma unroll
                for (int d0 = 0; d0 < 4; ++d0) sc[kt] = __builtin_amdgcn_mfma_f32_32x32x16_bf16(*(const bf16x8*)(kcb + (size_t)(32 * kt + l31) * 64 + 16 * d0 + 8 * hh), qr[d0], sc[kt], 0, 0, 0); }
            float mc = -1e30f;
#pragma unroll
            for (int kt = 0; kt < 4; ++kt) {
                float bv[16];
#pragma unroll
                for (int r = 0; r < 16; ++r) { const int n = 32 * kt + crow(r, hh), dist = tq - 16 * n - 31; bv[r] = bl[min(max(dist, 0), 128)]; }
#pragma unroll
                for (int r = 0; r < 16; ++r) asm volatile("" : "+v"(bv[r]));
#pragma unroll
                for (int r = 0; r < 16; ++r) { const int n = 32 * kt + crow(r, hh), dist = tq - 16 * n - 31; const bool ok = dist >= 0 && n < 127;
                    sc[kt][r] = ok ? sc[kt][r] + bv[r] : -1e30f; mc = fmaxf(mc, sc[kt][r]); }
            }
            mc = fmaxf(mc, __shfl_xor(mc, 32));
            float lc = 0.f;
#pragma unroll
            for (int kt = 0; kt < 4; ++kt)
#pragma unroll
                for (int r = 0; r < 16; ++r) { sc[kt][r] = (sc[kt][r] > -1e29f) ? __builtin_amdgcn_exp2f(sc[kt][r] - mc) : 0.f; lc += sc[kt][r]; }
            lc += __shfl_xor(lc, 32);
            const float inv = lc > 0.f ? 1.f / lc : 0.f;
            const int q = 32 * qh + l31;
#pragma unroll
            for (int kt = 0; kt < 4; ++kt) {
#pragma unroll
                for (int r = 0; r < 16; ++r) sc[kt][r] *= inv;
#pragma unroll
                for (int g4 = 0; g4 < 4; ++g4) { const int j = 8 * kt + 2 * g4 + hh;
                    sL[(hp * 64 + q) * 33 + j] = 2.f * (sc[kt][4 * g4] + sc[kt][4 * g4 + 1] + sc[kt][4 * g4 + 2]) + sc[kt][4 * g4 + 3];
                    cL[(hp * 64 + q) * 33 + j + 1] = sc[kt][4 * g4 + 3]; }
            }
            f32x16 oc[2]; oc[0] = (f32x16){}; oc[1] = (f32x16){};
#pragma unroll
            for (int dt = 0; dt < 2; ++dt)
#pragma unroll
                for (int kt = 0; kt < 4; ++kt)
#pragma unroll
                    for (int s = 0; s < 2; ++s)
                        oc[dt] = __builtin_amdgcn_mfma_f32_32x32x16_bf16(*(const bf16x8*)(vcb + (size_t)(32 * dt + l31) * 128 + 32 * kt + 16 * s + 8 * hh), pack8(sc[kt], s), oc[dt], 0, 0, 0);
#pragma unroll
            for (int dt = 0; dt < 2; ++dt)
#pragma unroll
                for (int r = 0; r < 16; ++r) Ot[dt][r] = g3[0] * oc[dt][r];
        }
        __syncthreads();
        {
            const int q = tid >> 3, sub = tid & 7;
            unsigned mask = 0u;
            if (qt < 16) mask = (2u << qt) - 1u;
            else {
#pragma unroll
                for (int i2 = 0; i2 < 4; ++i2) impT[q * 33 + sub + 8 * i2] = imp_sum(sL, cL, q, sub + 8 * i2);
                __syncthreads();
                float vj[4]; int rank[4];
#pragma unroll
                for (int i2 = 0; i2 < 4; ++i2) { vj[i2] = impT[q * 33 + sub + 8 * i2]; rank[i2] = 0; }
#pragma unroll 2
                for (int jj = 1; jj <= qt - 2; ++jj) {
                    const float vv = impT[q * 33 + jj];
#pragma unroll
                    for (int i2 = 0; i2 < 4; ++i2) { const int j = sub + 8 * i2;
                        rank[i2] += (int)((jj != j) & ((vv > vj[i2]) | ((vv == vj[i2]) & (jj < j)))); }
                }
#pragma unroll
                for (int i2 = 0; i2 < 4; ++i2) { const int j = sub + 8 * i2;
                    const bool forced = (j == 0) || (j == qt) || (j == qt - 1), cand = (j >= 1) && (j <= qt - 2);
                    if (forced || (cand && rank[i2] < 13)) mask |= 1u << j; }
                mask |= __shfl_xor(mask, 1); mask |= __shfl_xor(mask, 2); mask |= __shfl_xor(mask, 4);
            }
            if (sub == 0) { selL[q] = mask; __hip_atomic_fetch_or(uL, mask, __ATOMIC_RELAXED, __HIP_MEMORY_SCOPE_WORKGROUP); }
        }
        __syncthreads();
        const unsigned mysel = selL[32 * qh + l31], U = uL[0];
        LAS float* stash = (LAS float*)(lds + 4608 + wave * 8192) + lane;
#pragma unroll
        for (int dt = 0; dt < 2; ++dt)
#pragma unroll
            for (int r = 0; r < 16; ++r) stash[(dt * 16 + r) * 64] = Ot[dt][r];
        {
            const bf16* ksel = cas + (size_t)(b * SEQ) * LD_CAS + KS0 + g * 64; const bf16* kwin = cas + (size_t)(b * SEQ) * LD_CAS + KW0 + g * 64;
            const bf16* vts = (const bf16*)(p.ws + WS_VTS) + (size_t)bg * 32 * 4096; const bf16* vtw = (const bf16*)(p.ws + WS_VTW) + (size_t)bg * 32 * 4096;
            if (fastmode) attn_stream<true>(lds, ksel, kwin, vts, vtw, U, mysel, qt, tq, tmin, bl, qr, g3, stash, Ot, tid, l31, hh);
            else attn_stream<false>(lds, ksel, kwin, vts, vtw, U, mysel, qt, tq, tmin, bl, qr, g3, stash, Ot, tid, l31, hh);
        }
        u32x2 aw[2][4];
#pragma unroll
        for (int dt = 0; dt < 2; ++dt)
#pragma unroll
            for (int g4 = 0; g4 < 4; ++g4) aw[dt][g4] = *(const u32x2*)(cas + m * LD_CAS + ASILU0 + head * 64 + 32 * dt + 8 * g4 + 4 * hh);
        asm volatile("s_waitcnt lgkmcnt(0)\n\ts_barrier" ::: "memory");
#pragma unroll
        for (int dt = 0; dt < 2; ++dt)
#pragma unroll
            for (int g4 = 0; g4 < 4; ++g4) asm volatile("" : "+v"(aw[dt][g4]));
#pragma unroll
        for (int dt = 0; dt < 2; ++dt)
#pragma unroll
            for (int g4 = 0; g4 < 4; ++g4) {
                const int col = head * 64 + 32 * dt + 8 * g4 + 4 * hh;
                u32x2 w; w.x = pk2(Ot[dt][4 * g4] * siluf_(bflo(aw[dt][g4].x)), Ot[dt][4 * g4 + 1] * siluf_(bfhi(aw[dt][g4].x)));
                w.y = pk2(Ot[dt][4 * g4 + 2] * siluf_(bflo(aw[dt][g4].y)), Ot[dt][4 * g4 + 3] * siluf_(bfhi(aw[dt][g4].y)));
                *(u32x2*)((bf16*)(p.ws + WS_YA) + m * 512 + col) = w;
            }
        if (tid == 0) uL[0] = 0u;
    }
}
DI void phase3(const Params& p, LAS unsigned char* lds) { phase3a(p, lds); phase3b(p, lds); phase3c(p, lds); }


#define XB_TMO      128
#define XB_XCNT(j)  (256  + 64 * (j))
#define XB_XSUB(j)  (1280 + 64 * (j))
#define XB_XGEN(j)  (2304 + 64 * (j))
#define XB_TOP      3328
#define XB_TOPGEN   3392
#define XCD_BAR_WORDS 3456
#define XB_SPIN_CAP (1u << 22)
DI unsigned xb_ld(unsigned* p)              { return __hip_atomic_load(p, __ATOMIC_RELAXED, __HIP_MEMORY_SCOPE_AGENT); }
DI unsigned xb_add(unsigned* p, unsigned v) { return __hip_atomic_fetch_add(p, v, __ATOMIC_RELAXED, __HIP_MEMORY_SCOPE_AGENT); }
DI unsigned xb_xcc_id() { return (unsigned)__builtin_amdgcn_s_getreg((3 << 11) | 20) & 0xFu; }
#define XB_SPIN(cond, bar) do { unsigned _sp = 0; while (cond) { __builtin_amdgcn_s_sleep(1); \
    if ((++_sp & 255u) == 0u) { if (xb_ld(&(bar)[XB_TMO])) break; if (_sp > XB_SPIN_CAP) { atomicAdd(&(bar)[XB_TMO], 1u); break; } } } } while (0)
struct XcdBarrier { unsigned* bar; unsigned x; volatile LAS unsigned* st; };
DI XcdBarrier xcd_barrier_post(unsigned* bar, volatile LAS unsigned* st) {
    XcdBarrier b; b.bar = bar; b.x = xb_xcc_id(); b.st = st;
    if (threadIdx.x == 0) (void)xb_add(&bar[XB_XCNT(b.x)], 1u);
    return b;
}
DI void xcd_barrier_complete(unsigned* bar, unsigned x, unsigned& nloc, unsigned& nx) {
    const unsigned G = gridDim.x * gridDim.y * gridDim.z;
    unsigned sum, cnt, mine, sp = 0u;
    for (;;) {
        sum = 0u; cnt = 0u; mine = 0u;
#pragma unroll
        for (unsigned j = 0; j < 16; ++j) { const unsigned c = xb_ld(&bar[XB_XCNT(j)]); sum += c; cnt += (c > 0u) ? 1u : 0u; mine = (j == x) ? c : mine; }
        if (sum == G) break;
        __builtin_amdgcn_s_sleep(1);
        if ((++sp & 255u) == 0u) { if (xb_ld(&bar[XB_TMO])) break; if (sp > XB_SPIN_CAP) { atomicAdd(&bar[XB_TMO], 1u); break; } }
    }
    nloc = mine > 0u ? mine : 1u; nx = cnt > 0u ? cnt : 1u;
}
DI void xcd_barrier(const XcdBarrier& b) {
    asm volatile("s_waitcnt vmcnt(0)" ::: "memory");
    __syncthreads();
    if (threadIdx.x == 0) {
        unsigned* bar = b.bar;
        __builtin_amdgcn_s_waitcnt(0);
        unsigned nloc = b.st[0], nx = b.st[1];
        if (nloc == 0u) { xcd_barrier_complete(bar, b.x, nloc, nx); b.st[0] = nloc; b.st[1] = nx; }
        const unsigned old = xb_add(&bar[XB_XSUB(b.x)], 1u);
        const unsigned gen = old / nloc;
        if (old + 1u == (gen + 1u) * nloc) {
            __builtin_amdgcn_fence(__ATOMIC_RELEASE, "agent");
            asm volatile("s_waitcnt vmcnt(0)" ::: "memory");
            const unsigned og = xb_add(&bar[XB_TOP], 1u);
            const unsigned tg = og / nx;
            if (og + 1u == (tg + 1u) * nx) xb_add(&bar[XB_TOPGEN], 1u);
            else XB_SPIN(xb_ld(&bar[XB_TOPGEN]) == tg, bar);
            __builtin_amdgcn_fence(__ATOMIC_ACQUIRE, "agent");
            xb_add(&bar[XB_XGEN(b.x)], 1u);
            asm volatile("s_waitcnt vmcnt(0)" ::: "memory");
        } else {
            XB_SPIN(xb_ld(&bar[XB_XGEN(b.x)]) == gen, bar);
            __builtin_amdgcn_fence(__ATOMIC_ACQUIRE, "agent");
            asm volatile("s_waitcnt vmcnt(0)" ::: "memory");
        }
    }
    __syncthreads();
}

__global__ void __launch_bounds__(512, 2) hybrid_fwd(Params p) {
    extern __shared__ __attribute__((aligned(16))) unsigned char lds_raw[];
    LAS unsigned char* lds = (LAS unsigned char*)lds_raw;
#if USE_CG_SYNC
    cg::grid_group grid = cg::this_grid();
#define GRID_BAR() grid.sync()
#else
    volatile LAS unsigned* bst = (volatile LAS unsigned*)(lds + LDS_BYTES - 64);
    if (threadIdx.x < 2) bst[threadIdx.x] = 0u;
    __syncthreads();
    const XcdBarrier xbar = xcd_barrier_post((unsigned*)(p.ws + WS_CTL) + 1024, bst);
#define GRID_BAR() xcd_barrier(xbar)
#endif
    const int lo = p.ph_lo, hi = p.ph_hi;
#ifdef ONLYP
#define IN(k) ((k) == ONLYP && lo <= (k) && (k) < hi)
#else
#define IN(k) (lo <= (k) && (k) < hi)
#endif
#define SEAM(k) do { if (IN(k) && IN((k) + 1)) GRID_BAR(); } while (0)
    unsigned char* ws = p.ws;
    if (IN(0)) { phase0(p, lds); }
    SEAM(0);
    if (IN(1)) { phase1(p, lds); phase0w(p, lds); }
    SEAM(1);
    if (IN(2)) {
        pg8::Gemm g{(const bf16*)((unsigned char*)p.out + OUT_H), (const bf16*)(ws + WS_WIN_T), MTOK, N_IN_PAD, DM, DM, DM};
        pg8::StaticOrder S; S.init(MTOK, N_IN_PAD, gridDim.x, blockIdx.x);
        EpiInProj E{(bf16*)(ws + WS_CAS), (bf16*)(ws + WS_CR)};
        pg8::gemm_phase<EpiInProj, pg8::StaticOrder>(lds, g, S, E);
    }
    SEAM(2);
    if (IN(3)) { phase3(p, lds); }
    SEAM(3);
    if (IN(4)) { phase5a(p); phase4(p, lds); __syncthreads(); phase5b(p, lds); }
    SEAM(5);
    if (IN(6)) {
        { pg8::Gemm g{(const bf16*)(ws + WS_YA), (const bf16*)(ws + WS_WA_T), MTOK, DM, 512, 512, 512};
          pg8::StaticOrder S; S.init(MTOK, DM, gridDim.x, blockIdx.x);
          EpiGate<0> E{(bf16*)(ws + WS_MERGED), (const bf16*)(ws + WS_CR)};
          pg8::gemm_phase<EpiGate<0>, pg8::StaticOrder>(lds, g, S, E); }
        { pg8::Gemm g{(const bf16*)(ws + WS_YB), (const bf16*)(ws + WS_WB_T), MTOK, DM, 512, 512, 512};
          pg8::StaticOrder S; S.init(MTOK, DM, gridDim.x, blockIdx.x);
          EpiGate<1> E{(bf16*)(ws + WS_MERGED), (const bf16*)(ws + WS_CR)};
          pg8::gemm_phase<EpiGate<1>, pg8::StaticOrder>(lds, g, S, E); }
    }
    SEAM(6);
    if (IN(7)) {
        pg8::Gemm g{(const bf16*)(ws + WS_MERGED), (const bf16*)(ws + WS_WO_T), MTOK, DM, DM, DM, DM};
        pg8::StaticOrder S; S.init(MTOK, DM, gridDim.x, blockIdx.x);
        EpiFinal E{p.x, (const float*)(ws + WS_MOD), p.out};
        pg8::gemm_phase<EpiFinal, pg8::StaticOrder>(lds, g, S, E);
    }
#undef IN
#undef SEAM
}

extern "C" void kernel_launch(void* const* d_in, const int* in_sizes, int n_in, void* d_out, int out_size, void* d_ws, size_t ws_size, hipStream_t stream) {
    static int grid = 0;
    if (grid == 0) {
        if (n_in != 28 || out_size != MTOK * DM || ws_size < WS_END) { fprintf(stderr, "kernel_launch: unexpected shapes (n_in %d out %d ws %zu)\n", n_in, out_size, ws_size); grid = -1; return; }
        int dev = 0, cus = 0, per_cu = 0;
        (void)hipGetDevice(&dev); (void)hipDeviceGetAttribute(&cus, hipDeviceAttributeMultiprocessorCount, dev);
        if (hipFuncSetAttribute((const void*)hybrid_fwd, hipFuncAttributeMaxDynamicSharedMemorySize, LDS_BYTES) != hipSuccess) { fprintf(stderr, "kernel_launch: hipFuncSetAttribute failed\n"); grid = -1; return; }
        if (hipOccupancyMaxActiveBlocksPerMultiprocessor(&per_cu, (const void*)hybrid_fwd, 512, LDS_BYTES) != hipSuccess || per_cu < 1) { fprintf(stderr, "kernel_launch: occupancy query says %d\n", per_cu); per_cu = 1; }
        (void)hipGetLastError();
        grid = cus * 1;
        if (grid <= 0) grid = 256;
    }
    if (grid < 0) return;
    (void)hipMemsetAsync((char*)d_ws + WS_CTL, 0, CTL_ZERO_BYTES, stream);
    Params p{};
    const float** pp = (const float**)&p;
    for (int i = 0; i < 28; ++i) pp[i] = (const float*)d_in[i];
    p.out = (float*)d_out; p.ws = (unsigned char*)d_ws;
#if MK_LAUNCHES == 1
    p.ph_lo = 0; p.ph_hi = 8;
    void* args[] = {&p};
    hipError_t e = hipLaunchCooperativeKernel((const void*)hybrid_fwd, dim3(grid), dim3(512), args, LDS_BYTES, stream);
    if (e != hipSuccess) fprintf(stderr, "cooperative launch failed: %s (grid %d)\n", hipGetErrorString(e), grid);
#else
    const int cuts[][2] = {{0, 1}, {1, 2}, {2, 3}, {3, 4}, {4, 5}, {5, 6}, {6, 7}, {7, 8}};
    for (int li = 0; li < 8; ++li) {
        p.ph_lo = cuts[li][0]; p.ph_hi = cuts[li][1];
        hipLaunchKernelGGL(hybrid_fwd, dim3(grid), dim3(512), LDS_BYTES, stream, p);
    }
#endif
}
```

```cpp
#include <hip/hip_runtime.h>
#include <hip/hip_cooperative_groups.h>
#include <cstdio>
#include <cstdint>
namespace cg = cooperative_groups;

#ifndef USE_CG_SYNC
#define USE_CG_SYNC 0
#endif
#ifndef MK_LAUNCHES
#define MK_LAUNCHES 1
#endif

#define DI __device__ __forceinline__
#define LAS __attribute__((address_space(3)))
typedef unsigned short bf16;
typedef short bf16x8 __attribute__((ext_vector_type(8)));
typedef short s16x4 __attribute__((ext_vector_type(4)));
typedef float f32x2 __attribute__((ext_vector_type(2)));
typedef float f32x4 __attribute__((ext_vector_type(4)));
typedef float f32x16 __attribute__((ext_vector_type(16)));
typedef unsigned u32x2 __attribute__((ext_vector_type(2)));
typedef unsigned u32x4 __attribute__((ext_vector_type(4)));
typedef __bf16 bf16x2_t __attribute__((ext_vector_type(2)));

namespace pg8 {
typedef unsigned short bf16_t;
constexpr int BM = 256, BK = 64, HALF = 128, HTB = HALF * BK * 2, STAGE_BYTES = 8 * HTB, NXCD = 8, WGM = 8;
__host__ __device__ __forceinline__ int lds_byte(int r, int c) { const int st = (r >> 4) * 2 + (c >> 5), rr = r & 15, cc = c & 31, ob = rr * 64 + cc * 2; return st * 1024 + (ob ^ (((ob >> 9) & 1) << 5)); }
__host__ __device__ __forceinline__ void stage_rc(int b, int& R, int& C) { const int st = b / 1024, sb = b % 1024, swz = sb ^ (((sb >> 9) & 1) << 5); R = (st >> 1) * 16 + swz / 64; C = (st & 1) * 32 + (swz % 64) / 2; }
__host__ __device__ __forceinline__ int perm32(int rho) { const int n = rho >> 4, i = rho & 15; return 8 * (i >> 2) + 4 * n + (i & 3); }
struct Unit { int pm, pn; };
struct Gemm { const bf16_t* A; const bf16_t* Bt; int M, N, K, lda, ldb; };
struct StaticOrder {
    int nM, nN, nwg, G, c;
    __host__ __device__ void init(int M, int N, int G_, int c_) { nM = M / BM; nN = N / BM; nwg = nM * nN; G = G_; c = c_; }
    __host__ __device__ bool next(int i, Unit& u) const {
        const long L = (long)i * G + c; if (L >= nwg) return false;
        int wgid = (int)L; { const int q = nwg / NXCD, r = nwg % NXCD, xcd = wgid % NXCD, off = wgid / NXCD; wgid = (xcd < r ? xcd * (q + 1) : r * (q + 1) + (xcd - r) * q) + off; }
        const int nig = WGM * nN, gid = wgid / nig, fm = gid * WGM, gsz = (nM - fm) < WGM ? (nM - fm) : WGM;
        u.pm = fm + ((wgid % nig) % gsz); u.pn = (wgid % nig) / gsz; return true;
    }
};
__device__ __forceinline__ unsigned cvt_pk_bf16(float lo, float hi) { unsigned r; asm volatile("v_cvt_pk_bf16_f32 %0, %1, %2" : "=v"(r) : "v"(lo), "v"(hi)); return r; }

template <class Epi, class Sched, bool ALIGN_EPI = true, bool SP2 = true>
__device__ __forceinline__ void gemm_phase(LAS unsigned char* lds, const Gemm g, const Sched& S, const Epi& E) {
    const int tid = threadIdx.x, wid = __builtin_amdgcn_readfirstlane(tid >> 6), lane = tid & 63, wr = wid >> 2, wc = wid & 3, fr = lane & 15, fq = lane >> 4;
    const int K = g.K, nt = K / BK;
    unsigned voffA[2], voffB[2];
#pragma unroll
    for (int i = 0; i < 2; ++i) { int R, C; stage_rc(tid * 16 + i * 8192, R, C); const int Rb = Epi::PERM ? ((R & ~31) + perm32(R & 31)) : R;
        voffA[i] = (unsigned)(R * g.lda + C) * 2u; voffB[i] = (unsigned)(Rb * g.ldb + C) * 2u; }
    const size_t kstep = (size_t)(BK * 2);
    const size_t hstepA = (size_t)HALF * g.lda * 2, hstepB = (size_t)HALF * g.ldb * 2;
    const size_t tstepA = 2 * hstepA, tstepB = 2 * hstepB;
    const unsigned ldsw = (unsigned)wid * 1024u;
    const int aoff = lds_byte(wr * 64 + fr, fq * 8), boff = lds_byte(wc * 32 + fr, fq * 8);
#define PG8_SA(b, h) (((b) * 2 + (h)) * HTB)
#define PG8_SB(b, h) ((4 + (b) * 2 + (h)) * HTB)
#define PG8_STAGE(bufoff, gbase, voff) do { _Pragma("unroll") for (int _i = 0; _i < 2; ++_i) \
        __builtin_amdgcn_global_load_lds((const unsigned*)((const char*)(gbase) + (voff)[_i]), (LAS unsigned*)(lds + (bufoff) + ldsw + _i * 8192), 16, 0, 0); } while (0)
#define PG8_LDA(dst, b, h) do { _Pragma("unroll") for (int m = 0; m < 4; ++m) _Pragma("unroll") for (int k = 0; k < 2; ++k) dst[m][k] = *(const LAS bf16x8*)(lds + PG8_SA(b, h) + aoff + m * 2048 + k * 1024); } while (0)
#define PG8_LDB(dst, b, h) do { _Pragma("unroll") for (int n = 0; n < 2; ++n) _Pragma("unroll") for (int k = 0; k < 2; ++k) dst[n][k] = *(const LAS bf16x8*)(lds + PG8_SB(b, h) + boff + n * 2048 + k * 1024); } while (0)
#define PG8_MMA(ai, bj, At, Bt) do { __builtin_amdgcn_s_setprio(1); _Pragma("unroll") for (int m = 0; m < 4; ++m) _Pragma("unroll") for (int n = 0; n < 2; ++n) _Pragma("unroll") for (int k = 0; k < 2; ++k) \
        acc[ai][bj][m][n] = __builtin_amdgcn_mfma_f32_16x16x32_bf16(Bt[n][k], At[m][k], acc[ai][bj][m][n], 0, 0, 0); __builtin_amdgcn_s_setprio(0); } while (0)
#define PG8_WAIT_V(n) asm volatile("s_waitcnt vmcnt(" #n ")" ::: "memory")
#define PG8_WAIT_L(n) asm volatile("s_waitcnt lgkmcnt(" #n ")" ::: "memory")
#define PG8_BAR __builtin_amdgcn_s_barrier()
#define PG8_SCHED __builtin_amdgcn_sched_barrier(0)
    Unit cur, nxt; int ui = 0;
    if (!S.next(0, cur)) return;
    f32x4 acc[2][2][4][2];
#pragma unroll
    for (int a = 0; a < 2; ++a)
#pragma unroll
        for (int b = 0; b < 2; ++b)
#pragma unroll
            for (int m = 0; m < 4; ++m)
#pragma unroll
                for (int n = 0; n < 2; ++n) acc[a][b][m][n] = (f32x4){0.f, 0.f, 0.f, 0.f};
    bf16x8 At[4][2], B0[2][2], B1[2][2];
    const char* cA = (const char*)g.A + (size_t)cur.pm * tstepA; const char* cB = (const char*)g.Bt + (size_t)cur.pn * tstepB;
    if constexpr (SP2) {
        PG8_STAGE(PG8_SB(0, 0), cB, voffB); PG8_STAGE(PG8_SB(0, 1), cB + hstepB, voffB); PG8_STAGE(PG8_SA(0, 0), cA, voffA); PG8_STAGE(PG8_SA(0, 1), cA + hstepA, voffA);
        if (wr == 1) PG8_BAR;
        PG8_WAIT_V(2); PG8_BAR;
        PG8_STAGE(PG8_SB(1, 0), cB + kstep, voffB); PG8_STAGE(PG8_SA(1, 0), cA + kstep, voffA); PG8_STAGE(PG8_SB(1, 1), cB + hstepB + kstep, voffB);
        PG8_WAIT_V(6); PG8_BAR;
    } else {
        PG8_STAGE(PG8_SB(0, 0), cB, voffB); PG8_STAGE(PG8_SA(0, 0), cA, voffA); PG8_STAGE(PG8_SB(0, 1), cB + hstepB, voffB); PG8_STAGE(PG8_SA(0, 1), cA + hstepA, voffA);
        if (wr == 1) PG8_BAR;
        PG8_WAIT_V(4); PG8_BAR;
        PG8_STAGE(PG8_SB(1, 0), cB + kstep, voffB); PG8_STAGE(PG8_SA(1, 0), cA + kstep, voffA); PG8_STAGE(PG8_SB(1, 1), cB + hstepB + kstep, voffB);
        PG8_WAIT_V(6); PG8_BAR;
    }
    for (;;) {
        const bool has_next = S.next(ui + 1, nxt);
        const char* nA = has_next ? (const char*)g.A + (size_t)nxt.pm * tstepA : cA; const char* nB = has_next ? (const char*)g.Bt + (size_t)nxt.pn * tstepB : cB;
        for (int t = 0; t < nt; t += 2) {
            const bool last = (t == nt - 2);
            const char* a1 = cA + (size_t)(t + 1) * kstep;
            const char* a2 = last ? nA : cA + (size_t)(t + 2) * kstep; const char* b2 = last ? nB : cB + (size_t)(t + 2) * kstep;
            const char* a3 = a2 + kstep; const char* b3 = b2 + kstep;
            if constexpr (SP2) {
            PG8_LDB(B0, 0, 0); PG8_LDB(B1, 0, 1); PG8_SCHED; PG8_LDA(At, 0, 0); PG8_STAGE(PG8_SA(1, 1), a1 + hstepA, voffA);
            PG8_WAIT_V(8); PG8_WAIT_L(0); PG8_BAR; PG8_MMA(0, 0, At, B0); PG8_MMA(0, 1, At, B1); PG8_BAR; PG8_SCHED;
            PG8_LDA(At, 0, 1); PG8_STAGE(PG8_SB(0, 0), b2, voffB); PG8_STAGE(PG8_SB(0, 1), b2 + hstepB, voffB); PG8_STAGE(PG8_SA(0, 0), a2, voffA);
            PG8_WAIT_V(8); PG8_WAIT_L(0); PG8_BAR; PG8_MMA(1, 0, At, B0); PG8_MMA(1, 1, At, B1); PG8_BAR; PG8_SCHED;
            PG8_LDB(B0, 1, 0); PG8_LDB(B1, 1, 1); PG8_SCHED; PG8_LDA(At, 1, 0); PG8_STAGE(PG8_SA(0, 1), a2 + hstepA, voffA);
            PG8_WAIT_V(8); PG8_WAIT_L(0); PG8_BAR; PG8_MMA(0, 0, At, B0); PG8_MMA(0, 1, At, B1); PG8_BAR; PG8_SCHED;
            PG8_LDA(At, 1, 1); PG8_STAGE(PG8_SB(1, 0), b3, voffB); PG8_STAGE(PG8_SB(1, 1), b3 + hstepB, voffB); PG8_STAGE(PG8_SA(1, 0), a3, voffA);
            PG8_WAIT_V(8); PG8_WAIT_L(0); PG8_BAR; PG8_MMA(1, 0, At, B0); PG8_MMA(1, 1, At, B1); PG8_BAR; PG8_SCHED;
            } else {
            PG8_LDB(B0, 0, 0); PG8_SCHED; PG8_LDA(At, 0, 0); PG8_STAGE(PG8_SA(1, 1), a1 + hstepA, voffA);
            PG8_WAIT_L(8); PG8_BAR; PG8_WAIT_L(0); PG8_MMA(0, 0, At, B0); PG8_BAR; PG8_SCHED;
            PG8_LDB(B1, 0, 1); PG8_STAGE(PG8_SB(0, 0), b2, voffB);
            PG8_BAR; PG8_WAIT_L(0); PG8_MMA(0, 1, At, B1); PG8_BAR;
            PG8_LDA(At, 0, 1); PG8_STAGE(PG8_SA(0, 0), a2, voffA);
            PG8_BAR; PG8_WAIT_L(0); PG8_MMA(1, 0, At, B0); PG8_BAR; PG8_SCHED;
            PG8_STAGE(PG8_SB(0, 1), b2 + hstepB, voffB);
            PG8_WAIT_V(6); PG8_BAR; PG8_MMA(1, 1, At, B1); PG8_BAR;
            PG8_LDB(B0, 1, 0); PG8_SCHED; PG8_LDA(At, 1, 0); PG8_STAGE(PG8_SA(0, 1), a2 + hstepA, voffA);
            PG8_WAIT_L(8); PG8_BAR; PG8_WAIT_L(0); PG8_MMA(0, 0, At, B0); PG8_BAR; PG8_SCHED;
            PG8_LDB(B1, 1, 1); PG8_STAGE(PG8_SB(1, 0), b3, voffB);
            PG8_BAR; PG8_WAIT_L(0); PG8_MMA(0, 1, At, B1); PG8_BAR;
            PG8_LDA(At, 1, 1); PG8_STAGE(PG8_SA(1, 0), a3, voffA);
            PG8_BAR; PG8_WAIT_L(0); PG8_MMA(1, 0, At, B0); PG8_BAR; PG8_SCHED;
            PG8_STAGE(PG8_SB(1, 1), b3 + hstepB, voffB);
            PG8_WAIT_V(6); PG8_BAR; PG8_MMA(1, 1, At, B1); PG8_BAR;
            }
        }
        if constexpr (ALIGN_EPI) { if (wr == 0) PG8_BAR; }
        E(acc, cur, wr, wc, fr, fq);
        if (!has_next) break;
#pragma unroll
        for (int a = 0; a < 2; ++a)
#pragma unroll
            for (int b = 0; b < 2; ++b)
#pragma unroll
                for (int m = 0; m < 4; ++m)
#pragma unroll
                    for (int n = 0; n < 2; ++n) acc[a][b][m][n] = (f32x4){0.f, 0.f, 0.f, 0.f};
        cur = nxt; cA = nA; cB = nB; ++ui;
        if constexpr (ALIGN_EPI) { if (wr == 1) PG8_BAR; }
    }
    PG8_WAIT_V(0);
    if constexpr (!ALIGN_EPI) { if (wr == 0) PG8_BAR; }
    PG8_BAR;
#undef PG8_SA
#undef PG8_SB
#undef PG8_STAGE
#undef PG8_LDA
#undef PG8_LDB
#undef PG8_MMA
#undef PG8_WAIT_V
#undef PG8_WAIT_L
#undef PG8_BAR
#undef PG8_SCHED
}
}

constexpr int NB = 16, SEQ = 2048, DM = 1024, MTOK = NB * SEQ;
constexpr int LD_CAS = 3584, LD_CR = 2560, N_IN_PAD = 6144, N_IN = 6040;
constexpr int Q0 = 0, KC0 = 512, VC0 = 640, KS0 = 768, VS0 = 896, KW0 = 1024, VW0 = 1152, GATE0 = 1280, ASILU0 = 1304;
constexpr int SH0 = 1816, R0 = SH0, K0 = SH0 + 512, V0 = SH0 + 1024, WD0 = SH0 + 1536, AD0 = SH0 + 1600, CAS_USED = 3480;
constexpr int BSILU0 = 0, MA0 = 512, MB0 = 1536;
constexpr float LOG2E = 1.4426950408889634f;
constexpr float QSCALE = 0.125f * LOG2E;

constexpr size_t MiB = 1u << 20;
constexpr size_t WS_CTL = 0, CTL_ZERO_BYTES = 64 * 1024;
constexpr size_t WS_MOD = 256 * 1024;
constexpr size_t WS_POSB = 512 * 1024;
constexpr size_t WS_BIAS = 520 * 1024;
constexpr size_t WS_WA_T = 2 * MiB, WS_WB_T = 3 * MiB;
constexpr size_t WS_WO_T = 4 * MiB;
constexpr size_t WS_W1K_T = 6 * MiB, WS_W1V_T = 7 * MiB;
constexpr size_t WS_W2K_T = 8 * MiB, WS_W2V_T = 8 * MiB + 64 * 1024;
constexpr size_t WS_WLW_T = 8 * MiB + 128 * 1024, WS_WLA_T = 8 * MiB + 192 * 1024;
constexpr size_t WS_KC = 9 * MiB;
constexpr size_t WS_VCT = 9 * MiB + 512 * 1024;
constexpr size_t WS_BONUS = 10 * MiB;
constexpr size_t WS_DUMMY = 11 * MiB;
constexpr size_t WS_VTS = 12 * MiB, WS_VTW = 20 * MiB;
constexpr size_t WS_CAS = 28 * MiB;
constexpr size_t WS_CR = 252 * MiB;
constexpr size_t WS_YA = 412 * MiB, WS_YB = 444 * MiB;
constexpr size_t WS_WIN_T = 476 * MiB;
constexpr size_t WS_HS = 476 * MiB;
constexpr size_t WS_MERGED = WS_CAS;
constexpr size_t WS_END = 508 * MiB;
constexpr size_t OUT_H = 0;
constexpr size_t OUT_G = 0, OUT_Y1 = 32 * MiB, OUT_D = 64 * MiB, OUT_Y2 = 96 * MiB;

constexpr int LDS_BYTES = 147456;

struct Params {
    const float *x, *c, *w_ada, *b_ada, *norm_gain, *w_in, *q_norm_gain, *k_norm_gain, *cmp_pos_k, *cmp_pos_v,
        *cmp_k_w1, *cmp_k_w2, *cmp_v_w1, *cmp_v_w2, *rel_bias, *shift_mu, *w0, *w_lora_up, *a0, *a_lora_up,
        *k_k, *k_a, *r_k, *ln_x_w, *ln_x_b, *w_out_a, *w_out_b, *w_o;
    float* out; unsigned char* ws;
    int ph_lo, ph_hi;
};

DI unsigned f2bf(float f) { unsigned u = __builtin_bit_cast(unsigned, f); return (u + 0x7fffu + ((u >> 16) & 1u)) >> 16; }
DI float bf2f(unsigned h) { return __builtin_bit_cast(float, h << 16); }
DI unsigned pk2(float lo, float hi) { f32x2 v = {lo, hi}; bf16x2_t b = __builtin_convertvector(v, bf16x2_t); return __builtin_bit_cast(unsigned, b); }
DI float bflo(unsigned w) { return __builtin_bit_cast(float, w << 16); }
DI float bfhi(unsigned w) { return __builtin_bit_cast(float, w & 0xffff0000u); }
DI float sigmoidf_(float x) { return __builtin_amdgcn_rcpf(1.f + __expf(-x)); }
DI float siluf_(float x) { return x * __builtin_amdgcn_rcpf(1.f + __expf(-x)); }
DI int crow(int r, int hh) { return (r & 3) + 8 * (r >> 2) + 4 * hh; }
DI int pos16_of_key(int k16) { return 8 * ((k16 >> 2) & 1) + 4 * (k16 >> 3) + (k16 & 3); }
DI int key16_of_pos(int p16) { const int hh = p16 >> 3, j = p16 & 7; return 8 * (j >> 2) + 4 * hh + (j & 3); }
DI float wave_sum(float v) {
#pragma unroll
    for (int o = 1; o < 64; o <<= 1) v += __shfl_xor(v, o);
    return v;
}
DI void unpack8(u32x4 w, float* f) { f[0] = bflo(w.x); f[1] = bfhi(w.x); f[2] = bflo(w.y); f[3] = bfhi(w.y); f[4] = bflo(w.z); f[5] = bfhi(w.z); f[6] = bflo(w.w); f[7] = bfhi(w.w); }
typedef short v4i16_t __attribute__((ext_vector_type(4)));
DI s16x4 tr_read(const LAS bf16* p) { return __builtin_bit_cast(s16x4, __builtin_amdgcn_ds_read_tr16_b64_v4i16((LAS v4i16_t*)p)); }

__device__ const unsigned char T5_BUCKET[129] = {
    0, 1, 2, 3, 4, 5, 6, 7, 8, 9, 10, 11, 12, 13, 14, 15, 16, 16, 16, 17, 17, 18, 18, 18, 19, 19, 19, 20, 20, 20, 20, 21, 21, 21, 21, 22, 22, 22, 22, 22, 23, 23, 23, 23, 23, 23, 24, 24, 24, 24, 24, 24, 25, 25, 25, 25, 25, 25, 25, 26, 26, 26, 26, 26, 26, 26, 26, 27, 27, 27, 27, 27, 27, 27, 27, 27, 27, 28, 28, 28, 28, 28, 28, 28, 28, 28, 28, 29, 29, 29, 29, 29, 29, 29, 29, 29, 29, 29, 29, 30, 30, 30, 30, 30, 30, 30, 30, 30, 30, 30, 30, 30, 30, 31, 31, 31, 31, 31, 31, 31, 31, 31, 31, 31, 31, 31, 31, 31, 31};

template <class F> DI void transpose_item(const float* W, int K, int N, bf16* WT, F rowmap, LAS float* scr, int item, int lane) {
    const int nblk = (N + 63) / 64, kb = item / nblk, nb = item % nblk, k0 = 64 * kb, n0 = 64 * nb;
    const int n4 = (lane & 15) * 4;
    const bool inb = n0 + n4 < N; const int ncl = inb ? n0 + n4 : N - 4;
    f32x4 vv[16];
#pragma unroll
    for (int i = 0; i < 16; ++i) vv[i] = *(const f32x4*)(W + (size_t)(k0 + 4 * i + (lane >> 4)) * N + ncl);
#pragma unroll
    for (int i = 0; i < 16; ++i) asm volatile("" : "+v"(vv[i]));
#pragma unroll
    for (int i = 0; i < 16; ++i) { const int kk = 4 * i + (lane >> 4);
        const f32x4 v = inb ? vv[i] : (f32x4){0.f, 0.f, 0.f, 0.f};
        LAS float* d = scr + kk * 65 + n4; d[0] = v[0]; d[1] = v[1]; d[2] = v[2]; d[3] = v[3]; }
    asm volatile("s_waitcnt lgkmcnt(0)" ::: "memory");
    const int c = lane & 7;
#pragma unroll
    for (int j = 0; j < 8; ++j) { const int nl = (lane >> 3) + 8 * j, n = n0 + nl; const LAS float* s = scr + (8 * c) * 65 + nl;
        u32x4 o; o.x = pk2(s[0 * 65], s[1 * 65]); o.y = pk2(s[2 * 65], s[3 * 65]); o.z = pk2(s[4 * 65], s[5 * 65]); o.w = pk2(s[6 * 65], s[7 * 65]);
        if (n < N) *(u32x4*)(WT + (size_t)rowmap(n) * K + k0 + 8 * c) = o; }
    asm volatile("s_waitcnt lgkmcnt(0)" ::: "memory");
}

DI void phase0w(const Params& p, LAS unsigned char* lds) {
    const int tid = threadIdx.x, lane = tid & 63, wave = __builtin_amdgcn_readfirstlane(tid >> 6);
    const int gw = blockIdx.x * 8 + wave, NGW = gridDim.x * 8;
    unsigned char* ws = p.ws;
    {
        LAS float* scr = (LAS float*)(lds + wave * 16640);
        constexpr int I_IN = 16 * 95, I_OA = 8 * 16, I_OB = 8 * 16, I_O = 16 * 16, I_W1 = 32 * 4, I_W2 = 4 * 1, I_L = 1 * 8;
        constexpr int NIT = I_IN + I_OA + I_OB + I_O + 2 * I_W1 + 2 * I_W2 + 2 * I_L;
        auto ident = [](int n) { return n; };
        auto inmap = [](int n) { return n < CAS_USED ? n : n + (LD_CAS - CAS_USED); };
        for (int it = gw; it < NIT; it += NGW) {
            int r = it;
            if (r < I_IN) { transpose_item(p.w_in, DM, N_IN, (bf16*)(ws + WS_WIN_T), inmap, scr, r, lane); continue; } r -= I_IN;
            if (r < I_OA) { transpose_item(p.w_out_a, 512, DM, (bf16*)(ws + WS_WA_T), ident, scr, r, lane); continue; } r -= I_OA;
            if (r < I_OB) { transpose_item(p.w_out_b, 512, DM, (bf16*)(ws + WS_WB_T), ident, scr, r, lane); continue; } r -= I_OB;
            if (r < I_O) { transpose_item(p.w_o, DM, DM, (bf16*)(ws + WS_WO_T), ident, scr, r, lane); continue; } r -= I_O;
            if (r < I_W1) { transpose_item(p.cmp_k_w1, 2048, 256, (bf16*)(ws + WS_W1K_T), ident, scr, r, lane); continue; } r -= I_W1;
            if (r < I_W1) { transpose_item(p.cmp_v_w1, 2048, 256, (bf16*)(ws + WS_W1V_T), ident, scr, r, lane); continue; } r -= I_W1;
            if (r < I_W2) { transpose_item(p.cmp_k_w2, 256, 64, (bf16*)(ws + WS_W2K_T), ident, scr, r, lane); continue; } r -= I_W2;
            if (r < I_W2) { transpose_item(p.cmp_v_w2, 256, 64, (bf16*)(ws + WS_W2V_T), ident, scr, r, lane); continue; } r -= I_W2;
            if (r < I_L) { transpose_item(p.w_lora_up, 64, 512, (bf16*)(ws + WS_WLW_T), ident, scr, r, lane); continue; } r -= I_L;
            transpose_item(p.a_lora_up, 64, 512, (bf16*)(ws + WS_WLA_T), ident, scr, r, lane);
        }
    }
    {
        u32x4* z = (u32x4*)(ws + WS_WIN_T + (size_t)CAS_USED * DM * 2);
        const int n16 = (LD_CAS - CAS_USED) * DM * 2 / 16;
        for (int i = blockIdx.x * 512 + tid; i < n16; i += gridDim.x * 512) z[i] = (u32x4){0u, 0u, 0u, 0u};
    }
    __syncthreads();
}
constexpr size_t WS_MODP = 1 * MiB;
DI void phase0(const Params& p, LAS unsigned char* lds) {
    const int tid = threadIdx.x, lane = tid & 63, wave = __builtin_amdgcn_readfirstlane(tid >> 6);
    unsigned char* ws = p.ws;
    LAS float* red = (LAS float*)lds;
    LAS float* sc = (LAS float*)(lds + 32768);
    for (int task = blockIdx.x; task < 201; task += gridDim.x) {
        if (task < 192) {
            const int cg = task % 48, kq = task / 48;
            { float cv[8];
#pragma unroll
              for (int k8 = 0; k8 < 8; ++k8) { const int i = tid + 512 * k8; cv[k8] = p.c[(i >> 8) * 1024 + kq * 256 + (i & 255)]; }
#pragma unroll
              for (int k8 = 0; k8 < 8; ++k8) sc[tid + 512 * k8] = siluf_(cv[k8]); }
            __syncthreads();
            const int col = cg * 64 + lane;
            float acc[16];
#pragma unroll
            for (int b = 0; b < 16; ++b) acc[b] = 0.f;
#pragma unroll 4
            for (int kk = 0; kk < 32; ++kk) { const int kl = wave * 32 + kk; const float wv = p.w_ada[(size_t)(kq * 256 + kl) * 3072 + col];
#pragma unroll
                for (int b = 0; b < 16; ++b) acc[b] += sc[b * 256 + kl] * wv; }
#pragma unroll
            for (int b = 0; b < 16; ++b) red[(wave * 16 + b) * 64 + lane] = acc[b];
            __syncthreads();
            for (int o = tid; o < 1024; o += 512) { const int b = o >> 6, l = o & 63; float s = 0.f;
#pragma unroll
                for (int w = 0; w < 8; ++w) s += red[(w * 16 + b) * 64 + l];
                ((float*)(ws + WS_MODP))[(kq * 16 + b) * 3072 + cg * 64 + l] = s; }
            __syncthreads();
        } else if (task < 200) {
            const int t2 = task - 192, which = t2 >> 2, col = (t2 & 3) * 64 + lane;
            const float* pos = which ? p.cmp_pos_v : p.cmp_pos_k; const float* w1 = which ? p.cmp_v_w1 : p.cmp_k_w1;
            float a = 0.f;
#pragma unroll 4
            for (int kk = 0; kk < 256; ++kk) { const int k = wave * 256 + kk; a += pos[k] * w1[(size_t)k * 256 + col]; }
            red[wave * 64 + lane] = a;
            __syncthreads();
            if (tid < 64) { float s = 0.f;
#pragma unroll
                for (int w = 0; w < 8; ++w) s += red[w * 64 + tid];
                ((float*)(ws + WS_POSB))[which * 256 + (t2 & 3) * 64 + tid] = s; }
            __syncthreads();
        } else {
            for (int i = tid; i < 8 * 129; i += 512) { const int h = i / 129, d = i % 129; ((float*)(ws + WS_BIAS))[h * 132 + d] = p.rel_bias[T5_BUCKET[d] * 8 + h] * LOG2E; }
        }
    }
}

DI void phase1(const Params& p, LAS unsigned char* lds) {
    const int tid = threadIdx.x, lane = tid & 63, wave = tid >> 6;
    bf16* hb = (bf16*)((unsigned char*)p.out + OUT_H);
    LAS float* modL = (LAS float*)lds;
    for (int rb = blockIdx.x; rb < MTOK / 128; rb += gridDim.x) {
        const int b = rb >> 4;
        __syncthreads();
        { float sv[6];
#pragma unroll
          for (int c6 = 0; c6 < 6; ++c6) { const int col = tid + 512 * c6; float s = p.b_ada[col];
#pragma unroll
              for (int kq = 0; kq < 4; ++kq) s += ((const float*)(p.ws + WS_MODP))[(kq * 16 + b) * 3072 + col];
              sv[c6] = s; }
#pragma unroll
          for (int c6 = 0; c6 < 6; ++c6) asm volatile("" : "+v"(sv[c6]));
#pragma unroll
          for (int c6 = 0; c6 < 6; ++c6) { const int col = tid + 512 * c6; modL[col] = sv[c6]; if ((rb & 15) == 0) ((float*)(p.ws + WS_MOD))[b * 3072 + col] = sv[c6]; } }
        __syncthreads();
        f32x4 gq[4];
#pragma unroll
        for (int j = 0; j < 4; ++j) gq[j] = *(const f32x4*)(p.norm_gain + 4 * lane + 256 * j);
        for (int r = wave; r < 128; r += 8) {
            const int m = rb * 128 + r;
            const f32x4* xr = (const f32x4*)(p.x + (size_t)m * DM) + lane;
            f32x4 v[4]; float s = 0.f;
#pragma unroll
            for (int j = 0; j < 4; ++j) { v[j] = xr[64 * j]; s += (v[j].x * v[j].x + v[j].y * v[j].y) + (v[j].z * v[j].z + v[j].w * v[j].w); }
            const float rinv = rsqrtf(wave_sum(s) * (1.f / DM) + 1e-6f);
            u32x2* o8 = (u32x2*)(hb + (size_t)m * DM) + lane;
#pragma unroll
            for (int j = 0; j < 4; ++j) {
                const int k = 4 * lane + 256 * j;
                const f32x4 g = gq[j], sh = *(const LAS f32x4*)(modL + k), scl = *(const LAS f32x4*)(modL + 1024 + k);
                f32x4 h = v[j] * rinv * g * (scl + 1.f) + sh;
                u32x2 o; o.x = pk2(h.x, h.y); o.y = pk2(h.z, h.w); o8[64 * j] = o;
            }
        }
    }
    __syncthreads();
}

struct EpiInProj {
    static constexpr bool PERM = true;
    bf16* cas; bf16* cr;
    DI void operator()(const f32x4 (&acc)[2][2][4][2], const pg8::Unit& u, int wr, int wc, int fr, int fq) const {
        const int row0 = u.pm * 256 + wr * 64 + fr;
        bf16* base; int ldc, colt;
        if (u.pn < 14) { base = cas; ldc = LD_CAS; colt = u.pn * 256; } else { base = cr; ldc = LD_CR; colt = (u.pn - 14) * 256; }
        const int col0 = colt + wc * 32 + 8 * fq;
#pragma unroll
        for (int ai = 0; ai < 2; ++ai)
#pragma unroll
            for (int m = 0; m < 4; ++m) { bf16* rowp = base + (size_t)(row0 + ai * 128 + m * 16) * ldc + col0;
#pragma unroll
                for (int bj = 0; bj < 2; ++bj) { const f32x4 v0 = acc[ai][bj][m][0], v1 = acc[ai][bj][m][1];
                    u32x4 w; w.x = pk2(v0[0], v0[1]); w.y = pk2(v0[2], v0[3]); w.z = pk2(v1[0], v1[1]); w.w = pk2(v1[2], v1[3]);
                    *(u32x4*)(rowp + bj * 128) = w; } }
    }
};
template <int WHICH> struct EpiGate {
    static constexpr bool PERM = true;
    bf16* merged; const bf16* cr;
    DI void operator()(const f32x4 (&acc)[2][2][4][2], const pg8::Unit& u, int wr, int wc, int fr, int fq) const {
        const int row0 = u.pm * 256 + wr * 64 + fr, col0 = u.pn * 256 + wc * 32 + 8 * fq;
#pragma unroll
        for (int ai = 0; ai < 2; ++ai)
#pragma unroll
            for (int mp2 = 0; mp2 < 2; ++mp2) {
                u32x4 gw[2][2], ow[2][2];
#pragma unroll
                for (int m2 = 0; m2 < 2; ++m2)
#pragma unroll
                    for (int bj = 0; bj < 2; ++bj) { const size_t row = (size_t)(row0 + ai * 128 + (2 * mp2 + m2) * 16); const int col = col0 + bj * 128;
                        gw[m2][bj] = *(const u32x4*)(cr + row * LD_CR + (WHICH ? MB0 : MA0) + col);
                        if (WHICH) ow[m2][bj] = *(const u32x4*)(merged + row * DM + col); }
#pragma unroll
                for (int m2 = 0; m2 < 2; ++m2)
#pragma unroll
                    for (int bj = 0; bj < 2; ++bj) { asm volatile("" : "+v"(gw[m2][bj])); if (WHICH) asm volatile("" : "+v"(ow[m2][bj])); }
#pragma unroll
                for (int m2 = 0; m2 < 2; ++m2)
#pragma unroll
                    for (int bj = 0; bj < 2; ++bj) { const int m = 2 * mp2 + m2; const size_t row = (size_t)(row0 + ai * 128 + m * 16); const int col = col0 + bj * 128;
                        float gl[8]; unpack8(gw[m2][bj], gl);
                        const f32x4 v0 = acc[ai][bj][m][0], v1 = acc[ai][bj][m][1];
                        float r[8] = {v0[0], v0[1], v0[2], v0[3], v1[0], v1[1], v1[2], v1[3]};
                        if (WHICH) { float old[8]; unpack8(ow[m2][bj], old);
#pragma unroll
                            for (int i = 0; i < 8; ++i) r[i] = old[i] + sigmoidf_(gl[i]) * r[i]; }
                        else {
#pragma unroll
                            for (int i = 0; i < 8; ++i) r[i] = sigmoidf_(gl[i]) * r[i]; }
                        u32x4 w; w.x = pk2(r[0], r[1]); w.y = pk2(r[2], r[3]); w.z = pk2(r[4], r[5]); w.w = pk2(r[6], r[7]);
                        *(u32x4*)(merged + row * DM + col) = w; }
            }
    }
};
struct EpiFinal {
    static constexpr bool PERM = false;
    const float* x; const float* mod; float* out;
    DI void operator()(const f32x4 (&acc)[2][2][4][2], const pg8::Unit& u, int wr, int wc, int fr, int fq) const {
        const int row0 = u.pm * 256 + wr * 64 + fr, col0 = u.pn * 256 + wc * 32 + 4 * fq;
        const int b = (u.pm * 256) >> 11;
        f32x4 gv[2][2];
#pragma unroll
        for (int bj = 0; bj < 2; ++bj)
#pragma unroll
            for (int n = 0; n < 2; ++n) gv[bj][n] = *(const f32x4*)(mod + b * 3072 + 2048 + col0 + bj * 128 + n * 16);
#pragma unroll
        for (int ai = 0; ai < 2; ++ai)
#pragma unroll
            for (int mp = 0; mp < 2; ++mp) {
                f32x4 xv[2][2][2];
#pragma unroll
                for (int m2 = 0; m2 < 2; ++m2)
#pragma unroll
                    for (int bj = 0; bj < 2; ++bj)
#pragma unroll
                        for (int n = 0; n < 2; ++n) xv[m2][bj][n] = *(const f32x4*)(x + (size_t)(row0 + ai * 128 + (2 * mp + m2) * 16) * DM + col0 + bj * 128 + n * 16);
#pragma unroll
                for (int m2 = 0; m2 < 2; ++m2)
#pragma unroll
                    for (int bj = 0; bj < 2; ++bj)
#pragma unroll
                        for (int n = 0; n < 2; ++n) asm volatile("" : "+v"(xv[m2][bj][n]));
#pragma unroll
                for (int m2 = 0; m2 < 2; ++m2)
#pragma unroll
                    for (int bj = 0; bj < 2; ++bj)
#pragma unroll
                        for (int n = 0; n < 2; ++n)
                            *(f32x4*)(out + (size_t)(row0 + ai * 128 + (2 * mp + m2) * 16) * DM + col0 + bj * 128 + n * 16) = xv[m2][bj][n] + gv[bj][n] * acc[ai][bj][2 * mp + m2][n];
            }
    }
};

DI void phase3a(const Params& p, LAS unsigned char* lds) {
    const int tid = threadIdx.x, lane = tid & 63, wave = tid >> 6;
    const int gw = blockIdx.x * 8 + wave, NGW = gridDim.x * 8;
    bf16* cas = (bf16*)(p.ws + WS_CAS);
    {
        float gq[8], gk[8];
        const int dq = (8 * lane) & 63;
#pragma unroll
        for (int i = 0; i < 8; ++i) gq[i] = p.q_norm_gain[dq + i] * QSCALE;
        const int kr = (lane < 16) ? 1 : 2, dk = (8 * lane) & 63;
#pragma unroll
        for (int i = 0; i < 8; ++i) gk[i] = p.k_norm_gain[kr * 64 + dk + i];
        const int kcol = (lane < 16) ? (KS0 + 8 * lane) : (KW0 + 8 * (lane & 15));
        for (int m0 = gw * 4; m0 < MTOK; m0 += NGW * 4) {
            u32x4 qw[4], kw[4];
#pragma unroll
            for (int u = 0; u < 4; ++u) { bf16* row = cas + (size_t)(m0 + u) * LD_CAS;
                qw[u] = *(const u32x4*)(row + Q0 + 8 * lane);
                kw[u] = (lane < 32) ? *(const u32x4*)(row + kcol) : (u32x4){0u, 0u, 0u, 0u}; }
#pragma unroll
            for (int u = 0; u < 4; ++u) {
                bf16* row = cas + (size_t)(m0 + u) * LD_CAS;
                float q[8], k[8]; unpack8(qw[u], q); unpack8(kw[u], k);
                float sq = 0.f, sk = 0.f;
#pragma unroll
                for (int i = 0; i < 8; ++i) { sq += q[i] * q[i]; sk += k[i] * k[i]; }
#pragma unroll
                for (int o = 1; o < 8; o <<= 1) { sq += __shfl_xor(sq, o); sk += __shfl_xor(sk, o); }
                const float rq = rsqrtf(sq * (1.f / 64.f) + 1e-6f), rk = rsqrtf(sk * (1.f / 64.f) + 1e-6f);
#pragma unroll
                for (int i = 0; i < 8; ++i) { q[i] *= rq * gq[i]; k[i] *= rk * gk[i]; }
                u32x4 o; o.x = pk2(q[0], q[1]); o.y = pk2(q[2], q[3]); o.z = pk2(q[4], q[5]); o.w = pk2(q[6], q[7]);
                *(u32x4*)(row + Q0 + 8 * lane) = o;
                if (lane < 32) { u32x4 o2; o2.x = pk2(k[0], k[1]); o2.y = pk2(k[2], k[3]); o2.z = pk2(k[4], k[5]); o2.w = pk2(k[6], k[7]); *(u32x4*)(row + kcol) = o2; }
            }
        }
    }
    {
        LAS bf16* tile = (LAS bf16*)lds;
        for (int it = blockIdx.x; it < 2048; it += gridDim.x) {
            const int which = it >> 10, bg = (it >> 5) & 31, j = it & 31, b = bg >> 1, g = bg & 1;
            const int key = tid >> 3, ch = tid & 7;
            __syncthreads();
            *(LAS u32x4*)(tile + key * 72 + 8 * ch) = *(const u32x4*)(cas + (size_t)(b * SEQ + 64 * j + key) * LD_CAS + (which ? VW0 : VS0) + g * 64 + 8 * ch);
            __syncthreads();
            const int d = tid >> 3, pc = tid & 7;
            unsigned short v[8];
#pragma unroll
            for (int i = 0; i < 8; ++i) { const int pos = 8 * pc + i, k2 = (pos & ~15) | key16_of_pos(pos & 15); v[i] = tile[k2 * 72 + d]; }
            u32x4 o; o.x = v[0] | ((unsigned)v[1] << 16); o.y = v[2] | ((unsigned)v[3] << 16); o.z = v[4] | ((unsigned)v[5] << 16); o.w = v[6] | ((unsigned)v[7] << 16);
            bf16* vt = (bf16*)(p.ws + (which ? WS_VTW : WS_VTS)) + ((size_t)(bg * 32 + j) * 64 + d) * 64 + 8 * pc;
            *(u32x4*)vt = o;
        }
        __syncthreads();
    }
}

DI float gelu_tanh(float x) { const float u = 0.7978845608028654f * (x + 0.044715f * x * x * x); const float t = 1.f - 2.f * __builtin_amdgcn_rcpf(__expf(2.f * u) + 1.f); return 0.5f * x * (1.f + t); }
DI void phase3b(const Params& p, LAS unsigned char* lds) {
    const int tid = threadIdx.x, lane = tid & 63, wave = __builtin_amdgcn_readfirstlane(tid >> 6), l31 = lane & 31, hh = lane >> 5;
    const bf16* cas = (const bf16*)(p.ws + WS_CAS);
    LAS bf16* h1 = (LAS bf16*)lds;
    LAS float* o2 = (LAS float*)(lds + 32 * 264 * 2);
    LAS unsigned char* xs = lds + 32768;
    float kgain[8];
#pragma unroll
    for (int i = 0; i < 8; ++i) kgain[i] = p.k_norm_gain[(tid & 7) * 8 + i];
    for (int it = blockIdx.x; it < 256; it += gridDim.x) {
        const int which = it >> 7, bg = (it >> 2) & 31, rq = it & 3, b = bg >> 1, g = bg & 1;
        {
            const bf16* xsrc = cas + (size_t)(b * SEQ) * LD_CAS + (which ? VC0 : KC0) + g * 64;
            u32x4 stg[9];
#pragma unroll
            for (int k = 0; k < 9; ++k) { const int i = min(tid + 512 * k, 528 * 8 - 1); const int tr = i >> 3, ch = i & 7; int tok = 512 * rq + tr; tok = tok < SEQ ? tok : SEQ - 1;
                stg[k] = *(const u32x4*)(xsrc + (size_t)tok * LD_CAS + 8 * ch); }
#pragma unroll
            for (int k = 0; k < 9; ++k) asm volatile("" : "+v"(stg[k]));
#pragma unroll
            for (int k = 0; k < 9; ++k) { const int i = tid + 512 * k; const int tr = i >> 3, ch = i & 7;
                if (i < 528 * 8) *(LAS u32x4*)(xs + tr * 128 + ((ch ^ ((tr >> 4) & 7)) << 4)) = stg[k]; }
        }
        __syncthreads();
        const bf16* brow = (const bf16*)(p.ws + (which ? WS_W1V_T : WS_W1K_T)) + (size_t)(32 * wave + l31) * 2048 + 8 * hh;
        f32x16 acc = {};
        u32x4 wb0[16], wb1[16];
#pragma unroll
        for (int s = 0; s < 16; ++s) wb0[s] = *(const u32x4*)(brow + 16 * s);
#define W1_BATCH(CUR, NXT, BT) do { \
            _Pragma("unroll") for (int s = 0; s < 16; ++s) NXT[s] = *(const u32x4*)(brow + 16 * (16 * ((BT) < 7 ? (BT) + 1 : 7) + s)); \
            _Pragma("unroll") for (int s = 0; s < 16; ++s) asm volatile("" : "+v"(CUR[s])); \
            _Pragma("unroll") for (int s = 0; s < 16; ++s) { const int kk = 16 * (16 * (BT) + s), tr = 16 * l31 + (kk >> 6), ch = ((kk & 63) >> 3) + hh; \
                const bf16x8 a = *(const LAS bf16x8*)(xs + tr * 128 + ((ch ^ ((tr >> 4) & 7)) << 4)); \
                acc = __builtin_amdgcn_mfma_f32_32x32x16_bf16(a, __builtin_bit_cast(bf16x8, CUR[s]), acc, 0, 0, 0); } } while (0)
        for (int bt = 0; bt < 8; bt += 2) { W1_BATCH(wb0, wb1, bt); W1_BATCH(wb1, wb0, bt + 1); }
#undef W1_BATCH
        const float pb = ((const float*)(p.ws + WS_POSB))[which * 256 + 32 * wave + l31];
        __syncthreads();
#pragma unroll
        for (int r = 0; r < 16; ++r) h1[crow(r, hh) * 264 + 32 * wave + l31] = (bf16)f2bf(gelu_tanh(acc[r] + pb));
        __syncthreads();
        if (wave < 2) {
            const bf16* b2 = (const bf16*)(p.ws + (which ? WS_W2V_T : WS_W2K_T)) + (size_t)(32 * wave + l31) * 256 + 8 * hh;
            f32x16 a2 = {};
            u32x4 w2[16];
#pragma unroll
            for (int s = 0; s < 16; ++s) w2[s] = *(const u32x4*)(b2 + 16 * s);
#pragma unroll
            for (int s = 0; s < 16; ++s) asm volatile("" : "+v"(w2[s]));
#pragma unroll
            for (int s = 0; s < 16; ++s) {
                const bf16x8 a = *(const LAS bf16x8*)(h1 + l31 * 264 + 16 * s + 8 * hh);
                a2 = __builtin_amdgcn_mfma_f32_32x32x16_bf16(a, __builtin_bit_cast(bf16x8, w2[s]), a2, 0, 0, 0);
            }
#pragma unroll
            for (int r = 0; r < 16; ++r) o2[crow(r, hh) * 65 + 32 * wave + l31] = a2[r];
        }
        __syncthreads();
        if (tid < 256) {
            const int nl = tid >> 3, e8 = (tid & 7) * 8, nn = 32 * rq + nl;
            float v[8]; float ss = 0.f;
#pragma unroll
            for (int i = 0; i < 8; ++i) { v[i] = o2[nl * 65 + e8 + i]; ss += v[i] * v[i]; }
            if (which == 0) {
#pragma unroll
                for (int o = 1; o < 8; o <<= 1) ss += __shfl_xor(ss, o);
                const float rinv = rsqrtf(ss * (1.f / 64.f) + 1e-6f);
#pragma unroll
                for (int i = 0; i < 8; ++i) v[i] = (nn < 127) ? v[i] * rinv * kgain[i] : 0.f;
                u32x4 o; o.x = pk2(v[0], v[1]); o.y = pk2(v[2], v[3]); o.z = pk2(v[4], v[5]); o.w = pk2(v[6], v[7]);
                *(u32x4*)((bf16*)(p.ws + WS_KC) + (size_t)(bg * 128 + nn) * 64 + e8) = o;
            } else {
                const int pos = (nn & ~15) | pos16_of_key(nn & 15);
                bf16* vct = (bf16*)(p.ws + WS_VCT) + (size_t)bg * 64 * 128 + pos;
#pragma unroll
                for (int i = 0; i < 8; ++i) vct[(size_t)(e8 + i) * 128] = (bf16)f2bf((nn < 127) ? v[i] : 0.f);
            }
        }
        __syncthreads();
    }
}

constexpr int SLOTB = 8192;
DI int sw_el(int row, int col) { return row * 64 + ((((col >> 3) ^ (row & 7)) << 3) | (col & 7)); }
DI int swf_el(int row, int col) { return row * 64 + ((((col >> 2) ^ (row & 15)) << 2) | (col & 3)); }
DI bf16x8 frag_row(const LAS bf16* Mx, int row, int kc) { return *(const LAS bf16x8*)(Mx + sw_el(row, kc)); }
DI bf16x8 frag_col(const LAS bf16* Mx, int k0, int colbase, int lane) {
    const int i16 = lane & 15, q = i16 >> 2, pp = i16 & 3, blk = (lane >> 4) & 1, col = colbase + 16 * blk + 4 * pp;
    const s16x4 lo = tr_read(Mx + sw_el(k0 + q, col)), hi = tr_read(Mx + sw_el(k0 + 4 + q, col));
    return __builtin_shufflevector(lo, hi, 0, 1, 2, 3, 4, 5, 6, 7);
}
template <bool TA, bool TB> DI void mm_acc(f32x16& acc, const LAS bf16* A, const LAS bf16* Bm, int ti, int tj, int lane) {
    const int l31 = lane & 31, hh = lane >> 5;
#pragma unroll
    for (int s = 0; s < 4; ++s) {
        const int k0 = 16 * s + 8 * hh;
        bf16x8 x, y;
        if (TB) x = frag_row(Bm, 32 * tj + l31, k0); else x = frag_col(Bm, k0, 32 * tj, lane);
        if (TA) y = frag_col(A, k0, 32 * ti, lane); else y = frag_row(A, 32 * ti + l31, k0);
        acc = __builtin_amdgcn_mfma_f32_32x32x16_bf16(x, y, acc, 0, 0, 0);
    }
}
DI void ld_tile(f32x16& acc, const LAS bf16* Mx, int ti, int tj, int l31, int hh) {
#pragma unroll
    for (int g = 0; g < 4; ++g) { const u32x2 w = *(const LAS u32x2*)(Mx + sw_el(32 * ti + l31, 32 * tj + 8 * g + 4 * hh));
        acc[4 * g] = bflo(w.x); acc[4 * g + 1] = bfhi(w.x); acc[4 * g + 2] = bflo(w.y); acc[4 * g + 3] = bfhi(w.y); }
}
DI void st_tile(LAS bf16* Mx, const f32x16& acc, int ti, int tj, int l31, int hh) {
#pragma unroll
    for (int g = 0; g < 4; ++g) { u32x2 w; w.x = pk2(acc[4 * g], acc[4 * g + 1]); w.y = pk2(acc[4 * g + 2], acc[4 * g + 3]);
        *(LAS u32x2*)(Mx + sw_el(32 * ti + l31, 32 * tj + 8 * g + 4 * hh)) = w; }
}
DI void st_native_global(bf16* Tm, const f32x16& acc, int tile, int lane) {
    u32x4 a, b;
    a.x = pk2(acc[0], acc[1]); a.y = pk2(acc[2], acc[3]); a.z = pk2(acc[4], acc[5]); a.w = pk2(acc[6], acc[7]);
    b.x = pk2(acc[8], acc[9]); b.y = pk2(acc[10], acc[11]); b.z = pk2(acc[12], acc[13]); b.w = pk2(acc[14], acc[15]);
    u32x4* d = (u32x4*)(Tm + (size_t)tile * 1024 + lane * 8); d[0] = a; d[64] = b;
}
DI void ld_native_global(f32x16& acc, const bf16* Tm, int tile, int lane) {
    const u32x4* d = (const u32x4*)(Tm + (size_t)tile * 1024 + lane * 8); const u32x4 a = d[0], b = d[64];
    acc[0] = bflo(a.x); acc[1] = bfhi(a.x); acc[2] = bflo(a.y); acc[3] = bfhi(a.y); acc[4] = bflo(a.z); acc[5] = bfhi(a.z); acc[6] = bflo(a.w); acc[7] = bfhi(a.w);
    acc[8] = bflo(b.x); acc[9] = bfhi(b.x); acc[10] = bflo(b.y); acc[11] = bfhi(b.y); acc[12] = bflo(b.z); acc[13] = bfhi(b.z); acc[14] = bflo(b.w); acc[15] = bfhi(b.w);
}
DI bf16x8 pack8(const f32x16& x, int s) {
    u32x4 w; w.x = pk2(x[8 * s], x[8 * s + 1]); w.y = pk2(x[8 * s + 2], x[8 * s + 3]); w.z = pk2(x[8 * s + 4], x[8 * s + 5]); w.w = pk2(x[8 * s + 6], x[8 * s + 7]);
    return __builtin_bit_cast(bf16x8, w);
}
DI bf16x8 frag_col_perm(const LAS bf16* Mx, int kb16, int colbase, int lane) {
    const int i16 = lane & 15, q = i16 >> 2, pp = i16 & 3, blk = (lane >> 4) & 1, hh = lane >> 5, col = colbase + 16 * blk + 4 * pp;
    const s16x4 lo = tr_read(Mx + sw_el(kb16 + 4 * hh + q, col)), hi = tr_read(Mx + sw_el(kb16 + 8 + 4 * hh + q, col));
    return __builtin_shufflevector(lo, hi, 0, 1, 2, 3, 4, 5, 6, 7);
}
DI void mm32_acc(f32x16& C, const f32x16& A, const LAS bf16* Bm, int kb, int colbase, int lane) {
    const bf16x8 a0 = pack8(A, 0), a1 = pack8(A, 1);
    C = __builtin_amdgcn_mfma_f32_32x32x16_bf16(frag_col_perm(Bm, kb, colbase, lane), a0, C, 0, 0, 0);
    C = __builtin_amdgcn_mfma_f32_32x32x16_bf16(frag_col_perm(Bm, kb + 16, colbase, lane), a1, C, 0, 0, 0);
}
DI u32x4 pack8f(const float* v) { u32x4 o; o.x = pk2(v[0], v[1]); o.y = pk2(v[2], v[3]); o.z = pk2(v[4], v[5]); o.w = pk2(v[6], v[7]); return o; }

DI void phase3c(const Params& p, LAS unsigned char* lds) {
    const int tid0 = threadIdx.x, wave = __builtin_amdgcn_readfirstlane(tid0 >> 6);
    const int half = wave >> 2, lw = wave & 3, ti = (lw >> 1) & 1, tj = lw & 1;
    const bf16* cas = (const bf16*)(p.ws + WS_CAS);
    LAS unsigned char* hb = lds + half * 65536;
#define SL(i) ((LAS bf16*)(hb + (i) * SLOTB))
    LAS float* F1 = (LAS float*)(hb);
    LAS float* F2 = (LAS float*)(hb + 2 * SLOTB);
    LAS float* gam = (LAS float*)(lds + 131072) + half * 64;
    LAS float* tot = (LAS float*)(lds + 131072 + 512) + half * 256;
    LAS float* parL = (LAS float*)(lds + 131072 + 512 + 2048) + half * 640;
    int par_h = -1;
#define LDS_BAR() asm volatile("s_waitcnt lgkmcnt(0)\n\ts_barrier" ::: "memory")
    u32x4 nwd[2], nad[2], npw[2], npa[2];
#define E1_FETCH(PR) do { const int it_ = 2 * (PR) + half; const int c_ = it_ & 31; const size_t me_ = (size_t)(it_ >> 8) * SEQ + 64 * c_ + ((tid0 & 255) >> 2); \
        const bool hp_ = (64 * c_ + ((tid0 & 255) >> 2)) > 0; const int j16_ = (tid0 & 3) * 16; \
        _Pragma("unroll") for (int sp = 0; sp < 2; ++sp) { \
            nwd[sp] = *(const u32x4*)(cas + me_ * LD_CAS + WD0 + j16_ + 8 * sp); nad[sp] = *(const u32x4*)(cas + me_ * LD_CAS + AD0 + j16_ + 8 * sp); \
            npw[sp] = *(const u32x4*)(cas + (me_ - (hp_ ? 1 : 0)) * LD_CAS + WD0 + j16_ + 8 * sp); npa[sp] = *(const u32x4*)(cas + (me_ - (hp_ ? 1 : 0)) * LD_CAS + AD0 + j16_ + 8 * sp); } } while (0)
    unsigned pf0 = 0u, pf1 = 0u;
    if ((int)blockIdx.x < 2048) E1_FETCH((int)blockIdx.x);
#pragma unroll
    for (int k = 0; k < 8; ++k) *(u32x4*)(p.ws + WS_DUMMY + (size_t)k * 8192 + tid0 * 16) = (u32x4){0u, 0u, 0u, 0u};
    for (int pr = blockIdx.x; pr < 2048; pr += gridDim.x) {
        int tid = tid0; asm volatile("" : "+v"(tid));
        const int lane = tid & 63, l31 = lane & 31, hh = lane >> 5, ltid = tid & 255;
        const int item = 2 * pr + half;
        const int c = item & 31, h = (item >> 5) & 7, b = item >> 8;
        const size_t m0 = (size_t)b * SEQ + 64 * c;
        const int te = ltid >> 2, c16 = (ltid & 3) * 16; const size_t me = m0 + te; const bool hpv = (64 * c + te) > 0;
        if (h != par_h) {
            par_h = h;
            for (int i = ltid; i < 640; i += 256) { const int rw = i >> 6, cc = i & 63; float v;
                if (rw == 0) v = p.w0[h * 64 + cc]; else if (rw == 1) v = p.a0[h * 64 + cc]; else if (rw == 2) v = p.k_k[h * 64 + cc]; else if (rw == 3) v = p.k_a[h * 64 + cc];
                else if (rw == 4) v = p.r_k[h * 64 + cc]; else if (rw < 8) v = p.shift_mu[(rw - 5) * 512 + h * 64 + cc]; else v = p.shift_mu[1536 + (rw - 8) * 64 + cc];
                parL[i] = v; }
            LDS_BAR();
        }
        u32x4 gk[2], gr[2], gv[2], gkp[2], grp[2], gvp[2];
#pragma unroll
        for (int sp = 0; sp < 2; ++sp) { const int hc8 = h * 64 + c16 + 8 * sp;
            gk[sp] = *(const u32x4*)(cas + me * LD_CAS + K0 + hc8); gr[sp] = *(const u32x4*)(cas + me * LD_CAS + R0 + hc8); gv[sp] = *(const u32x4*)(cas + me * LD_CAS + V0 + hc8);
            const size_t mp = me - (hpv ? 1 : 0);
            gkp[sp] = *(const u32x4*)(cas + mp * LD_CAS + K0 + hc8); grp[sp] = *(const u32x4*)(cas + mp * LD_CAS + R0 + hc8); gvp[sp] = *(const u32x4*)(cas + mp * LD_CAS + V0 + hc8); }
        bf16x8 wfr[2][4];
#pragma unroll
        for (int pd = 0; pd < 2; ++pd) { const bf16* wt = (const bf16*)(p.ws + (pd ? WS_WLA_T : WS_WLW_T)) + (size_t)(h * 64 + 32 * tj + l31) * 64;
#pragma unroll
            for (int s = 0; s < 4; ++s) wfr[pd][s] = *(const bf16x8*)(wt + 16 * s + 8 * hh); }
#pragma unroll
        for (int sp = 0; sp < 2; ++sp) {
            const int j8 = c16 + 8 * sp;
            float wd[8], ad[8], pw[8], pa[8];
            asm volatile("" : "+v"(npw[sp]), "+v"(npa[sp]));
            unpack8(nwd[sp], wd); unpack8(nad[sp], ad); unpack8(hpv ? npw[sp] : (u32x4){0u, 0u, 0u, 0u}, pw); unpack8(hpv ? npa[sp] : (u32x4){0u, 0u, 0u, 0u}, pa);
#pragma unroll
            for (int i = 0; i < 8; ++i) { const float x = wd[i] + (pw[i] - wd[i]) * parL[512 + j8 + i]; const float e2 = __expf(2.f * x); wd[i] = 1.f - 2.f * __builtin_amdgcn_rcpf(e2 + 1.f);
                ad[i] = ad[i] + (pa[i] - ad[i]) * parL[576 + j8 + i]; }
            *(LAS u32x4*)(SL(6) + sw_el(te, j8)) = pack8f(wd);
            *(LAS u32x4*)(SL(7) + sw_el(te, j8)) = pack8f(ad);
        }
        E1_FETCH(min(pr + (int)gridDim.x, 2047));
        LDS_BAR();
#pragma unroll
        for (int pd = 0; pd < 2; ++pd) {
            const LAS bf16* Am = pd ? SL(7) : SL(6);
            f32x16 acc = {};
#pragma unroll
            for (int s = 0; s < 4; ++s) { const int k0 = 16 * s + 8 * hh;
                const bf16x8 y = frag_row(Am, 32 * ti + l31, k0);
                acc = __builtin_amdgcn_mfma_f32_32x32x16_bf16(wfr[pd][s], y, acc, 0, 0, 0); }
            LAS float* F = pd ? F2 : F1;
#pragma unroll
            for (int g = 0; g < 4; ++g) *(LAS f32x4*)(F + swf_el(32 * ti + l31, 32 * tj + 8 * g + 4 * hh)) = (f32x4){acc[4 * g], acc[4 * g + 1], acc[4 * g + 2], acc[4 * g + 3]};
        }
        LDS_BAR();
        asm volatile("" :: "v"(pf0), "v"(pf1));
        float lw16[16], av16[16], bv16[16], km16[16], rs16[16];
        {
            float kraw[16], icl[16]; float ss = 0.f, bon = 0.f;
#pragma unroll
            for (int sp = 0; sp < 2; ++sp) {
                const int c8 = c16 + 8 * sp, hc8 = h * 64 + c8;
                float kc_[8], kp_[8], rc_[8], rp_[8], vc_[8], vp_[8];
                asm volatile("" : "+v"(gkp[sp]), "+v"(grp[sp]), "+v"(gvp[sp]));
                const u32x4 z4 = {0u, 0u, 0u, 0u};
                unpack8(gk[sp], kc_); unpack8(gr[sp], rc_); unpack8(gv[sp], vc_); unpack8(hpv ? gkp[sp] : z4, kp_); unpack8(hpv ? grp[sp] : z4, rp_); unpack8(hpv ? gvp[sp] : z4, vp_);
                const f32x4 z0 = *(const LAS f32x4*)(F1 + swf_el(te, c8)), z1 = *(const LAS f32x4*)(F1 + swf_el(te, c8 + 4));
                const f32x4 a0_ = *(const LAS f32x4*)(F2 + swf_el(te, c8)), a1_ = *(const LAS f32x4*)(F2 + swf_el(te, c8 + 4));
                const float zz[8] = {z0[0], z0[1], z0[2], z0[3], z1[0], z1[1], z1[2], z1[3]}, ap[8] = {a0_[0], a0_[1], a0_[2], a0_[3], a1_[0], a1_[1], a1_[2], a1_[3]};
                float vs[8];
#pragma unroll
                for (int i = 0; i < 8; ++i) {
                    const int e = 8 * sp + i;
                    const int pc = c8 + i;
                    const float ks = kc_[i] + (kp_[i] - kc_[i]) * parL[384 + pc];
                    rs16[e] = rc_[i] + (rp_[i] - rc_[i]) * parL[320 + pc];
                    vs[i] = vc_[i] + (vp_[i] - vc_[i]) * parL[448 + pc];
                    const float nz = -(parL[pc] + zz[i]), spv = nz > 20.f ? nz : __logf(1.f + __expf(nz));
                    lw16[e] = -__expf(-spv - 0.5f);
                    icl[e] = sigmoidf_(parL[64 + pc] + ap[i]);
                    kraw[e] = ks * parL[128 + pc]; ss += kraw[e] * kraw[e];
                    km16[e] = ks * (1.f + (icl[e] - 1.f) * parL[192 + pc]);
                    bon += rs16[e] * km16[e] * parL[256 + pc];
                }
                *(LAS u32x4*)(SL(7) + sw_el(te, c8)) = pack8f(vs);
            }
            ss += __shfl_xor(ss, 1); ss += __shfl_xor(ss, 2); bon += __shfl_xor(bon, 1); bon += __shfl_xor(bon, 2);
            const float rn = rsqrtf(fmaxf(ss, 1e-24f));
#pragma unroll
            for (int e = 0; e < 16; ++e) { const float kk = kraw[e] * rn; av16[e] = -kk; bv16[e] = kk * icl[e]; }
#pragma unroll
            for (int q4 = 0; q4 < 4; ++q4) *(LAS f32x4*)(F1 + swf_el(te, c16 + 4 * q4)) = (f32x4){lw16[4 * q4], lw16[4 * q4 + 1], lw16[4 * q4 + 2], lw16[4 * q4 + 3]};
            if ((ltid & 3) == 0) ((float*)(p.ws + WS_BONUS))[me * 8 + h] = bon;
        }
        LDS_BAR();
        {
            const int cc = ltid & 63, tq = ltid >> 6;
            float L[16]; L[0] = F1[swf_el(16 * tq, cc)];
#pragma unroll
            for (int i = 1; i < 16; ++i) L[i] = L[i - 1] + F1[swf_el(16 * tq + i, cc)];
            tot[tq * 64 + cc] = L[15];
            LDS_BAR();
            float off = 0.f;
            for (int q = 0; q < tq; ++q) off += tot[q * 64 + cc];
#pragma unroll
            for (int i = 0; i < 16; ++i) F1[swf_el(16 * tq + i, cc)] = off + L[i];
            if (tq == 3) gam[cc] = __expf(off + L[15]);
        }
        LDS_BAR();
        {
            float Lt[16];
#pragma unroll
            for (int q4 = 0; q4 < 4; ++q4) { const f32x4 a = *(const LAS f32x4*)(F1 + swf_el(te, c16 + 4 * q4)); Lt[4 * q4] = a[0]; Lt[4 * q4 + 1] = a[1]; Lt[4 * q4 + 2] = a[2]; Lt[4 * q4 + 3] = a[3]; }
#pragma unroll
            for (int sp = 0; sp < 2; ++sp) {
                float oa[8], ob[8], ok[8], orr[8];
#pragma unroll
                for (int i = 0; i < 8; ++i) { const int e = 8 * sp + i; const float ep = __expf(Lt[e]), en = __builtin_amdgcn_rcpf(ep), e3 = __expf(Lt[e] - lw16[e]);
                    oa[i] = av16[e] * e3; ob[i] = bv16[e] * en; ok[i] = km16[e] * en; orr[i] = rs16[e] * ep; }
                *(LAS u32x4*)(SL(4) + sw_el(te, c16 + 8 * sp)) = pack8f(oa);
                *(LAS u32x4*)(SL(5) + sw_el(te, c16 + 8 * sp)) = pack8f(ob);
                *(LAS u32x4*)(SL(6) + sw_el(te, c16 + 8 * sp)) = pack8f(ok);
                *(LAS u32x4*)(SL(3) + sw_el(te, c16 + 8 * sp)) = pack8f(orr);
            }
        }
        LDS_BAR();
        { const int itn = 2 * min(pr + (int)gridDim.x, 2047) + half; const int w3 = ltid & 3;
          const bf16* rowp = cas + ((size_t)(itn >> 8) * SEQ + 64 * (itn & 31) + te) * LD_CAS + (w3 == 1 ? R0 : w3 == 2 ? V0 : K0) + ((itn >> 5) & 7) * 64;
          pf0 = *(const unsigned*)rowp; pf1 = *(const unsigned*)(rowp + 56); }
        u32x2 rtw[4]; f32x16 y2p, dp;
        {
            const int row = 32 * ti + l31;
            bf16x8 aA[4], aR[4], bB[4], bK0[4], bK1[4];
#pragma unroll
            for (int s = 0; s < 4; ++s) { const int k0 = 16 * s + 8 * hh;
                aA[s] = frag_row(SL(4), row, k0); aR[s] = frag_row(SL(3), row, k0); bB[s] = frag_row(SL(5), 32 * tj + l31, k0);
                bK0[s] = frag_row(SL(6), l31, k0); bK1[s] = frag_row(SL(6), 32 + l31, k0); }
            f32x16 acc = {};
#pragma unroll
            for (int s = 0; s < 4; ++s) acc = __builtin_amdgcn_mfma_f32_32x32x16_bf16(bB[s], aA[s], acc, 0, 0, 0);
#pragma unroll
            for (int r = 0; r < 16; ++r) acc[r] = (32 * tj + crow(r, hh) < row) ? acc[r] : 0.f;
            st_tile(SL(0), acc, ti, tj, l31, hh);
            acc = (f32x16){};
#pragma unroll
            for (int s = 0; s < 4; ++s) acc = __builtin_amdgcn_mfma_f32_32x32x16_bf16(tj ? bK1[s] : bK0[s], aA[s], acc, 0, 0, 0);
#pragma unroll
            for (int r = 0; r < 16; ++r) acc[r] = (32 * tj + crow(r, hh) < row) ? acc[r] : 0.f;
            st_tile(SL(2), acc, ti, tj, l31, hh);
            acc = (f32x16){};
#pragma unroll
            for (int s = 0; s < 4; ++s) acc = __builtin_amdgcn_mfma_f32_32x32x16_bf16(bB[s], aR[s], acc, 0, 0, 0);
#pragma unroll
            for (int r = 0; r < 16; ++r) acc[r] = (32 * tj + crow(r, hh) <= row) ? acc[r] : 0.f;
            st_tile(SL(1), acc, ti, tj, l31, hh);
            f32x16 ak0 = {}, ak1 = {};
#pragma unroll
            for (int s = 0; s < 4; ++s) ak0 = __builtin_amdgcn_mfma_f32_32x32x16_bf16(bK0[s], aR[s], ak0, 0, 0, 0);
#pragma unroll
            for (int r = 0; r < 16; ++r) ak0[r] = (crow(r, hh) <= row) ? ak0[r] : 0.f;
            y2p = (f32x16){};
            mm32_acc(y2p, ak0, SL(7), 0, 32 * tj, lane);
            if (ti) {
#pragma unroll
                for (int s = 0; s < 4; ++s) ak1 = __builtin_amdgcn_mfma_f32_32x32x16_bf16(bK1[s], aR[s], ak1, 0, 0, 0);
#pragma unroll
                for (int r = 0; r < 16; ++r) ak1[r] = (32 + crow(r, hh) <= row) ? ak1[r] : 0.f;
                mm32_acc(y2p, ak1, SL(7), 32, 32 * tj, lane);
            }
            dp = (f32x16){};
            mm_acc<true, false>(dp, SL(7), SL(6), ti, tj, lane);
#pragma unroll
            for (int g = 0; g < 4; ++g) rtw[g] = *(const LAS u32x2*)(SL(3) + sw_el(row, 32 * tj + 8 * g + 4 * hh));
        }
        LDS_BAR();
        if (lw == 0) {
            f32x16 Q0, Q1, T0, T1;
            ld_tile(Q0, SL(0), 0, 0, l31, hh); ld_tile(Q1, SL(0), 1, 1, l31, hh);
#pragma unroll
            for (int r = 0; r < 16; ++r) { const float idn = (crow(r, hh) == l31) ? 1.f : 0.f; T0[r] = Q0[r] + idn; T1[r] = Q1[r] + idn; }
            { f32x16 S0 = {}, S1 = {}; mm32_acc(S0, Q0, SL(0), 0, 0, lane); mm32_acc(S1, Q1, SL(0), 32, 32, lane); Q0 = S0; Q1 = S1; }
#pragma unroll
            for (int k = 1; k <= 4; ++k) {
                st_tile(SL(3), Q0, 0, 0, l31, hh); st_tile(SL(3), Q1, 1, 1, l31, hh);
                const bf16x8 b00 = frag_col_perm(SL(3), 0, 0, lane), b01 = frag_col_perm(SL(3), 16, 0, lane);
                const bf16x8 b10 = frag_col_perm(SL(3), 32, 32, lane), b11 = frag_col_perm(SL(3), 48, 32, lane);
                const bf16x8 t00 = pack8(T0, 0), t01 = pack8(T0, 1), t10 = pack8(T1, 0), t11 = pack8(T1, 1);
                T0 = __builtin_amdgcn_mfma_f32_32x32x16_bf16(b00, t00, T0, 0, 0, 0); T1 = __builtin_amdgcn_mfma_f32_32x32x16_bf16(b10, t10, T1, 0, 0, 0);
                T0 = __builtin_amdgcn_mfma_f32_32x32x16_bf16(b01, t01, T0, 0, 0, 0); T1 = __builtin_amdgcn_mfma_f32_32x32x16_bf16(b11, t11, T1, 0, 0, 0);
                if (k < 4) {
                    const bf16x8 q00 = pack8(Q0, 0), q01 = pack8(Q0, 1), q10 = pack8(Q1, 0), q11 = pack8(Q1, 1);
                    f32x16 S0 = {}, S1 = {};
                    S0 = __builtin_amdgcn_mfma_f32_32x32x16_bf16(b00, q00, S0, 0, 0, 0); S1 = __builtin_amdgcn_mfma_f32_32x32x16_bf16(b10, q10, S1, 0, 0, 0);
                    S0 = __builtin_amdgcn_mfma_f32_32x32x16_bf16(b01, q01, S0, 0, 0, 0); S1 = __builtin_amdgcn_mfma_f32_32x32x16_bf16(b11, q11, S1, 0, 0, 0);
                    Q0 = S0; Q1 = S1;
                }
            }
            st_tile(SL(3), T0, 0, 0, l31, hh); st_tile(SL(3), T1, 1, 1, l31, hh);
            { const f32x16 z = {}; st_tile(SL(3), z, 0, 1, l31, hh); }
            f32x16 Mx = {};
#pragma unroll
            for (int s = 0; s < 2; ++s) { const int k0 = 16 * s + 8 * hh;
                Mx = __builtin_amdgcn_mfma_f32_32x32x16_bf16(frag_col(SL(3), k0, 0, lane), frag_row(SL(0), 32 + l31, k0), Mx, 0, 0, 0); }
            st_tile(SL(3), Mx, 1, 0, l31, hh);
            f32x16 T21 = {};
            mm32_acc(T21, T1, SL(3), 32, 0, lane);
            st_tile(SL(3), T21, 1, 0, l31, hh);
        } else if (lw == 3) {
            f32x16 x0 = {}, x1 = {};
#pragma unroll
            for (int s = 0; s < 2; ++s) { const int k0 = 16 * s + 8 * hh; const bf16x8 a = frag_row(SL(2), l31, k0);
                x0 = __builtin_amdgcn_mfma_f32_32x32x16_bf16(frag_col(SL(7), k0, 0, lane), a, x0, 0, 0, 0);
                x1 = __builtin_amdgcn_mfma_f32_32x32x16_bf16(frag_col(SL(7), k0, 32, lane), a, x1, 0, 0, 0); }
            st_tile(SL(6), x0, 0, 0, l31, hh); st_tile(SL(6), x1, 0, 1, l31, hh);
        } else {
            f32x16 x = {}; mm_acc<false, false>(x, SL(2), SL(7), 1, lw - 1, lane); st_tile(SL(6), x, 1, lw - 1, l31, hh);
        }
        LDS_BAR();
        { f32x16 acc = {}; mm_acc<false, false>(acc, SL(3), SL(4), ti, tj, lane); st_tile(SL(0), acc, ti, tj, l31, hh);
          f32x16 a2 = {}; mm_acc<false, false>(a2, SL(3), SL(6), ti, tj, lane); st_tile(SL(2), a2, ti, tj, l31, hh); }
        LDS_BAR();
        {
            unsigned char* ob = (unsigned char*)p.out;
            { f32x16 acc;
#pragma unroll
              for (int g = 0; g < 4; ++g) { acc[4 * g] = bflo(rtw[g].x); acc[4 * g + 1] = bfhi(rtw[g].x); acc[4 * g + 2] = bflo(rtw[g].y); acc[4 * g + 3] = bfhi(rtw[g].y); }
              mm_acc<false, false>(acc, SL(1), SL(0), ti, tj, lane);
              st_native_global((bf16*)(ob + OUT_Y1) + (size_t)item * 4096, acc, ti * 2 + tj, lane); }
            { f32x16 g2 = {};
              mm_acc<true, false>(g2, SL(5), SL(0), ti, tj, lane);
              const float gm = gam[32 * ti + l31];
#pragma unroll
              for (int r = 0; r < 16; ++r) g2[r] = (g2[r] + ((32 * tj + crow(r, hh) == 32 * ti + l31) ? 1.f : 0.f)) * gm;
              st_native_global((bf16*)(ob + OUT_G) + (size_t)item * 4096, g2, ti * 2 + tj, lane); }
            { mm_acc<false, false>(y2p, SL(1), SL(2), ti, tj, lane);
              st_native_global((bf16*)(ob + OUT_Y2) + (size_t)item * 4096, y2p, tj * 2 + ti, lane); }
            { mm_acc<true, false>(dp, SL(2), SL(5), ti, tj, lane);
#pragma unroll
              for (int r = 0; r < 16; ++r) dp[r] *= gam[32 * tj + crow(r, hh)];
              st_native_global((bf16*)(ob + OUT_D) + (size_t)item * 4096, dp, tj * 2 + ti, lane); }
        }
    }
#undef SL
#undef LDS_BAR
#undef E1_FETCH
}

DI void phase5a(const Params& p) {
    const int tid = threadIdx.x, lane = tid & 63, wave = tid >> 6, l31 = lane & 31, hh = lane >> 5;
    if (blockIdx.x >= 16) return;
    const unsigned char* ob = (const unsigned char*)p.out;
    {
        const int chain = blockIdx.x * 8 + wave;
        f32x16 H[2][2];
#pragma unroll
        for (int a = 0; a < 2; ++a)
#pragma unroll
            for (int c2 = 0; c2 < 2; ++c2) H[a][c2] = (f32x16){};
        bf16x8 gf[2][2][2];
        { const bf16* Gp = (const bf16*)(ob + OUT_G) + (size_t)chain * 32 * 4096;
#pragma unroll
          for (int ti = 0; ti < 2; ++ti)
#pragma unroll
              for (int tk = 0; tk < 2; ++tk)
#pragma unroll
                  for (int s = 0; s < 2; ++s) gf[ti][tk][s] = *(const bf16x8*)(Gp + (ti * 2 + tk) * 1024 + 512 * s + lane * 8); }
        for (int c = 0; c < 32; ++c) {
            const size_t item = (size_t)chain * 32 + c;
            const bf16* Dn = (const bf16*)(ob + OUT_D) + item * 4096;
            bf16x8 gn[2][2][2];
            { const bf16* Gp = (const bf16*)(ob + OUT_G) + (item + (c < 31 ? 1 : 0)) * 4096;
#pragma unroll
              for (int ti = 0; ti < 2; ++ti)
#pragma unroll
                  for (int tk = 0; tk < 2; ++tk)
#pragma unroll
                      for (int s = 0; s < 2; ++s) gn[ti][tk][s] = *(const bf16x8*)(Gp + (ti * 2 + tk) * 1024 + 512 * s + lane * 8); }
            f32x16 Dv[2][2];
#pragma unroll
            for (int ti = 0; ti < 2; ++ti)
#pragma unroll
                for (int tj = 0; tj < 2; ++tj) ld_native_global(Dv[ti][tj], Dn, ti * 2 + tj, lane);
            bf16x8 hp[2][2][2];
            u32x4* hs = (u32x4*)((bf16*)(p.ws + WS_HS) + item * 4096);
#pragma unroll
            for (int tk = 0; tk < 2; ++tk)
#pragma unroll
                for (int tj = 0; tj < 2; ++tj)
#pragma unroll
                    for (int s = 0; s < 2; ++s) { hp[tk][tj][s] = pack8(H[tk][tj], s); hs[((tk * 2 + tj) * 2 + s) * 64 + lane] = __builtin_bit_cast(u32x4, hp[tk][tj][s]); }
#pragma unroll
            for (int ti = 0; ti < 2; ++ti)
#pragma unroll
                for (int tj = 0; tj < 2; ++tj) {
                    f32x16 acc = Dv[ti][tj];
#pragma unroll
                    for (int tk = 0; tk < 2; ++tk)
#pragma unroll
                        for (int s = 0; s < 2; ++s) acc = __builtin_amdgcn_mfma_f32_32x32x16_bf16(gf[ti][tk][s], hp[tk][tj][s], acc, 0, 0, 0);
                    H[ti][tj] = acc;
                }
#pragma unroll
            for (int ti = 0; ti < 2; ++ti)
#pragma unroll
                for (int tk = 0; tk < 2; ++tk)
#pragma unroll
                    for (int s = 0; s < 2; ++s) gf[ti][tk][s] = gn[ti][tk][s];
        }
    }
    asm volatile("s_waitcnt vmcnt(0)" ::: "memory");
    __syncthreads();
    if (tid == 0) { __builtin_amdgcn_fence(__ATOMIC_RELEASE, "agent"); asm volatile("s_waitcnt vmcnt(0)" ::: "memory");
        __hip_atomic_fetch_add((unsigned*)(p.ws + WS_CTL) + 12288, 1u, __ATOMIC_RELAXED, __HIP_MEMORY_SCOPE_AGENT); }
}
DI void phase5b(const Params& p, LAS unsigned char* lds) {
    const int tid0 = threadIdx.x, wave = __builtin_amdgcn_readfirstlane(tid0 >> 6);
    const bf16* cas = (const bf16*)(p.ws + WS_CAS); const bf16* cr = (const bf16*)(p.ws + WS_CR);
    const unsigned char* ob = (const unsigned char*)p.out;
    LAS float* Zl = (LAS float*)(lds + wave * 17408);
    LAS unsigned* qL = (LAS unsigned*)(lds + 8 * 17408);
    __syncthreads();
    if (tid0 == 0) { unsigned* done = (unsigned*)(p.ws + WS_CTL) + 12288; unsigned sp = 0;
        while (__hip_atomic_load(done, __ATOMIC_RELAXED, __HIP_MEMORY_SCOPE_AGENT) < 16u) { __builtin_amdgcn_s_sleep(4); if (++sp > (1u << 24)) break; }
        __builtin_amdgcn_fence(__ATOMIC_ACQUIRE, "agent"); asm volatile("s_waitcnt vmcnt(0)" ::: "memory"); }
    __syncthreads();
    unsigned* q5 = (unsigned*)(p.ws + WS_CTL) + 12352;
    for (;;) {
        if (tid0 == 0) qL[0] = atomicAdd(q5, 1u);
        __syncthreads();
        const unsigned qb = qL[0];
        __syncthreads();
        if (qb >= 512u) break;
        const int item = (int)qb * 8 + wave;
        int tid = tid0; asm volatile("" : "+v"(tid));
        const int lane = tid & 63, l31 = lane & 31, hh = lane >> 5;
        const int c = item & 31, h = (item >> 5) & 7, b = item >> 8;
        const bf16* Y1p = (const bf16*)(ob + OUT_Y1) + (size_t)item * 4096; const bf16* Y2n = (const bf16*)(ob + OUT_Y2) + (size_t)item * 4096;
        const u32x4* hs = (const u32x4*)((const bf16*)(p.ws + WS_HS) + (size_t)item * 4096);
        bf16x8 hp[2][2][2];
#pragma unroll
        for (int tk = 0; tk < 2; ++tk)
#pragma unroll
            for (int tj = 0; tj < 2; ++tj)
#pragma unroll
                for (int s = 0; s < 2; ++s) hp[tk][tj][s] = __builtin_bit_cast(bf16x8, hs[((tk * 2 + tj) * 2 + s) * 64 + lane]);
#pragma unroll
        for (int tt = 0; tt < 2; ++tt) {
            f32x16 Z[2];
#pragma unroll
            for (int vj = 0; vj < 2; ++vj) {
                ld_native_global(Z[vj], Y2n, vj * 2 + tt, lane);
#pragma unroll
                for (int tk = 0; tk < 2; ++tk)
#pragma unroll
                    for (int s = 0; s < 2; ++s) {
                        const bf16x8 bb = *(const bf16x8*)(Y1p + (tt * 2 + tk) * 1024 + 512 * s + lane * 8);
                        Z[vj] = __builtin_amdgcn_mfma_f32_32x32x16_bf16(hp[tk][vj][s], bb, Z[vj], 0, 0, 0);
                    }
            }
            float sum = 0.f;
#pragma unroll
            for (int vj = 0; vj < 2; ++vj)
#pragma unroll
                for (int r = 0; r < 16; ++r) sum += Z[vj][r];
            sum += __shfl_xor(sum, 32);
            const float mean = sum * (1.f / 64.f);
            float sq = 0.f;
#pragma unroll
            for (int vj = 0; vj < 2; ++vj)
#pragma unroll
                for (int r = 0; r < 16; ++r) { const float d = Z[vj][r] - mean; sq += d * d; }
            sq += __shfl_xor(sq, 32);
            const float rstd = rsqrtf(sq * (1.f / 64.f) + 64e-5f);
#pragma unroll
            for (int vj = 0; vj < 2; ++vj)
#pragma unroll
                for (int g = 0; g < 4; ++g)
                    *(LAS f32x4*)(Zl + (32 * tt + l31) * 68 + 32 * vj + 8 * g + 4 * hh) =
                        (f32x4){(Z[vj][4 * g] - mean) * rstd, (Z[vj][4 * g + 1] - mean) * rstd, (Z[vj][4 * g + 2] - mean) * rstd, (Z[vj][4 * g + 3] - mean) * rstd};
        }
        const int v8 = (lane & 7) * 8, col = h * 64 + v8;
        float mu[8], lw[8], lb[8];
#pragma unroll
        for (int i = 0; i < 8; ++i) { mu[i] = p.shift_mu[1024 + col + i]; lw[i] = p.ln_x_w[col + i]; lb[i] = p.ln_x_b[col + i]; }
#pragma unroll
        for (int pb = 0; pb < 2; ++pb) {
            u32x4 cw[4], pw[4], sw[4]; float bn[4];
#pragma unroll
            for (int q = 0; q < 4; ++q) { const int t = (4 * pb + q) * 8 + (lane >> 3); const size_t m = (size_t)b * SEQ + 64 * c + t; const bool hprev = (64 * c + t) > 0;
                cw[q] = *(const u32x4*)(cas + m * LD_CAS + V0 + col); pw[q] = *(const u32x4*)(cas + (m - (hprev ? 1 : 0)) * LD_CAS + V0 + col);
                sw[q] = *(const u32x4*)(cr + m * LD_CR + BSILU0 + col); bn[q] = ((const float*)(p.ws + WS_BONUS))[m * 8 + h]; }
#pragma unroll
            for (int q = 0; q < 4; ++q) asm volatile("" : "+v"(cw[q]), "+v"(pw[q]), "+v"(sw[q]), "+v"(bn[q]));
#pragma unroll
            for (int q = 0; q < 4; ++q) { const int t = (4 * pb + q) * 8 + (lane >> 3); const size_t m = (size_t)b * SEQ + 64 * c + t; const bool hprev = (64 * c + t) > 0;
                float cu[8], pv[8], sg[8];
                unpack8(cw[q], cu); unpack8(hprev ? pw[q] : (u32x4){0u, 0u, 0u, 0u}, pv); unpack8(sw[q], sg);
                const float bon = bn[q];
                const f32x4 z0 = *(const LAS f32x4*)(Zl + t * 68 + v8), z1 = *(const LAS f32x4*)(Zl + t * 68 + v8 + 4);
                const float zz[8] = {z0[0], z0[1], z0[2], z0[3], z1[0], z1[1], z1[2], z1[3]};
                float o[8];
#pragma unroll
                for (int i = 0; i < 8; ++i) { const float vsh = cu[i] + (pv[i] - cu[i]) * mu[i]; o[i] = (zz[i] * lw[i] + lb[i] + bon * vsh) * siluf_(sg[i]); }
                u32x4 w; w.x = pk2(o[0], o[1]); w.y = pk2(o[2], o[3]); w.z = pk2(o[4], o[5]); w.w = pk2(o[6], o[7]);
                *(u32x4*)((bf16*)(p.ws + WS_YB) + m * 512 + col) = w; }
        }
    }
}

constexpr int A_STAGE = 81920, A_TILE = 8192;
DI int swz_off(int row, int chunk) { return row * 128 + ((chunk ^ ((row >> 1) & 7)) << 4); }
DI void attn_qk(f32x16& s0, f32x16& s1, const LAS unsigned char* kl, const bf16x8 (&qr)[4], const f32x16& cinit, int l31, int hh) {
#pragma unroll
    for (int d0 = 0; d0 < 4; ++d0) {
        const bf16x8 k0f = *(const LAS bf16x8*)(kl + swz_off(l31, 2 * d0 + hh));
        const bf16x8 k1f = *(const LAS bf16x8*)(kl + swz_off(32 + l31, 2 * d0 + hh));
        s0 = __builtin_amdgcn_mfma_f32_32x32x16_bf16(k0f, qr[d0], d0 == 0 ? cinit : s0, 0, 0, 0);
        s1 = __builtin_amdgcn_mfma_f32_32x32x16_bf16(k1f, qr[d0], d0 == 0 ? cinit : s1, 0, 0, 0);
    }
}
DI void attn_sv(f32x16& s0, f32x16& s1, const LAS unsigned char* vl, int key0, int tq, bool laneok, int tmin, const LAS float* bl, bool win, bool bound,
                float& m_run, float& l_run, f32x16 (&O)[2], int l31, int hh) {
    const bool far = (tmin - (key0 + 63)) >= 128;
    const bool fast = far && !bound;
    int dbase = tq - key0; asm volatile("" : "+v"(dbase));
    float rm = -1e30f, cb = 0.f;
    if (fast) {
        cb = bl[128];
#pragma unroll
        for (int r = 0; r < 16; ++r) rm = fmaxf(rm, fmaxf(s0[r], s1[r]));
        rm = laneok ? rm + cb : -1e30f;
    } else {
        const int dmax = win ? 512 : 0x7fffffff, dmin = bound ? 0 : -0x7fffffff;
#pragma unroll
        for (int r = 0; r < 16; ++r) {
            const int d0_ = dbase - crow(r, hh), d1_ = d0_ - 32;
            const bool v0 = laneok && d0_ >= dmin && d0_ < dmax, v1 = laneok && d1_ >= dmin && d1_ < dmax;
            const float b0 = bl[min(max(d0_, 0), 128)], b1 = bl[min(max(d1_, 0), 128)];
            s0[r] = v0 ? s0[r] + b0 : -1e30f; s1[r] = v1 ? s1[r] + b1 : -1e30f;
            rm = fmaxf(rm, fmaxf(s0[r], s1[r]));
        }
    }
    rm = fmaxf(rm, __shfl_xor(rm, 32));
    if (__any(rm > m_run + 8.f)) {
        const float m_new = fmaxf(m_run, rm), alpha = __builtin_amdgcn_exp2f(m_run - m_new);
        l_run *= alpha; m_run = m_new;
#pragma unroll
        for (int dt = 0; dt < 2; ++dt)
#pragma unroll
            for (int r = 0; r < 16; ++r) O[dt][r] *= alpha;
    }
    const float sh = m_run - cb;
    float rs = 0.f;
    if (fast) {
#pragma unroll
        for (int r = 0; r < 16; ++r) { s0[r] = __builtin_amdgcn_exp2f(s0[r] - sh); s1[r] = __builtin_amdgcn_exp2f(s1[r] - sh); rs += s0[r] + s1[r]; }
        if (!__all(laneok)) { if (!laneok) {
#pragma unroll
            for (int r = 0; r < 16; ++r) { s0[r] = 0.f; s1[r] = 0.f; }
            rs = 0.f; } }
    } else {
#pragma unroll
        for (int r = 0; r < 16; ++r) {
            s0[r] = (s0[r] > -1e29f) ? __builtin_amdgcn_exp2f(s0[r] - sh) : 0.f; s1[r] = (s1[r] > -1e29f) ? __builtin_amdgcn_exp2f(s1[r] - sh) : 0.f;
            rs += s0[r] + s1[r];
        }
    }
    rs += __shfl_xor(rs, 32);
    l_run += rs;
    const bf16x8 p00 = pack8(s0, 0), p01 = pack8(s0, 1), p10 = pack8(s1, 0), p11 = pack8(s1, 1);
#pragma unroll
    for (int dt = 0; dt < 2; ++dt) {
        const int d = 32 * dt + l31;
        O[dt] = __builtin_amdgcn_mfma_f32_32x32x16_bf16(*(const LAS bf16x8*)(vl + swz_off(d, 0 + hh)), p00, O[dt], 0, 0, 0);
        O[dt] = __builtin_amdgcn_mfma_f32_32x32x16_bf16(*(const LAS bf16x8*)(vl + swz_off(d, 2 + hh)), p01, O[dt], 0, 0, 0);
        O[dt] = __builtin_amdgcn_mfma_f32_32x32x16_bf16(*(const LAS bf16x8*)(vl + swz_off(d, 4 + hh)), p10, O[dt], 0, 0, 0);
        O[dt] = __builtin_amdgcn_mfma_f32_32x32x16_bf16(*(const LAS bf16x8*)(vl + swz_off(d, 6 + hh)), p11, O[dt], 0, 0, 0);
    }
}
DI void attn_sv_fast(f32x16& s0, f32x16& s1, const LAS unsigned char* vl, int key0, int tq, bool laneok, int tmin, const LAS float* bl, bool win, bool bound, float cb,
                     float& l_run, f32x16 (&O)[2], int l31, int hh) {
    const bool far = (tmin - (key0 + 63)) >= 128;
    float rs = 0.f;
    if (far && !bound) {
#pragma unroll
        for (int r = 0; r < 16; ++r) { s0[r] = __builtin_amdgcn_exp2f(s0[r]); s1[r] = __builtin_amdgcn_exp2f(s1[r]); }
        if (!__all(laneok)) {
#pragma unroll
            for (int r = 0; r < 16; ++r) { s0[r] = laneok ? s0[r] : 0.f; s1[r] = laneok ? s1[r] : 0.f; }
        }
    } else {
        int dbase = tq - key0; asm volatile("" : "+v"(dbase));
        const int dmax = win ? 512 : 0x7fffffff, dmin = bound ? 0 : -0x7fffffff;
        float b0[16], b1[16];
#pragma unroll
        for (int r = 0; r < 16; ++r) { const int d0_ = dbase - crow(r, hh), d1_ = d0_ - 32; b0[r] = bl[min(max(d0_, 0), 128)]; b1[r] = bl[min(max(d1_, 0), 128)]; }
#pragma unroll
        for (int r = 0; r < 16; ++r) asm volatile("" : "+v"(b0[r]), "+v"(b1[r]));
#pragma unroll
        for (int r = 0; r < 16; ++r) {
            const int d0_ = dbase - crow(r, hh), d1_ = d0_ - 32;
            const bool v0 = laneok && d0_ >= dmin && d0_ < dmax, v1 = laneok && d1_ >= dmin && d1_ < dmax;
            const float e0 = __builtin_amdgcn_exp2f(s0[r] + (b0[r] - cb)), e1 = __builtin_amdgcn_exp2f(s1[r] + (b1[r] - cb));
            s0[r] = v0 ? e0 : 0.f; s1[r] = v1 ? e1 : 0.f;
        }
    }
#pragma unroll
    for (int r = 0; r < 16; ++r) rs += s0[r] + s1[r];
    l_run += rs;
    const bf16x8 p00 = pack8(s0, 0), p01 = pack8(s0, 1), p10 = pack8(s1, 0), p11 = pack8(s1, 1);
#pragma unroll
    for (int dt = 0; dt < 2; ++dt) {
        const int d = 32 * dt + l31;
        O[dt] = __builtin_amdgcn_mfma_f32_32x32x16_bf16(*(const LAS bf16x8*)(vl + swz_off(d, 0 + hh)), p00, O[dt], 0, 0, 0);
        O[dt] = __builtin_amdgcn_mfma_f32_32x32x16_bf16(*(const LAS bf16x8*)(vl + swz_off(d, 2 + hh)), p01, O[dt], 0, 0, 0);
        O[dt] = __builtin_amdgcn_mfma_f32_32x32x16_bf16(*(const LAS bf16x8*)(vl + swz_off(d, 4 + hh)), p10, O[dt], 0, 0, 0);
        O[dt] = __builtin_amdgcn_mfma_f32_32x32x16_bf16(*(const LAS bf16x8*)(vl + swz_off(d, 6 + hh)), p11, O[dt], 0, 0, 0);
    }
}
DI float imp_sum(const LAS float* sL, const LAS float* cL, int q, int j) {
    float v = 0.f;
#pragma unroll
    for (int h4 = 0; h4 < 4; ++h4) { v += sL[(h4 * 64 + q) * 33 + j]; if (j > 0) v += cL[(h4 * 64 + q) * 33 + j]; }
    return v;
}
template <bool FAST>
DI void attn_stream(LAS unsigned char* lds, const bf16* ksel, const bf16* kwin, const bf16* vts, const bf16* vtw, unsigned U, unsigned mysel, int qt, int tq, int tmin,
                    const LAS float* bl, const bf16x8 (&qr)[4], const float (&g3)[3], LAS float* stash, f32x16 (&Ot)[2], int tid, int l31, int hh) {
    const int nsel = __builtin_popcount(U), w0 = qt > 8 ? qt - 8 : 0, ntile = nsel + (qt - w0 + 1);
    const int srow = tid >> 3, sch = tid & 7;
    unsigned rem = U;
    int jseq = 0;
    int jt = 0; bool wt = false;
#define NEXT_TILE() do { if (jseq < nsel) { jt = __builtin_ctz(rem); rem &= rem - 1; wt = false; } else { jt = w0 + (jseq - nsel); wt = true; } ++jseq; } while (0)
#define LOAD_TILE(KR, VR) do { KR = *(const u32x4*)((wt ? kwin : ksel) + (size_t)(64 * jt + srow) * LD_CAS + 8 * sch); \
                               VR = *(const u32x4*)((wt ? vtw : vts) + (size_t)jt * 4096 + srow * 64 + 8 * sch); } while (0)
    u32x4 kr0, vr0, kr1, vr1;
    NEXT_TILE(); int j0 = jt; bool wn0 = wt; LOAD_TILE(kr0, vr0);
    *(LAS u32x4*)(lds + A_STAGE + swz_off(srow, sch)) = kr0; *(LAS u32x4*)(lds + A_STAGE + 2 * A_TILE + swz_off(srow, sch)) = vr0;
    int j1 = 0; bool wn1 = false;
    if (ntile > 1) { NEXT_TILE(); j1 = jt; wn1 = wt; LOAD_TILE(kr0, vr0); }
    asm volatile("s_waitcnt lgkmcnt(0)\n\ts_barrier" ::: "memory");
    float m_run = -1e30f, l_run = 0.f; f32x16 O[2]; O[0] = (f32x16){}; O[1] = (f32x16){};
    const float cbf = bl[128];
    f32x16 cinit;
#pragma unroll
    for (int r = 0; r < 16; ++r) cinit[r] = FAST ? cbf : 0.f;
#define TILE_ITER(I, KRA, VRA, KRB, VRB) do { \
        const int jc = j0; const bool wc = wn0; j0 = j1; wn0 = wn1; \
        if ((I) + 2 < ntile) { NEXT_TILE(); j1 = jt; wn1 = wt; LOAD_TILE(KRB, VRB); } \
        if ((I) == nsel) { if (FAST) l_run += __shfl_xor(l_run, 32); const float f_ = l_run > 0.f ? g3[1] / l_run : 0.f; \
            _Pragma("unroll") for (int dt = 0; dt < 2; ++dt) _Pragma("unroll") for (int r = 0; r < 16; ++r) { stash[(dt * 16 + r) * 64] += f_ * O[dt][r]; O[dt][r] = 0.f; } \
            m_run = -1e30f; l_run = 0.f; } \
        const LAS unsigned char* kl = lds + A_STAGE + ((I) & 1) * A_TILE; \
        const LAS unsigned char* vl = lds + A_STAGE + 2 * A_TILE + ((I) % 3) * A_TILE; \
        const bool ok_ = wc ? true : (bool)((mysel >> jc) & 1u); \
        if (__any(ok_)) { f32x16 s0, s1; attn_qk(s0, s1, kl, qr, cinit, l31, hh); \
            const bool bnd = wc ? (jc == qt || jc + 8 == qt) : (jc == qt); \
            if (FAST) attn_sv_fast(s0, s1, vl, 64 * jc, tq, ok_, tmin, bl, wc, bnd, cbf, l_run, O, l31, hh); \
            else attn_sv(s0, s1, vl, 64 * jc, tq, ok_, tmin, bl, wc, bnd, m_run, l_run, O, l31, hh); } \
        if ((I) + 1 < ntile) { *(LAS u32x4*)(lds + A_STAGE + (((I) + 1) & 1) * A_TILE + swz_off(srow, sch)) = KRA; \
                               *(LAS u32x4*)(lds + A_STAGE + 2 * A_TILE + (((I) + 1) % 3) * A_TILE + swz_off(srow, sch)) = VRA; } \
        asm volatile("s_waitcnt lgkmcnt(0)\n\ts_barrier" ::: "memory"); } while (0)
    for (int i = 0; i < ntile; i += 2) {
        TILE_ITER(i, kr0, vr0, kr1, vr1);
        if (i + 1 < ntile) TILE_ITER(i + 1, kr1, vr1, kr0, vr0);
    }
#undef TILE_ITER
#undef LOAD_TILE
#undef NEXT_TILE
    if (FAST) l_run += __shfl_xor(l_run, 32);
    const float f = l_run > 0.f ? g3[2] / l_run : 0.f;
#pragma unroll
    for (int dt = 0; dt < 2; ++dt)
#pragma unroll
        for (int r = 0; r < 16; ++r) Ot[dt][r] = stash[(dt * 16 + r) * 64] + f * O[dt][r];
}
DI void phase4(const Params& p, LAS unsigned char* lds) {
    const int tid0 = threadIdx.x, wave = __builtin_amdgcn_readfirstlane(tid0 >> 6);
    const int hp = wave & 3, qh = wave >> 2;
    const bf16* cas = (const bf16*)(p.ws + WS_CAS);
    LAS float* biasL = (LAS float*)lds;
    LAS float* sL = (LAS float*)(lds + 4608);
    LAS float* cL = (LAS float*)(lds + 4608 + 33792);
    LAS unsigned* selL = (LAS unsigned*)(lds + 4608 + 2 * 33792);
    LAS unsigned* uL = selL + 64;
    LAS float* impT = (LAS float*)(lds + 4608 + 2 * 33792 + 512);
    LAS float* auxL = (LAS float*)(lds + 81152);
    for (int i = tid0; i < 8 * 132; i += 512) biasL[i] = ((const float*)(p.ws + WS_BIAS))[i];
    if (tid0 == 0) uL[0] = 0u;
    __syncthreads();
    {
        const int ln = tid0 & 63;
        float bm = fmaxf(fabsf(biasL[wave * 132 + ln]), fabsf(biasL[wave * 132 + 64 + ln]));
        if (ln == 0) bm = fmaxf(bm, fabsf(biasL[wave * 132 + 128]));
        const float* gp = wave == 2 ? p.q_norm_gain : p.k_norm_gain + ((wave & 1) + 1) * 64;
        float gm = fabsf(gp[ln]);
#pragma unroll
        for (int o = 32; o >= 1; o >>= 1) { bm = fmaxf(bm, __shfl_xor(bm, o)); gm = fmaxf(gm, __shfl_xor(gm, o)); }
        if (ln == 0) { auxL[wave] = bm; if (wave < 3) auxL[8 + wave] = gm; }
    }
    __syncthreads();
    bool fastmode;
    { float bm = 0.f;
#pragma unroll
      for (int hq = 0; hq < 8; ++hq) bm = fmaxf(bm, auxL[hq]);
      fastmode = (8.1f * auxL[10] * QSCALE) * (8.1f * fmaxf(auxL[8], auxL[9])) + bm <= 96.f; }
    unsigned* qctr = (unsigned*)(p.ws + WS_CTL) + 8192 + 64 * (blockIdx.x & 7);
    for (;;) {
        if (tid0 == 0) uL[1] = atomicAdd(qctr, 1u);
        __syncthreads();
        const unsigned qi = uL[1];
        __syncthreads();
        if (qi >= 128u) break;
        int tid = tid0; asm volatile("" : "+v"(tid));
        const int lane = tid & 63, l31 = lane & 31, hh = lane >> 5;
        const int qt = 31 - (int)(qi & 31), bg = (blockIdx.x & 7) + 8 * (int)(qi >> 5);
        const int b = bg >> 1, g = bg & 1, head = g * 4 + hp, t0 = 64 * qt, tmin = t0 + 32 * qh, tq = tmin + l31;
        const size_t m = (size_t)b * SEQ + tq;
        const LAS float* bl = biasL + head * 132;
        bf16x8 qr[4];
#pragma unroll
        for (int d0 = 0; d0 < 4; ++d0) qr[d0] = *(const bf16x8*)(cas + m * LD_CAS + Q0 + head * 64 + 16 * d0 + 8 * hh);
        float g3[3];
#pragma unroll
        for (int br = 0; br < 3; ++br) g3[br] = sigmoidf_(bf2f(cas[m * LD_CAS + GATE0 + br * 8 + head]));
        f32x16 Ot[2]; Ot[0] = (f32x16){}; Ot[1] = (f32x16){};
        {
            const bf16* kcb = (const bf16*)(p.ws + WS_KC) + (size_t)bg * 128 * 64;
            const bf16* vcb = (const bf16*)(p.ws + WS_VCT) + (size_t)bg * 64 * 128;
            f32x16 sc[4];
#pragma unroll
            for (int kt = 0; kt < 4; ++kt) { sc[kt] = (f32x16){};
#pragma unroll
                for (int d0 = 0; d0 < 4; ++d0) sc[kt] = __builtin_amdgcn_mfma_f32_32x32x16_bf16(*(const bf16x8*)(kcb + (size_t)(32 * kt + l31) * 64 + 16 * d0 + 8 * hh), qr[d0], sc[kt], 0, 0, 0); }
            float mc = -1e30f;
#pragma unroll
            for (int kt = 0; kt < 4; ++kt) {
                float bv[16];
#pragma unroll
                for (int r = 0; r < 16; ++r) { const int n = 32 * kt + crow(r, hh), dist = tq - 16 * n - 31; bv[r] = bl[min(max(dist, 0), 128)]; }
#pragma unroll
                for (int r = 0; r < 16; ++r) asm volatile("" : "+v"(bv[r]));
#pragma unroll
                for (int r = 0; r < 16; ++r) { const int n = 32 * kt + crow(r, hh), dist = tq - 16 * n - 31; const bool ok = dist >= 0 && n < 127;
                    sc[kt][r] = ok ? sc[kt][r] + bv[r] : -1e30f; mc = fmaxf(mc, sc[kt][r]); }
            }
            mc = fmaxf(mc, __shfl_xor(mc, 32));
            float lc = 0.f;
#pragma unroll
            for (int kt = 0; kt < 4; ++kt)
#pragma unroll
                for (int r = 0; r < 16; ++r) { sc[kt][r] = (sc[kt][r] > -1e29f) ? __builtin_amdgcn_exp2f(sc[kt][r] - mc) : 0.f; lc += sc[kt][r]; }
            lc += __shfl_xor(lc, 32);
            const float inv = lc > 0.f ? 1.f / lc : 0.f;
            const int q = 32 * qh + l31;
#pragma unroll
            for (int kt = 0; kt < 4; ++kt) {
#pragma unroll
                for (int r = 0; r < 16; ++r) sc[kt][r] *= inv;
#pragma unroll
                for (int g4 = 0; g4 < 4; ++g4) { const int j = 8 * kt + 2 * g4 + hh;
                    sL[(hp * 64 + q) * 33 + j] = 2.f * (sc[kt][4 * g4] + sc[kt][4 * g4 + 1] + sc[kt][4 * g4 + 2]) + sc[kt][4 * g4 + 3];
                    cL[(hp * 64 + q) * 33 + j + 1] = sc[kt][4 * g4 + 3]; }
            }
            f32x16 oc[2]; oc[0] = (f32x16){}; oc[1] = (f32x16){};
#pragma unroll
            for (int dt = 0; dt < 2; ++dt)
#pragma unroll
                for (int kt = 0; kt < 4; ++kt)
#pragma unroll
                    for (int s = 0; s < 2; ++s)
                        oc[dt] = __builtin_amdgcn_mfma_f32_32x32x16_bf16(*(const bf16x8*)(vcb + (size_t)(32 * dt + l31) * 128 + 32 * kt + 16 * s + 8 * hh), pack8(sc[kt], s), oc[dt], 0, 0, 0);
#pragma unroll
            for (int dt = 0; dt < 2; ++dt)
#pragma unroll
                for (int r = 0; r < 16; ++r) Ot[dt][r] = g3[0] * oc[dt][r];
        }
        __syncthreads();
        {
            const int q = tid >> 3, sub = tid & 7;
            unsigned mask = 0u;
            if (qt < 16) mask = (2u << qt) - 1u;
            else {
#pragma unroll
                for (int i2 = 0; i2 < 4; ++i2) impT[q * 33 + sub + 8 * i2] = imp_sum(sL, cL, q, sub + 8 * i2);
                __syncthreads();
                float vj[4]; int rank[4];
#pragma unroll
                for (int i2 = 0; i2 < 4; ++i2) { vj[i2] = impT[q * 33 + sub + 8 * i2]; rank[i2] = 0; }
#pragma unroll 2
                for (int jj = 1; jj <= qt - 2; ++jj) {
                    const float vv = impT[q * 33 + jj];
#pragma unroll
                    for (int i2 = 0; i2 < 4; ++i2) { const int j = sub + 8 * i2;
                        rank[i2] += (int)((jj != j) & ((vv > vj[i2]) | ((vv == vj[i2]) & (jj < j)))); }
                }
#pragma unroll
                for (int i2 = 0; i2 < 4; ++i2) { const int j = sub + 8 * i2;
                    const bool forced = (j == 0) || (j == qt) || (j == qt - 1), cand = (j >= 1) && (j <= qt - 2);
                    if (forced || (cand && rank[i2] < 13)) mask |= 1u << j; }
                mask |= __shfl_xor(mask, 1); mask |= __shfl_xor(mask, 2); mask |= __shfl_xor(mask, 4);
            }
            if (sub == 0) { selL[q] = mask; __hip_atomic_fetch_or(uL, mask, __ATOMIC_RELAXED, __HIP_MEMORY_SCOPE_WORKGROUP); }
        }
        __syncthreads();
        const unsigned mysel = selL[32 * qh + l31], U = uL[0];
        LAS float* stash = (LAS float*)(lds + 4608 + wave * 8192) + lane;
#pragma unroll
        for (int dt = 0; dt < 2; ++dt)
#pragma unroll
            for (int r = 0; r < 16; ++r) stash[(dt * 16 + r) * 64] = Ot[dt][r];
        {
            const bf16* ksel = cas + (size_t)(b * SEQ) * LD_CAS + KS0 + g * 64; const bf16* kwin = cas + (size_t)(b * SEQ) * LD_CAS + KW0 + g * 64;
            const bf16* vts = (const bf16*)(p.ws + WS_VTS) + (size_t)bg * 32 * 4096; const bf16* vtw = (const bf16*)(p.ws + WS_VTW) + (size_t)bg * 32 * 4096;
            if (fastmode) attn_stream<true>(lds, ksel, kwin, vts, vtw, U, mysel, qt, tq, tmin, bl, qr, g3, stash, Ot, tid, l31, hh);
            else attn_stream<false>(lds, ksel, kwin, vts, vtw, U, mysel, qt, tq, tmin, bl, qr, g3, stash, Ot, tid, l31, hh);
        }
        u32x2 aw[2][4];
#pragma unroll
        for (int dt = 0; dt < 2; ++dt)
#pragma unroll
            for (int g4 = 0; g4 < 4; ++g4) aw[dt][g4] = *(const u32x2*)(cas + m * LD_CAS + ASILU0 + head * 64 + 32 * dt + 8 * g4 + 4 * hh);
        asm volatile("s_waitcnt lgkmcnt(0)\n\ts_barrier" ::: "memory");
#pragma unroll
        for (int dt = 0; dt < 2; ++dt)
#pragma unroll
            for (int g4 = 0; g4 < 4; ++g4) asm volatile("" : "+v"(aw[dt][g4]));
#pragma unroll
        for (int dt = 0; dt < 2; ++dt)
#pragma unroll
            for (int g4 = 0; g4 < 4; ++g4) {
                const int col = head * 64 + 32 * dt + 8 * g4 + 4 * hh;
                u32x2 w; w.x = pk2(Ot[dt][4 * g4] * siluf_(bflo(aw[dt][g4].x)), Ot[dt][4 * g4 + 1] * siluf_(bfhi(aw[dt][g4].x)));
                w.y = pk2(Ot[dt][4 * g4 + 2] * siluf_(bflo(aw[dt][g4].y)), Ot[dt][4 * g4 + 3] * siluf_(bfhi(aw[dt][g4].y)));
                *(u32x2*)((bf16*)(p.ws + WS_YA) + m * 512 + col) = w;
            }
        if (tid == 0) uL[0] = 0u;
    }
}
DI void phase3(const Params& p, LAS unsigned char* lds) { phase3a(p, lds); phase3b(p, lds); phase3c(p, lds); }


#define XB_TMO      128
#define XB_XCNT(j)  (256  + 64 * (j))
#define XB_XSUB(j)  (1280 + 64 * (j))
#define XB_XGEN(j)  (2304 + 64 * (j))
#define XB_TOP      3328
#define XB_TOPGEN   3392
#define XCD_BAR_WORDS 3456
#define XB_SPIN_CAP (1u << 22)
DI unsigned xb_ld(unsigned* p)              { return __hip_atomic_load(p, __ATOMIC_RELAXED, __HIP_MEMORY_SCOPE_AGENT); }
DI unsigned xb_add(unsigned* p, unsigned v) { return __hip_atomic_fetch_add(p, v, __ATOMIC_RELAXED, __HIP_MEMORY_SCOPE_AGENT); }
DI unsigned xb_xcc_id() { return (unsigned)__builtin_amdgcn_s_getreg((3 << 11) | 20) & 0xFu; }
#define XB_SPIN(cond, bar) do { unsigned _sp = 0; while (cond) { __builtin_amdgcn_s_sleep(1); \
    if ((++_sp & 255u) == 0u) { if (xb_ld(&(bar)[XB_TMO])) break; if (_sp > XB_SPIN_CAP) { atomicAdd(&(bar)[XB_TMO], 1u); break; } } } } while (0)
struct XcdBarrier { unsigned* bar; unsigned x; volatile LAS unsigned* st; };
DI XcdBarrier xcd_barrier_post(unsigned* bar, volatile LAS unsigned* st) {
    XcdBarrier b; b.bar = bar; b.x = xb_xcc_id(); b.st = st;
    if (threadIdx.x == 0) (void)xb_add(&bar[XB_XCNT(b.x)], 1u);
    return b;
}
DI void xcd_barrier_complete(unsigned* bar, unsigned x, unsigned& nloc, unsigned& nx) {
    const unsigned G = gridDim.x * gridDim.y * gridDim.z;
    unsigned sum, cnt, mine, sp = 0u;
    for (;;) {
        sum = 0u; cnt = 0u; mine = 0u;
#pragma unroll
        for (unsigned j = 0; j < 16; ++j) { const unsigned c = xb_ld(&bar[XB_XCNT(j)]); sum += c; cnt += (c > 0u) ? 1u : 0u; mine = (j == x) ? c : mine; }
        if (sum == G) break;
        __builtin_amdgcn_s_sleep(1);
        if ((++sp & 255u) == 0u) { if (xb_ld(&bar[XB_TMO])) break; if (sp > XB_SPIN_CAP) { atomicAdd(&bar[XB_TMO], 1u); break; } }
    }
    nloc = mine > 0u ? mine : 1u; nx = cnt > 0u ? cnt : 1u;
}
DI void xcd_barrier(const XcdBarrier& b) {
    asm volatile("s_waitcnt vmcnt(0)" ::: "memory");
    __syncthreads();
    if (threadIdx.x == 0) {
        unsigned* bar = b.bar;
        __builtin_amdgcn_s_waitcnt(0);
        unsigned nloc = b.st[0], nx = b.st[1];
        if (nloc == 0u) { xcd_barrier_complete(bar, b.x, nloc, nx); b.st[0] = nloc; b.st[1] = nx; }
        const unsigned old = xb_add(&bar[XB_XSUB(b.x)], 1u);
        const unsigned gen = old / nloc;
        if (old + 1u == (gen + 1u) * nloc) {
            __builtin_amdgcn_fence(__ATOMIC_RELEASE, "agent");
            asm volatile("s_waitcnt vmcnt(0)" ::: "memory");
            const unsigned og = xb_add(&bar[XB_TOP], 1u);
            const unsigned tg = og / nx;
            if (og + 1u == (tg + 1u) * nx) xb_add(&bar[XB_TOPGEN], 1u);
            else XB_SPIN(xb_ld(&bar[XB_TOPGEN]) == tg, bar);
            __builtin_amdgcn_fence(__ATOMIC_ACQUIRE, "agent");
            xb_add(&bar[XB_XGEN(b.x)], 1u);
            asm volatile("s_waitcnt vmcnt(0)" ::: "memory");
        } else {
            XB_SPIN(xb_ld(&bar[XB_XGEN(b.x)]) == gen, bar);
            __builtin_amdgcn_fence(__ATOMIC_ACQUIRE, "agent");
            asm volatile("s_waitcnt vmcnt(0)" ::: "memory");
        }
    }
    __syncthreads();
}

__global__ void __launch_bounds__(512, 2) hybrid_fwd(Params p) {
    extern __shared__ __attribute__((aligned(16))) unsigned char lds_raw[];
    LAS unsigned char* lds = (LAS unsigned char*)lds_raw;
#if USE_CG_SYNC
    cg::grid_group grid = cg::this_grid();
#define GRID_BAR() grid.sync()
#else
    volatile LAS unsigned* bst = (volatile LAS unsigned*)(lds + LDS_BYTES - 64);
    if (threadIdx.x < 2) bst[threadIdx.x] = 0u;
    __syncthreads();
    const XcdBarrier xbar = xcd_barrier_post((unsigned*)(p.ws + WS_CTL) + 1024, bst);
#define GRID_BAR() xcd_barrier(xbar)
#endif
    const int lo = p.ph_lo, hi = p.ph_hi;
#ifdef ONLYP
#define IN(k) ((k) == ONLYP && lo <= (k) && (k) < hi)
#else
#define IN(k) (lo <= (k) && (k) < hi)
#endif
#define SEAM(k) do { if (IN(k) && IN((k) + 1)) GRID_BAR(); } while (0)
    unsigned char* ws = p.ws;
    if (IN(0)) { phase0(p, lds); }
    SEAM(0);
    if (IN(1)) { phase1(p, lds); phase0w(p, lds); }
    SEAM(1);
    if (IN(2)) {
        pg8::Gemm g{(const bf16*)((unsigned char*)p.out + OUT_H), (const bf16*)(ws + WS_WIN_T), MTOK, N_IN_PAD, DM, DM, DM};
        pg8::StaticOrder S; S.init(MTOK, N_IN_PAD, gridDim.x, blockIdx.x);
        EpiInProj E{(bf16*)(ws + WS_CAS), (bf16*)(ws + WS_CR)};
        pg8::gemm_phase<EpiInProj, pg8::StaticOrder>(lds, g, S, E);
    }
    SEAM(2);
    if (IN(3)) { phase3(p, lds); }
    SEAM(3);
    if (IN(4)) { phase5a(p); phase4(p, lds); __syncthreads(); phase5b(p, lds); }
    SEAM(5);
    if (IN(6)) {
        { pg8::Gemm g{(const bf16*)(ws + WS_YA), (const bf16*)(ws + WS_WA_T), MTOK, DM, 512, 512, 512};
          pg8::StaticOrder S; S.init(MTOK, DM, gridDim.x, blockIdx.x);
          EpiGate<0> E{(bf16*)(ws + WS_MERGED), (const bf16*)(ws + WS_CR)};
          pg8::gemm_phase<EpiGate<0>, pg8::StaticOrder>(lds, g, S, E); }
        { pg8::Gemm g{(const bf16*)(ws + WS_YB), (const bf16*)(ws + WS_WB_T), MTOK, DM, 512, 512, 512};
          pg8::StaticOrder S; S.init(MTOK, DM, gridDim.x, blockIdx.x);
          EpiGate<1> E{(bf16*)(ws + WS_MERGED), (const bf16*)(ws + WS_CR)};
          pg8::gemm_phase<EpiGate<1>, pg8::StaticOrder>(lds, g, S, E); }
    }
    SEAM(6);
    if (IN(7)) {
        pg8::Gemm g{(const bf16*)(ws + WS_MERGED), (const bf16*)(ws + WS_WO_T), MTOK, DM, DM, DM, DM};
        pg8::StaticOrder S; S.init(MTOK, DM, gridDim.x, blockIdx.x);
        EpiFinal E{p.x, (const float*)(ws + WS_MOD), p.out};
        pg8::gemm_phase<EpiFinal, pg8::StaticOrder>(lds, g, S, E);
    }
#undef IN
#undef SEAM
}

extern "C" void kernel_launch(void* const* d_in, const int* in_sizes, int n_in, void* d_out, int out_size, void* d_ws, size_t ws_size, hipStream_t stream) {
    static int grid = 0;
    if (grid == 0) {
        if (n_in != 28 || out_size != MTOK * DM || ws_size < WS_END) { fprintf(stderr, "kernel_launch: unexpected shapes (n_in %d out %d ws %zu)\n", n_in, out_size, ws_size); grid = -1; return; }
        int dev = 0, cus = 0, per_cu = 0;
        (void)hipGetDevice(&dev); (void)hipDeviceGetAttribute(&cus, hipDeviceAttributeMultiprocessorCount, dev);
        if (hipFuncSetAttribute((const void*)hybrid_fwd, hipFuncAttributeMaxDynamicSharedMemorySize, LDS_BYTES) != hipSuccess) { fprintf(stderr, "kernel_launch: hipFuncSetAttribute failed\n"); grid = -1; return; }
        if (hipOccupancyMaxActiveBlocksPerMultiprocessor(&per_cu, (const void*)hybrid_fwd, 512, LDS_BYTES) != hipSuccess || per_cu < 1) { fprintf(stderr, "kernel_launch: occupancy query says %d\n", per_cu); per_cu = 1; }
        (void)hipGetLastError();
        grid = cus * 1;
        if (grid <= 0) grid = 256;
    }
    if (grid < 0) return;
    (void)hipMemsetAsync((char*)d_ws + WS_CTL, 0, CTL_ZERO_BYTES, stream);
    Params p{};
    const float** pp = (const float**)&p;
    for (int i = 0; i < 28; ++i) pp[i] = (const float*)d_in[i];
    p.out = (float*)d_out; p.ws = (unsigned char*)d_ws;
#if MK_LAUNCHES == 1
    p.ph_lo = 0; p.ph_hi = 8;
    void* args[] = {&p};
    hipError_t e = hipLaunchCooperativeKernel((const void*)hybrid_fwd, dim3(grid), dim3(512), args, LDS_BYTES, stream);
    if (e != hipSuccess) fprintf(stderr, "cooperative launch failed: %s (grid %d)\n", hipGetErrorString(e), grid);
#else
    const int cuts[][2] = {{0, 1}, {1, 2}, {2, 3}, {3, 4}, {4, 5}, {5, 6}, {6, 7}, {7, 8}};
    for (int li = 0; li < 8; ++li) {
        p.ph_lo = cuts[li][0]; p.ph_hi = cuts[li][1];
        hipLaunchKernelGGL(hybrid_fwd, dim3(grid), dim3(512), LDS_BYTES, stream, p);
    }
#endif
}
```
